# Optimizing an MI355X kernel written in HIP

```python
import math
import jax, jax.numpy as jnp
from jax import lax
import numpy as np

D_MODEL = 1024
BATCH = 16
SEQ = 2048
DEPTH = 4

GRID_W = 64
CTX_LEN = 256
BLOCK = 128
ROPE_THETA = 10000.0
EPS = 1e-6
NEG_INF = -1e30
N_MOD = 6

MLA_HEADS = 4
MLA_Q_RANK = 256
MLA_KV_RANK = 128
MLA_NOPE = 64
MLA_ROPE = 32
MLA_V = 64

DIFF_HEADS = 4
DIFF_QK = 32
DIFF_V = 2 * DIFF_QK

SWA_HEADS = 8
SWA_KV_HEADS = 2
SWA_DIM = 64
WINDOW = 128

N_EXPERTS = 32
TOP_K = 4
D_EXPERT = D_MODEL
SWIGLU_LIMIT = 7.0
SWIGLU_ALPHA = 1.702

IN_SPLIT_SIZES = (MLA_Q_RANK, MLA_KV_RANK, MLA_ROPE,
                  DIFF_HEADS * 2 * DIFF_QK, DIFF_HEADS * 2 * DIFF_QK, DIFF_HEADS * DIFF_V,
                  SWA_HEADS * SWA_DIM, SWA_KV_HEADS * SWA_DIM, SWA_KV_HEADS * SWA_DIM)
D_IN = (MLA_Q_RANK + MLA_KV_RANK + MLA_ROPE
        + 2 * DIFF_HEADS * 2 * DIFF_QK + DIFF_HEADS * DIFF_V
        + SWA_HEADS * SWA_DIM + 2 * SWA_KV_HEADS * SWA_DIM)
D_MIX = MLA_HEADS * MLA_V + DIFF_HEADS * DIFF_V + SWA_HEADS * SWA_DIM

kernel_name = 'hybrid_mla_diff_swa_moe_dit_trunk'


def rms_norm(x, g):
    xf = x.astype(jnp.float32)
    y = xf * lax.rsqrt(jnp.mean(xf * xf, axis=-1, keepdims=True) + EPS)
    return (y * g.astype(jnp.float32)).astype(x.dtype)


def modulate(h, g, shift, scale):
    return rms_norm(h, g) * (1 + scale) + shift


def axial_rope_tables(rows, rot_dim):
    n_freq = rot_dim // 4
    inv_freq = ROPE_THETA ** (-jnp.arange(n_freq, dtype=jnp.float32) / n_freq)
    row_pos = jnp.repeat(jnp.arange(rows, dtype=jnp.float32), GRID_W)
    col_pos = jnp.tile(jnp.arange(GRID_W, dtype=jnp.float32), rows)
    ang = jnp.concatenate([row_pos[:, None] * inv_freq, col_pos[:, None] * inv_freq], axis=-1)
    return jnp.cos(ang), jnp.sin(ang)


def apply_rope(x, cos, sin):
    half = x.shape[-1] // 2
    xf = x.astype(jnp.float32)
    x1, x2 = xf[..., :half], xf[..., half:]
    c, s = cos[None, :, None, :], sin[None, :, None, :]
    return jnp.concatenate([x1 * c - x2 * s, x2 * c + x1 * s], axis=-1).astype(x.dtype)


def to_heads(t, h, d):
    return t.reshape(t.shape[0], t.shape[1], h, d)


def merge_heads(t):
    return t.reshape(t.shape[0], t.shape[1], -1)


def softmax_attention(q, k, v, scale):
    s = jnp.einsum('bqhd,bkhd->bhqk', q, k).astype(jnp.float32) * scale
    p = jax.nn.softmax(s, axis=-1).astype(v.dtype)
    return jnp.einsum('bhqk,bkhd->bqhd', p, v)


def dense_blocked_attention(q, k, v, k_ctx, v_ctx, scale):
    b, s_len, h, _ = q.shape
    kk = jnp.concatenate([k_ctx, k], axis=1)
    vv = jnp.concatenate([v_ctx, v], axis=1)

    def one_block(n):
        q_blk = lax.dynamic_slice_in_dim(q, n * BLOCK, BLOCK, axis=1)
        return softmax_attention(q_blk, kk, vv, scale)

    out = lax.map(one_block, jnp.arange(s_len // BLOCK))
    return jnp.moveaxis(out, 0, 1).reshape(b, s_len, h, v.shape[-1])


def sink_softmax(s, sink):
    col = jnp.broadcast_to(sink.astype(jnp.float32).reshape(SWA_KV_HEADS, -1, 1, 1), s.shape[:-1] + (1,))
    p = jax.nn.softmax(jnp.concatenate([s, col], axis=-1), axis=-1)
    return p[..., :-1]


def banded_sink_attention(q, k, v, k_ctx, v_ctx, sink, scale):
    b, s_len, h, d = q.shape
    g = h // SWA_KV_HEADS
    n_ctx = k_ctx.shape[1]
    pad = ((0, 0), (BLOCK, BLOCK), (0, 0), (0, 0))
    kp, vp = jnp.pad(k, pad), jnp.pad(v, pad)

    def one_block(n):
        start = n * BLOCK
        q_blk = lax.dynamic_slice_in_dim(q, start, BLOCK, axis=1).reshape(b, BLOCK, SWA_KV_HEADS, g, d)
        k_blk = lax.dynamic_slice_in_dim(kp, start, 3 * BLOCK, axis=1)
        v_blk = lax.dynamic_slice_in_dim(vp, start, 3 * BLOCK, axis=1)
        q_pos = start + jnp.arange(BLOCK)
        k_pos = start - BLOCK + jnp.arange(3 * BLOCK)
        allowed = ((jnp.abs(k_pos[None, :] - q_pos[:, None]) <= WINDOW)
                   & (k_pos >= 0)[None, :] & (k_pos < s_len)[None, :])
        s_band = jnp.einsum('bqhgd,bkhd->bhgqk', q_blk, k_blk).astype(jnp.float32) * scale
        s_band = jnp.where(allowed, s_band, NEG_INF)
        s_ctx = jnp.einsum('bqhgd,bkhd->bhgqk', q_blk, k_ctx).astype(jnp.float32) * scale
        p = sink_softmax(jnp.concatenate([s_ctx, s_band], axis=-1), sink).astype(v.dtype)
        o = (jnp.einsum('bhgqk,bkhd->bqhgd', p[..., :n_ctx], v_ctx)
             + jnp.einsum('bhgqk,bkhd->bqhgd', p[..., n_ctx:], v_blk))
        return o.reshape(b, BLOCK, h, d)

    out = lax.map(one_block, jnp.arange(s_len // BLOCK))
    return jnp.moveaxis(out, 0, 1).reshape(b, s_len, h, d)


def context_sink_attention(q, k, v, sink, scale):
    b, n, h, d = q.shape
    qg = q.reshape(b, n, SWA_KV_HEADS, h // SWA_KV_HEADS, d)
    s = jnp.einsum('bqhgd,bkhd->bhgqk', qg, k).astype(jnp.float32) * scale
    p = sink_softmax(s, sink).astype(v.dtype)
    return jnp.einsum('bhgqk,bkhd->bqhgd', p, v).reshape(b, n, h, d)


def mla_queries(c_q, q_norm_g, w_uq, cos, sin):
    q = to_heads(rms_norm(c_q, q_norm_g) @ w_uq, MLA_HEADS, MLA_NOPE + MLA_ROPE)
    q_nope, q_rope = q[..., :MLA_NOPE], q[..., MLA_NOPE:]
    if cos is not None:
        q_rope = apply_rope(q_rope, cos, sin)
    return jnp.concatenate([q_nope, q_rope], axis=-1)


def mla_keys_values(c_kv, k_rope, kv_norm_g, w_ukv, cos, sin):
    b, n, _ = c_kv.shape
    kv = to_heads(rms_norm(c_kv, kv_norm_g) @ w_ukv, MLA_HEADS, MLA_NOPE + MLA_V)
    k_nope, v = kv[..., :MLA_NOPE], kv[..., MLA_NOPE:]
    k_rope = k_rope[:, :, None, :]
    if cos is not None:
        k_rope = apply_rope(k_rope, cos, sin)
    k = jnp.concatenate([k_nope, jnp.broadcast_to(k_rope, (b, n, MLA_HEADS, MLA_ROPE))], axis=-1)
    return k, v


def mla_mixer(pl, pc, q_norm_g, w_uq, kv_norm_g, w_ukv, cos, sin, need_ctx):
    scale = (MLA_NOPE + MLA_ROPE) ** -0.5
    kc, vc = mla_keys_values(pc[1], pc[2], kv_norm_g, w_ukv, None, None)
    ql = mla_queries(pl[0], q_norm_g, w_uq, cos, sin)
    kl, vl = mla_keys_values(pl[1], pl[2], kv_norm_g, w_ukv, cos, sin)
    out_l = merge_heads(dense_blocked_attention(ql, kl, vl, kc, vc, scale))
    out_c = None
    if need_ctx:
        qc = mla_queries(pc[0], q_norm_g, w_uq, None, None)
        out_c = merge_heads(softmax_attention(qc, kc, vc, scale))
    return out_l, out_c


def diff_heads(t, cos, sin):
    b, n, _ = t.shape
    t = t.reshape(b, n, DIFF_HEADS * 2, DIFF_QK)
    if cos is not None:
        t = apply_rope(t, cos, sin)
    return t.reshape(b, n, DIFF_HEADS, 2, DIFF_QK)


def diff_mixer(pl, pc, lam, subln_g, lambda_init, cos, sin, need_ctx):
    scale = DIFF_QK ** -0.5
    lam = lam.astype(jnp.float32)
    lam_full = jnp.exp(jnp.sum(lam[0] * lam[1])) - jnp.exp(jnp.sum(lam[2] * lam[3])) + lambda_init

    def finish(a1, a2):
        o = a1.astype(jnp.float32) - lam_full * a2.astype(jnp.float32)
        o = rms_norm(o, subln_g) * (1.0 - lambda_init)
        return merge_heads(o.astype(a1.dtype))

    kc = diff_heads(pc[1], None, None)
    vc = to_heads(pc[2], DIFF_HEADS, DIFF_V)
    ql = diff_heads(pl[0], cos, sin)
    kl = diff_heads(pl[1], cos, sin)
    vl = to_heads(pl[2], DIFF_HEADS, DIFF_V)
    out_l = finish(dense_blocked_attention(ql[..., 0, :], kl[..., 0, :], vl, kc[..., 0, :], vc, scale),
                   dense_blocked_attention(ql[..., 1, :], kl[..., 1, :], vl, kc[..., 1, :], vc, scale))
    out_c = None
    if need_ctx:
        qc = diff_heads(pc[0], None, None)
        out_c = finish(softmax_attention(qc[..., 0, :], kc[..., 0, :], vc, scale),
                       softmax_attention(qc[..., 1, :], kc[..., 1, :], vc, scale))
    return out_l, out_c


def swa_mixer(pl, pc, sink, cos, sin, need_ctx):
    scale = SWA_DIM ** -0.5
    kc = to_heads(pc[1], SWA_KV_HEADS, SWA_DIM)
    vc = to_heads(pc[2], SWA_KV_HEADS, SWA_DIM)
    ql = apply_rope(to_heads(pl[0], SWA_HEADS, SWA_DIM), cos, sin)
    kl = apply_rope(to_heads(pl[1], SWA_KV_HEADS, SWA_DIM), cos, sin)
    vl = to_heads(pl[2], SWA_KV_HEADS, SWA_DIM)
    out_l = merge_heads(banded_sink_attention(ql, kl, vl, kc, vc, sink, scale))
    out_c = None
    if need_ctx:
        qc = to_heads(pc[0], SWA_HEADS, SWA_DIM)
        out_c = merge_heads(context_sink_attention(qc, kc, vc, sink, scale))
    return out_l, out_c


def clamped_swiglu(gate, up):
    gate = jnp.minimum(gate, SWIGLU_LIMIT)
    up = jnp.clip(up, -SWIGLU_LIMIT, SWIGLU_LIMIT)
    return gate * jax.nn.sigmoid(SWIGLU_ALPHA * gate) * (up + 1)


def moe_ffn(h, w_router, b_router, w_gate, b_gate, w_up, b_up, w_down, b_down):
    shape = h.shape
    hf = h.reshape(-1, shape[-1])
    logits = (hf @ w_router + b_router).astype(jnp.float32)
    top_val, top_idx = lax.top_k(logits, TOP_K)
    top_w = jax.nn.softmax(top_val, axis=-1)
    gates = jnp.sum(jax.nn.one_hot(top_idx, N_EXPERTS, dtype=jnp.float32) * top_w[..., None], axis=1).astype(hf.dtype)
    out = jnp.zeros_like(hf)
    for e in range(N_EXPERTS):
        act = clamped_swiglu(hf @ w_gate[e] + b_gate[e], hf @ w_up[e] + b_up[e])
        out = out + gates[:, e:e + 1] * (act @ w_down[e] + b_down[e])
    return out.reshape(shape)


def setup_inputs(seed: int = 0) -> dict:
    key = jax.random.key(seed)
    ks = jax.random.split(key, 26)
    L, D, E, F = DEPTH, D_MODEL, N_EXPERTS, D_EXPERT

    def nrm(k, shape, scale):
        return jax.random.normal(k, shape, jnp.float32) * scale

    def gain(k, shape):
        return 1.0 + nrm(k, shape, 0.05)

    return {
        'x': nrm(ks[0], (BATCH, SEQ, D), 1.0),
        'c': nrm(ks[1], (BATCH, D), 1.0),
        'ctx': nrm(ks[2], (BATCH, CTX_LEN, D), 1.0),
        'c_ctx': nrm(ks[3], (D,), 1.0),
        'w_ada': nrm(ks[4], (L, D, N_MOD * D), 0.5 * D ** -0.5),
        'b_ada': nrm(ks[5], (L, N_MOD * D), 0.02),
        'g_attn': gain(ks[6], (L, D)),
        'w_in': nrm(ks[7], (L, D, D_IN), D ** -0.5),
        'mla_q_norm': gain(ks[8], (L, MLA_Q_RANK)),
        'mla_w_uq': nrm(ks[9], (L, MLA_Q_RANK, MLA_HEADS * (MLA_NOPE + MLA_ROPE)), MLA_Q_RANK ** -0.5),
        'mla_kv_norm': gain(ks[10], (L, MLA_KV_RANK)),
        'mla_w_ukv': nrm(ks[11], (L, MLA_KV_RANK, MLA_HEADS * (MLA_NOPE + MLA_V)), MLA_KV_RANK ** -0.5),
        'diff_lambda': nrm(ks[12], (L, 4, DIFF_QK), 0.1),
        'diff_subln': gain(ks[13], (L, DIFF_V)),
        'swa_sink': nrm(ks[14], (L, SWA_HEADS), 0.5),
        'w_out': nrm(ks[15], (L, D_MIX, D), D_MIX ** -0.5),
        'g_ffn': gain(ks[16], (L, D)),
        'w_router': nrm(ks[17], (L, D, E), D ** -0.5),
        'b_router': nrm(ks[18], (L, E), 0.01),
        'w_gate': nrm(ks[19], (L, E, D, F), D ** -0.5),
        'b_gate': nrm(ks[20], (L, E, F), 0.02),
        'w_up': nrm(ks[21], (L, E, D, F), D ** -0.5),
        'b_up': nrm(ks[22], (L, E, F), 0.02),
        'w_down': nrm(ks[23], (L, E, F, D), F ** -0.5),
        'b_down': nrm(ks[24], (L, E, D), 0.02),
        'g_final': gain(ks[25], (D,)),
    }


def reference(x, c, ctx, c_ctx, w_ada, b_ada, g_attn, w_in, mla_q_norm, mla_w_uq, mla_kv_norm, mla_w_ukv,
              diff_lambda, diff_subln, swa_sink, w_out, g_ffn, w_router, b_router, w_gate, b_gate, w_up, b_up,
              w_down, b_down, g_final):
    b, s_len, d = x.shape
    n_ctx = ctx.shape[1]
    rows = s_len // GRID_W
    cos_r, sin_r = axial_rope_tables(rows, MLA_ROPE)
    cos_w, sin_w = axial_rope_tables(rows, SWA_DIM)
    split_points = [int(p) for p in np.cumsum(IN_SPLIT_SIZES)[:-1]]
    silu_c = jax.nn.silu(c)
    silu_cc = jax.nn.silu(c_ctx)[None, :]
    xl, xc = x, ctx
    for i in range(DEPTH):
        need_ctx = i < DEPTH - 1
        lambda_init = 0.8 - 0.6 * math.exp(-0.3 * i)
        mod_l = jnp.split((silu_c @ w_ada[i] + b_ada[i]).reshape(b, N_MOD, d), N_MOD, axis=1)
        mod_c = jnp.split((silu_cc @ w_ada[i] + b_ada[i]).reshape(1, N_MOD, d), N_MOD, axis=1)
        hl = modulate(xl, g_attn[i], mod_l[0], mod_l[1])
        hc = modulate(xc, g_attn[i], mod_c[0], mod_c[1])
        pl = jnp.split(hl @ w_in[i], split_points, axis=-1)
        pc = jnp.split(hc @ w_in[i], split_points, axis=-1)
        mla_l, mla_c = mla_mixer(pl[0:3], pc[0:3], mla_q_norm[i], mla_w_uq[i], mla_kv_norm[i], mla_w_ukv[i],
                                 cos_r, sin_r, need_ctx)
        diff_l, diff_c = diff_mixer(pl[3:6], pc[3:6], diff_lambda[i], diff_subln[i], lambda_init,
                                    cos_r, sin_r, need_ctx)
        swa_l, swa_c = swa_mixer(pl[6:9], pc[6:9], swa_sink[i], cos_w, sin_w, need_ctx)
        xl = xl + mod_l[2] * (jnp.concatenate([mla_l, diff_l, swa_l], axis=-1) @ w_out[i])
        fl = modulate(xl, g_ffn[i], mod_l[3], mod_l[4])
        if need_ctx:
            xc = xc + mod_c[2] * (jnp.concatenate([mla_c, diff_c, swa_c], axis=-1) @ w_out[i])
            fc = modulate(xc, g_ffn[i], mod_c[3], mod_c[4])
            y = moe_ffn(jnp.concatenate([fc, fl], axis=1), w_router[i], b_router[i], w_gate[i], b_gate[i],
                        w_up[i], b_up[i], w_down[i], b_down[i])
            xc = xc + mod_c[5] * y[:, :n_ctx]
            xl = xl + mod_l[5] * y[:, n_ctx:]
        else:
            xl = xl + mod_l[5] * moe_ffn(fl, w_router[i], b_router[i], w_gate[i], b_gate[i],
                                         w_up[i], b_up[i], w_down[i], b_down[i])
    return rms_norm(xl, g_final)
```

```cpp
#include <hip/hip_runtime.h>
#include <cstdio>
#include <cstdint>
#include <cmath>

#ifndef MK_ONE_LAUNCH
#define MK_ONE_LAUNCH 1
#endif

#define LAS __attribute__((address_space(3)))
#define GAS __attribute__((address_space(1)))
typedef unsigned short bf16_t;
typedef short bf16x8 __attribute__((ext_vector_type(8)));
typedef short v4i16_t __attribute__((ext_vector_type(4)));
typedef float f32x4 __attribute__((ext_vector_type(4)));
typedef float f32x2 __attribute__((ext_vector_type(2)));
typedef float f32x16 __attribute__((ext_vector_type(16)));
typedef unsigned u32x4 __attribute__((ext_vector_type(4)));
typedef unsigned u32x2 __attribute__((ext_vector_type(2)));
typedef __bf16 bf16x2_t __attribute__((ext_vector_type(2)));

constexpr int NB = 16, SEQ = 2048, CTX = 256, NTK = SEQ + CTX, T = NB * NTK, D = 1024, NL = 4, NE = 32;
constexpr int PW = 2048;
constexpr int NPAN = T / 256;
constexpr int MAXPAN = 608;
constexpr int NWAVES = 8, NTHR = 512;
constexpr float EPS = 1e-6f;
constexpr float LOG2E = 1.4426950408889634f;
constexpr float SC_MLA = 0.10206207261596577f * LOG2E;
constexpr float SC_DIFF = 0.17677669529663687f * LOG2E;
constexpr float SC_SWA = 0.125f * LOG2E;
constexpr float F8_SW = 64.0f, F8_SA = 4.0f;
constexpr float F8_INV = 1.0f / (F8_SW * F8_SA);
constexpr float F8_SM = 16.0f, F8_INVM = 1.0f / (F8_SW * F8_SM);
constexpr float F8_SY = 64.0f;

constexpr size_t MiB = 1u << 20;
constexpr size_t WS_CTL = 0, CTL_ZERO_BYTES = 1 * MiB;
constexpr size_t WS_MOD = 1 * MiB;
constexpr size_t WS_ROPER = 3 * MiB;
constexpr size_t WS_ROPEW = WS_ROPER + 262144;
constexpr size_t WS_SSQ = 4 * MiB;
constexpr size_t WS_TOKSLOT = 6 * MiB;
constexpr size_t WS_SLOTTOK = 7 * MiB;
constexpr size_t WS_SLOTW = 12 * MiB;
constexpr size_t WS_WR = 17 * MiB;
constexpr size_t WS_WUQ = 18 * MiB;
constexpr size_t WS_WUKV = 19 * MiB;
constexpr size_t WS_WIN = 20 * MiB;
constexpr size_t WS_WOUT = 36 * MiB;
constexpr size_t WS_WGU = 44 * MiB;
constexpr size_t WS_WD = 556 * MiB;
constexpr size_t WS_X = 812 * MiB;
constexpr size_t WS_H = 956 * MiB;
constexpr size_t WS_ACT = 1028 * MiB;
constexpr size_t WS_P = WS_ACT;
constexpr size_t WS_QM = WS_ACT + 144 * MiB;
constexpr size_t WS_KVM = WS_ACT + 171 * MiB;
constexpr size_t WS_MIX = WS_ACT + 207 * MiB;
constexpr size_t WS_Y = 1332 * MiB;
constexpr size_t WS_END = 1636 * MiB;
constexpr int CW_LAM = 64;
constexpr int CW_ATTQ = 2048;
constexpr int CW_CUR = 1024;
constexpr int CW_BAR = 4096;

constexpr int RING_BYTES = 131072;
constexpr int MISC_OFF = RING_BYTES;
constexpr int GOFF_OFF = RING_BYTES + 4096;
constexpr int LDS_BYTES = RING_BYTES + 4096 + 8192;

__device__ __forceinline__ unsigned cvtpk(float lo, float hi) { f32x2 v = {lo, hi}; bf16x2_t b = __builtin_convertvector(v, bf16x2_t); return __builtin_bit_cast(unsigned, b); }
__device__ __forceinline__ float bf2f(unsigned short b) { return __uint_as_float(((unsigned)b) << 16); }
__device__ __forceinline__ float bflo(unsigned w) { return __uint_as_float(w << 16); }
__device__ __forceinline__ float bfhi(unsigned w) { return __uint_as_float(w & 0xffff0000u); }
__device__ __forceinline__ float wave_sum(float v) {
#pragma unroll
    for (int o = 1; o < 64; o <<= 1) v += __shfl_xor(v, o);
    return v;
}
__device__ __forceinline__ int opaque_tid() { int t = threadIdx.x; asm volatile("" : "+v"(t)); return t; }
__device__ __forceinline__ int il(int i, int hd) { return (i & 1) ? (i >> 1) + (hd >> 1) : (i >> 1); }

#define XB_TMO      128
#define XB_XCNT(j)  (256  + 64 * (j))
#define XB_XSUB(j)  (1280 + 64 * (j))
#define XB_XGEN(j)  (2304 + 64 * (j))
#define XB_TOP      3328
#define XB_TOPGEN   3392
#define XCD_BAR_WORDS 3456
#define XB_SPIN_CAP (1u << 20)
__device__ __forceinline__ unsigned xb_ld(unsigned* p)              { return __hip_atomic_load(p, __ATOMIC_RELAXED, __HIP_MEMORY_SCOPE_AGENT); }
__device__ __forceinline__ unsigned xb_add(unsigned* p, unsigned v) { return __hip_atomic_fetch_add(p, v, __ATOMIC_RELAXED, __HIP_MEMORY_SCOPE_AGENT); }
__device__ __forceinline__ unsigned xb_xcc_id() { return (unsigned)__builtin_amdgcn_s_getreg((3 << 11) | 20) & 0xFu; }
#define XB_SPIN(cond, bar) do { unsigned _sp = 0; while (cond) { __builtin_amdgcn_s_sleep(1); \
    if ((++_sp & 255u) == 0u) { if (xb_ld(&(bar)[XB_TMO])) break; if (_sp > XB_SPIN_CAP) { atomicAdd(&(bar)[XB_TMO], 1u); break; } } } } while (0)
struct XcdBarrier { unsigned* bar; unsigned x; volatile LAS unsigned* st; };
__device__ __forceinline__ XcdBarrier xcd_barrier_post(unsigned* bar, volatile LAS unsigned* st) {
    XcdBarrier b; b.bar = bar; b.x = xb_xcc_id(); b.st = st;
    if (threadIdx.x == 0) (void)xb_add(&bar[XB_XCNT(b.x)], 1u);
    return b;
}
__device__ __forceinline__ void xcd_barrier_complete(unsigned* bar, unsigned x, unsigned& nloc, unsigned& nx) {
    const unsigned G = gridDim.x * gridDim.y * gridDim.z;
    unsigned sum, cnt, mine, sp = 0u;
    for (;;) {
        sum = 0u; cnt = 0u; mine = 0u;
#pragma unroll
        for (unsigned j = 0; j < 16; ++j) { const unsigned c = xb_ld(&bar[XB_XCNT(j)]); sum += c; cnt += (c > 0u) ? 1u : 0u; mine = (j == x) ? c : mine; }
        if (sum == G) break;
        __builtin_amdgcn_s_sleep(1);
        if ((++sp & 255u) == 0u) { if (xb_ld(&bar[XB_TMO])) break; if (sp > XB_SPIN_CAP) { atomicAdd(&bar[XB_TMO], 1u); break; } }
    }
    nloc = mine > 0u ? mine : 1u; nx = cnt > 0u ? cnt : 1u;
}
__device__ __forceinline__ void xcd_barrier(const XcdBarrier& b) {
    asm volatile("s_waitcnt vmcnt(0)" ::: "memory");
    __syncthreads();
    if (threadIdx.x == 0) {
        unsigned* bar = b.bar;
        __builtin_amdgcn_s_waitcnt(0);
        unsigned nloc = b.st[0], nx = b.st[1];
        if (nloc == 0u) { xcd_barrier_complete(bar, b.x, nloc, nx); b.st[0] = nloc; b.st[1] = nx; }
        const unsigned old = xb_add(&bar[XB_XSUB(b.x)], 1u);
        const unsigned gen = old / nloc;
        if (old + 1u == (gen + 1u) * nloc) {
            __builtin_amdgcn_fence(__ATOMIC_RELEASE, "agent");
            asm volatile("s_waitcnt vmcnt(0)" ::: "memory");
            const unsigned og = xb_add(&bar[XB_TOP], 1u);
            const unsigned tg = og / nx;
            if (og + 1u == (tg + 1u) * nx) xb_add(&bar[XB_TOPGEN], 1u);
            else XB_SPIN(xb_ld(&bar[XB_TOPGEN]) == tg, bar);
            __builtin_amdgcn_fence(__ATOMIC_ACQUIRE, "agent");
            xb_add(&bar[XB_XGEN(b.x)], 1u);
            asm volatile("s_waitcnt vmcnt(0)" ::: "memory");
        } else {
            XB_SPIN(xb_ld(&bar[XB_XGEN(b.x)]) == gen, bar);
            __builtin_amdgcn_fence(__ATOMIC_ACQUIRE, "agent");
            asm volatile("s_waitcnt vmcnt(0)" ::: "memory");
        }
    }
    __syncthreads();
}

struct Args {
    const float* in[26];
    float* out; unsigned char* ws;
    double invf8[8]; double invf16[16];
    float lam_init[4];
    int ph_lo, ph_hi;
};
struct Frame {
    LAS unsigned char* lds;
    unsigned char* ws;
    int tid, lane, wave, vcu, G;
};

namespace pg8 {
constexpr int BM = 256, BK = 64, HALF = 128, HTB = HALF * BK * 2, STAGE_BYTES = 8 * HTB;
__host__ __device__ __forceinline__ int lds_byte(int r, int c) { const int st = (r >> 4) * 2 + (c >> 5), rr = r & 15, cc = c & 31, ob = rr * 64 + cc * 2; return st * 1024 + (ob ^ (((ob >> 9) & 1) << 5)); }
__host__ __device__ __forceinline__ void stage_rc(int b, int& R, int& C) { const int st = b / 1024, sb = b % 1024, swz = sb ^ (((sb >> 9) & 1) << 5); R = (st >> 1) * 16 + swz / 64; C = (st & 1) * 32 + (swz % 64) / 2; }
__host__ __device__ __forceinline__ int perm32(int rho) { const int n = rho >> 4, i = rho & 15; return 8 * (i >> 2) + 4 * n + (i & 3); }

typedef int v8i32 __attribute__((ext_vector_type(8)));
typedef int u32x4i __attribute__((ext_vector_type(4)));
__device__ __forceinline__ v8i32 pk8(bf16x8 lo, bf16x8 hi) { const u32x4 a = __builtin_bit_cast(u32x4, lo), b = __builtin_bit_cast(u32x4, hi); return (v8i32){(int)a.x, (int)a.y, (int)a.z, (int)a.w, (int)b.x, (int)b.y, (int)b.z, (int)b.w}; }
struct Unit { const char* a; const char* b; int pm, pn, e, j, cnt; };

template <class Epi, class Sched, bool ALIGN_EPI, bool FP8 = false>
__device__ __forceinline__ void gemm_phase(LAS unsigned char* lds, const int K, const int lda, const int ldb, const Sched& S, const Epi& E) {
    const int tid = opaque_tid(), wid = __builtin_amdgcn_readfirstlane(tid >> 6), lane = tid & 63, wr = wid >> 2, wc = wid & 3, fr = lane & 15, fq = lane >> 4;
    const int nt = K / BK;
    int Rs[2], Cs[2]; unsigned voffBp[2];
#pragma unroll
    for (int i = 0; i < 2; ++i) { int R, C; stage_rc(tid * 16 + i * 8192, R, C); Rs[i] = R; Cs[i] = C; const int Rb = Epi::PERM ? ((R & ~31) + perm32(R & 31)) : R; voffBp[i] = (unsigned)(Rb * ldb + C) * 2u; }
    const size_t kstep = (size_t)(BK * 2);
    const size_t hstepB = (size_t)HALF * ldb * 2;
    const unsigned ldsw = (unsigned)wid * 1024u;
#define PG8_SA(b, h) (((b) * 2 + (h)) * HTB)
#define PG8_SB(b, h) ((4 + (b) * 2 + (h)) * HTB)
#define PG8_STAGE2(bufoff, gbase, o0, o1) do { \
        __builtin_amdgcn_global_load_lds((const unsigned*)((const char*)(gbase) + (o0)), (LAS unsigned*)(lds + (bufoff) + ldsw), 16, 0, 0); \
        __builtin_amdgcn_global_load_lds((const unsigned*)((const char*)(gbase) + (o1)), (LAS unsigned*)(lds + (bufoff) + ldsw + 8192), 16, 0, 0); } while (0)
#define PG8_STAGEB(bufoff, gbase) PG8_STAGE2(bufoff, gbase, voffB[0], voffB[1])
#define PG8_STAGEBP(bufoff, gbase) PG8_STAGE2(bufoff, gbase, voffBp[0], voffBp[1])
#define PG8_LD32(p) __builtin_shufflevector(*(const LAS u32x4i*)(p), *(const LAS u32x4i*)((p) + 1024), 0, 1, 2, 3, 4, 5, 6, 7)
#define PG8_LDA(dst, b, h) do { if constexpr (FP8) { _Pragma("unroll") for (int m = 0; m < 4; ++m) dst##8[m] = PG8_LD32(lds + PG8_SA(b, h) + aoff + m * 2048); } \
        else { _Pragma("unroll") for (int m = 0; m < 4; ++m) _Pragma("unroll") for (int k = 0; k < 2; ++k) dst[m][k] = *(const LAS bf16x8*)(lds + PG8_SA(b, h) + aoff + m * 2048 + k * 1024); } } while (0)
#define PG8_LDB(dst, b, h) do { if constexpr (FP8) { _Pragma("unroll") for (int n = 0; n < 2; ++n) dst##8[n] = PG8_LD32(lds + PG8_SB(b, h) + boff + n * 2048); } \
        else { _Pragma("unroll") for (int n = 0; n < 2; ++n) _Pragma("unroll") for (int k = 0; k < 2; ++k) dst[n][k] = *(const LAS bf16x8*)(lds + PG8_SB(b, h) + boff + n * 2048 + k * 1024); } } while (0)
  \

#define PG8_MMA(ai, bj, At, Bt) do { __builtin_amdgcn_s_setprio(1); _Pragma("unroll") for (int m = 0; m < 4; ++m) _Pragma("unroll") for (int n = 0; n < 2; ++n) { \
        if constexpr (FP8) { asm volatile("v_mfma_scale_f32_16x16x128_f8f6f4 %0, %1, %2, %0, %3, %3 op_sel_hi:[0,0,0]" : "+v"(acc[ai][bj][m][n]) : "v"(Bt##8[n]), "v"(At##8[m]), "v"(f8scale)); } \
        else { _Pragma("unroll") for (int k = 0; k < 2; ++k) acc[ai][bj][m][n] = __builtin_amdgcn_mfma_f32_16x16x32_bf16(Bt[n][k], At[m][k], acc[ai][bj][m][n], 0, 0, 0); } } \
        __builtin_amdgcn_s_setprio(0); } while (0)
#define PG8_WAIT_V(n) asm volatile("s_waitcnt vmcnt(" #n ")" ::: "memory")
#define PG8_WAIT_L(n) asm volatile("s_waitcnt lgkmcnt(" #n ")" ::: "memory")
#define PG8_BAR __builtin_amdgcn_s_barrier()
#define PG8_SCHED __builtin_amdgcn_sched_barrier(0)
    Unit cur, nxt; int ui = 0;
    if (!S.next(0, cur)) return;
    f32x4 acc[2][2][4][2];
#pragma unroll
    for (int a = 0; a < 2; ++a)
#pragma unroll
        for (int b = 0; b < 2; ++b)
#pragma unroll
            for (int m = 0; m < 4; ++m)
#pragma unroll
                for (int n = 0; n < 2; ++n) acc[a][b][m][n] = (f32x4){0.f, 0.f, 0.f, 0.f};
    bf16x8 At[4][2], B0[2][2], B1[2][2]; v8i32 At8[4], B08[2], B18[2];
    unsigned vc00, vc01, vc10, vc11, vn00, vn01, vn10, vn11;
    vc00 = (unsigned)(S.arow(cur, Rs[0]) * lda + Cs[0]) * 2u; vc01 = (unsigned)(S.arow(cur, Rs[1]) * lda + Cs[1]) * 2u;
    vc10 = (unsigned)(S.arow(cur, HALF + Rs[0]) * lda + Cs[0]) * 2u; vc11 = (unsigned)(S.arow(cur, HALF + Rs[1]) * lda + Cs[1]) * 2u;
    const char* cA = cur.a; const char* cB = cur.b;
    PG8_STAGEBP(PG8_SB(0, 0), cB); PG8_STAGEBP(PG8_SB(0, 1), cB + hstepB); PG8_STAGE2(PG8_SA(0, 0), cA, vc00, vc01); PG8_STAGE2(PG8_SA(0, 1), cA, vc10, vc11);
    if (wr == 1) PG8_BAR;
    PG8_WAIT_V(2); PG8_BAR;
    PG8_STAGEBP(PG8_SB(1, 0), cB + kstep); PG8_STAGE2(PG8_SA(1, 0), cA + kstep, vc00, vc01); PG8_STAGEBP(PG8_SB(1, 1), cB + hstepB + kstep);
    PG8_WAIT_V(6); PG8_BAR;
    bool has_next = S.next(1, nxt);
    if (Sched::GATHER && has_next) {
        int R0, C0, R1, C1; { const int t2_ = opaque_tid(); stage_rc(t2_ * 16, R0, C0); stage_rc(t2_ * 16 + 8192, R1, C1); }
        LAS unsigned* gp = (LAS unsigned*)(lds + GOFF_OFF) + (opaque_tid() << 2);
        gp[0] = (unsigned)(S.arow(nxt, R0) * lda + C0) * 2u; gp[1] = (unsigned)(S.arow(nxt, R1) * lda + C1) * 2u;
        gp[2] = (unsigned)(S.arow(nxt, HALF + R0) * lda + C0) * 2u; gp[3] = (unsigned)(S.arow(nxt, HALF + R1) * lda + C1) * 2u;
    }
    for (;;) {
        const char* nA = has_next ? nxt.a : cA; const char* nB = has_next ? nxt.b : cB;
        vn00 = vc00; vn01 = vc01; vn10 = vc10; vn11 = vc11;
#ifndef KREP
#define KREP 1
#endif
        constexpr int krep = (FP8 && Epi::PROBE) ? KREP : 1;
#pragma unroll 1
        for (int tq = 0; tq < krep * nt; tq += 2) {
            const int t = tq % nt;
            const bool last = (tq == krep * nt - 2);
            const int f8scale = (tq < nt) ? 0x7F7F7F7F : 0;
            unsigned voffB[2]; int aoff, boff;
            { const int t3_ = opaque_tid(), l3_ = t3_ & 63, fr3_ = l3_ & 15, fq3_ = l3_ >> 4;
#pragma unroll
              for (int i = 0; i < 2; ++i) { int R, C; stage_rc(t3_ * 16 + i * 8192, R, C); const int Rb = Epi::PERM ? ((R & ~31) + perm32(R & 31)) : R; voffB[i] = (unsigned)(Rb * ldb + C) * 2u; }
              aoff = lds_byte(wr * 64 + fr3_, fq3_ * 8); boff = lds_byte(wc * 32 + fr3_, fq3_ * 8); }
            if (Sched::GATHER && last) { const LAS unsigned* gp = (const LAS unsigned*)(lds + GOFF_OFF) + (opaque_tid() << 2); vn00 = gp[0]; vn01 = gp[1]; vn10 = gp[2]; vn11 = gp[3]; }
            const char* a1 = cA + (size_t)(t + 1) * kstep;
            const char* a2 = last ? nA : cA + (size_t)((t + 2) % nt) * kstep; const char* b2 = last ? nB : cB + (size_t)((t + 2) % nt) * kstep;
            const char* a3 = a2 + kstep; const char* b3 = b2 + kstep;
            const unsigned w00 = (Sched::GATHER && last) ? vn00 : vc00, w01 = (Sched::GATHER && last) ? vn01 : vc01, w10 = (Sched::GATHER && last) ? vn10 : vc10, w11 = (Sched::GATHER && last) ? vn11 : vc11;
            const bool relax = (Epi::NST > 0) && (tq == 0) && (ui > 0);
            PG8_LDB(B0, 0, 0); PG8_LDB(B1, 0, 1); PG8_SCHED; PG8_LDA(At, 0, 0); PG8_STAGE2(PG8_SA(1, 1), a1, vc10, vc11);
            if (relax) asm volatile("s_waitcnt vmcnt(%0)" :: "n"(8 + Epi::NST) : "memory"); else PG8_WAIT_V(8);
            PG8_WAIT_L(0); PG8_BAR; PG8_MMA(0, 0, At, B0); PG8_MMA(0, 1, At, B1); PG8_BAR; PG8_SCHED;
            PG8_LDA(At, 0, 1); PG8_STAGEB(PG8_SB(0, 0), b2); PG8_STAGEB(PG8_SB(0, 1), b2 + hstepB); PG8_STAGE2(PG8_SA(0, 0), a2, w00, w01);
            if (relax) asm volatile("s_waitcnt vmcnt(%0)" :: "n"(8 + Epi::NST) : "memory"); else PG8_WAIT_V(8);
            PG8_WAIT_L(0); PG8_BAR; PG8_MMA(1, 0, At, B0); PG8_MMA(1, 1, At, B1); PG8_BAR; PG8_SCHED;
            PG8_LDB(B0, 1, 0); PG8_LDB(B1, 1, 1); PG8_SCHED; PG8_LDA(At, 1, 0); PG8_STAGE2(PG8_SA(0, 1), a2, w10, w11);
            PG8_WAIT_V(8); PG8_WAIT_L(0); PG8_BAR; PG8_MMA(0, 0, At, B0); PG8_MMA(0, 1, At, B1); PG8_BAR; PG8_SCHED;
            PG8_LDA(At, 1, 1); PG8_STAGEB(PG8_SB(1, 0), b3); PG8_STAGEB(PG8_SB(1, 1), b3 + hstepB); PG8_STAGE2(PG8_SA(1, 0), a3, w00, w01);
            PG8_WAIT_V(8); PG8_WAIT_L(0); PG8_BAR; PG8_MMA(1, 0, At, B0); PG8_MMA(1, 1, At, B1); PG8_BAR; PG8_SCHED;
        }
        Unit nn; bool has_nn = has_next && S.next(ui + 2, nn);
        int gt0 = 0, gt1 = 0, gt2 = 0, gt3 = 0;
        if constexpr (Sched::GATHER) if (has_nn) {
            int R0, C0, R1, C1; { const int t2_ = opaque_tid(); stage_rc(t2_ * 16, R0, C0); stage_rc(t2_ * 16 + 8192, R1, C1); }
            gt0 = S.arow_raw(nn, R0); gt1 = S.arow_raw(nn, R1); gt2 = S.arow_raw(nn, HALF + R0); gt3 = S.arow_raw(nn, HALF + R1);
        }
        if constexpr (ALIGN_EPI) { if (wr == 0) PG8_BAR; }
#ifndef REP_EPI
#define REP_EPI 1
#endif
        if constexpr (FP8) asm volatile("s_nop 15\n\ts_nop 15" ::: "memory");
        { const int l2_ = opaque_tid() & 63; for (int rep_ = 0; rep_ < (Epi::PROBE ? REP_EPI : 1); ++rep_) E(acc, cur, wr, wc, l2_ & 15, l2_ >> 4); }
        if (!has_next) break;
#pragma unroll
        for (int a = 0; a < 2; ++a)
#pragma unroll
            for (int b = 0; b < 2; ++b)
#pragma unroll
                for (int m = 0; m < 4; ++m)
#pragma unroll
                    for (int n = 0; n < 2; ++n) acc[a][b][m][n] = (f32x4){0.f, 0.f, 0.f, 0.f};
        cur = nxt; cA = nA; cB = nB; ++ui; vc00 = vn00; vc01 = vn01; vc10 = vn10; vc11 = vn11;
        nxt = nn; has_next = has_nn;
        if constexpr (Sched::GATHER) asm volatile("" : "+v"(gt0), "+v"(gt1), "+v"(gt2), "+v"(gt3));
        if constexpr (Sched::GATHER) if (has_next) {
            int R0, C0, R1, C1; { const int t2_ = opaque_tid(); stage_rc(t2_ * 16, R0, C0); stage_rc(t2_ * 16 + 8192, R1, C1); }
            LAS unsigned* gp = (LAS unsigned*)(lds + GOFF_OFF) + (opaque_tid() << 2);
            gp[0] = (unsigned)(S.arow_fix(nxt, R0, gt0) * lda + C0) * 2u; gp[1] = (unsigned)(S.arow_fix(nxt, R1, gt1) * lda + C1) * 2u;
            gp[2] = (unsigned)(S.arow_fix(nxt, HALF + R0, gt2) * lda + C0) * 2u; gp[3] = (unsigned)(S.arow_fix(nxt, HALF + R1, gt3) * lda + C1) * 2u;
        }
        if constexpr (ALIGN_EPI) { if (wr == 1) PG8_BAR; }
    }
    PG8_WAIT_V(0);
    if constexpr (!ALIGN_EPI) { if (wr == 0) PG8_BAR; }
    PG8_BAR;
#undef PG8_SA
#undef PG8_SB
#undef PG8_STAGE2
#undef PG8_STAGEB
#undef PG8_LDA
#undef PG8_LD32
#undef PG8_LDB
#undef PG8_MMA
#undef PG8_WAIT_V
#undef PG8_WAIT_L
#undef PG8_BAR
#undef PG8_SCHED
}

__device__ __forceinline__ int xcd_remap(int L, int nwg) {
    const int q = nwg / 8, r = nwg % 8, xcd = L % 8, off = L / 8;
    return (xcd < r ? xcd * (q + 1) : r * (q + 1) + (xcd - r) * q) + off;
}

struct DenseSched {
    static constexpr bool GATHER = false;
    const char* A; const char* Bt; int lda, ldb, npan, nN, G, c, latent_only;
    __device__ __forceinline__ bool next(int i, Unit& u) const {
        const int L = i * G + c, nwg = npan * nN; if (L >= nwg) return false;
        const int w = xcd_remap(L, nwg), p = w / nN, pn = w % nN;
        const int pm = latent_only ? (p >> 3) * 9 + 1 + (p & 7) : p;
        u.pm = pm; u.pn = pn; u.e = 0; u.j = 0; u.cnt = 0;
        u.a = A + (size_t)pm * 256 * lda * 2; u.b = Bt + (size_t)pn * 256 * ldb * 2; return true;
    }
    __device__ __forceinline__ int arow(const Unit&, int r) const { return r; }
};
struct UpSched {
    static constexpr bool GATHER = false;
    const char* P; const char* Wuq; const char* Wukv; int G, c;
    __device__ __forceinline__ bool next(int i, Unit& u) const {
        const int L = i * G + c, nwg = NPAN * 4; if (L >= nwg) return false;
        const int w = xcd_remap(L, nwg), p = w >> 2, pn = w & 3;
        u.pm = p; u.pn = pn; u.e = 0; u.j = 0; u.cnt = 0;
        u.a = P + (size_t)p * 256 * PW * 2 + (pn >= 2 ? 512 : 0);
        u.b = (pn >= 2 ? Wukv : Wuq) + (size_t)(pn & 1) * 256 * 256 * 2; return true;
    }
    __device__ __forceinline__ int arow(const Unit&, int r) const { return r; }
};
struct ChainMap {
    int x, r;
    __device__ __forceinline__ int nchain() const { return r < 4 ? 2 : 1; }
    __device__ __forceinline__ int chain(int j) const { return r + 32 * j; }
    __device__ __forceinline__ int nplain() const { return r < 4 ? 1 : (r < 24 ? 4 : 3); }
    __device__ __forceinline__ int plain(int j) const { return r < 4 ? 56 + r : (j == 0 ? r - 4 : (j == 1 ? 24 + r : (j == 2 ? 56 + r : 84 + r))); }
};
struct WinChainSched {
    static constexpr bool GATHER = false;
    const char* A; const char* Bt; int lda, ldb; ChainMap M;
    __device__ __forceinline__ bool next(int i, Unit& u) const {
        const int nc = M.nchain(); if (i >= nc + M.nplain()) return false;
        int q, pn;
        if (i < nc) { const int ch = M.chain(i); q = ch >> 1; pn = ch & 1; } else { const int idx = M.plain(i - nc); q = idx / 6; pn = 2 + idx - q * 6; }
        const int pm = M.x + 8 * q;
        u.pm = pm; u.pn = pn; u.e = 0; u.j = 0; u.cnt = 0;
        u.a = A + (size_t)pm * 256 * lda * 2; u.b = Bt + (size_t)pn * 256 * ldb * 2; return true;
    }
    __device__ __forceinline__ int arow(const Unit&, int r) const { return r; }
};
struct UpChainSched {
    static constexpr bool GATHER = false;
    const char* P; const char* Wuq; const char* Wukv; ChainMap M;
    __device__ __forceinline__ bool next(int i, Unit& u) const {
        if (i >= 2 * M.nchain()) return false;
        const int ch = M.chain(i >> 1), q = ch >> 1, hf = ch & 1, pn = 2 * hf + (i & 1), pm = M.x + 8 * q;
        u.pm = pm; u.pn = pn; u.e = 0; u.j = 0; u.cnt = 0;
        u.a = P + (size_t)pm * 256 * PW * 2 + (hf ? 512 : 0);
        u.b = (hf ? Wukv : Wuq) + (size_t)(pn & 1) * 256 * 256 * 2; return true;
    }
    __device__ __forceinline__ int arow(const Unit&, int r) const { return r; }
};
template <bool GATHER_> struct MoeSched {
    static constexpr bool GATHER = GATHER_;
    const char* A; const char* Bt; const int* slot_tok; volatile LAS int* PB; volatile LAS int* CNT; int nN, G, c; size_t bexp; int ln;
    __device__ __forceinline__ bool next(int i, Unit& u) const {
        const int np = PB[32], nwg = np * nN; const int L = i * G + c; if (L >= nwg) return false;
        const int w = xcd_remap(L, nwg), p = w / nN, pn = w % nN;
        const unsigned long long bal = __ballot(PB[ln + 1] <= p);
        const int e = __builtin_popcount((unsigned)(bal & 0xffffffffull));
        u.pm = p; u.pn = pn; u.e = e; u.j = p - PB[e]; u.cnt = CNT[e];
        u.a = GATHER ? A : A + (size_t)p * 256 * D;
        u.b = Bt + (size_t)e * bexp + (size_t)pn * 256 * D; return true;
    }
    __device__ __forceinline__ int arow_raw(const Unit& u, int r) const { if constexpr (GATHER) return slot_tok[(size_t)u.e * T + min(u.j * 256 + r, u.cnt - 1)]; else return r; }
    __device__ __forceinline__ int arow_fix(const Unit& u, int r, int v) const { if constexpr (GATHER) return (u.j * 256 + r) < u.cnt ? v : 0; else return r; }
    __device__ __forceinline__ int arow(const Unit& u, int r) const {
        if constexpr (GATHER) { const int pos = u.j * 256 + r; const int v = slot_tok[(size_t)u.e * T + min(pos, u.cnt - 1)]; return pos < u.cnt ? v : 0; }
        else return r;
    }
};

__device__ __forceinline__ void rope4(f32x4& v0, f32x4& v1, const f32x4* tab) {
    const f32x4 t0 = tab[0], t1 = tab[1];
    f32x4 a, b;
    a[0] = v0[0] * t0[0] - v0[1] * t0[1]; a[1] = v0[1] * t0[0] + v0[0] * t0[1];
    a[2] = v0[2] * t0[2] - v0[3] * t0[3]; a[3] = v0[3] * t0[2] + v0[2] * t0[3];
    b[0] = v1[0] * t1[0] - v1[1] * t1[1]; b[1] = v1[1] * t1[0] + v1[0] * t1[1];
    b[2] = v1[2] * t1[2] - v1[3] * t1[3]; b[3] = v1[3] * t1[2] + v1[2] * t1[3];
    v0 = a; v1 = b;
}
__device__ __forceinline__ u32x4 pack8(const f32x4& v0, const f32x4& v1) { u32x4 w; w.x = cvtpk(v0[0], v0[1]); w.y = cvtpk(v0[2], v0[3]); w.z = cvtpk(v1[0], v1[1]); w.w = cvtpk(v1[2], v1[3]); return w; }

struct EpiWin {
    static constexpr bool PERM = true, PROBE = false; static constexpr int NST = 16;
    bf16_t* P; float* ssq; const float* ropeR; const float* ropeW;
    __device__ __forceinline__ void operator()(const f32x4 (&acc)[2][2][4][2], const Unit& u, int wr, int wc, int fr, int fq) const {
        const int pn = u.pn;
        int mode[2];
        mode[0] = (pn == 2 || pn == 3) ? 1 : ((pn == 5 || pn == 6 || pn == 7) ? 2 : 0);
        mode[1] = (pn == 2 || pn == 3) ? 1 : ((pn == 5 || pn == 6) ? 2 : ((pn == 1 && wc == 0) ? 1 : 0));
        const int iR = 4 * fq, iW = 16 * (wc & 1) + 4 * fq;
        f32x4 tb[2][2][2];
        auto rowof = [&](int g) { return u.pm * 256 + (g >> 2) * 128 + wr * 64 + (g & 3) * 16 + fr; };
        auto ldtab = [&](int g) {
            const int nb = rowof(g) % NTK; const int t = nb >= CTX ? nb - CTX : 0;
#pragma unroll
            for (int bj = 0; bj < 2; ++bj) {
                if (mode[bj] == 1) { const f32x4* p = (const f32x4*)(ropeR + ((size_t)t * 16 + iR) * 2); tb[g & 1][bj][0] = p[0]; tb[g & 1][bj][1] = p[1]; }
                else if (mode[bj] == 2) { const f32x4* p = (const f32x4*)(ropeW + ((size_t)t * 32 + iW) * 2); tb[g & 1][bj][0] = p[0]; tb[g & 1][bj][1] = p[1]; }
            }
        };
        ldtab(0);
#pragma unroll
        for (int g = 0; g < 8; ++g) {
            const int ai = g >> 2, m = g & 3;
            const int row = rowof(g);
            const bool latent = (row % NTK) >= CTX;
            if (g + 1 < 8) ldtab(g + 1);
            float ss = 0.f;
#pragma unroll
            for (int bj = 0; bj < 2; ++bj) {
                f32x4 v0 = acc[ai][bj][m][0] * F8_INV, v1 = acc[ai][bj][m][1] * F8_INV;
                if (pn == 0 || (pn == 1 && bj == 0)) ss += (v0[0] * v0[0] + v0[1] * v0[1]) + (v0[2] * v0[2] + v0[3] * v0[3]) + (v1[0] * v1[0] + v1[1] * v1[1]) + (v1[2] * v1[2] + v1[3] * v1[3]);
                if (mode[bj] != 0) {
                    f32x4 t0 = tb[g & 1][bj][0], t1 = tb[g & 1][bj][1];
                    if (!latent) { t0 = (f32x4){1.f, 0.f, 1.f, 0.f}; t1 = t0; }
                    const f32x4 tt[2] = {t0, t1};
                    rope4(v0, v1, tt);
                }
                *(u32x4*)(P + (size_t)row * PW + pn * 256 + bj * 128 + wc * 32 + fq * 8) = pack8(v0, v1);
            }
            if (pn < 2) { ss += __shfl_xor(ss, 16); ss += __shfl_xor(ss, 32); if (fq == 0) ssq[(size_t)row * 8 + pn * 4 + wc] = ss; }
        }
    }
};
struct EpiUp {
    static constexpr bool PERM = true, PROBE = false; static constexpr int NST = 0;
    bf16_t* QM; bf16_t* KVM; const float* ssq; const float* ropeR;
    __device__ __forceinline__ void operator()(const f32x4 (&acc)[2][2][4][2], const Unit& u, int wr, int wc, int fr, int fq) const {
        const bool isq = u.pn < 2;
        int col0[2], rp[2];
#pragma unroll
        for (int bj = 0; bj < 2; ++bj) { col0[bj] = (u.pn & 1) * 256 + bj * 128 + wc * 32 + fq * 8; const int hl = col0[bj] % 96; rp[bj] = (isq && col0[bj] < 384 && hl >= 64) ? ((hl - 64) >> 1) : -1; }
        f32x4 sq[2]; f32x4 tb[2][2][2];
        auto rowof = [&](int g) { return u.pm * 256 + (g >> 2) * 128 + wr * 64 + (g & 3) * 16 + fr; };
        auto ld = [&](int g) {
            const int row = rowof(g); const int nb = row % NTK; const int t = nb >= CTX ? nb - CTX : 0;
            sq[g & 1] = *(const f32x4*)(ssq + (size_t)row * 8 + (isq ? 0 : 4));
#pragma unroll
            for (int bj = 0; bj < 2; ++bj) if (rp[bj] >= 0) { const f32x4* p = (const f32x4*)(ropeR + ((size_t)t * 16 + rp[bj]) * 2); tb[g & 1][bj][0] = p[0]; tb[g & 1][bj][1] = p[1]; }
        };
        ld(0);
#pragma unroll
        for (int g = 0; g < 8; ++g) {
            const int ai = g >> 2, m = g & 3;
            const int row = rowof(g);
            const bool latent = (row % NTK) >= CTX;
            if (g + 1 < 8) ld(g + 1);
            const f32x4 s4 = sq[g & 1];
            const float ssum = (s4[0] + s4[1]) + (s4[2] + s4[3]);
            const float rstd = __builtin_amdgcn_rsqf(ssum * (isq ? (1.f / 256.f) : (1.f / 128.f)) + EPS);
#pragma unroll
            for (int bj = 0; bj < 2; ++bj) {
                f32x4 v0 = acc[ai][bj][m][0] * rstd, v1 = acc[ai][bj][m][1] * rstd;
                if (isq) {
                    if (col0[bj] < 384) {
                        if (rp[bj] >= 0) {
                            f32x4 t0 = tb[g & 1][bj][0], t1 = tb[g & 1][bj][1];
                            if (!latent) { t0 = (f32x4){1.f, 0.f, 1.f, 0.f}; t1 = t0; }
                            const f32x4 tt[2] = {t0, t1};
                            rope4(v0, v1, tt);
                        }
                        *(u32x4*)(QM + (size_t)row * 384 + col0[bj]) = pack8(v0, v1);
                    }
                } else *(u32x4*)(KVM + (size_t)row * 512 + col0[bj]) = pack8(v0, v1);
            }
        }
    }
};
struct EpiWout {
    static constexpr bool PERM = true, PROBE = false; static constexpr int NST = 16;
    bf16_t* X; const float* modl;
    __device__ __forceinline__ void operator()(const f32x4 (&acc)[2][2][4][2], const Unit& u, int wr, int wc, int fr, int fq) const {
        const int b = u.pm / 9, modrow = (u.pm - b * 9 == 0) ? 16 : b;
        const float* gate = modl + (size_t)modrow * 6144 + 2 * D;
        const int col0 = u.pn * 256 + wc * 32 + 8 * fq;
        f32x4 gv[2][2];
#pragma unroll
        for (int bj = 0; bj < 2; ++bj)
#pragma unroll
            for (int n = 0; n < 2; ++n) gv[bj][n] = *(const f32x4*)(gate + col0 + bj * 128 + n * 4);
        u32x4 xq[2][2];
        auto rowp = [&](int g) { return X + (size_t)(u.pm * 256 + (g >> 2) * 128 + wr * 64 + (g & 3) * 16 + fr) * D + col0; };
        xq[0][0] = *(const u32x4*)(rowp(0)); xq[0][1] = *(const u32x4*)(rowp(0) + 128);
#pragma unroll
        for (int g = 0; g < 8; ++g) {
            const int ai = g >> 2, m = g & 3;
            if (g + 1 < 8) { xq[(g + 1) & 1][0] = *(const u32x4*)(rowp(g + 1)); xq[(g + 1) & 1][1] = *(const u32x4*)(rowp(g + 1) + 128); }
#pragma unroll
            for (int bj = 0; bj < 2; ++bj) {
                const u32x4 xw = xq[g & 1][bj];
                f32x4 x0 = {bflo(xw.x), bfhi(xw.x), bflo(xw.y), bfhi(xw.y)}, x1 = {bflo(xw.z), bfhi(xw.z), bflo(xw.w), bfhi(xw.w)};
                x0 += gv[bj][0] * (acc[ai][bj][m][0] * F8_INVM); x1 += gv[bj][1] * (acc[ai][bj][m][1] * F8_INVM);
                *(u32x4*)(rowp(g) + bj * 128) = pack8(x0, x1);
            }
        }
    }
};
__device__ __forceinline__ f32x4 swiglu4(f32x4 g, f32x4 up, float s) {
    g = __builtin_elementwise_min(g, (f32x4){7.0f, 7.0f, 7.0f, 7.0f});
    up = __builtin_elementwise_min(__builtin_elementwise_max(up, (f32x4){-7.0f, -7.0f, -7.0f, -7.0f}), (f32x4){7.0f, 7.0f, 7.0f, 7.0f});
    const f32x4 t = g * (-1.702f * LOG2E);
    f32x4 e; e[0] = __builtin_amdgcn_exp2f(t[0]); e[1] = __builtin_amdgcn_exp2f(t[1]); e[2] = __builtin_amdgcn_exp2f(t[2]); e[3] = __builtin_amdgcn_exp2f(t[3]);
    const f32x4 d = e + 1.0f;
    f32x4 r; r[0] = __builtin_amdgcn_rcpf(d[0]); r[1] = __builtin_amdgcn_rcpf(d[1]); r[2] = __builtin_amdgcn_rcpf(d[2]); r[3] = __builtin_amdgcn_rcpf(d[3]);
    return (g * r) * (up * s + s);
}
struct EpiGateUp {
    static constexpr bool PERM = true, PROBE = true; static constexpr int NST = 4;
    unsigned char* ACT; const float* bg; const float* bu;
    __device__ __forceinline__ void operator()(const f32x4 (&acc)[2][2][4][2], const Unit& u, int wr, int wc, int fr, int fq) const {
        const int colL = u.pn * 128 + wc * 32 + fq * 8;
        const f32x4 g0 = *(const f32x4*)(bg + (size_t)u.e * D + colL), g1 = *(const f32x4*)(bg + (size_t)u.e * D + colL + 4);
        const f32x4 u0 = *(const f32x4*)(bu + (size_t)u.e * D + colL), u1 = *(const f32x4*)(bu + (size_t)u.e * D + colL + 4);
#pragma unroll
        for (int ai = 0; ai < 2; ++ai)
#pragma unroll
            for (int mp = 0; mp < 2; ++mp) {
                u32x2 w8[2];
#pragma unroll
                for (int h = 0; h < 2; ++h) {
                    const int m = 2 * mp + h;
                    const f32x4 ga = acc[ai][0][m][0] * F8_INV + g0, gb = acc[ai][0][m][1] * F8_INV + g1, ua = acc[ai][1][m][0] * F8_INV + u0, ub = acc[ai][1][m][1] * F8_INV + u1;
                    const f32x4 ra = swiglu4(ga, ua, F8_SA), rb = swiglu4(gb, ub, F8_SA);
                    w8[h].x = (unsigned)__builtin_amdgcn_cvt_pk_fp8_f32(ra[2], ra[3], __builtin_amdgcn_cvt_pk_fp8_f32(ra[0], ra[1], 0, false), true);
                    w8[h].y = (unsigned)__builtin_amdgcn_cvt_pk_fp8_f32(rb[2], rb[3], __builtin_amdgcn_cvt_pk_fp8_f32(rb[0], rb[1], 0, false), true);
                }
                const auto sx = __builtin_amdgcn_permlane16_swap(w8[0].x, w8[1].x, false, false), sy = __builtin_amdgcn_permlane16_swap(w8[0].y, w8[1].y, false, false);
                const int srow = u.pm * 256 + ai * 128 + wr * 64 + (2 * mp + (fq & 1)) * 16 + fr;
                u32x4 w16; w16.x = sx[0]; w16.y = sy[0]; w16.z = sx[1]; w16.w = sy[1];
                *(u32x4*)(ACT + (size_t)srow * D + (u.pn * 128 + wc * 32 + (fq & 2) * 8)) = w16;
            }
    }
};
struct EpiDown {
    static constexpr bool PERM = true, PROBE = true; static constexpr int NST = 8;
    bf16_t* Y; const float* bd; const float* slot_w;
    __device__ __forceinline__ void operator()(const f32x4 (&acc)[2][2][4][2], const Unit& u, int wr, int wc, int fr, int fq) const {
        const int col0 = u.pn * 256 + wc * 32 + fq * 8;
        f32x4 bv[2][2];
#pragma unroll
        for (int bj = 0; bj < 2; ++bj)
#pragma unroll
            for (int n = 0; n < 2; ++n) bv[bj][n] = *(const f32x4*)(bd + (size_t)u.e * D + col0 + bj * 128 + n * 4);
        float wv[8];
#pragma unroll
        for (int g = 0; g < 8; ++g) { const int pos = u.j * 256 + (g >> 2) * 128 + wr * 64 + (g & 3) * 16 + fr; wv[g] = slot_w[(size_t)u.e * T + min(pos, u.cnt - 1)]; }
#pragma unroll
        for (int g = 0; g < 8; ++g) { const int pos = u.j * 256 + (g >> 2) * 128 + wr * 64 + (g & 3) * 16 + fr; wv[g] = pos < u.cnt ? wv[g] : 0.f; }
#pragma unroll
        for (int ai = 0; ai < 2; ++ai)
#pragma unroll
            for (int mp = 0; mp < 2; ++mp) {
                const int rl = ai * 128 + wr * 64 + (2 * mp + (fq & 1)) * 16 + fr;
#pragma unroll
                for (int bj = 0; bj < 2; ++bj) {
                    u32x2 w8[2];
#pragma unroll
                    for (int h = 0; h < 2; ++h) {
                        const int m = 2 * mp + h; const float w = wv[ai * 4 + m];
                        const f32x4 v0 = (acc[ai][bj][m][0] * F8_INV + bv[bj][0]) * (w * F8_SY), v1 = (acc[ai][bj][m][1] * F8_INV + bv[bj][1]) * (w * F8_SY);
                        w8[h].x = (unsigned)__builtin_amdgcn_cvt_pk_fp8_f32(v0[2], v0[3], __builtin_amdgcn_cvt_pk_fp8_f32(v0[0], v0[1], 0, false), true);
                        w8[h].y = (unsigned)__builtin_amdgcn_cvt_pk_fp8_f32(v1[2], v1[3], __builtin_amdgcn_cvt_pk_fp8_f32(v1[0], v1[1], 0, false), true);
                    }
                    const auto sx = __builtin_amdgcn_permlane16_swap(w8[0].x, w8[1].x, false, false), sy = __builtin_amdgcn_permlane16_swap(w8[0].y, w8[1].y, false, false);
                    u32x4 w16; w16.x = sx[0]; w16.y = sy[0]; w16.z = sx[1]; w16.w = sy[1];
                    *(u32x4*)((unsigned char*)Y + (size_t)(u.pm * 256 + rl) * D + (u.pn * 256 + wc * 32 + (fq & 2) * 8) + bj * 128) = w16;
                }
            }
    }
};
}

__device__ __forceinline__ int winmap(int p, float& sc) {
    sc = 1.f;
    if (p < 384) return p;
    if (p < 416) return 384 + il(p - 384, 32);
    if (p < 512) return -1;
    if (p < 768)  { const int q = p - 512;  sc = SC_DIFF; return 416 + (q & ~31) + il(q & 31, 32); }
    if (p < 1024) { const int q = p - 768;  return 672 + (q & ~31) + il(q & 31, 32); }
    if (p < 1280) return 928 + (p - 1024);
    if (p < 1792) { const int q = p - 1280; sc = SC_SWA; return 1184 + (q & ~63) + il(q & 63, 64); }
    if (p < 1920) { const int q = p - 1792; return 1696 + (q & ~63) + il(q & 63, 64); }
    return 1824 + (p - 1920);
}
__device__ __forceinline__ int uqmap(int n) {
    if (n >= 384) return -1;
    const int h = n / 96, i = n - h * 96;
    return h * 96 + (i < 64 ? i : 64 + il(i - 64, 32));
}
struct CvtItem { const float* src; int ld, kvalid, k0, n0, nrows, mapkind, ldd; bf16_t* dst; const float* rowscale; };
constexpr int CVT_PER_LAYER = 256 + 16 + 16 + 8;
constexpr int CVT_ITEMS = NL * CVT_PER_LAYER;
__device__ __forceinline__ void cvt_decode(const Args& a, unsigned char* ws, int it, CvtItem& c) {
    const int l = it / CVT_PER_LAYER; int r = it - l * CVT_PER_LAYER;
    c.rowscale = nullptr; c.mapkind = 0; c.nrows = 64;
    if (r < 256) { c.src = a.in[7] + (size_t)l * D * 1952; c.ld = 1952; c.kvalid = D; c.k0 = (r >> 5) * 128; c.n0 = (r & 31) * 64; c.mapkind = 1; c.ldd = D;
        c.dst = (bf16_t*)(ws + WS_WIN + ((size_t)l * PW * D + (size_t)c.n0 * D)); return; }
    r -= 256;
    if (r < 16) { c.src = a.in[9] + (size_t)l * 256 * 384; c.ld = 384; c.kvalid = 256; c.k0 = (r >> 3) * 128; c.n0 = (r & 7) * 64; c.mapkind = 2; c.ldd = 256; c.rowscale = a.in[8] + l * 256;
        c.dst = (bf16_t*)(ws + WS_WUQ) + (size_t)l * 512 * 256 + (size_t)c.n0 * 256; return; }
    r -= 16;
    if (r < 16) { c.src = a.in[11] + (size_t)l * 128 * 512; c.ld = 512; c.kvalid = 128; c.k0 = (r >> 3) * 128; c.n0 = (r & 7) * 64; c.ldd = 256; c.rowscale = a.in[10] + l * 128;
        c.dst = (bf16_t*)(ws + WS_WUKV) + (size_t)l * 512 * 256 + (size_t)c.n0 * 256; return; }
    r -= 16;
    c.src = a.in[17] + (size_t)l * D * 32; c.ld = 32; c.kvalid = D; c.k0 = r * 128; c.n0 = 0; c.nrows = 32; c.mapkind = 3; c.ldd = D;
    c.dst = (bf16_t*)(ws + WS_WR) + (size_t)l * 32 * D;
}
constexpr int FAST_MATS = NL * (1 + 3 * NE);
constexpr int FAST_ITEMS = FAST_MATS * 256;
constexpr int FAST_PER_LAYER = (1 + 3 * NE) * 256;
constexpr int CONV_CHUNK = 64, CONV_NCHUNK = FAST_PER_LAYER / CONV_CHUNK;
__device__ __forceinline__ void fast_decode(const Args& a, unsigned char* ws, int it, const float*& src, unsigned char*& dst8, bool& f8) {
    const int mat = it >> 8, tile = it & 255, k0 = (tile >> 4) * 64, n0 = (tile & 15) * 64;
    const int l = mat / (1 + 3 * NE); int r = mat - l * (1 + 3 * NE);
    const float* sb;
    if (r == 0) { sb = a.in[15] + (size_t)l * D * D; dst8 = ws + WS_WOUT + ((size_t)l * D * D + (size_t)n0 * D + k0); f8 = true; }
    else { r -= 1; const int e = r / 3, which = r - e * 3; const size_t le = (size_t)l * NE + e; f8 = true;
        if (which == 0)      { sb = a.in[19] + le * D * D; dst8 = ws + WS_WGU + le * 2048 * D + (size_t)((n0 >> 7) * 256 + (n0 & 127)) * D + k0; }
        else if (which == 1) { sb = a.in[21] + le * D * D; dst8 = ws + WS_WGU + le * 2048 * D + (size_t)((n0 >> 7) * 256 + 128 + (n0 & 127)) * D + k0; }
        else                 { sb = a.in[23] + le * D * D; dst8 = ws + WS_WD + le * D * D + (size_t)n0 * D + k0; } }
    src = sb + (size_t)k0 * D + n0;
}
__device__ __forceinline__ void fast_convert(Frame& F, const Args& a, int tid, int it0, int it1, int gw, int NGW) {
    unsigned char* ws = F.ws;
    const int lane = tid & 63, q = lane >> 4, c4 = (lane & 15) * 4;
    LAS unsigned char* tl = F.lds + F.wave * 8704;
    f32x4 v[16]; const float* src; unsigned char* dst8; bool f8;
#define FAST_LOAD() do { _Pragma("unroll") for (int x = 0; x < 16; ++x) { const int kr = f8 ? 16 * (x >> 2) + 4 * q + (x & 3) : 8 * (x >> 1) + 2 * q + (x & 1); \
        v[x] = __builtin_nontemporal_load((const f32x4*)(src + (size_t)kr * D + c4)); } } while (0)
    int it = it0 + gw;
    if (it < it1) { fast_decode(a, ws, it, src, dst8, f8); FAST_LOAD(); }
    for (; it < it1; it += NGW) {
        unsigned char* cdst = dst8; const bool cf8 = f8;
        if (cf8) {
#pragma unroll
            for (int i = 0; i < 4; ++i)
#pragma unroll
                for (int j = 0; j < 4; ++j)
                    *(LAS unsigned*)(tl + (c4 + j) * 68 + 16 * i + 4 * q) = (unsigned)__builtin_amdgcn_cvt_pk_fp8_f32(v[4 * i + 2][j] * F8_SW, v[4 * i + 3][j] * F8_SW, __builtin_amdgcn_cvt_pk_fp8_f32(v[4 * i][j] * F8_SW, v[4 * i + 1][j] * F8_SW, 0, false), true);
        } else {
#pragma unroll
            for (int i = 0; i < 8; ++i)
#pragma unroll
                for (int j = 0; j < 4; ++j) *(LAS unsigned*)(tl + (c4 + j) * 136 + (8 * i + 2 * q) * 2) = cvtpk(v[2 * i][j], v[2 * i + 1][j]);
        }
        const int nx = it + NGW;
        if (nx < it1) { fast_decode(a, ws, nx, src, dst8, f8); FAST_LOAD(); }
        asm volatile("s_waitcnt lgkmcnt(0)" ::: "memory");
        if (cf8) {
#pragma unroll
            for (int p = 0; p < 4; ++p) {
                const int n = 16 * p + (lane >> 2), c = lane & 3;
                const LAS unsigned* t4 = (const LAS unsigned*)(tl + n * 68 + c * 16);
                u32x4 w; w.x = t4[0]; w.y = t4[1]; w.z = t4[2]; w.w = t4[3];
                __builtin_nontemporal_store(w, (u32x4*)(cdst + (size_t)n * D + c * 16));
            }
        } else {
#pragma unroll
            for (int p = 0; p < 8; ++p) {
                const int n = 8 * p + (lane >> 3), c = lane & 7;
                const u32x2 lo = *(const LAS u32x2*)(tl + n * 136 + c * 16), hi2 = *(const LAS u32x2*)(tl + n * 136 + c * 16 + 8);
                u32x4 w; w.x = lo.x; w.y = lo.y; w.z = hi2.x; w.w = hi2.y;
                __builtin_nontemporal_store(w, (u32x4*)(cdst + (size_t)n * D * 2 + c * 16));
            }
        }
        asm volatile("s_waitcnt lgkmcnt(0)" ::: "memory");
    }
#undef FAST_LOAD
}
__device__ __forceinline__ void cvt_load(const CvtItem& c, int tid, float (&v)[16]) {
    const int nn = tid & 63, kk = tid >> 6;
    float sc = 1.f; int sn;
    if (c.mapkind == 1) sn = winmap(c.n0 + nn, sc);
    else if (c.mapkind == 2) { sn = uqmap(c.n0 + nn); sc = SC_MLA; }
    else if (c.mapkind == 3) sn = nn < 32 ? nn : -1;
    else sn = c.n0 + nn;
#pragma unroll
    for (int i = 0; i < 16; ++i) {
        const int k = c.k0 + kk + 8 * i;
        float x = 0.f;
        if (sn >= 0 && k < c.kvalid) { x = c.src[(size_t)k * c.ld + sn] * sc; if (c.rowscale) x *= c.rowscale[k]; }
        v[i] = x;
    }
}
__device__ __forceinline__ void prologue_phase(Frame& F, const Args& a) {
    unsigned char* ws = F.ws;
    const int tid = opaque_tid();
    __syncthreads();
    {
        LAS unsigned short* tile = (LAS unsigned short*)F.lds;
        float v[16]; CvtItem c;
        int it = F.vcu;
        if (it < CVT_ITEMS) { cvt_decode(a, ws, it, c); cvt_load(c, tid, v); }
        for (; it < CVT_ITEMS; it += F.G) {
            const int nn = tid & 63, kk = tid >> 6;
            const bool f8 = (c.mapkind == 1);
            if (f8) {
                LAS unsigned char* t8 = (LAS unsigned char*)tile;
#pragma unroll
                for (int i = 0; i < 16; ++i) t8[nn * 132 + kk + 8 * i] = (unsigned char)(__builtin_amdgcn_cvt_pk_fp8_f32(v[i] * F8_SW, 0.f, 0, false) & 0xff);
            } else {
#pragma unroll
                for (int i = 0; i < 16; ++i) tile[nn * 130 + kk + 8 * i] = (unsigned short)(cvtpk(v[i], 0.f) & 0xffffu);
            }
            __syncthreads();
            const CvtItem cc = c;
            const int nx = it + F.G;
            if (nx < CVT_ITEMS) { cvt_decode(a, ws, nx, c); cvt_load(c, tid, v); }
            const LAS unsigned* t32 = (const LAS unsigned*)tile;
            if (f8) {
                const int n = tid >> 3, ch = tid & 7;
                u32x4 w; const LAS unsigned* s = t32 + n * 33 + ch * 4;
                w.x = s[0]; w.y = s[1]; w.z = s[2]; w.w = s[3];
                *(u32x4*)((unsigned char*)cc.dst + (size_t)n * cc.ldd + cc.k0 + ch * 16) = w;
            } else {
#pragma unroll
                for (int p = 0; p < 2; ++p) {
                    const int n = (tid >> 4) + 32 * p, ch = tid & 15;
                    if (n < cc.nrows) {
                        u32x4 w; const LAS unsigned* s = t32 + n * 65 + ch * 4;
                        w.x = s[0]; w.y = s[1]; w.z = s[2]; w.w = s[3];
                        *(u32x4*)(cc.dst + (size_t)n * cc.ldd + cc.k0 + ch * 8) = w;
                    }
                }
            }
            __syncthreads();
        }
    }
    {
        LAS float* sil = (LAS float*)F.lds;
        LAS float* part = (LAS float*)(F.lds + 1024 * 17 * 4);
        __syncthreads();
        for (int i = tid; i < 17 * D; i += NTHR) { const int r = i / D, k = i - r * D; const float x = r < 16 ? a.in[1][(size_t)r * D + k] : a.in[3][k]; sil[k * 17 + r] = x / (1.f + __expf(-x)); }
        __syncthreads();
        float* MOD = (float*)(ws + WS_MOD);
        const int col = tid & 63, kg = tid >> 6;
        for (int ch = F.vcu; ch < NL * 96; ch += F.G) {
            const int l = ch / 96, j0 = (ch - l * 96) * 64;
            const float* w = a.in[4] + (size_t)l * D * 6144 + j0 + col;
            float accv[17];
#pragma unroll
            for (int r = 0; r < 17; ++r) accv[r] = 0.f;
#pragma unroll 4
            for (int k = kg * 128; k < kg * 128 + 128; ++k) {
                const float wv = w[(size_t)k * 6144];
#pragma unroll
                for (int r = 0; r < 17; ++r) accv[r] += sil[k * 17 + r] * wv;
            }
#pragma unroll
            for (int r = 0; r < 17; ++r) part[(kg * 17 + r) * 64 + col] = accv[r];
            __syncthreads();
            for (int i = tid; i < 17 * 64; i += NTHR) {
                const int r = i >> 6, cc = i & 63; float s = 0.f;
#pragma unroll
                for (int g = 0; g < 8; ++g) s += part[(g * 17 + r) * 64 + cc];
                MOD[((size_t)l * 17 + r) * 6144 + j0 + cc] = s + a.in[5][(size_t)l * 6144 + j0 + cc];
            }
            __syncthreads();
        }
    }
    {
        const int gt = F.vcu * NTHR + tid, GT = F.G * NTHR;
        float* ropeR = (float*)(ws + WS_ROPER); float* ropeW = (float*)(ws + WS_ROPEW);
        for (int i = gt; i < SEQ * 48; i += GT) {
            int t, j; double f; float* dst;
            if (i < SEQ * 16) { t = i >> 4; j = i & 15; f = a.invf8[j & 7]; dst = ropeR + (size_t)i * 2; const int pos = (j < 8) ? (t >> 6) : (t & 63); f *= (double)pos; }
            else { const int ii = i - SEQ * 16; t = ii >> 5; j = ii & 31; f = a.invf16[j & 15]; dst = ropeW + (size_t)ii * 2; const int pos = (j < 16) ? (t >> 6) : (t & 63); f *= (double)pos; }
            const double n = __builtin_rint(f * 0.15915494309189535);
            const double r = (f - n * 6.283185307179586) - n * 2.4492935982947064e-16;
            const double r2 = r * r;
            double s = 1.0, cs = 1.0;
#pragma unroll
            for (int q = 27; q >= 3; q -= 2) s = 1.0 - s * r2 / (double)(q * (q - 1));
            s *= r;
#pragma unroll
            for (int q = 26; q >= 2; q -= 2) cs = 1.0 - cs * r2 / (double)(q * (q - 1));
            dst[0] = (float)cs; dst[1] = (float)s;
        }
        if (gt < NL) {
            const float* lam = a.in[12] + gt * 128; float s1 = 0.f, s2 = 0.f;
            for (int k = 0; k < 32; ++k) { s1 += lam[k] * lam[32 + k]; s2 += lam[64 + k] * lam[96 + k]; }
            ((float*)(ws + WS_CTL))[CW_LAM + gt] = expf(s1) - expf(s2) + a.lam_init[gt];
        }
    }
}

__device__ __forceinline__ void load_counts(Frame& F, int l) {
    volatile LAS int* PB = (volatile LAS int*)(F.lds + MISC_OFF + 256);
    volatile LAS int* CNT = (volatile LAS int*)(F.lds + MISC_OFF + 512);
    __syncthreads();
    const int tid = opaque_tid(), lane = tid & 63;
    if (tid < 64) {
        const unsigned* cur = (const unsigned*)(F.ws + WS_CTL) + CW_CUR + l * 32;
        const int c = lane < 32 ? (int)cur[lane] : 0;
        const int np = (c + 255) >> 8;
        int incl = np;
#pragma unroll
        for (int o = 1; o < 32; o <<= 1) { const int y = __shfl_up(incl, o); if ((lane & 31) >= o) incl += y; }
        if (lane < 32) { PB[lane + 1] = incl; CNT[lane] = c; }
        if (lane == 0) PB[0] = 0;
    }
    __syncthreads();
}
template <int MODE, bool FIRST> __device__ __forceinline__ void norm1_phase(Frame& F, const Args& a, int l, bool dummy = false) {
    unsigned char* ws = F.ws;
    bf16_t* X = (bf16_t*)(ws + WS_X); bf16_t* H = (bf16_t*)(ws + WS_H); const bf16_t* Y = (const bf16_t*)(ws + WS_Y);
    bf16_t* Xw = dummy ? (bf16_t*)(ws + WS_ACT + 160 * MiB) : X; if (dummy) H = (bf16_t*)(ws + WS_ACT + 232 * MiB);
    const float* MOD = (const float*)(ws + WS_MOD);
    const unsigned* tokslot = (const unsigned*)(ws + WS_TOKSLOT);
    constexpr bool comb = (MODE == 1) || !FIRST;
    constexpr int NR = FIRST ? 4 : 2;
    const int lp = (MODE == 1) ? NL - 1 : l - 1;
    if (comb) load_counts(F, lp);
    volatile LAS int* PB = (volatile LAS int*)(F.lds + MISC_OFF + 256);
    const int lane = opaque_tid() & 63;
    int vcu_ = F.vcu; asm volatile("" : "+s"(vcu_));
    const int gw = vcu_ * NWAVES + F.wave, NGW = F.G * NWAVES;
    const int nrows = (MODE == 1) ? NB * SEQ : T;
    const float* gvec = (MODE == 1) ? a.in[25] : a.in[6] + (size_t)l * D;
    f32x4 gv[4];
#pragma unroll
    for (int j = 0; j < 4; ++j) gv[j] = *(const f32x4*)(gvec + 16 * lane + 4 * j);
    auto rowinfo = [&](int ri, int& tok, int& bb, int& nb) { if (MODE == 1) { bb = ri >> 11; nb = CTX + (ri & 2047); tok = bb * NTK + nb; } else { tok = ri; bb = tok / NTK; nb = tok - bb * NTK; } };
    auto stageA = [&](int ri, u32x4 (&raw)[NR], u32x4& ts) {
        int tok, bb, nb; rowinfo(ri, tok, bb, nb);
        if constexpr (FIRST) {
            const float* src = nb < CTX ? a.in[2] + ((size_t)bb * CTX + nb) * D : a.in[0] + ((size_t)bb * SEQ + (nb - CTX)) * D;
#pragma unroll
            for (int j = 0; j < 4; ++j) raw[j] = *(const u32x4*)(src + 16 * lane + 4 * j);
        } else {
            const u32x4* xp = (const u32x4*)(X + (size_t)tok * D + 16 * lane); raw[0] = xp[0]; raw[1] = xp[1];
        }
        if (comb) ts = *(const u32x4*)(tokslot + (size_t)tok * 4);
    };
    auto stageB = [&](const u32x4& ts, u32x4 (&yv)[4]) {
#pragma unroll
        for (int k = 0; k < 4; ++k) {
            const unsigned w = ts[k]; const int e = (int)(w >> 16), pos = (int)(w & 0xffffu);
            const unsigned char* yr = (const unsigned char*)Y + ((size_t)PB[e] * 256 + pos) * D;
            yv[k] = *(const u32x4*)(yr + 16 * lane);
        }
    };
    auto stageC = [&](int ri, const u32x4 (&raw)[NR], const u32x4 (&yv)[4]) {
        __builtin_amdgcn_sched_barrier(0);
        int tok, bb, nb; rowinfo(ri, tok, bb, nb);
        const int modrow = nb < CTX ? 16 : bb;
        f32x4 v[4];
#pragma unroll
        for (int j = 0; j < 4; ++j) {
            if constexpr (FIRST) v[j] = __builtin_bit_cast(f32x4, raw[j]);
            else { const unsigned w0 = (j & 1) ? raw[j >> 1].z : raw[j >> 1].x, w1 = (j & 1) ? raw[j >> 1].w : raw[j >> 1].y; v[j] = (f32x4){bflo(w0), bfhi(w0), bflo(w1), bfhi(w1)}; }
        }
        if (comb) {
            const float* g5 = MOD + ((size_t)lp * 17 + modrow) * 6144 + 5 * D;
#pragma unroll
            for (int j = 0; j < 4; ++j) {
                f32x4 sj = (f32x4){0.f, 0.f, 0.f, 0.f};
#pragma unroll
                for (int k = 0; k < 4; ++k) { const unsigned y = yv[k][j]; const f32x2 lo = __builtin_amdgcn_cvt_pk_f32_fp8((int)y, false), hi2 = __builtin_amdgcn_cvt_pk_f32_fp8((int)y, true); sj[0] += lo[0]; sj[1] += lo[1]; sj[2] += hi2[0]; sj[3] += hi2[1]; }
                v[j] += *(const f32x4*)(g5 + 16 * lane + 4 * j) * (sj * (1.0f / F8_SY));
            }
        }
        float ss = 0.f;
#pragma unroll
        for (int j = 0; j < 4; ++j) ss += (v[j][0] * v[j][0] + v[j][1] * v[j][1]) + (v[j][2] * v[j][2] + v[j][3] * v[j][3]);
        const float rstd = 1.0f / sqrtf(wave_sum(ss) * (1.f / D) + EPS);
        if (MODE == 1) {
            float* o = a.out + (size_t)ri * D;
#pragma unroll
            for (int j = 0; j < 4; ++j) *(f32x4*)(o + 16 * lane + 4 * j) = v[j] * rstd * gv[j];
        } else {
            const float* mr = MOD + ((size_t)l * 17 + modrow) * 6144;
            u32x4 xb[2], h8;
#pragma unroll
            for (int j = 0; j < 4; ++j) {
                const unsigned p0 = cvtpk(v[j][0], v[j][1]), p1 = cvtpk(v[j][2], v[j][3]);
                if (j & 1) { xb[j >> 1].z = p0; xb[j >> 1].w = p1; } else { xb[j >> 1].x = p0; xb[j >> 1].y = p1; }
                const f32x4 sh = *(const f32x4*)(mr + 16 * lane + 4 * j), sc = *(const f32x4*)(mr + D + 16 * lane + 4 * j);
                const f32x4 h = (v[j] * rstd * gv[j] * (sc + 1.0f) + sh) * F8_SA;
                h8[j] = (unsigned)__builtin_amdgcn_cvt_pk_fp8_f32(h[2], h[3], __builtin_amdgcn_cvt_pk_fp8_f32(h[0], h[1], 0, false), true);
            }
            { u32x4* xp = (u32x4*)(Xw + (size_t)tok * D + 16 * lane); xp[0] = xb[0]; xp[1] = xb[1]; }
            *(u32x4*)((unsigned char*)H + (size_t)tok * D + 16 * lane) = h8;
        }
    };
    u32x4 rawC[NR], rawN[NR], rawF[NR]; u32x4 tsN = {0u, 0u, 0u, 0u}, tsF = {0u, 0u, 0u, 0u}, tsC = {0u, 0u, 0u, 0u}; u32x4 yC[4], yN[4];
    if (gw < nrows) stageA(gw, rawC, tsC);
    if (gw + NGW < nrows) stageA(gw + NGW, rawN, tsN);
    if (comb && gw < nrows) stageB(tsC, yC);
    for (int ri = gw; ri < nrows; ri += NGW) {
        if (ri + 2 * NGW < nrows) stageA(ri + 2 * NGW, rawF, tsF);
        if (comb && ri + NGW < nrows) stageB(tsN, yN);
        stageC(ri, rawC, yC);
#pragma unroll
        for (int j = 0; j < NR; ++j) { rawC[j] = rawN[j]; rawN[j] = rawF[j]; }
        tsN = tsF;
#pragma unroll
        for (int k = 0; k < 4; ++k) yC[k] = yN[k];
    }
}
__device__ __forceinline__ void norm2_router_phase(Frame& F, const Args& a, int l) {
    unsigned char* ws = F.ws;
    const bf16_t* X = (const bf16_t*)(ws + WS_X); unsigned char* H8 = (unsigned char*)(ws + WS_H);
    const float* MOD = (const float*)(ws + WS_MOD);
    unsigned* tokslot = (unsigned*)(ws + WS_TOKSLOT); int* slot_tok = (int*)(ws + WS_SLOTTOK); float* slot_w = (float*)(ws + WS_SLOTW);
    unsigned* cursor = (unsigned*)(ws + WS_CTL) + CW_CUR + l * 32;
    const bf16_t* Wr = (const bf16_t*)(ws + WS_WR) + (size_t)l * 32 * D;
    const bool last = (l == NL - 1);
    const int ngroups = last ? NB * SEQ / 32 : T / 32;
    const int tid = opaque_tid(), lane = tid & 63, wave = F.wave, r32 = lane & 31, hi = lane >> 5;
    constexpr int FT_RS = 2064;
    LAS unsigned char* FT = F.lds;
    LAS float* LP = (LAS float*)(F.lds + 32 * FT_RS);
    LAS float* LG = LP + 8 * 32 * 33;
    LAS int* lcnt = (LAS int*)(LG + 32 * 33);
    LAS int* lbase = lcnt + 32;
    bf16x8 wf[8];
#pragma unroll
    for (int s = 0; s < 8; ++s) wf[s] = *(const bf16x8*)(Wr + (size_t)r32 * D + (8 * wave + s) * 16 + hi * 8);
    const float* gvec = a.in[16] + (size_t)l * D;
    f32x4 gv[4];
#pragma unroll
    for (int j = 0; j < 4; ++j) gv[j] = *(const f32x4*)(gvec + 16 * lane + 4 * j);
    if (tid < 32) lcnt[tid] = 0;
    __syncthreads();
    auto ginfo = [&](int g, int& tok0, int& modrow) {
        int b; bool isctx;
        if (last) { b = g >> 6; tok0 = b * NTK + CTX + (g & 63) * 32; isctx = false; } else { tok0 = g * 32; b = tok0 / NTK; isctx = (tok0 - b * NTK) < CTX; }
        modrow = isctx ? 16 : b;
    };
    u32x4 xq[4][2], xn[4][2]; f32x4 shv[4], scv[4], shn[4], scn[4];
    auto gload = [&](int g, u32x4 (&x)[4][2], f32x4 (&sh)[4], f32x4 (&sc)[4]) {
        int tok0, modrow; ginfo(g, tok0, modrow);
        const float* mr = MOD + ((size_t)l * 17 + modrow) * 6144;
#pragma unroll
        for (int q = 0; q < 4; ++q) { const u32x4* xp = (const u32x4*)(X + (size_t)(tok0 + wave * 4 + q) * D + 16 * lane); x[q][0] = xp[0]; x[q][1] = xp[1]; }
#pragma unroll
        for (int j = 0; j < 4; ++j) { sh[j] = *(const f32x4*)(mr + 3 * D + 16 * lane + 4 * j); sc[j] = *(const f32x4*)(mr + 4 * D + 16 * lane + 4 * j); }
    };
    if ((int)F.vcu >= ngroups) return;
    const int glast = F.vcu + ((ngroups - 1 - F.vcu) / F.G) * F.G;
    gload(F.vcu, xq, shv, scv);
    for (int g = F.vcu; g < ngroups; g += F.G) {
        int tok0, modrow_; ginfo(g, tok0, modrow_);
        gload(min(g + F.G, glast), xn, shn, scn);
#pragma unroll
        for (int q = 0; q < 4; ++q) {
            const int rl = wave * 4 + q, tok = tok0 + rl;
            f32x4 v[4]; float ss = 0.f;
#pragma unroll
            for (int j = 0; j < 4; ++j) { const unsigned w0 = (j & 1) ? xq[q][j >> 1].z : xq[q][j >> 1].x, w1 = (j & 1) ? xq[q][j >> 1].w : xq[q][j >> 1].y;
                v[j] = (f32x4){bflo(w0), bfhi(w0), bflo(w1), bfhi(w1)}; ss += (v[j][0] * v[j][0] + v[j][1] * v[j][1]) + (v[j][2] * v[j][2] + v[j][3] * v[j][3]); }
            const float rstd = 1.0f / sqrtf(wave_sum(ss) * (1.f / D) + EPS);
            u32x4 h8; u32x4 hb[2];
#pragma unroll
            for (int j = 0; j < 4; ++j) {
                const f32x4 h = v[j] * rstd * gv[j] * (scv[j] + 1.0f) + shv[j];
                const unsigned p0 = cvtpk(h[0], h[1]), p1 = cvtpk(h[2], h[3]);
                if (j & 1) { hb[j >> 1].z = p0; hb[j >> 1].w = p1; } else { hb[j >> 1].x = p0; hb[j >> 1].y = p1; }
                h8[j] = (unsigned)__builtin_amdgcn_cvt_pk_fp8_f32(h[2] * F8_SA, h[3] * F8_SA, __builtin_amdgcn_cvt_pk_fp8_f32(h[0] * F8_SA, h[1] * F8_SA, 0, false), true);
            }
            *(u32x4*)(H8 + (size_t)tok * D + 16 * lane) = h8;
            LAS u32x4* fp = (LAS u32x4*)(FT + rl * FT_RS + 32 * lane); fp[0] = hb[0]; fp[1] = hb[1];
        }
#pragma unroll
        for (int q = 0; q < 4; ++q) { xq[q][0] = xn[q][0]; xq[q][1] = xn[q][1]; }
#pragma unroll
        for (int j = 0; j < 4; ++j) { shv[j] = shn[j]; scv[j] = scn[j]; }
        __syncthreads();
        {
            f32x16 acc = {};
#pragma unroll
            for (int s = 0; s < 8; ++s) {
                const bf16x8 af = *(const LAS bf16x8*)(FT + r32 * FT_RS + ((8 * wave + s) * 16 + hi * 8) * 2);
                acc = __builtin_amdgcn_mfma_f32_32x32x16_bf16(af, wf[s], acc, 0, 0, 0);
            }
#pragma unroll
            for (int r = 0; r < 16; ++r) { const int row = (r & 3) + 8 * (r >> 2) + 4 * hi; LP[(wave * 32 + row) * 33 + r32] = acc[r]; }
        }
        __syncthreads();
        for (int i = tid; i < 1024; i += NTHR) {
            const int row = i >> 5, e = i & 31; float s = a.in[18][l * 32 + e];
#pragma unroll
            for (int w = 0; w < 8; ++w) s += LP[(w * 32 + row) * 33 + e];
            LG[row * 33 + e] = s;
        }
        __syncthreads();
        int te[4]; float tw[4]; int rk[4];
        if (tid < 32) {
            float lv[32];
#pragma unroll
            for (int e = 0; e < 32; ++e) lv[e] = LG[tid * 33 + e];
            float tv[4];
#pragma unroll
            for (int k = 0; k < 4; ++k) {
                float best = -3.0e38f; int bi = 0;
#pragma unroll
                for (int e = 0; e < 32; ++e) { const bool up = lv[e] > best; best = up ? lv[e] : best; bi = up ? e : bi; }
                tv[k] = best; te[k] = bi;
#pragma unroll
                for (int e = 0; e < 32; ++e) lv[e] = (e == bi) ? -3.0e38f : lv[e];
            }
            const float e1 = __expf(tv[1] - tv[0]), e2 = __expf(tv[2] - tv[0]), e3 = __expf(tv[3] - tv[0]);
            const float inv = 1.0f / (1.0f + e1 + e2 + e3);
            tw[0] = inv; tw[1] = e1 * inv; tw[2] = e2 * inv; tw[3] = e3 * inv;
#pragma unroll
            for (int k = 0; k < 4; ++k) rk[k] = atomicAdd((int*)&lcnt[te[k]], 1);
        }
        __syncthreads();
        if (tid < 32) { const int c = lcnt[tid]; lbase[tid] = c ? (int)atomicAdd(&cursor[tid], (unsigned)c) : 0; }
        __syncthreads();
        if (tid < 32) {
            const int tok = tok0 + tid; u32x4 ts;
#pragma unroll
            for (int k = 0; k < 4; ++k) { const int pos = lbase[te[k]] + rk[k]; slot_tok[(size_t)te[k] * T + pos] = tok; slot_w[(size_t)te[k] * T + pos] = tw[k]; ts[k] = ((unsigned)te[k] << 16) | (unsigned)pos; }
            *(u32x4*)(tokslot + (size_t)tok * 4) = ts;
            lcnt[tid] = 0;
        }
        __syncthreads();
    }
}

struct AttnPtrs { const bf16_t* P; const bf16_t* QM; const bf16_t* KVM; unsigned char* MIX; const float* sink; const float* subg; float lam_full, one_m_li; };
constexpr int KB_OFF0 = 0, KB_STRIDE = 16384, VB_OFF0 = 32768, VB_STRIDE = 12288, XCH_OFF = 81920;
#define ATT_PIN(x) asm volatile("" : "+v"(x))
#define ATT_SBAR() __builtin_amdgcn_sched_barrier(0)
#define ATT_THR 8.0f
#ifndef ATT_PF
#define ATT_PF 2
#endif
template <int KIND> __device__ __forceinline__ void attn_unit(const AttnPtrs& A, int b, int h, int qblk, LAS unsigned char* lds, unsigned& qnext) {
    constexpr int DQK = KIND == 0 ? 96 : (KIND == 1 ? 32 : 64);
    constexpr int NF = DQK / 16, RSK = DQK * 2 + 16, RSV = 192, NMF = 8 + 2 * NF;
    const int tid = opaque_tid(), lane = tid & 63, r32 = lane & 31, hi = lane >> 5, wid = __builtin_amdgcn_readfirstlane(tid >> 6);
    const size_t tokb = (size_t)b * NTK;
    const int mp = KIND == 1 ? (wid >> 2) : 0;
    const int qrow0 = KIND == 1 ? qblk * 128 + (wid & 3) * 32 : qblk * 256 + wid * 32;
    const bool ctxunit = KIND == 1 ? (qblk < 2) : (qblk == 0);
    const size_t tokq = tokb + qrow0 + r32;
    const int kvh = h >> 2;
    bf16x8 qf[NF];
#pragma unroll
    for (int d0 = 0; d0 < NF; ++d0) {
        const bf16_t* src = KIND == 0 ? A.QM + tokq * 384 + h * 96 + d0 * 16 + hi * 8
                          : KIND == 1 ? A.P + tokq * PW + 512 + (2 * h + mp) * 32 + d0 * 16 + hi * 8
                                      : A.P + tokq * PW + 1280 + h * 64 + d0 * 16 + hi * 8;
        qf[d0] = *(const bf16x8*)src;
    }
    float mrun = 0.f, lrun = 0.f; f32x16 o[2]; o[0] = f32x16{}; o[1] = f32x16{};
    f32x16 negm = f32x16{};
    const int T0 = KIND == 2 ? (qblk - 1) * 256 : 0;
    int ntile, ttlo = 0;
    if (ctxunit) ntile = 4;
    else if (KIND == 2) { ttlo = max(0, (T0 >> 6) - 2); const int tthi = min(31, (T0 >> 6) + 5); ntile = 4 + (tthi - ttlo + 1); }
    else ntile = 36;
#define TILE_OF(i) ((KIND == 2 && (i) >= 4) ? 4 + ttlo + ((i) - 4) : (i))
    u32x4 krA0, krA1, vrA, krB0, krB1, vrB;
    const char* kp0; const char* kp1 = nullptr; const char* vp; unsigned ks0, ks1 = 0u, vs;
    if (KIND == 0) {
        { const int row = tid / 12, ch = tid - row * 12; const size_t tok = tokb + row;
          kp0 = ch < 8 ? (const char*)(A.KVM + tok * 512 + h * 128 + ch * 8) : (const char*)(A.P + tok * PW + 384 + (ch - 8) * 8); ks0 = ch < 8 ? 64u * 512u * 2u : 64u * PW * 2u; }
        { const int q = (tid & 255) + 512, row = q / 12, ch = q - row * 12; const size_t tok = tokb + row;
          kp1 = ch < 8 ? (const char*)(A.KVM + tok * 512 + h * 128 + ch * 8) : (const char*)(A.P + tok * PW + 384 + (ch - 8) * 8); ks1 = ch < 8 ? 64u * 512u * 2u : 64u * PW * 2u; }
        { const int row = tid >> 3, ch = tid & 7; vp = (const char*)(A.KVM + (tokb + row) * 512 + h * 128 + 64 + ch * 8); vs = 64u * 512u * 2u; }
    } else if (KIND == 1) {
        { const int m2 = tid >> 8, row = (tid & 255) >> 2, ch = tid & 3; kp0 = (const char*)(A.P + (tokb + row) * PW + 768 + (2 * h + m2) * 32 + ch * 8); ks0 = 64u * PW * 2u; }
        { const int row = tid >> 3, ch = tid & 7; vp = (const char*)(A.P + (tokb + row) * PW + 1024 + h * 64 + ch * 8); vs = 64u * PW * 2u; }
    } else {
        const int row = tid >> 3, ch = tid & 7;
        kp0 = (const char*)(A.P + (tokb + row) * PW + 1792 + kvh * 64 + ch * 8); ks0 = 64u * PW * 2u;
        vp = (const char*)(A.P + (tokb + row) * PW + 1920 + kvh * 64 + ch * 8); vs = 64u * PW * 2u;
    }
    auto gload = [&](int tt, u32x4& kr0, u32x4& kr1, u32x4& vr) {
        kr0 = *(const u32x4*)(kp0 + (size_t)tt * ks0);
        if (KIND == 0) kr1 = *(const u32x4*)(kp1 + (size_t)tt * ks1);
        vr = *(const u32x4*)(vp + (size_t)tt * vs);
    };
    auto lstore = [&](int i, const u32x4& kr0, const u32x4& kr1, const u32x4& vr) {
        LAS unsigned char* kb = lds + KB_OFF0 + (i & 1) * KB_STRIDE; LAS unsigned char* vb = lds + VB_OFF0 + (i & 3) * VB_STRIDE;
        if (KIND == 0) {
            { const int row = tid / 12, ch = tid - row * 12; *(LAS u32x4*)(kb + row * RSK + ch * 16) = kr0; }
            if (tid < 256) { const int q = tid + 512, row = q / 12, ch = q - row * 12; *(LAS u32x4*)(kb + row * RSK + ch * 16) = kr1; }
        } else if (KIND == 1) {
            const int m2 = tid >> 8, row = (tid & 255) >> 2, ch = tid & 3; *(LAS u32x4*)(kb + m2 * 8192 + row * RSK + ch * 16) = kr0;
        } else { const int row = tid >> 3, ch = tid & 7; *(LAS u32x4*)(kb + row * RSK + ch * 16) = kr0; }
        { const int row = tid >> 3, ch = tid & 7; *(LAS u32x4*)(vb + row * RSV + ch * 16) = vr; }
    };
    const int qpos = T0 + wid * 32 + r32;
    const int koff = (KIND == 1 ? mp * 8192 : 0) + r32 * RSK + hi * 16;
    const int voff = ((lane >> 4) & 1) * 32 + (lane & 3) * 8 + (4 * hi + ((lane & 15) >> 2)) * RSV;
    auto fetch = [&](int j, const LAS unsigned char* vb, const LAS unsigned char* kb) -> bf16x8 {
        if (j < 8) {
            const int sI = j >> 1, d0 = j & 1;
            const v4i16_t lo = __builtin_amdgcn_ds_read_tr16_b64_v4i16((LAS v4i16_t*)(vb + voff + (16 * sI) * RSV + d0 * 64));
            const v4i16_t hh = __builtin_amdgcn_ds_read_tr16_b64_v4i16((LAS v4i16_t*)(vb + voff + (16 * sI + 8) * RSV + d0 * 64));
            return (bf16x8){lo[0], lo[1], lo[2], lo[3], hh[0], hh[1], hh[2], hh[3]};
        } else {
            const int d0 = (j - 8) >> 1, half = (j - 8) & 1;
            return *(const LAS bf16x8*)(kb + koff + half * 32 * RSK + d0 * 32);
        }
    };
    gload(TILE_OF(0), krA0, krA1, vrA); gload(TILE_OF(1), krB0, krB1, vrB);
    lstore(0, krA0, krA1, vrA); lstore(1, krB0, krB1, vrB);
    gload(TILE_OF(2), krA0, krA1, vrA);
    qnext = (unsigned)__builtin_amdgcn_readfirstlane((int)qnext);
    __syncthreads();
    f32x16 pA0 = f32x16{}, pA1 = f32x16{}, pB0, pB1;
    {
        const LAS unsigned char* kb = lds + KB_OFF0;
#pragma unroll
        for (int d0 = 0; d0 < NF; ++d0) {
            const bf16x8 k0 = *(const LAS bf16x8*)(kb + koff + d0 * 32), k1 = *(const LAS bf16x8*)(kb + koff + 32 * RSK + d0 * 32);
            pA0 = __builtin_amdgcn_mfma_f32_32x32x16_bf16(k0, qf[d0], pA0, 0, 0, 0);
            pA1 = __builtin_amdgcn_mfma_f32_32x32x16_bf16(k1, qf[d0], pA1, 0, 0, 0);
        }
    }
    bf16x8 paX[4], paY[4];
#pragma unroll
    for (int sI = 0; sI < 4; ++sI) { paX[sI] = (bf16x8){0, 0, 0, 0, 0, 0, 0, 0}; paY[sI] = (bf16x8){0, 0, 0, 0, 0, 0, 0, 0}; }
    __syncthreads();
#define ATT_STEP(C0, C1, N0, N1, PP, PC, i) do { \
        const int tt_ = TILE_OF(i); \
        if (KIND == 2 && !ctxunit && tt_ >= 4) { \
            const int k0_ = (tt_ - 4) * 64, tw_ = T0 + wid * 32; \
            if (k0_ + 63 - tw_ > 128 || k0_ - (tw_ + 31) < -128) {     \
                const int kbase_ = k0_ + 4 * hi - qpos; \
                _Pragma("unroll") for (int r = 0; r < 16; ++r) { const int dk = kbase_ + (r & 3) + 8 * (r >> 2); if (dk > 128 || dk < -128) C0[r] = -1.0e30f; if (dk + 32 > 128 || dk + 32 < -128) C1[r] = -1.0e30f; } \
            } \
        } \
        const LAS unsigned char* vb_ = lds + VB_OFF0 + (((i) == 0 ? 0 : (i) - 1) & 3) * VB_STRIDE;                  \
        const LAS unsigned char* kb_ = lds + KB_OFF0 + (((i) + 1 < ntile ? (i) + 1 : (i)) & 1) * KB_STRIDE;       \
        bf16x8 op_[ATT_PF + 1]; _Pragma("unroll") for (int j = 0; j < ATT_PF; ++j) op_[j] = fetch(j, vb_, kb_); \
        float mx_ = -3.0e38f, alpha_ = 1.f; f32x2 ls2_ = {0.f, 0.f}; bool grow_ = false; \
        ATT_SBAR(); \
        _Pragma("unroll") for (int k = 0; k < 20; ++k) { \
            if (k + ATT_PF < NMF) op_[(k + ATT_PF) % (ATT_PF + 1)] = fetch(k + ATT_PF, vb_, kb_); \
            if (k < 8) { o[k & 1] = __builtin_amdgcn_mfma_f32_32x32x16_bf16(op_[k % (ATT_PF + 1)], PP[k >> 1], o[k & 1], 0, 0, 0); } \
            else if (k < NMF) { const int j_ = k - 8; \
                if (j_ == 0) N0 = __builtin_amdgcn_mfma_f32_32x32x16_bf16(op_[k % (ATT_PF + 1)], qf[0], negm, 0, 0, 0); \
                else if (j_ == 1) N1 = __builtin_amdgcn_mfma_f32_32x32x16_bf16(op_[k % (ATT_PF + 1)], qf[0], negm, 0, 0, 0); \
                else if (j_ & 1) N1 = __builtin_amdgcn_mfma_f32_32x32x16_bf16(op_[k % (ATT_PF + 1)], qf[j_ >> 1], N1, 0, 0, 0); \
                else N0 = __builtin_amdgcn_mfma_f32_32x32x16_bf16(op_[k % (ATT_PF + 1)], qf[j_ >> 1], N0, 0, 0, 0); } \
            if (k < 4) { float a_ = fmaxf(fmaxf(C0[4 * k], C0[4 * k + 1]), C0[4 * k + 2]); a_ = fmaxf(fmaxf(a_, C0[4 * k + 3]), C1[4 * k]); a_ = fmaxf(fmaxf(a_, C1[4 * k + 1]), C1[4 * k + 2]); a_ = fmaxf(a_, C1[4 * k + 3]); mx_ = fmaxf(mx_, a_); ATT_PIN(mx_); } \
            else if (k == 4) { auto rr_ = __builtin_amdgcn_permlane32_swap(__float_as_uint(mx_), __float_as_uint(mx_), false, false); mx_ = fmaxf(__uint_as_float(rr_[0]), __uint_as_float(rr_[1])); \
                  \
                const bool far_ = ((i) == 0) ? (fabsf(mx_) > ATT_THR) : (mx_ > ATT_THR); \
                grow_ = __builtin_amdgcn_ballot_w64(far_) != 0ull; \
                if (grow_) { const float dl_ = ((i) == 0) ? mx_ : fmaxf(mx_, 0.f); \
                    _Pragma("unroll") for (int r = 0; r < 16; ++r) { C0[r] -= dl_; C1[r] -= dl_; } \
                    mrun += dl_; alpha_ = ((i) == 0) ? 1.0f : __builtin_amdgcn_exp2f(-dl_); \
                    _Pragma("unroll") for (int r = 0; r < 16; ++r) negm[r] = -mrun; ATT_PIN(negm); ATT_PIN(alpha_); } } \
            else if (k < 13) { const int e_ = k - 5; \
                C0[2 * e_] = __builtin_amdgcn_exp2f(C0[2 * e_]); C0[2 * e_ + 1] = __builtin_amdgcn_exp2f(C0[2 * e_ + 1]); \
                C1[2 * e_] = __builtin_amdgcn_exp2f(C1[2 * e_]); C1[2 * e_ + 1] = __builtin_amdgcn_exp2f(C1[2 * e_ + 1]); \
                ls2_ += (f32x2){C0[2 * e_], C0[2 * e_ + 1]}; ls2_ += (f32x2){C1[2 * e_], C1[2 * e_ + 1]}; ATT_PIN(ls2_); } \
            else if (k < 17) { const int c_ = k - 13; u32x4 w_; \
                if (c_ < 2) { w_.x = cvtpk(C0[8 * c_ + 0], C0[8 * c_ + 1]); w_.y = cvtpk(C0[8 * c_ + 2], C0[8 * c_ + 3]); w_.z = cvtpk(C0[8 * c_ + 4], C0[8 * c_ + 5]); w_.w = cvtpk(C0[8 * c_ + 6], C0[8 * c_ + 7]); } \
                else { const int c2_ = c_ - 2; w_.x = cvtpk(C1[8 * c2_ + 0], C1[8 * c2_ + 1]); w_.y = cvtpk(C1[8 * c2_ + 2], C1[8 * c2_ + 3]); w_.z = cvtpk(C1[8 * c2_ + 4], C1[8 * c2_ + 5]); w_.w = cvtpk(C1[8 * c2_ + 6], C1[8 * c2_ + 7]); } \
                ATT_PIN(w_); PC[c_] = __builtin_bit_cast(bf16x8, w_); } \
            else if (k == 17) { lrun = lrun * alpha_ + (ls2_[0] + ls2_[1]); if (grow_) { _Pragma("unroll") for (int r = 0; r < 16; ++r) o[0][r] *= alpha_; ATT_PIN(o[0]); } } \
            else if (k == 18) { if (grow_) { _Pragma("unroll") for (int r = 0; r < 16; ++r) o[1][r] *= alpha_; ATT_PIN(o[1]); } } \
            ATT_SBAR(); \
        } \
    } while (0)
#ifndef ATT_PRIO
#define ATT_PRIO 1
#endif
    if (ATT_PRIO && wid >= 4) __builtin_amdgcn_s_setprio(1);
    for (int i = 0; i < ntile; i += 2) {
        { const int j3 = min(i + 3, ntile - 1); gload(TILE_OF(j3), krB0, krB1, vrB); }
        ATT_STEP(pA0, pA1, pB0, pB1, paY, paX, i);
        if (i + 2 < ntile) lstore(i + 2, krA0, krA1, vrA);
        __syncthreads();
        { const int j4 = min(i + 4, ntile - 1); gload(TILE_OF(j4), krA0, krA1, vrA); }
        ATT_STEP(pB0, pB1, pA0, pA1, paX, paY, i + 1);
        if (i + 3 < ntile) lstore(i + 3, krB0, krB1, vrB);
        __syncthreads();
    }
#undef ATT_STEP
#undef TILE_OF
    if (ATT_PRIO) __builtin_amdgcn_s_setprio(0);
    {
        const LAS unsigned char* vb = lds + VB_OFF0 + ((ntile - 1) & 3) * VB_STRIDE;
#pragma unroll
        for (int j = 0; j < 8; ++j) { const bf16x8 vfr = fetch(j, vb, vb); o[j & 1] = __builtin_amdgcn_mfma_f32_32x32x16_bf16(vfr, paY[j >> 1], o[j & 1], 0, 0, 0); }
    }
    float lt = lrun + __shfl_xor(lrun, 32);
    if (KIND == 2) lt += __builtin_amdgcn_exp2f(A.sink[h] * LOG2E - mrun);
    const float inv = 1.0f / lt;
    const int colbase = (KIND == 0 ? 0 : (KIND == 1 ? 256 : 512)) + h * 64;
    unsigned char* orow = A.MIX + tokq * D + colbase;
    unsigned W8[2][4];
    auto store_rows = [&]() {
#pragma unroll
        for (int d0 = 0; d0 < 2; ++d0) {
            const auto s0 = __builtin_amdgcn_permlane32_swap(W8[d0][0], W8[d0][1], false, false), s1 = __builtin_amdgcn_permlane32_swap(W8[d0][2], W8[d0][3], false, false);
            const auto t0 = __builtin_amdgcn_permlane32_swap(s0[0], s1[0], false, false), t1 = __builtin_amdgcn_permlane32_swap(s0[1], s1[1], false, false);
            u32x4 w; w.x = t0[0]; w.y = t1[0]; w.z = t0[1]; w.w = t1[1];
            *(u32x4*)(orow + 32 * d0 + 16 * hi) = w;
        }
    };
    if (KIND == 1) {
        LAS float* xch = (LAS float*)(lds + XCH_OFF) + (wid & 3) * 2048 + lane;
        if (wid >= 4) {
#pragma unroll
            for (int d0 = 0; d0 < 2; ++d0)
#pragma unroll
                for (int r = 0; r < 16; ++r) xch[(d0 * 16 + r) * 64] = o[d0][r] * inv;
        }
        __syncthreads();
        if (wid < 4) {
            float ss = 0.f;
#pragma unroll
            for (int d0 = 0; d0 < 2; ++d0)
#pragma unroll
                for (int r = 0; r < 16; ++r) { const float x = o[d0][r] * inv - A.lam_full * xch[(d0 * 16 + r) * 64]; o[d0][r] = x; ss += x * x; }
            ss += __shfl_xor(ss, 32);
            const float rs = (1.0f / sqrtf(ss * (1.f / 64.f) + EPS)) * A.one_m_li;
#pragma unroll
            for (int d0 = 0; d0 < 2; ++d0)
#pragma unroll
                for (int g4 = 0; g4 < 4; ++g4) {
                    const int dd = 32 * d0 + 8 * g4 + 4 * hi;
                    const f32x4 gg = *(const f32x4*)(A.subg + dd);
                    const float rs8 = rs * F8_SM;
                    W8[d0][g4] = (unsigned)__builtin_amdgcn_cvt_pk_fp8_f32(o[d0][4 * g4 + 2] * rs8 * gg[2], o[d0][4 * g4 + 3] * rs8 * gg[3], __builtin_amdgcn_cvt_pk_fp8_f32(o[d0][4 * g4 + 0] * rs8 * gg[0], o[d0][4 * g4 + 1] * rs8 * gg[1], 0, false), true);
                }
            store_rows();
        }
    } else {
#pragma unroll
        for (int d0 = 0; d0 < 2; ++d0)
#pragma unroll
            for (int g4 = 0; g4 < 4; ++g4) {
                const float inv8 = inv * F8_SM;
                W8[d0][g4] = (unsigned)__builtin_amdgcn_cvt_pk_fp8_f32(o[d0][4 * g4 + 2] * inv8, o[d0][4 * g4 + 3] * inv8, __builtin_amdgcn_cvt_pk_fp8_f32(o[d0][4 * g4 + 0] * inv8, o[d0][4 * g4 + 1] * inv8, 0, false), true);
            }
        store_rows();
    }
    __syncthreads();
}
__device__ __forceinline__ void attn_phase(Frame& F, const Args& a, int l) {
    unsigned char* ws = F.ws;
    AttnPtrs A;
    A.P = (const bf16_t*)(ws + WS_P); A.QM = (const bf16_t*)(ws + WS_QM); A.KVM = (const bf16_t*)(ws + WS_KVM); A.MIX = (unsigned char*)(ws + WS_MIX);
    A.sink = a.in[14] + l * 8; A.subg = a.in[13] + l * 64;
    A.lam_full = ((const float*)(ws + WS_CTL))[CW_LAM + l]; A.one_m_li = 1.0f - a.lam_init[l];
    const int n1 = NB * 4 * 8, n2 = n1 + NB * 4 * 16, n3 = n2 + NB * 8 * 8;
    const int n4 = (l == NL - 1) ? n3 : n3 + NB * 4, n5 = (l == NL - 1) ? n3 : n4 + NB * 4 * 2, n6 = (l == NL - 1) ? n3 : n5 + NB * 8;
    unsigned* ctr = (unsigned*)(ws + WS_CTL) + CW_ATTQ + l;
    volatile LAS unsigned* qslot = (volatile LAS unsigned*)(F.lds + MISC_OFF + 1024);
#ifndef ATT_DUP
#define ATT_DUP 0
#endif
    const int ndup = ATT_DUP == 1 ? n1 : (ATT_DUP == 2 ? n2 - n1 : (ATT_DUP == 3 ? n3 - n2 : 0));
    const int nconv = CONV_NCHUNK, total = n6 + nconv + ndup;
    if (opaque_tid() == 0) qslot[0] = atomicAdd(ctr, 1u);
    __syncthreads();
    int u = (int)qslot[0];
    while (u < total) {
        unsigned nxt = 0u;
        if (opaque_tid() == 0) nxt = atomicAdd((unsigned*)(ws + WS_CTL) + CW_ATTQ + l, 1u);
        if ((u & 3) == 3 && (u >> 2) < nconv) {
            nxt = (unsigned)__builtin_amdgcn_readfirstlane((int)nxt);
            const int ch = u >> 2, base = l * FAST_PER_LAYER + ch * CONV_CHUNK;
            fast_convert(F, a, opaque_tid(), base, base + CONV_CHUNK, F.wave, NWAVES);
        } else {
            int ua = u - min(nconv, u >> 2);
            if (ua >= n6) ua = (ATT_DUP == 1 ? 0 : (ATT_DUP == 2 ? n1 : n2)) + (ua - n6);
            int kind, ub, uh, uq;
            if (ua < n1) { kind = 0; ub = ua >> 5; uh = (ua >> 3) & 3; uq = 1 + (ua & 7); }
            else if (ua < n2) { const int v = ua - n1; kind = 1; ub = v >> 6; uh = (v >> 4) & 3; uq = 2 + (v & 15); }
            else if (ua < n3) { const int v = ua - n2; kind = 2; ub = v >> 6; uh = (v >> 3) & 7; uq = 1 + (v & 7); }
            else if (ua < n4) { const int v = ua - n3; kind = 0; ub = v >> 2; uh = v & 3; uq = 0; }
            else if (ua < n5) { const int v = ua - n4; kind = 1; ub = v >> 3; uh = (v >> 1) & 3; uq = v & 1; }
            else { const int v = ua - n5; kind = 2; ub = v >> 3; uh = v & 7; uq = 0; }
            if (kind == 0) attn_unit<0>(A, ub, uh, uq, F.lds, nxt);
            else if (kind == 1) attn_unit<1>(A, ub, uh, uq, F.lds, nxt);
            else attn_unit<2>(A, ub, uh, uq, F.lds, nxt);
        }
        if (opaque_tid() == 0) qslot[0] = nxt;
        __syncthreads();
        u = (int)qslot[0];
    }
}

constexpr int PH_PER_LAYER = 8, N_PHASES = 2 + NL * PH_PER_LAYER;
__global__ void __launch_bounds__(NTHR, 2) trunk_fwd(Args args) {
    extern __shared__ __attribute__((aligned(16))) unsigned char lds_raw[];
    Frame F;
    F.lds = (LAS unsigned char*)lds_raw; F.ws = args.ws;
    F.tid = threadIdx.x; F.lane = F.tid & 63; F.wave = __builtin_amdgcn_readfirstlane(F.tid >> 6);
    F.G = gridDim.x; { const int bx = blockIdx.x; F.vcu = (F.G % 8 == 0) ? (bx % 8) * (F.G / 8) + bx / 8 : bx; }
    volatile LAS unsigned* MISC = (volatile LAS unsigned*)(F.lds + MISC_OFF);
    if (F.tid < 64) MISC[F.tid] = 0u;
    __syncthreads();
    const int lo = args.ph_lo, hi = args.ph_hi;
    const bool multi = (hi - lo) > 1;
    XcdBarrier bar; bar.bar = (unsigned*)(F.ws + WS_CTL) + CW_BAR; bar.x = 0; bar.st = MISC;
    if (multi) bar = xcd_barrier_post((unsigned*)(F.ws + WS_CTL) + CW_BAR, MISC);
    unsigned char* ws = F.ws;
#ifndef DIAG_KINDS
#define DIAG_KINDS 0x3ff
#endif
#ifndef REP_PRO
#define REP_PRO 1
#define REP_WIN 1
#define REP_UP 1
#define REP_ATT 1
#define REP_GU 1
#define REP_DOWN 1
#endif
#define KON(x) (((DIAG_KINDS) >> (x)) & 1)
#define IN(k) (lo <= (k) && (k) < hi)
#define SEAM(k) do { if (IN(k) && IN((k) + 1)) xcd_barrier(bar); } while (0)
    if (KON(0) && IN(0)) { asm volatile("; PHASE_MARK 0"); for (int rep = 0; rep < REP_PRO; ++rep) prologue_phase(F, args); }
    SEAM(0);
    for (int l = 0; l < NL; ++l) {
        const int pb = 1 + l * PH_PER_LAYER;
        const bool last = (l == NL - 1);
        if (KON(1) && IN(pb + 0)) { asm volatile("; PHASE_MARK 1");
#ifndef REP_N1
#define REP_N1 1
#endif
            for (int rep = 1; rep < REP_N1; ++rep) norm1_phase<0, false>(F, args, l, true);
            if (l == 0) norm1_phase<0, true>(F, args, l); else norm1_phase<0, false>(F, args, l); }
        SEAM(pb + 0);
        const bool chain = (F.G == 256);
        const pg8::ChainMap CM{(int)blockIdx.x & 7, (int)blockIdx.x >> 3};
        if (KON(2) && IN(pb + 1)) { asm volatile("; PHASE_MARK 2");
            pg8::EpiWin E{(bf16_t*)(ws + WS_P), (float*)(ws + WS_SSQ), (const float*)(ws + WS_ROPER), (const float*)(ws + WS_ROPEW)};
            if (chain) {
                pg8::WinChainSched S{(const char*)(ws + WS_H), (const char*)(ws + WS_WIN) + (size_t)l * PW * D, D / 2, D / 2, CM};
                for (int rep = 0; rep < REP_WIN; ++rep) pg8::gemm_phase<pg8::EpiWin, pg8::WinChainSched, true, true>(F.lds, D / 2, D / 2, D / 2, S, E);
            } else {
                pg8::DenseSched S{(const char*)(ws + WS_H), (const char*)(ws + WS_WIN) + (size_t)l * PW * D, D / 2, D / 2, NPAN, PW / 256, F.G, (int)blockIdx.x, 0};
                for (int rep = 0; rep < REP_WIN; ++rep) pg8::gemm_phase<pg8::EpiWin, pg8::DenseSched, true, true>(F.lds, D / 2, D / 2, D / 2, S, E);
            }
        }
        if (!chain) SEAM(pb + 1);
        else {
            __builtin_amdgcn_fence(__ATOMIC_ACQUIRE, "agent"); asm volatile("s_waitcnt vmcnt(0)" ::: "memory"); __syncthreads();
        }
        if (KON(3) && IN(pb + 2)) { asm volatile("; PHASE_MARK 3");
            pg8::EpiUp E{(bf16_t*)(ws + WS_QM), (bf16_t*)(ws + WS_KVM), (const float*)(ws + WS_SSQ), (const float*)(ws + WS_ROPER)};
            if (chain) {
                pg8::UpChainSched S{(const char*)(ws + WS_P), (const char*)(ws + WS_WUQ) + (size_t)l * 512 * 256 * 2, (const char*)(ws + WS_WUKV) + (size_t)l * 512 * 256 * 2, CM};
                for (int rep = 0; rep < REP_UP; ++rep) pg8::gemm_phase<pg8::EpiUp, pg8::UpChainSched, true>(F.lds, 256, PW, 256, S, E);
            } else {
                pg8::UpSched S{(const char*)(ws + WS_P), (const char*)(ws + WS_WUQ) + (size_t)l * 512 * 256 * 2, (const char*)(ws + WS_WUKV) + (size_t)l * 512 * 256 * 2, F.G, (int)blockIdx.x};
                for (int rep = 0; rep < REP_UP; ++rep) pg8::gemm_phase<pg8::EpiUp, pg8::UpSched, true>(F.lds, 256, PW, 256, S, E);
            }
        }
        SEAM(pb + 2);
        if (KON(4) && IN(pb + 3)) { asm volatile("; PHASE_MARK 4"); for (int rep = 0; rep < REP_ATT; ++rep) attn_phase(F, args, l); }
        SEAM(pb + 3);
        if (KON(5) && IN(pb + 4)) { asm volatile("; PHASE_MARK 5");
            pg8::DenseSched S{(const char*)(ws + WS_MIX), (const char*)(ws + WS_WOUT) + (size_t)l * D * D, D / 2, D / 2, last ? NB * 8 : NPAN, D / 256, F.G, (int)blockIdx.x, last ? 1 : 0};
            pg8::EpiWout E{(bf16_t*)(ws + WS_X), (const float*)(ws + WS_MOD) + (size_t)l * 17 * 6144};
            pg8::gemm_phase<pg8::EpiWout, pg8::DenseSched, true, true>(F.lds, D / 2, D / 2, D / 2, S, E);
        }
        SEAM(pb + 4);
        if (KON(6) && IN(pb + 5)) { asm volatile("; PHASE_MARK 6"); norm2_router_phase(F, args, l); }
        SEAM(pb + 5);
        if (KON(7) && IN(pb + 6)) { asm volatile("; PHASE_MARK 7");
            load_counts(F, l);
            pg8::MoeSched<true> S{(const char*)(ws + WS_H), (const char*)(ws + WS_WGU) + (size_t)l * NE * 2048 * D, (const int*)(ws + WS_SLOTTOK),
                                  (volatile LAS int*)(F.lds + MISC_OFF + 256), (volatile LAS int*)(F.lds + MISC_OFF + 512), 8, F.G, (int)blockIdx.x, (size_t)2048 * D, opaque_tid() & 31};
            pg8::EpiGateUp E{(unsigned char*)(ws + WS_ACT), args.in[20] + (size_t)l * NE * D, args.in[22] + (size_t)l * NE * D};
            for (int rep = 0; rep < REP_GU; ++rep) pg8::gemm_phase<pg8::EpiGateUp, pg8::MoeSched<true>, true, true>(F.lds, D / 2, D / 2, D / 2, S, E);
        }
        SEAM(pb + 6);
        if (KON(8) && IN(pb + 7)) { asm volatile("; PHASE_MARK 8");
            load_counts(F, l);
            pg8::MoeSched<false> S{(const char*)(ws + WS_ACT), (const char*)(ws + WS_WD) + (size_t)l * NE * D * D, (const int*)(ws + WS_SLOTTOK),
                                   (volatile LAS int*)(F.lds + MISC_OFF + 256), (volatile LAS int*)(F.lds + MISC_OFF + 512), 4, F.G, (int)blockIdx.x, (size_t)D * D, opaque_tid() & 31};
            pg8::EpiDown E{(bf16_t*)(ws + WS_Y), args.in[24] + (size_t)l * NE * D, (const float*)(ws + WS_SLOTW)};
            for (int rep = 0; rep < REP_DOWN; ++rep) pg8::gemm_phase<pg8::EpiDown, pg8::MoeSched<false>, true, true>(F.lds, D / 2, D / 2, D / 2, S, E);
        }
        SEAM(pb + 7);
    }
    if (KON(9) && IN(N_PHASES - 1)) { asm volatile("; PHASE_MARK 9"); norm1_phase<1, false>(F, args, NL); }
#undef IN
#undef SEAM
}

extern "C" void kernel_launch(void* const* d_in, const int* in_sizes, int n_in, void* d_out, int out_size, void* d_ws, size_t ws_size, hipStream_t stream) {
    static int grid = 0;
    if (grid == 0) {
        if (n_in != 26 || ws_size < WS_END) { fprintf(stderr, "kernel_launch: unexpected inputs (n_in %d, ws %zu)\n", n_in, ws_size); grid = -1; return; }
        int dev = 0, cus = 0, per_cu = 0;
        if (hipGetDevice(&dev) != hipSuccess || hipDeviceGetAttribute(&cus, hipDeviceAttributeMultiprocessorCount, dev) != hipSuccess) { grid = -1; return; }
        if (hipFuncSetAttribute((const void*)trunk_fwd, hipFuncAttributeMaxDynamicSharedMemorySize, LDS_BYTES) != hipSuccess) { fprintf(stderr, "kernel_launch: hipFuncSetAttribute failed\n"); grid = -1; return; }
        if (hipOccupancyMaxActiveBlocksPerMultiprocessor(&per_cu, (const void*)trunk_fwd, NTHR, LDS_BYTES) != hipSuccess || per_cu < 1)
            fprintf(stderr, "kernel_launch: occupancy query reports %d workgroups per CU\n", per_cu);
        (void)hipGetLastError();
        grid = cus;
    }
    if (grid < 0) return;
    if (hipMemsetAsync((char*)d_ws + WS_CTL, 0, CTL_ZERO_BYTES, stream) != hipSuccess) return;
    Args a{};
    for (int i = 0; i < 26; ++i) a.in[i] = (const float*)d_in[i];
    a.out = (float*)d_out; a.ws = (unsigned char*)d_ws;
    for (int i = 0; i < 8; ++i) a.invf8[i] = pow(10000.0, -(double)i / 8.0);
    for (int i = 0; i < 16; ++i) a.invf16[i] = pow(10000.0, -(double)i / 16.0);
    for (int i = 0; i < 4; ++i) a.lam_init[i] = (float)(0.8 - 0.6 * exp(-0.3 * (double)i));
#if MK_ONE_LAUNCH
    a.ph_lo = 0; a.ph_hi = N_PHASES;
    hipLaunchKernelGGL(trunk_fwd, dim3(grid), dim3(NTHR), LDS_BYTES, stream, a);
#else
    for (int p = 0; p < N_PHASES; ++p) { a.ph_lo = p; a.ph_hi = p + 1; hipLaunchKernelGGL(trunk_fwd, dim3(grid), dim3(NTHR), LDS_BYTES, stream, a); }
#endif
}
```

```cpp
#include <hip/hip_runtime.h>
#include <cstdio>
#include <cstdint>
#include <cmath>

#ifndef MK_ONE_LAUNCH
#define MK_ONE_LAUNCH 1
#endif

#define LAS __attribute__((address_space(3)))
#define GAS __attribute__((address_space(1)))
typedef unsigned short bf16_t;
typedef short bf16x8 __attribute__((ext_vector_type(8)));
typedef short v4i16_t __attribute__((ext_vector_type(4)));
typedef float f32x4 __attribute__((ext_vector_type(4)));
typedef float f32x2 __attribute__((ext_vector_type(2)));
typedef float f32x16 __attribute__((ext_vector_type(16)));
typedef unsigned u32x4 __attribute__((ext_vector_type(4)));
typedef unsigned u32x2 __attribute__((ext_vector_type(2)));
typedef __bf16 bf16x2_t __attribute__((ext_vector_type(2)));

constexpr int NB = 16, SEQ = 2048, CTX = 256, NTK = SEQ + CTX, T = NB * NTK, D = 1024, NL = 4, NE = 32;
constexpr int PW = 2048;
constexpr int NPAN = T / 256;
constexpr int MAXPAN = 608;
constexpr int NWAVES = 8, NTHR = 512;
constexpr float EPS = 1e-6f;
constexpr float LOG2E = 1.4426950408889634f;
constexpr float SC_MLA = 0.10206207261596577f * LOG2E;
constexpr float SC_DIFF = 0.17677669529663687f * LOG2E;
constexpr float SC_SWA = 0.125f * LOG2E;
constexpr float F8_SW = 64.0f, F8_SA = 4.0f;
constexpr float F8_INV = 1.0f / (F8_SW * F8_SA);
constexpr float F8_SM = 16.0f, F8_INVM = 1.0f / (F8_SW * F8_SM);
constexpr float F8_SY = 64.0f;

constexpr size_t MiB = 1u << 20;
constexpr size_t WS_CTL = 0, CTL_ZERO_BYTES = 1 * MiB;
constexpr size_t WS_MOD = 1 * MiB;
constexpr size_t WS_ROPER = 3 * MiB;
constexpr size_t WS_ROPEW = WS_ROPER + 262144;
constexpr size_t WS_SSQ = 4 * MiB;
constexpr size_t WS_TOKSLOT = 6 * MiB;
constexpr size_t WS_SLOTTOK = 7 * MiB;
constexpr size_t WS_SLOTW = 12 * MiB;
constexpr size_t WS_WR = 17 * MiB;
constexpr size_t WS_WUQ = 18 * MiB;
constexpr size_t WS_WUKV = 19 * MiB;
constexpr size_t WS_WIN = 20 * MiB;
constexpr size_t WS_WOUT = 36 * MiB;
constexpr size_t WS_WGU = 44 * MiB;
constexpr size_t WS_WD = 556 * MiB;
constexpr size_t WS_X = 812 * MiB;
constexpr size_t WS_H = 956 * MiB;
constexpr size_t WS_ACT = 1028 * MiB;
constexpr size_t WS_P = WS_ACT;
constexpr size_t WS_QM = WS_ACT + 144 * MiB;
constexpr size_t WS_KVM = WS_ACT + 171 * MiB;
constexpr size_t WS_MIX = WS_ACT + 207 * MiB;
constexpr size_t WS_Y = 1332 * MiB;
constexpr size_t WS_END = 1636 * MiB;
constexpr int CW_LAM = 64;
constexpr int CW_ATTQ = 2048;
constexpr int CW_CUR = 1024;
constexpr int CW_BAR = 4096;

constexpr int RING_BYTES = 131072;
constexpr int MISC_OFF = RING_BYTES;
constexpr int GOFF_OFF = RING_BYTES + 4096;
constexpr int LDS_BYTES = RING_BYTES + 4096 + 8192;

__device__ __forceinline__ unsigned cvtpk(float lo, float hi) { f32x2 v = {lo, hi}; bf16x2_t b = __builtin_convertvector(v, bf16x2_t); return __builtin_bit_cast(unsigned, b); }
__device__ __forceinline__ float bf2f(unsigned short b) { return __uint_as_float(((unsigned)b) << 16); }
__device__ __forceinline__ float bflo(unsigned w) { return __uint_as_float(w << 16); }
__device__ __forceinline__ float bfhi(unsigned w) { return __uint_as_float(w & 0xffff0000u); }
__device__ __forceinline__ float wave_sum(float v) {
#pragma unroll
    for (int o = 1; o < 64; o <<= 1) v += __shfl_xor(v, o);
    return v;
}
__device__ __forceinline__ int opaque_tid() { int t = threadIdx.x; asm volatile("" : "+v"(t)); return t; }
__device__ __forceinline__ int il(int i, int hd) { return (i & 1) ? (i >> 1) + (hd >> 1) : (i >> 1); }

#define XB_TMO      128
#define XB_XCNT(j)  (256  + 64 * (j))
#define XB_XSUB(j)  (1280 + 64 * (j))
#define XB_XGEN(j)  (2304 + 64 * (j))
#define XB_TOP      3328
#define XB_TOPGEN   3392
#define XCD_BAR_WORDS 3456
#define XB_SPIN_CAP (1u << 20)
__device__ __forceinline__ unsigned xb_ld(unsigned* p)              { return __hip_atomic_load(p, __ATOMIC_RELAXED, __HIP_MEMORY_SCOPE_AGENT); }
__device__ __forceinline__ unsigned xb_add(unsigned* p, unsigned v) { return __hip_atomic_fetch_add(p, v, __ATOMIC_RELAXED, __HIP_MEMORY_SCOPE_AGENT); }
__device__ __forceinline__ unsigned xb_xcc_id() { return (unsigned)__builtin_amdgcn_s_getreg((3 << 11) | 20) & 0xFu; }
#define XB_SPIN(cond, bar) do { unsigned _sp = 0; while (cond) { __builtin_amdgcn_s_sleep(1); \
    if ((++_sp & 255u) == 0u) { if (xb_ld(&(bar)[XB_TMO])) break; if (_sp > XB_SPIN_CAP) { atomicAdd(&(bar)[XB_TMO], 1u); break; } } } } while (0)
struct XcdBarrier { unsigned* bar; unsigned x; volatile LAS unsigned* st; };
__device__ __forceinline__ XcdBarrier xcd_barrier_post(unsigned* bar, volatile LAS unsigned* st) {
    XcdBarrier b; b.bar = bar; b.x = xb_xcc_id(); b.st = st;
    if (threadIdx.x == 0) (void)xb_add(&bar[XB_XCNT(b.x)], 1u);
    return b;
}
__device__ __forceinline__ void xcd_barrier_complete(unsigned* bar, unsigned x, unsigned& nloc, unsigned& nx) {
    const unsigned G = gridDim.x * gridDim.y * gridDim.z;
    unsigned sum, cnt, mine, sp = 0u;
    for (;;) {
        sum = 0u; cnt = 0u; mine = 0u;
#pragma unroll
        for (unsigned j = 0; j < 16; ++j) { const unsigned c = xb_ld(&bar[XB_XCNT(j)]); sum += c; cnt += (c > 0u) ? 1u : 0u; mine = (j == x) ? c : mine; }
        if (sum == G) break;
        __builtin_amdgcn_s_sleep(1);
        if ((++sp & 255u) == 0u) { if (xb_ld(&bar[XB_TMO])) break; if (sp > XB_SPIN_CAP) { atomicAdd(&bar[XB_TMO], 1u); break; } }
    }
    nloc = mine > 0u ? mine : 1u; nx = cnt > 0u ? cnt : 1u;
}
__device__ __forceinline__ void xcd_barrier(const XcdBarrier& b) {
    asm volatile("s_waitcnt vmcnt(0)" ::: "memory");
    __syncthreads();
    if (threadIdx.x == 0) {
        unsigned* bar = b.bar;
        __builtin_amdgcn_s_waitcnt(0);
        unsigned nloc = b.st[0], nx = b.st[1];
        if (nloc == 0u) { xcd_barrier_complete(bar, b.x, nloc, nx); b.st[0] = nloc; b.st[1] = nx; }
        const unsigned old = xb_add(&bar[XB_XSUB(b.x)], 1u);
        const unsigned gen = old / nloc;
        if (old + 1u == (gen + 1u) * nloc) {
            __builtin_amdgcn_fence(__ATOMIC_RELEASE, "agent");
            asm volatile("s_waitcnt vmcnt(0)" ::: "memory");
            const unsigned og = xb_add(&bar[XB_TOP], 1u);
            const unsigned tg = og / nx;
            if (og + 1u == (tg + 1u) * nx) xb_add(&bar[XB_TOPGEN], 1u);
            else XB_SPIN(xb_ld(&bar[XB_TOPGEN]) == tg, bar);
            __builtin_amdgcn_fence(__ATOMIC_ACQUIRE, "agent");
            xb_add(&bar[XB_XGEN(b.x)], 1u);
            asm volatile("s_waitcnt vmcnt(0)" ::: "memory");
        } else {
            XB_SPIN(xb_ld(&bar[XB_XGEN(b.x)]) == gen, bar);
            __builtin_amdgcn_fence(__ATOMIC_ACQUIRE, "agent");
            asm volatile("s_waitcnt vmcnt(0)" ::: "memory");
        }
    }
    __syncthreads();
}

struct Args {
    const float* in[26];
    float* out; unsigned char* ws;
    double invf8[8]; double invf16[16];
    float lam_init[4];
    int ph_lo, ph_hi;
};
struct Frame {
    LAS unsigned char* lds;
    unsigned char* ws;
    int tid, lane, wave, vcu, G;
};

namespace pg8 {
constexpr int BM = 256, BK = 64, HALF = 128, HTB = HALF * BK * 2, STAGE_BYTES = 8 * HTB;
__host__ __device__ __forceinline__ int lds_byte(int r, int c) { const int st = (r >> 4) * 2 + (c >> 5), rr = r & 15, cc = c & 31, ob = rr * 64 + cc * 2; return st * 1024 + (ob ^ (((ob >> 9) & 1) << 5)); }
__host__ __device__ __forceinline__ void stage_rc(int b, int& R, int& C) { const int st = b / 1024, sb = b % 1024, swz = sb ^ (((sb >> 9) & 1) << 5); R = (st >> 1) * 16 + swz / 64; C = (st & 1) * 32 + (swz % 64) / 2; }
__host__ __device__ __forceinline__ int perm32(int rho) { const int n = rho >> 4, i = rho & 15; return 8 * (i >> 2) + 4 * n + (i & 3); }

typedef int v8i32 __attribute__((ext_vector_type(8)));
typedef int u32x4i __attribute__((ext_vector_type(4)));
__device__ __forceinline__ v8i32 pk8(bf16x8 lo, bf16x8 hi) { const u32x4 a = __builtin_bit_cast(u32x4, lo), b = __builtin_bit_cast(u32x4, hi); return (v8i32){(int)a.x, (int)a.y, (int)a.z, (int)a.w, (int)b.x, (int)b.y, (int)b.z, (int)b.w}; }
struct Unit { const char* a; const char* b; int pm, pn, e, j, cnt; };

template <class Epi, class Sched, bool ALIGN_EPI, bool FP8 = false>
__device__ __forceinline__ void gemm_phase(LAS unsigned char* lds, const int K, const int lda, const int ldb, const Sched& S, const Epi& E) {
    const int tid = opaque_tid(), wid = __builtin_amdgcn_readfirstlane(tid >> 6), lane = tid & 63, wr = wid >> 2, wc = wid & 3, fr = lane & 15, fq = lane >> 4;
    const int nt = K / BK;
    int Rs[2], Cs[2]; unsigned voffBp[2];
#pragma unroll
    for (int i = 0; i < 2; ++i) { int R, C; stage_rc(tid * 16 + i * 8192, R, C); Rs[i] = R; Cs[i] = C; const int Rb = Epi::PERM ? ((R & ~31) + perm32(R & 31)) : R; voffBp[i] = (unsigned)(Rb * ldb + C) * 2u; }
    const size_t kstep = (size_t)(BK * 2);
    const size_t hstepB = (size_t)HALF * ldb * 2;
    const unsigned ldsw = (unsigned)wid * 1024u;
#define PG8_SA(b, h) (((b) * 2 + (h)) * HTB)
#define PG8_SB(b, h) ((4 + (b) * 2 + (h)) * HTB)
#define PG8_STAGE2(bufoff, gbase, o0, o1) do { \
        __builtin_amdgcn_global_load_lds((const unsigned*)((const char*)(gbase) + (o0)), (LAS unsigned*)(lds + (bufoff) + ldsw), 16, 0, 0); \
        __builtin_amdgcn_global_load_lds((const unsigned*)((const char*)(gbase) + (o1)), (LAS unsigned*)(lds + (bufoff) + ldsw + 8192), 16, 0, 0); } while (0)
#define PG8_STAGEB(bufoff, gbase) PG8_STAGE2(bufoff, gbase, voffB[0], voffB[1])
#define PG8_STAGEBP(bufoff, gbase) PG8_STAGE2(bufoff, gbase, voffBp[0], voffBp[1])
#define PG8_LD32(p) __builtin_shufflevector(*(const LAS u32x4i*)(p), *(const LAS u32x4i*)((p) + 1024), 0, 1, 2, 3, 4, 5, 6, 7)
#define PG8_LDA(dst, b, h) do { if constexpr (FP8) { _Pragma("unroll") for (int m = 0; m < 4; ++m) dst##8[m] = PG8_LD32(lds + PG8_SA(b, h) + aoff + m * 2048); } \
        else { _Pragma("unroll") for (int m = 0; m < 4; ++m) _Pragma("unroll") for (int k = 0; k < 2; ++k) dst[m][k] = *(const LAS bf16x8*)(lds + PG8_SA(b, h) + aoff + m * 2048 + k * 1024); } } while (0)
#define PG8_LDB(dst, b, h) do { if constexpr (FP8) { _Pragma("unroll") for (int n = 0; n < 2; ++n) dst##8[n] = PG8_LD32(lds + PG8_SB(b, h) + boff + n * 2048); } \
        else { _Pragma("unroll") for (int n = 0; n < 2; ++n) _Pragma("unroll") for (int k = 0; k < 2; ++k) dst[n][k] = *(const LAS bf16x8*)(lds + PG8_SB(b, h) + boff + n * 2048 + k * 1024); } } while (0)
  \

#define PG8_MMA(ai, bj, At, Bt) do { __builtin_amdgcn_s_setprio(1); _Pragma("unroll") for (int m = 0; m < 4; ++m) _Pragma("unroll") for (int n = 0; n < 2; ++n) { \
        if constexpr (FP8) { asm volatile("v_mfma_scale_f32_16x16x128_f8f6f4 %0, %1, %2, %0, %3, %3 op_sel_hi:[0,0,0]" : "+v"(acc[ai][bj][m][n]) : "v"(Bt##8[n]), "v"(At##8[m]), "v"(f8scale)); } \
        else { _Pragma("unroll") for (int k = 0; k < 2; ++k) acc[ai][bj][m][n] = __builtin_amdgcn_mfma_f32_16x16x32_bf16(Bt[n][k], At[m][k], acc[ai][bj][m][n], 0, 0, 0); } } \
        __builtin_amdgcn_s_setprio(0); } while (0)
#define PG8_WAIT_V(n) asm volatile("s_waitcnt vmcnt(" #n ")" ::: "memory")
#define PG8_WAIT_L(n) asm volatile("s_waitcnt lgkmcnt(" #n ")" ::: "memory")
#define PG8_BAR __builtin_amdgcn_s_barrier()
#define PG8_SCHED __builtin_amdgcn_sched_barrier(0)
    Unit cur, nxt; int ui = 0;
    if (!S.next(0, cur)) return;
    f32x4 acc[2][2][4][2];
#pragma unroll
    for (int a = 0; a < 2; ++a)
#pragma unroll
        for (int b = 0; b < 2; ++b)
#pragma unroll
            for (int m = 0; m < 4; ++m)
#pragma unroll
                for (int n = 0; n < 2; ++n) acc[a][b][m][n] = (f32x4){0.f, 0.f, 0.f, 0.f};
    bf16x8 At[4][2], B0[2][2], B1[2][2]; v8i32 At8[4], B08[2], B18[2];
    unsigned vc00, vc01, vc10, vc11, vn00, vn01, vn10, vn11;
    vc00 = (unsigned)(S.arow(cur, Rs[0]) * lda + Cs[0]) * 2u; vc01 = (unsigned)(S.arow(cur, Rs[1]) * lda + Cs[1]) * 2u;
    vc10 = (unsigned)(S.arow(cur, HALF + Rs[0]) * lda + Cs[0]) * 2u; vc11 = (unsigned)(S.arow(cur, HALF + Rs[1]) * lda + Cs[1]) * 2u;
    const char* cA = cur.a; const char* cB = cur.b;
    PG8_STAGEBP(PG8_SB(0, 0), cB); PG8_STAGEBP(PG8_SB(0, 1), cB + hstepB); PG8_STAGE2(PG8_SA(0, 0), cA, vc00, vc01); PG8_STAGE2(PG8_SA(0, 1), cA, vc10, vc11);
    if (wr == 1) PG8_BAR;
    PG8_WAIT_V(2); PG8_BAR;
    PG8_STAGEBP(PG8_SB(1, 0), cB + kstep); PG8_STAGE2(PG8_SA(1, 0), cA + kstep, vc00, vc01); PG8_STAGEBP(PG8_SB(1, 1), cB + hstepB + kstep);
    PG8_WAIT_V(6); PG8_BAR;
    bool has_next = S.next(1, nxt);
    if (Sched::GATHER && has_next) {
        int R0, C0, R1, C1; { const int t2_ = opaque_tid(); stage_rc(t2_ * 16, R0, C0); stage_rc(t2_ * 16 + 8192, R1, C1); }
        LAS unsigned* gp = (LAS unsigned*)(lds + GOFF_OFF) + (opaque_tid() << 2);
        gp[0] = (unsigned)(S.arow(nxt, R0) * lda + C0) * 2u; gp[1] = (unsigned)(S.arow(nxt, R1) * lda + C1) * 2u;
        gp[2] = (unsigned)(S.arow(nxt, HALF + R0) * lda + C0) * 2u; gp[3] = (unsigned)(S.arow(nxt, HALF + R1) * lda + C1) * 2u;
    }
    for (;;) {
        const char* nA = has_next ? nxt.a : cA; const char* nB = has_next ? nxt.b : cB;
        vn00 = vc00; vn01 = vc01; vn10 = vc10; vn11 = vc11;
#ifndef KREP
#define KREP 1
#endif
        constexpr int krep = (FP8 && Epi::PROBE) ? KREP : 1;
#pragma unroll 1
        for (int tq = 0; tq < krep * nt; tq += 2) {
            const int t = tq % nt;
            const bool last = (tq == krep * nt - 2);
            const int f8scale = (tq < nt) ? 0x7F7F7F7F : 0;
            unsigned voffB[2]; int aoff, boff;
            { const int t3_ = opaque_tid(), l3_ = t3_ & 63, fr3_ = l3_ & 15, fq3_ = l3_ >> 4;
#pragma unroll
              for (int i = 0; i < 2; ++i) { int R, C; stage_rc(t3_ * 16 + i * 8192, R, C); const int Rb = Epi::PERM ? ((R & ~31) + perm32(R & 31)) : R; voffB[i] = (unsigned)(Rb * ldb + C) * 2u; }
              aoff = lds_byte(wr * 64 + fr3_, fq3_ * 8); boff = lds_byte(wc * 32 + fr3_, fq3_ * 8); }
            if (Sched::GATHER && last) { const LAS unsigned* gp = (const LAS unsigned*)(lds + GOFF_OFF) + (opaque_tid() << 2); vn00 = gp[0]; vn01 = gp[1]; vn10 = gp[2]; vn11 = gp[3]; }
            const char* a1 = cA + (size_t)(t + 1) * kstep;
            const char* a2 = last ? nA : cA + (size_t)((t + 2) % nt) * kstep; const char* b2 = last ? nB : cB + (size_t)((t + 2) % nt) * kstep;
            const char* a3 = a2 + kstep; const char* b3 = b2 + kstep;
            const unsigned w00 = (Sched::GATHER && last) ? vn00 : vc00, w01 = (Sched::GATHER && last) ? vn01 : vc01, w10 = (Sched::GATHER && last) ? vn10 : vc10, w11 = (Sched::GATHER && last) ? vn11 : vc11;
            const bool relax = (Epi::NST > 0) && (tq == 0) && (ui > 0);
            PG8_LDB(B0, 0, 0); PG8_LDB(B1, 0, 1); PG8_SCHED; PG8_LDA(At, 0, 0); PG8_STAGE2(PG8_SA(1, 1), a1, vc10, vc11);
            if (relax) asm volatile("s_waitcnt vmcnt(%0)" :: "n"(8 + Epi::NST) : "memory"); else PG8_WAIT_V(8);
            PG8_WAIT_L(0); PG8_BAR; PG8_MMA(0, 0, At, B0); PG8_MMA(0, 1, At, B1); PG8_BAR; PG8_SCHED;
            PG8_LDA(At, 0, 1); PG8_STAGEB(PG8_SB(0, 0), b2); PG8_STAGEB(PG8_SB(0, 1), b2 + hstepB); PG8_STAGE2(PG8_SA(0, 0), a2, w00, w01);
            if (relax) asm volatile("s_waitcnt vmcnt(%0)" :: "n"(8 + Epi::NST) : "memory"); else PG8_WAIT_V(8);
            PG8_WAIT_L(0); PG8_BAR; PG8_MMA(1, 0, At, B0); PG8_MMA(1, 1, At, B1); PG8_BAR; PG8_SCHED;
            PG8_LDB(B0, 1, 0); PG8_LDB(B1, 1, 1); PG8_SCHED; PG8_LDA(At, 1, 0); PG8_STAGE2(PG8_SA(0, 1), a2, w10, w11);
            PG8_WAIT_V(8); PG8_WAIT_L(0); PG8_BAR; PG8_MMA(0, 0, At, B0); PG8_MMA(0, 1, At, B1); PG8_BAR; PG8_SCHED;
            PG8_LDA(At, 1, 1); PG8_STAGEB(PG8_SB(1, 0), b3); PG8_STAGEB(PG8_SB(1, 1), b3 + hstepB); PG8_STAGE2(PG8_SA(1, 0), a3, w00, w01);
            PG8_WAIT_V(8); PG8_WAIT_L(0); PG8_BAR; PG8_MMA(1, 0, At, B0); PG8_MMA(1, 1, At, B1); PG8_BAR; PG8_SCHED;
        }
        Unit nn; bool has_nn = has_next && S.next(ui + 2, nn);
        int gt0 = 0, gt1 = 0, gt2 = 0, gt3 = 0;
        if constexpr (Sched::GATHER) if (has_nn) {
            int R0, C0, R1, C1; { const int t2_ = opaque_tid(); stage_rc(t2_ * 16, R0, C0); stage_rc(t2_ * 16 + 8192, R1, C1); }
            gt0 = S.arow_raw(nn, R0); gt1 = S.arow_raw(nn, R1); gt2 = S.arow_raw(nn, HALF + R0); gt3 = S.arow_raw(nn, HALF + R1);
        }
        if constexpr (ALIGN_EPI) { if (wr == 0) PG8_BAR; }
#ifndef REP_EPI
#define REP_EPI 1
#endif
        if constexpr (FP8) asm volatile("s_nop 15\n\ts_nop 15" ::: "memory");
        { const int l2_ = opaque_tid() & 63; for (int rep_ = 0; rep_ < (Epi::PROBE ? REP_EPI : 1); ++rep_) E(acc, cur, wr, wc, l2_ & 15, l2_ >> 4); }
        if (!has_next) break;
#pragma unroll
        for (int a = 0; a < 2; ++a)
#pragma unroll
            for (int b = 0; b < 2; ++b)
#pragma unroll
                for (int m = 0; m < 4; ++m)
#pragma unroll
                    for (int n = 0; n < 2; ++n) acc[a][b][m][n] = (f32x4){0.f, 0.f, 0.f, 0.f};
        cur = nxt; cA = nA; cB = nB; ++ui; vc00 = vn00; vc01 = vn01; vc10 = vn10; vc11 = vn11;
        nxt = nn; has_next = has_nn;
        if constexpr (Sched::GATHER) asm volatile("" : "+v"(gt0), "+v"(gt1), "+v"(gt2), "+v"(gt3));
        if constexpr (Sched::GATHER) if (has_next) {
            int R0, C0, R1, C1; { const int t2_ = opaque_tid(); stage_rc(t2_ * 16, R0, C0); stage_rc(t2_ * 16 + 8192, R1, C1); }
            LAS unsigned* gp = (LAS unsigned*)(lds + GOFF_OFF) + (opaque_tid() << 2);
            gp[0] = (unsigned)(S.arow_fix(nxt, R0, gt0) * lda + C0) * 2u; gp[1] = (unsigned)(S.arow_fix(nxt, R1, gt1) * lda + C1) * 2u;
            gp[2] = (unsigned)(S.arow_fix(nxt, HALF + R0, gt2) * lda + C0) * 2u; gp[3] = (unsigned)(S.arow_fix(nxt, HALF + R1, gt3) * lda + C1) * 2u;
        }
        if constexpr (ALIGN_EPI) { if (wr == 1) PG8_BAR; }
    }
    PG8_WAIT_V(0);
    if constexpr (!ALIGN_EPI) { if (wr == 0) PG8_BAR; }
    PG8_BAR;
#undef PG8_SA
#undef PG8_SB
#undef PG8_STAGE2
#undef PG8_STAGEB
#undef PG8_LDA
#undef PG8_LD32
#undef PG8_LDB
#undef PG8_MMA
#undef PG8_WAIT_V
#undef PG8_WAIT_L
#undef PG8_BAR
#undef PG8_SCHED
}

__device__ __forceinline__ int xcd_remap(int L, int nwg) {
    const int q = nwg / 8, r = nwg % 8, xcd = L % 8, off = L / 8;
    return (xcd < r ? xcd * (q + 1) : r * (q + 1) + (xcd - r) * q) + off;
}

struct DenseSched {
    static constexpr bool GATHER = false;
    const char* A; const char* Bt; int lda, ldb, npan, nN, G, c, latent_only;
    __device__ __forceinline__ bool next(int i, Unit& u) const {
        const int L = i * G + c, nwg = npan * nN; if (L >= nwg) return false;
        const int w = xcd_remap(L, nwg), p = w / nN, pn = w % nN;
        const int pm = latent_only ? (p >> 3) * 9 + 1 + (p & 7) : p;
        u.pm = pm; u.pn = pn; u.e = 0; u.j = 0; u.cnt = 0;
        u.a = A + (size_t)pm * 256 * lda * 2; u.b = Bt + (size_t)pn * 256 * ldb * 2; return true;
    }
    __device__ __forceinline__ int arow(const Unit&, int r) const { return r; }
};
struct UpSched {
    static constexpr bool GATHER = false;
    const char* P; const char* Wuq; const char* Wukv; int G, c;
    __device__ __forceinline__ bool next(int i, Unit& u) const {
        const int L = i * G + c, nwg = NPAN * 4; if (L >= nwg) return false;
        const int w = xcd_remap(L, nwg), p = w >> 2, pn = w & 3;
        u.pm = p; u.pn = pn; u.e = 0; u.j = 0; u.cnt = 0;
        u.a = P + (size_t)p * 256 * PW * 2 + (pn >= 2 ? 512 : 0);
        u.b = (pn >= 2 ? Wukv : Wuq) + (size_t)(pn & 1) * 256 * 256 * 2; return true;
    }
    __device__ __forceinline__ int arow(const Unit&, int r) const { return r; }
};
struct ChainMap {
    int x, r;
    __device__ __forceinline__ int nchain() const { return r < 4 ? 2 : 1; }
    __device__ __forceinline__ int chain(int j) const { return r + 32 * j; }
    __device__ __forceinline__ int nplain() const { return r < 4 ? 1 : (r < 24 ? 4 : 3); }
    __device__ __forceinline__ int plain(int j) const { return r < 4 ? 56 + r : (j == 0 ? r - 4 : (j == 1 ? 24 + r : (j == 2 ? 56 + r : 84 + r))); }
};
struct WinChainSched {
    static constexpr bool GATHER = false;
    const char* A; const char* Bt; int lda, ldb; ChainMap M;
    __device__ __forceinline__ bool next(int i, Unit& u) const {
        const int nc = M.nchain(); if (i >= nc + M.nplain()) return false;
        int q, pn;
        if (i < nc) { const int ch = M.chain(i); q = ch >> 1; pn = ch & 1; } else { const int idx = M.plain(i - nc); q = idx / 6; pn = 2 + idx - q * 6; }
        const int pm = M.x + 8 * q;
        u.pm = pm; u.pn = pn; u.e = 0; u.j = 0; u.cnt = 0;
        u.a = A + (size_t)pm * 256 * lda * 2; u.b = Bt + (size_t)pn * 256 * ldb * 2; return true;
    }
    __device__ __forceinline__ int arow(const Unit&, int r) const { return r; }
};
struct UpChainSched {
    static constexpr bool GATHER = false;
    const char* P; const char* Wuq; const char* Wukv; ChainMap M;
    __device__ __forceinline__ bool next(int i, Unit& u) const {
        if (i >= 2 * M.nchain()) return false;
        const int ch = M.chain(i >> 1), q = ch >> 1, hf = ch & 1, pn = 2 * hf + (i & 1), pm = M.x + 8 * q;
        u.pm = pm; u.pn = pn; u.e = 0; u.j = 0; u.cnt = 0;
        u.a = P + (size_t)pm * 256 * PW * 2 + (hf ? 512 : 0);
        u.b = (hf ? Wukv : Wuq) + (size_t)(pn & 1) * 256 * 256 * 2; return true;
    }
    __device__ __forceinline__ int arow(const Unit&, int r) const { return r; }
};
template <bool GATHER_> struct MoeSched {
    static constexpr bool GATHER = GATHER_;
    const char* A; const char* Bt; const int* slot_tok; volatile LAS int* PB; volatile LAS int* CNT; int nN, G, c; size_t bexp; int ln;
    __device__ __forceinline__ bool next(int i, Unit& u) const {
        const int np = PB[32], nwg = np * nN; const int L = i * G + c; if (L >= nwg) return false;
        const int w = xcd_remap(L, nwg), p = w / nN, pn = w % nN;
        const unsigned long long bal = __ballot(PB[ln + 1] <= p);
        const int e = __builtin_popcount((unsigned)(bal & 0xffffffffull));
        u.pm = p; u.pn = pn; u.e = e; u.j = p - PB[e]; u.cnt = CNT[e];
        u.a = GATHER ? A : A + (size_t)p * 256 * D;
        u.b = Bt + (size_t)e * bexp + (size_t)pn * 256 * D; return true;
    }
    __device__ __forceinline__ int arow_raw(const Unit& u, int r) const { if constexpr (GATHER) return slot_tok[(size_t)u.e * T + min(u.j * 256 + r, u.cnt - 1)]; else return r; }
    __device__ __forceinline__ int arow_fix(const Unit& u, int r, int v) const { if constexpr (GATHER) return (u.j * 256 + r) < u.cnt ? v : 0; else return r; }
    __device__ __forceinline__ int arow(const Unit& u, int r) const {
        if constexpr (GATHER) { const int pos = u.j * 256 + r; const int v = slot_tok[(size_t)u.e * T + min(pos, u.cnt - 1)]; return pos < u.cnt ? v : 0; }
        else return r;
    }
};

__device__ __forceinline__ void rope4(f32x4& v0, f32x4& v1, const f32x4* tab) {
    const f32x4 t0 = tab[0], t1 = tab[1];
    f32x4 a, b;
    a[0] = v0[0] * t0[0] - v0[1] * t0[1]; a[1] = v0[1] * t0[0] + v0[0] * t0[1];
    a[2] = v0[2] * t0[2] - v0[3] * t0[3]; a[3] = v0[3] * t0[2] + v0[2] * t0[3];
    b[0] = v1[0] * t1[0] - v1[1] * t1[1]; b[1] = v1[1] * t1[0] + v1[0] * t1[1];
    b[2] = v1[2] * t1[2] - v1[3] * t1[3]; b[3] = v1[3] * t1[2] + v1[2] * t1[3];
    v0 = a; v1 = b;
}
__device__ __forceinline__ u32x4 pack8(const f32x4& v0, const f32x4& v1) { u32x4 w; w.x = cvtpk(v0[0], v0[1]); w.y = cvtpk(v0[2], v0[3]); w.z = cvtpk(v1[0], v1[1]); w.w = cvtpk(v1[2], v1[3]); return w; }

struct EpiWin {
    static constexpr bool PERM = true, PROBE = false; static constexpr int NST = 16;
    bf16_t* P; float* ssq; const float* ropeR; const float* ropeW;
    __device__ __forceinline__ void operator()(const f32x4 (&acc)[2][2][4][2], const Unit& u, int wr, int wc, int fr, int fq) const {
        const int pn = u.pn;
        int mode[2];
        mode[0] = (pn == 2 || pn == 3) ? 1 : ((pn == 5 || pn == 6 || pn == 7) ? 2 : 0);
        mode[1] = (pn == 2 || pn == 3) ? 1 : ((pn == 5 || pn == 6) ? 2 : ((pn == 1 && wc == 0) ? 1 : 0));
        const int iR = 4 * fq, iW = 16 * (wc & 1) + 4 * fq;
        f32x4 tb[2][2][2];
        auto rowof = [&](int g) { return u.pm * 256 + (g >> 2) * 128 + wr * 64 + (g & 3) * 16 + fr; };
        auto ldtab = [&](int g) {
            const int nb = rowof(g) % NTK; const int t = nb >= CTX ? nb - CTX : 0;
#pragma unroll
            for (int bj = 0; bj < 2; ++bj) {
                if (mode[bj] == 1) { const f32x4* p = (const f32x4*)(ropeR + ((size_t)t * 16 + iR) * 2); tb[g & 1][bj][0] = p[0]; tb[g & 1][bj][1] = p[1]; }
                else if (mode[bj] == 2) { const f32x4* p = (const f32x4*)(ropeW + ((size_t)t * 32 + iW) * 2); tb[g & 1][bj][0] = p[0]; tb[g & 1][bj][1] = p[1]; }
            }
        };
        ldtab(0);
#pragma unroll
        for (int g = 0; g < 8; ++g) {
            const int ai = g >> 2, m = g & 3;
            const int row = rowof(g);
            const bool latent = (row % NTK) >= CTX;
            if (g + 1 < 8) ldtab(g + 1);
            float ss = 0.f;
#pragma unroll
            for (int bj = 0; bj < 2; ++bj) {
                f32x4 v0 = acc[ai][bj][m][0] * F8_INV, v1 = acc[ai][bj][m][1] * F8_INV;
                if (pn == 0 || (pn == 1 && bj == 0)) ss += (v0[0] * v0[0] + v0[1] * v0[1]) + (v0[2] * v0[2] + v0[3] * v0[3]) + (v1[0] * v1[0] + v1[1] * v1[1]) + (v1[2] * v1[2] + v1[3] * v1[3]);
                if (mode[bj] != 0) {
                    f32x4 t0 = tb[g & 1][bj][0], t1 = tb[g & 1][bj][1];
                    if (!latent) { t0 = (f32x4){1.f, 0.f, 1.f, 0.f}; t1 = t0; }
                    const f32x4 tt[2] = {t0, t1};
                    rope4(v0, v1, tt);
                }
                *(u32x4*)(P + (size_t)row * PW + pn * 256 + bj * 128 + wc * 32 + fq * 8) = pack8(v0, v1);
            }
            if (pn < 2) { ss += __shfl_xor(ss, 16); ss += __shfl_xor(ss, 32); if (fq == 0) ssq[(size_t)row * 8 + pn * 4 + wc] = ss; }
        }
    }
};
struct EpiUp {
    static constexpr bool PERM = true, PROBE = false; static constexpr int NST = 0;
    bf16_t* QM; bf16_t* KVM; const float* ssq; const float* ropeR;
    __device__ __forceinline__ void operator()(const f32x4 (&acc)[2][2][4][2], const Unit& u, int wr, int wc, int fr, int fq) const {
        const bool isq = u.pn < 2;
        int col0[2], rp[2];
#pragma unroll
        for (int bj = 0; bj < 2; ++bj) { col0[bj] = (u.pn & 1) * 256 + bj * 128 + wc * 32 + fq * 8; const int hl = col0[bj] % 96; rp[bj] = (isq && col0[bj] < 384 && hl >= 64) ? ((hl - 64) >> 1) : -1; }
        f32x4 sq[2]; f32x4 tb[2][2][2];
        auto rowof = [&](int g) { return u.pm * 256 + (g >> 2) * 128 + wr * 64 + (g & 3) * 16 + fr; };
        auto ld = [&](int g) {
            const int row = rowof(g); const int nb = row % NTK; const int t = nb >= CTX ? nb - CTX : 0;
            sq[g & 1] = *(const f32x4*)(ssq + (size_t)row * 8 + (isq ? 0 : 4));
#pragma unroll
            for (int bj = 0; bj < 2; ++bj) if (rp[bj] >= 0) { const f32x4* p = (const f32x4*)(ropeR + ((size_t)t * 16 + rp[bj]) * 2); tb[g & 1][bj][0] = p[0]; tb[g & 1][bj][1] = p[1]; }
        };
        ld(0);
#pragma unroll
        for (int g = 0; g < 8; ++g) {
            const int ai = g >> 2, m = g & 3;
            const int row = rowof(g);
            const bool latent = (row % NTK) >= CTX;
            if (g + 1 < 8) ld(g + 1);
            const f32x4 s4 = sq[g & 1];
            const float ssum = (s4[0] + s4[1]) + (s4[2] + s4[3]);
            const float rstd = __builtin_amdgcn_rsqf(ssum * (isq ? (1.f / 256.f) : (1.f / 128.f)) + EPS);
#pragma unroll
            for (int bj = 0; bj < 2; ++bj) {
                f32x4 v0 = acc[ai][bj][m][0] * rstd, v1 = acc[ai][bj][m][1] * rstd;
                if (isq) {
                    if (col0[bj] < 384) {
                        if (rp[bj] >= 0) {
                            f32x4 t0 = tb[g & 1][bj][0], t1 = tb[g & 1][bj][1];
                            if (!latent) { t0 = (f32x4){1.f, 0.f, 1.f, 0.f}; t1 = t0; }
                            const f32x4 tt[2] = {t0, t1};
                            rope4(v0, v1, tt);
                        }
                        *(u32x4*)(QM + (size_t)row * 384 + col0[bj]) = pack8(v0, v1);
                    }
                } else *(u32x4*)(KVM + (size_t)row * 512 + col0[bj]) = pack8(v0, v1);
            }
        }
    }
};
struct EpiWout {
    static constexpr bool PERM = true, PROBE = false; static constexpr int NST = 16;
    bf16_t* X; const float* modl;
    __device__ __forceinline__ void operator()(const f32x4 (&acc)[2][2][4][2], const Unit& u, int wr, int wc, int fr, int fq) const {
        const int b = u.pm / 9, modrow = (u.pm - b * 9 == 0) ? 16 : b;
        const float* gate = modl + (size_t)modrow * 6144 + 2 * D;
        const int col0 = u.pn * 256 + wc * 32 + 8 * fq;
        f32x4 gv[2][2];
#pragma unroll
        for (int bj = 0; bj < 2; ++bj)
#pragma unroll
            for (int n = 0; n < 2; ++n) gv[bj][n] = *(const f32x4*)(gate + col0 + bj * 128 + n * 4);
        u32x4 xq[2][2];
        auto rowp = [&](int g) { return X + (size_t)(u.pm * 256 + (g >> 2) * 128 + wr * 64 + (g & 3) * 16 + fr) * D + col0; };
        xq[0][0] = *(const u32x4*)(rowp(0)); xq[0][1] = *(const u32x4*)(rowp(0) + 128);
#pragma unroll
        for (int g = 0; g < 8; ++g) {
            const int ai = g >> 2, m = g & 3;
            if (g + 1 < 8) { xq[(g + 1) & 1][0] = *(const u32x4*)(rowp(g + 1)); xq[(g + 1) & 1][1] = *(const u32x4*)(rowp(g + 1) + 128); }
#pragma unroll
            for (int bj = 0; bj < 2; ++bj) {
                const u32x4 xw = xq[g & 1][bj];
                f32x4 x0 = {bflo(xw.x), bfhi(xw.x), bflo(xw.y), bfhi(xw.y)}, x1 = {bflo(xw.z), bfhi(xw.z), bflo(xw.w), bfhi(xw.w)};
                x0 += gv[bj][0] * (acc[ai][bj][m][0] * F8_INVM); x1 += gv[bj][1] * (acc[ai][bj][m][1] * F8_INVM);
                *(u32x4*)(rowp(g) + bj * 128) = pack8(x0, x1);
            }
        }
    }
};
__device__ __forceinline__ f32x4 swiglu4(f32x4 g, f32x4 up, float s) {
    g = __builtin_elementwise_min(g, (f32x4){7.0f, 7.0f, 7.0f, 7.0f});
    up = __builtin_elementwise_min(__builtin_elementwise_max(up, (f32x4){-7.0f, -7.0f, -7.0f, -7.0f}), (f32x4){7.0f, 7.0f, 7.0f, 7.0f});
    const f32x4 t = g * (-1.702f * LOG2E);
    f32x4 e; e[0] = __builtin_amdgcn_exp2f(t[0]); e[1] = __builtin_amdgcn_exp2f(t[1]); e[2] = __builtin_amdgcn_exp2f(t[2]); e[3] = __builtin_amdgcn_exp2f(t[3]);
    const f32x4 d = e + 1.0f;
    f32x4 r; r[0] = __builtin_amdgcn_rcpf(d[0]); r[1] = __builtin_amdgcn_rcpf(d[1]); r[2] = __builtin_amdgcn_rcpf(d[2]); r[3] = __builtin_amdgcn_rcpf(d[3]);
    return (g * r) * (up * s + s);
}
struct EpiGateUp {
    static constexpr bool PERM = true, PROBE = true; static constexpr int NST = 4;
    unsigned char* ACT; const float* bg; const float* bu;
    __device__ __forceinline__ void operator()(const f32x4 (&acc)[2][2][4][2], const Unit& u, int wr, int wc, int fr, int fq) const {
        const int colL = u.pn * 128 + wc * 32 + fq * 8;
        const f32x4 g0 = *(const f32x4*)(bg + (size_t)u.e * D + colL), g1 = *(const f32x4*)(bg + (size_t)u.e * D + colL + 4);
        const f32x4 u0 = *(const f32x4*)(bu + (size_t)u.e * D + colL), u1 = *(const f32x4*)(bu + (size_t)u.e * D + colL + 4);
#pragma unroll
        for (int ai = 0; ai < 2; ++ai)
#pragma unroll
            for (int mp = 0; mp < 2; ++mp) {
                u32x2 w8[2];
#pragma unroll
                for (int h = 0; h < 2; ++h) {
                    const int m = 2 * mp + h;
                    const f32x4 ga = acc[ai][0][m][0] * F8_INV + g0, gb = acc[ai][0][m][1] * F8_INV + g1, ua = acc[ai][1][m][0] * F8_INV + u0, ub = acc[ai][1][m][1] * F8_INV + u1;
                    const f32x4 ra = swiglu4(ga, ua, F8_SA), rb = swiglu4(gb, ub, F8_SA);
                    w8[h].x = (unsigned)__builtin_amdgcn_cvt_pk_fp8_f32(ra[2], ra[3], __builtin_amdgcn_cvt_pk_fp8_f32(ra[0], ra[1], 0, false), true);
                    w8[h].y = (unsigned)__builtin_amdgcn_cvt_pk_fp8_f32(rb[2], rb[3], __builtin_amdgcn_cvt_pk_fp8_f32(rb[0], rb[1], 0, false), true);
                }
                const auto sx = __builtin_amdgcn_permlane16_swap(w8[0].x, w8[1].x, false, false), sy = __builtin_amdgcn_permlane16_swap(w8[0].y, w8[1].y, false, false);
                const int srow = u.pm * 256 + ai * 128 + wr * 64 + (2 * mp + (fq & 1)) * 16 + fr;
                u32x4 w16; w16.x = sx[0]; w16.y = sy[0]; w16.z = sx[1]; w16.w = sy[1];
                *(u32x4*)(ACT + (size_t)srow * D + (u.pn * 128 + wc * 32 + (fq & 2) * 8)) = w16;
            }
    }
};
struct EpiDown {
    static constexpr bool PERM = true, PROBE = true; static constexpr int NST = 8;
    bf16_t* Y; const float* bd; const float* slot_w;
    __device__ __forceinline__ void operator()(const f32x4 (&acc)[2][2][4][2], const Unit& u, int wr, int wc, int fr, int fq) const {
        const int col0 = u.pn * 256 + wc * 32 + fq * 8;
        f32x4 bv[2][2];
#pragma unroll
        for (int bj = 0; bj < 2; ++bj)
#pragma unroll
            for (int n = 0; n < 2; ++n) bv[bj][n] = *(const f32x4*)(bd + (size_t)u.e * D + col0 + bj * 128 + n * 4);
        float wv[8];
#pragma unroll
        for (int g = 0; g < 8; ++g) { const int pos = u.j * 256 + (g >> 2) * 128 + wr * 64 + (g & 3) * 16 + fr; wv[g] = slot_w[(size_t)u.e * T + min(pos, u.cnt - 1)]; }
#pragma unroll
        for (int g = 0; g < 8; ++g) { const int pos = u.j * 256 + (g >> 2) * 128 + wr * 64 + (g & 3) * 16 + fr; wv[g] = pos < u.cnt ? wv[g] : 0.f; }
#pragma unroll
        for (int ai = 0; ai < 2; ++ai)
#pragma unroll
            for (int mp = 0; mp < 2; ++mp) {
                const int rl = ai * 128 + wr * 64 + (2 * mp + (fq & 1)) * 16 + fr;
#pragma unroll
                for (int bj = 0; bj < 2; ++bj) {
                    u32x2 w8[2];
#pragma unroll
                    for (int h = 0; h < 2; ++h) {
                        const int m = 2 * mp + h; const float w = wv[ai * 4 + m];
                        const f32x4 v0 = (acc[ai][bj][m][0] * F8_INV + bv[bj][0]) * (w * F8_SY), v1 = (acc[ai][bj][m][1] * F8_INV + bv[bj][1]) * (w * F8_SY);
                        w8[h].x = (unsigned)__builtin_amdgcn_cvt_pk_fp8_f32(v0[2], v0[3], __builtin_amdgcn_cvt_pk_fp8_f32(v0[0], v0[1], 0, false), true);
                        w8[h].y = (unsigned)__builtin_amdgcn_cvt_pk_fp8_f32(v1[2], v1[3], __builtin_amdgcn_cvt_pk_fp8_f32(v1[0], v1[1], 0, false), true);
                    }
                    const auto sx = __builtin_amdgcn_permlane16_swap(w8[0].x, w8[1].x, false, false), sy = __builtin_amdgcn_permlane16_swap(w8[0].y, w8[1].y, false, false);
                    u32x4 w16; w16.x = sx[0]; w16.y = sy[0]; w16.z = sx[1]; w16.w = sy[1];
                    *(u32x4*)((unsigned char*)Y + (size_t)(u.pm * 256 + rl) * D + (u.pn * 256 + wc * 32 + (fq & 2) * 8) + bj * 128) = w16;
                }
            }
    }
};
}

__device__ __forceinline__ int winmap(int p, float& sc) {
    sc = 1.f;
    if (p < 384) return p;
    if (p < 416) return 384 + il(p - 384, 32);
    if (p < 512) return -1;
    if (p < 768)  { const int q = p - 512;  sc = SC_DIFF; return 416 + (q & ~31) + il(q & 31, 32); }
    if (p < 1024) { const int q = p - 768;  return 672 + (q & ~31) + il(q & 31, 32); }
    if (p < 1280) return 928 + (p - 1024);
    if (p < 1792) { const int q = p - 1280; sc = SC_SWA; return 1184 + (q & ~63) + il(q & 63, 64); }
    if (p < 1920) { const int q = p - 1792; return 1696 + (q & ~63) + il(q & 63, 64); }
    return 1824 + (p - 1920);
}
__device__ __forceinline__ int uqmap(int n) {
    if (n >= 384) return -1;
    const int h = n / 96, i = n - h * 96;
    return h * 96 + (i < 64 ? i : 64 + il(i - 64, 32));
}
struct CvtItem { const float* src; int ld, kvalid, k0, n0, nrows, mapkind, ldd; bf16_t* dst; const float* rowscale; };
constexpr int CVT_PER_LAYER = 256 + 16 + 16 + 8;
constexpr int CVT_ITEMS = NL * CVT_PER_LAYER;
__device__ __forceinline__ void cvt_decode(const Args& a, unsigned char* ws, int it, CvtItem& c) {
    const int l = it / CVT_PER_LAYER; int r = it - l * CVT_PER_LAYER;
    c.rowscale = nullptr; c.mapkind = 0; c.nrows = 64;
    if (r < 256) { c.src = a.in[7] + (size_t)l * D * 1952; c.ld = 1952; c.kvalid = D; c.k0 = (r >> 5) * 128; c.n0 = (r & 31) * 64; c.mapkind = 1; c.ldd = D;
        c.dst = (bf16_t*)(ws + WS_WIN + ((size_t)l * PW * D + (size_t)c.n0 * D)); return; }
    r -= 256;
    if (r < 16) { c.src = a.in[9] + (size_t)l * 256 * 384; c.ld = 384; c.kvalid = 256; c.k0 = (r >> 3) * 128; c.n0 = (r & 7) * 64; c.mapkind = 2; c.ldd = 256; c.rowscale = a.in[8] + l * 256;
        c.dst = (bf16_t*)(ws + WS_WUQ) + (size_t)l * 512 * 256 + (size_t)c.n0 * 256; return; }
    r -= 16;
    if (r < 16) { c.src = a.in[11] + (size_t)l * 128 * 512; c.ld = 512; c.kvalid = 128; c.k0 = (r >> 3) * 128; c.n0 = (r & 7) * 64; c.ldd = 256; c.rowscale = a.in[10] + l * 128;
        c.dst = (bf16_t*)(ws + WS_WUKV) + (size_t)l * 512 * 256 + (size_t)c.n0 * 256; return; }
    r -= 16;
    c.src = a.in[17] + (size_t)l * D * 32; c.ld = 32; c.kvalid = D; c.k0 = r * 128; c.n0 = 0; c.nrows = 32; c.mapkind = 3; c.ldd = D;
    c.dst = (bf16_t*)(ws + WS_WR) + (size_t)l * 32 * D;
}
constexpr int FAST_MATS = NL * (1 + 3 * NE);
constexpr int FAST_ITEMS = FAST_MATS * 256;
constexpr int FAST_PER_LAYER = (1 + 3 * NE) * 256;
constexpr int CONV_CHUNK = 64, CONV_NCHUNK = FAST_PER_LAYER / CONV_CHUNK;
__device__ __forceinline__ void fast_decode(const Args& a, unsigned char* ws, int it, const float*& src, unsigned char*& dst8, bool& f8) {
    const int mat = it >> 8, tile = it & 255, k0 = (tile >> 4) * 64, n0 = (tile & 15) * 64;
    const int l = mat / (1 + 3 * NE); int r = mat - l * (1 + 3 * NE);
    const float* sb;
    if (r == 0) { sb = a.in[15] + (size_t)l * D * D; dst8 = ws + WS_WOUT + ((size_t)l * D * D + (size_t)n0 * D + k0); f8 = true; }
    else { r -= 1; const int e = r / 3, which = r - e * 3; const size_t le = (size_t)l * NE + e; f8 = true;
        if (which == 0)      { sb = a.in[19] + le * D * D; dst8 = ws + WS_WGU + le * 2048 * D + (size_t)((n0 >> 7) * 256 + (n0 & 127)) * D + k0; }
        else if (which == 1) { sb = a.in[21] + le * D * D; dst8 = ws + WS_WGU + le * 2048 * D + (size_t)((n0 >> 7) * 256 + 128 + (n0 & 127)) * D + k0; }
        else                 { sb = a.in[23] + le * D * D; dst8 = ws + WS_WD + le * D * D + (size_t)n0 * D + k0; } }
    src = sb + (size_t)k0 * D + n0;
}
__device__ __forceinline__ void fast_convert(Frame& F, const Args& a, int tid, int it0, int it1, int gw, int NGW) {
    unsigned char* ws = F.ws;
    const int lane = tid & 63, q = lane >> 4, c4 = (lane & 15) * 4;
    LAS unsigned char* tl = F.lds + F.wave * 8704;
    f32x4 v[16]; const float* src; unsigned char* dst8; bool f8;
#define FAST_LOAD() do { _Pragma("unroll") for (int x = 0; x < 16; ++x) { const int kr = f8 ? 16 * (x >> 2) + 4 * q + (x & 3) : 8 * (x >> 1) + 2 * q + (x & 1); \
        v[x] = __builtin_nontemporal_load((const f32x4*)(src + (size_t)kr * D + c4)); } } while (0)
    int it = it0 + gw;
    if (it < it1) { fast_decode(a, ws, it, src, dst8, f8); FAST_LOAD(); }
    for (; it < it1; it += NGW) {
        unsigned char* cdst = dst8; const bool cf8 = f8;
        if (cf8) {
#pragma unroll
            for (int i = 0; i < 4; ++i)
#pragma unroll
                for (int j = 0; j < 4; ++j)
                    *(LAS unsigned*)(tl + (c4 + j) * 68 + 16 * i + 4 * q) = (unsigned)__builtin_amdgcn_cvt_pk_fp8_f32(v[4 * i + 2][j] * F8_SW, v[4 * i + 3][j] * F8_SW, __builtin_amdgcn_cvt_pk_fp8_f32(v[4 * i][j] * F8_SW, v[4 * i + 1][j] * F8_SW, 0, false), true);
        } else {
#pragma unroll
            for (int i = 0; i < 8; ++i)
#pragma unroll
                for (int j = 0; j < 4; ++j) *(LAS unsigned*)(tl + (c4 + j) * 136 + (8 * i + 2 * q) * 2) = cvtpk(v[2 * i][j], v[2 * i + 1][j]);
        }
        const int nx = it + NGW;
        if (nx < it1) { fast_decode(a, ws, nx, src, dst8, f8); FAST_LOAD(); }
        asm volatile("s_waitcnt lgkmcnt(0)" ::: "memory");
        if (cf8) {
#pragma unroll
            for (int p = 0; p < 4; ++p) {
                const int n = 16 * p + (lane >> 2), c = lane & 3;
                const LAS unsigned* t4 = (const LAS unsigned*)(tl + n * 68 + c * 16);
                u32x4 w; w.x = t4[0]; w.y = t4[1]; w.z = t4[2]; w.w = t4[3];
                __builtin_nontemporal_store(w, (u32x4*)(cdst + (size_t)n * D + c * 16));
            }
        } else {
#pragma unroll
            for (int p = 0; p < 8; ++p) {
                const int n = 8 * p + (lane >> 3), c = lane & 7;
                const u32x2 lo = *(const LAS u32x2*)(tl + n * 136 + c * 16), hi2 = *(const LAS u32x2*)(tl + n * 136 + c * 16 + 8);
                u32x4 w; w.x = lo.x; w.y = lo.y; w.z = hi2.x; w.w = hi2.y;
                __builtin_nontemporal_store(w, (u32x4*)(cdst + (size_t)n * D * 2 + c * 16));
            }
        }
        asm volatile("s_waitcnt lgkmcnt(0)" ::: "memory");
    }
#undef FAST_LOAD
}
__device__ __forceinline__ void cvt_load(const CvtItem& c, int tid, float (&v)[16]) {
    const int nn = tid & 63, kk = tid >> 6;
    float sc = 1.f; int sn;
    if (c.mapkind == 1) sn = winmap(c.n0 + nn, sc);
    else if (c.mapkind == 2) { sn = uqmap(c.n0 + nn); sc = SC_MLA; }
    else if (c.mapkind == 3) sn = nn < 32 ? nn : -1;
    else sn = c.n0 + nn;
#pragma unroll
    for (int i = 0; i < 16; ++i) {
        const int k = c.k0 + kk + 8 * i;
        float x = 0.f;
        if (sn >= 0 && k < c.kvalid) { x = c.src[(size_t)k * c.ld + sn] * sc; if (c.rowscale) x *= c.rowscale[k]; }
        v[i] = x;
    }
}
__device__ __forceinline__ void prologue_phase(Frame& F, const Args& a) {
    unsigned char* ws = F.ws;
    const int tid = opaque_tid();
    __syncthreads();
    {
        LAS unsigned short* tile = (LAS unsigned short*)F.lds;
        float v[16]; CvtItem c;
        int it = F.vcu;
        if (it < CVT_ITEMS) { cvt_decode(a, ws, it, c); cvt_load(c, tid, v); }
        for (; it < CVT_ITEMS; it += F.G) {
            const int nn = tid & 63, kk = tid >> 6;
            const bool f8 = (c.mapkind == 1);
            if (f8) {
                LAS unsigned char* t8 = (LAS unsigned char*)tile;
#pragma unroll
                for (int i = 0; i < 16; ++i) t8[nn * 132 + kk + 8 * i] = (unsigned char)(__builtin_amdgcn_cvt_pk_fp8_f32(v[i] * F8_SW, 0.f, 0, false) & 0xff);
            } else {
#pragma unroll
                for (int i = 0; i < 16; ++i) tile[nn * 130 + kk + 8 * i] = (unsigned short)(cvtpk(v[i], 0.f) & 0xffffu);
            }
            __syncthreads();
            const CvtItem cc = c;
            const int nx = it + F.G;
            if (nx < CVT_ITEMS) { cvt_decode(a, ws, nx, c); cvt_load(c, tid, v); }
            const LAS unsigned* t32 = (const LAS unsigned*)tile;
            if (f8) {
                const int n = tid >> 3, ch = tid & 7;
                u32x4 w; const LAS unsigned* s = t32 + n * 33 + ch * 4;
                w.x = s[0]; w.y = s[1]; w.z = s[2]; w.w = s[3];
                *(u32x4*)((unsigned char*)cc.dst + (size_t)n * cc.ldd + cc.k0 + ch * 16) = w;
            } else {
#pragma unroll
                for (int p = 0; p < 2; ++p) {
                    const int n = (tid >> 4) + 32 * p, ch = tid & 15;
                    if (n < cc.nrows) {
                        u32x4 w; const LAS unsigned* s = t32 + n * 65 + ch * 4;
                        w.x = s[0]; w.y = s[1]; w.z = s[2]; w.w = s[3];
                        *(u32x4*)(cc.dst + (size_t)n * cc.ldd + cc.k0 + ch * 8) = w;
                    }
                }
            }
            __syncthreads();
        }
    }
    {
        LAS float* sil = (LAS float*)F.lds;
        LAS float* part = (LAS float*)(F.lds + 1024 * 17 * 4);
        __syncthreads();
        for (int i = tid; i < 17 * D; i += NTHR) { const int r = i / D, k = i - r * D; const float x = r < 16 ? a.in[1][(size_t)r * D + k] : a.in[3][k]; sil[k * 17 + r] = x / (1.f + __expf(-x)); }
        __syncthreads();
        float* MOD = (float*)(ws + WS_MOD);
        const int col = tid & 63, kg = tid >> 6;
        for (int ch = F.vcu; ch < NL * 96; ch += F.G) {
            const int l = ch / 96, j0 = (ch - l * 96) * 64;
            const float* w = a.in[4] + (size_t)l * D * 6144 + j0 + col;
            float accv[17];
#pragma unroll
            for (int r = 0; r < 17; ++r) accv[r] = 0.f;
#pragma unroll 4
            for (int k = kg * 128; k < kg * 128 + 128; ++k) {
                const float wv = w[(size_t)k * 6144];
#pragma unroll
                for (int r = 0; r < 17; ++r) accv[r] += sil[k * 17 + r] * wv;
            }
#pragma unroll
            for (int r = 0; r < 17; ++r) part[(kg * 17 + r) * 64 + col] = accv[r];
            __syncthreads();
            for (int i = tid; i < 17 * 64; i += NTHR) {
                const int r = i >> 6, cc = i & 63; float s = 0.f;
#pragma unroll
                for (int g = 0; g < 8; ++g) s += part[(g * 17 + r) * 64 + cc];
                MOD[((size_t)l * 17 + r) * 6144 + j0 + cc] = s + a.in[5][(size_t)l * 6144 + j0 + cc];
            }
            __syncthreads();
        }
    }
    {
        const int gt = F.vcu * NTHR + tid, GT = F.G * NTHR;
        float* ropeR = (float*)(ws + WS_ROPER); float* ropeW = (float*)(ws + WS_ROPEW);
        for (int i = gt; i < SEQ * 48; i += GT) {
            int t, j; double f; float* dst;
            if (i < SEQ * 16) { t = i >> 4; j = i & 15; f = a.invf8[j & 7]; dst = ropeR + (size_t)i * 2; const int pos = (j < 8) ? (t >> 6) : (t & 63); f *= (double)pos; }
            else { const int ii = i - SEQ * 16; t = ii >> 5; j = ii & 31; f = a.invf16[j & 15]; dst = ropeW + (size_t)ii * 2; const int pos = (j < 16) ? (t >> 6) : (t & 63); f *= (double)pos; }
            const double n = __builtin_rint(f * 0.15915494309189535);
            const double r = (f - n * 6.283185307179586) - n * 2.4492935982947064e-16;
            const double r2 = r * r;
            double s = 1.0, cs = 1.0;
#pragma unroll
            for (int q = 27; q >= 3; q -= 2) s = 1.0 - s * r2 / (double)(q * (q - 1));
            s *= r;
#pragma unroll
            for (int q = 26; q >= 2; q -= 2) cs = 1.0 - cs * r2 / (double)(q * (q - 1));
            dst[0] = (float)cs; dst[1] = (float)s;
        }
        if (gt < NL) {
            const float* lam = a.in[12] + gt * 128; float s1 = 0.f, s2 = 0.f;
            for (int k = 0; k < 32; ++k) { s1 += lam[k] * lam[32 + k]; s2 += lam[64 + k] * lam[96 + k]; }
            ((float*)(ws + WS_CTL))[CW_LAM + gt] = expf(s1) - expf(s2) + a.lam_init[gt];
        }
    }
}

__device__ __forceinline__ void load_counts(Frame& F, int l) {
    volatile LAS int* PB = (volatile LAS int*)(F.lds + MISC_OFF + 256);
    volatile LAS int* CNT = (volatile LAS int*)(F.lds + MISC_OFF + 512);
    __syncthreads();
    const int tid = opaque_tid(), lane = tid & 63;
    if (tid < 64) {
        const unsigned* cur = (const unsigned*)(F.ws + WS_CTL) + CW_CUR + l * 32;
        const int c = lane < 32 ? (int)cur[lane] : 0;
        const int np = (c + 255) >> 8;
        int incl = np;
#pragma unroll
        for (int o = 1; o < 32; o <<= 1) { const int y = __shfl_up(incl, o); if ((lane & 31) >= o) incl += y; }
        if (lane < 32) { PB[lane + 1] = incl; CNT[lane] = c; }
        if (lane == 0) PB[0] = 0;
    }
    __syncthreads();
}
template <int MODE, bool FIRST> __device__ __forceinline__ void norm1_phase(Frame& F, const Args& a, int l, bool dummy = false) {
    unsigned char* ws = F.ws;
    bf16_t* X = (bf16_t*)(ws + WS_X); bf16_t* H = (bf16_t*)(ws + WS_H); const bf16_t* Y = (const bf16_t*)(ws + WS_Y);
    bf16_t* Xw = dummy ? (bf16_t*)(ws + WS_ACT + 160 * MiB) : X; if (dummy) H = (bf16_t*)(ws + WS_ACT + 232 * MiB);
    const float* MOD = (const float*)(ws + WS_MOD);
    const unsigned* tokslot = (const unsigned*)(ws + WS_TOKSLOT);
    constexpr bool comb = (MODE == 1) || !FIRST;
    constexpr int NR = FIRST ? 4 : 2;
    const int lp = (MODE == 1) ? NL - 1 : l - 1;
    if (comb) load_counts(F, lp);
    volatile LAS int* PB = (volatile LAS int*)(F.lds + MISC_OFF + 256);
    const int lane = opaque_tid() & 63;
    int vcu_ = F.vcu; asm volatile("" : "+s"(vcu_));
    const int gw = vcu_ * NWAVES + F.wave, NGW = F.G * NWAVES;
    const int nrows = (MODE == 1) ? NB * SEQ : T;
    const float* gvec = (MODE == 1) ? a.in[25] : a.in[6] + (size_t)l * D;
    f32x4 gv[4];
#pragma unroll
    for (int j = 0; j < 4; ++j) gv[j] = *(const f32x4*)(gvec + 16 * lane + 4 * j);
    auto rowinfo = [&](int ri, int& tok, int& bb, int& nb) { if (MODE == 1) { bb = ri >> 11; nb = CTX + (ri & 2047); tok = bb * NTK + nb; } else { tok = ri; bb = tok / NTK; nb = tok - bb * NTK; } };
    auto stageA = [&](int ri, u32x4 (&raw)[NR], u32x4& ts) {
        int tok, bb, nb; rowinfo(ri, tok, bb, nb);
        if constexpr (FIRST) {
            const float* src = nb < CTX ? a.in[2] + ((size_t)bb * CTX + nb) * D : a.in[0] + ((size_t)bb * SEQ + (nb - CTX)) * D;
#pragma unroll
            for (int j = 0; j < 4; ++j) raw[j] = *(const u32x4*)(src + 16 * lane + 4 * j);
        } else {
            const u32x4* xp = (const u32x4*)(X + (size_t)tok * D + 16 * lane); raw[0] = xp[0]; raw[1] = xp[1];
        }
        if (comb) ts = *(const u32x4*)(tokslot + (size_t)tok * 4);
    };
    auto stageB = [&](const u32x4& ts, u32x4 (&yv)[4]) {
#pragma unroll
        for (int k = 0; k < 4; ++k) {
            const unsigned w = ts[k]; const int e = (int)(w >> 16), pos = (int)(w & 0xffffu);
            const unsigned char* yr = (const unsigned char*)Y + ((size_t)PB[e] * 256 + pos) * D;
            yv[k] = *(const u32x4*)(yr + 16 * lane);
        }
    };
    auto stageC = [&](int ri, const u32x4 (&raw)[NR], const u32x4 (&yv)[4]) {
        __builtin_amdgcn_sched_barrier(0);
        int tok, bb, nb; rowinfo(ri, tok, bb, nb);
        const int modrow = nb < CTX ? 16 : bb;
        f32x4 v[4];
#pragma unroll
        for (int j = 0; j < 4; ++j) {
            if constexpr (FIRST) v[j] = __builtin_bit_cast(f32x4, raw[j]);
            else { const unsigned w0 = (j & 1) ? raw[j >> 1].z : raw[j >> 1].x, w1 = (j & 1) ? raw[j >> 1].w : raw[j >> 1].y; v[j] = (f32x4){bflo(w0), bfhi(w0), bflo(w1), bfhi(w1)}; }
        }
        if (comb) {
            const float* g5 = MOD + ((size_t)lp * 17 + modrow) * 6144 + 5 * D;
#pragma unroll
            for (int j = 0; j < 4; ++j) {
                f32x4 sj = (f32x4){0.f, 0.f, 0.f, 0.f};
#pragma unroll
                for (int k = 0; k < 4; ++k) { const unsigned y = yv[k][j]; const f32x2 lo = __builtin_amdgcn_cvt_pk_f32_fp8((int)y, false), hi2 = __builtin_amdgcn_cvt_pk_f32_fp8((int)y, true); sj[0] += lo[0]; sj[1] += lo[1]; sj[2] += hi2[0]; sj[3] += hi2[1]; }
                v[j] += *(const f32x4*)(g5 + 16 * lane + 4 * j) * (sj * (1.0f / F8_SY));
            }
        }
        float ss = 0.f;
#pragma unroll
        for (int j = 0; j < 4; ++j) ss += (v[j][0] * v[j][0] + v[j][1] * v[j][1]) + (v[j][2] * v[j][2] + v[j][3] * v[j][3]);
        const float rstd = 1.0f / sqrtf(wave_sum(ss) * (1.f / D) + EPS);
        if (MODE == 1) {
            float* o = a.out + (size_t)ri * D;
#pragma unroll
            for (int j = 0; j < 4; ++j) *(f32x4*)(o + 16 * lane + 4 * j) = v[j] * rstd * gv[j];
        } else {
            const float* mr = MOD + ((size_t)l * 17 + modrow) * 6144;
            u32x4 xb[2], h8;
#pragma unroll
            for (int j = 0; j < 4; ++j) {
                const unsigned p0 = cvtpk(v[j][0], v[j][1]), p1 = cvtpk(v[j][2], v[j][3]);
                if (j & 1) { xb[j >> 1].z = p0; xb[j >> 1].w = p1; } else { xb[j >> 1].x = p0; xb[j >> 1].y = p1; }
                const f32x4 sh = *(const f32x4*)(mr + 16 * lane + 4 * j), sc = *(const f32x4*)(mr + D + 16 * lane + 4 * j);
                const f32x4 h = (v[j] * rstd * gv[j] * (sc + 1.0f) + sh) * F8_SA;
                h8[j] = (unsigned)__builtin_amdgcn_cvt_pk_fp8_f32(h[2], h[3], __builtin_amdgcn_cvt_pk_fp8_f32(h[0], h[1], 0, false), true);
            }
            { u32x4* xp = (u32x4*)(Xw + (size_t)tok * D + 16 * lane); xp[0] = xb[0]; xp[1] = xb[1]; }
            *(u32x4*)((unsigned char*)H + (size_t)tok * D + 16 * lane) = h8;
        }
    };
    u32x4 rawC[NR], rawN[NR], rawF[NR]; u32x4 tsN = {0u, 0u, 0u, 0u}, tsF = {0u, 0u, 0u, 0u}, tsC = {0u, 0u, 0u, 0u}; u32x4 yC[4], yN[4];
    if (gw < nrows) stageA(gw, rawC, tsC);
    if (gw + NGW < nrows) stageA(gw + NGW, rawN, tsN);
    if (comb && gw < nrows) stageB(tsC, yC);
    for (int ri = gw; ri < nrows; ri += NGW) {
        if (ri + 2 * NGW < nrows) stageA(ri + 2 * NGW, rawF, tsF);
        if (comb && ri + NGW < nrows) stageB(tsN, yN);
        stageC(ri, rawC, yC);
#pragma unroll
        for (int j = 0; j < NR; ++j) { rawC[j] = rawN[j]; rawN[j] = rawF[j]; }
        tsN = tsF;
#pragma unroll
        for (int k = 0; k < 4; ++k) yC[k] = yN[k];
    }
}
__device__ __forceinline__ void norm2_router_phase(Frame& F, const Args& a, int l) {
    unsigned char* ws = F.ws;
    const bf16_t* X = (const bf16_t*)(ws + WS_X); unsigned char* H8 = (unsigned char*)(ws + WS_H);
    const float* MOD = (const float*)(ws + WS_MOD);
    unsigned* tokslot = (unsigned*)(ws + WS_TOKSLOT); int* slot_tok = (int*)(ws + WS_SLOTTOK); float* slot_w = (float*)(ws + WS_SLOTW);
    unsigned* cursor = (unsigned*)(ws + WS_CTL) + CW_CUR + l * 32;
    const bf16_t* Wr = (const bf16_t*)(ws + WS_WR) + (size_t)l * 32 * D;
    const bool last = (l == NL - 1);
    const int ngroups = last ? NB * SEQ / 32 : T / 32;
    const int tid = opaque_tid(), lane = tid & 63, wave = F.wave, r32 = lane & 31, hi = lane >> 5;
    constexpr int FT_RS = 2064;
    LAS unsigned char* FT = F.lds;
    LAS float* LP = (LAS float*)(F.lds + 32 * FT_RS);
    LAS float* LG = LP + 8 * 32 * 33;
    LAS int* lcnt = (LAS int*)(LG + 32 * 33);
    LAS int* lbase = lcnt + 32;
    bf16x8 wf[8];
#pragma unroll
    for (int s = 0; s < 8; ++s) wf[s] = *(const bf16x8*)(Wr + (size_t)r32 * D + (8 * wave + s) * 16 + hi * 8);
    const float* gvec = a.in[16] + (size_t)l * D;
    f32x4 gv[4];
#pragma unroll
    for (int j = 0; j < 4; ++j) gv[j] = *(const f32x4*)(gvec + 16 * lane + 4 * j);
    if (tid < 32) lcnt[tid] = 0;
    __syncthreads();
    auto ginfo = [&](int g, int& tok0, int& modrow) {
        int b; bool isctx;
        if (last) { b = g >> 6; tok0 = b * NTK + CTX + (g & 63) * 32; isctx = false; } else { tok0 = g * 32; b = tok0 / NTK; isctx = (tok0 - b * NTK) < CTX; }
        modrow = isctx ? 16 : b;
    };
    u32x4 xq[4][2], xn[4][2]; f32x4 shv[4], scv[4], shn[4], scn[4];
    auto gload = [&](int g, u32x4 (&x)[4][2], f32x4 (&sh)[4], f32x4 (&sc)[4]) {
        int tok0, modrow; ginfo(g, tok0, modrow);
        const float* mr = MOD + ((size_t)l * 17 + modrow) * 6144;
#pragma unroll
        for (int q = 0; q < 4; ++q) { const u32x4* xp = (const u32x4*)(X + (size_t)(tok0 + wave * 4 + q) * D + 16 * lane); x[q][0] = xp[0]; x[q][1] = xp[1]; }
#pragma unroll
        for (int j = 0; j < 4; ++j) { sh[j] = *(const f32x4*)(mr + 3 * D + 16 * lane + 4 * j); sc[j] = *(const f32x4*)(mr + 4 * D + 16 * lane + 4 * j); }
    };
    if ((int)F.vcu >= ngroups) return;
    const int glast = F.vcu + ((ngroups - 1 - F.vcu) / F.G) * F.G;
    gload(F.vcu, xq, shv, scv);
    for (int g = F.vcu; g < ngroups; g += F.G) {
        int tok0, modrow_; ginfo(g, tok0, modrow_);
        gload(min(g + F.G, glast), xn, shn, scn);
#pragma unroll
        for (int q = 0; q < 4; ++q) {
            const int rl = wave * 4 + q, tok = tok0 + rl;
            f32x4 v[4]; float ss = 0.f;
#pragma unroll
            for (int j = 0; j < 4; ++j) { const unsigned w0 = (j & 1) ? xq[q][j >> 1].z : xq[q][j >> 1].x, w1 = (j & 1) ? xq[q][j >> 1].w : xq[q][j >> 1].y;
                v[j] = (f32x4){bflo(w0), bfhi(w0), bflo(w1), bfhi(w1)}; ss += (v[j][0] * v[j][0] + v[j][1] * v[j][1]) + (v[j][2] * v[j][2] + v[j][3] * v[j][3]); }
            const float rstd = 1.0f / sqrtf(wave_sum(ss) * (1.f / D) + EPS);
            u32x4 h8; u32x4 hb[2];
#pragma unroll
            for (int j = 0; j < 4; ++j) {
                const f32x4 h = v[j] * rstd * gv[j] * (scv[j] + 1.0f) + shv[j];
                const unsigned p0 = cvtpk(h[0], h[1]), p1 = cvtpk(h[2], h[3]);
                if (j & 1) { hb[j >> 1].z = p0; hb[j >> 1].w = p1; } else { hb[j >> 1].x = p0; hb[j >> 1].y = p1; }
                h8[j] = (unsigned)__builtin_amdgcn_cvt_pk_fp8_f32(h[2] * F8_SA, h[3] * F8_SA, __builtin_amdgcn_cvt_pk_fp8_f32(h[0] * F8_SA, h[1] * F8_SA, 0, false), true);
            }
            *(u32x4*)(H8 + (size_t)tok * D + 16 * lane) = h8;
            LAS u32x4* fp = (LAS u32x4*)(FT + rl * FT_RS + 32 * lane); fp[0] = hb[0]; fp[1] = hb[1];
        }
#pragma unroll
        for (int q = 0; q < 4; ++q) { xq[q][0] = xn[q][0]; xq[q][1] = xn[q][1]; }
#pragma unroll
        for (int j = 0; j < 4; ++j) { shv[j] = shn[j]; scv[j] = scn[j]; }
        __syncthreads();
        {
            f32x16 acc = {};
#pragma unroll
            for (int s = 0; s < 8; ++s) {
                const bf16x8 af = *(const LAS bf16x8*)(FT + r32 * FT_RS + ((8 * wave + s) * 16 + hi * 8) * 2);
                acc = __builtin_amdgcn_mfma_f32_32x32x16_bf16(af, wf[s], acc, 0, 0, 0);
            }
#pragma unroll
            for (int r = 0; r < 16; ++r) { const int row = (r & 3) + 8 * (r >> 2) + 4 * hi; LP[(wave * 32 + row) * 33 + r32] = acc[r]; }
        }
        __syncthreads();
        for (int i = tid; i < 1024; i += NTHR) {
            const int row = i >> 5, e = i & 31; float s = a.in[18][l * 32 + e];
#pragma unroll
            for (int w = 0; w < 8; ++w) s += LP[(w * 32 + row) * 33 + e];
            LG[row * 33 + e] = s;
        }
        __syncthreads();
        int te[4]; float tw[4]; int rk[4];
        if (tid < 32) {
            float lv[32];
#pragma unroll
            for (int e = 0; e < 32; ++e) lv[e] = LG[tid * 33 + e];
            float tv[4];
#pragma unroll
            for (int k = 0; k < 4; ++k) {
                float best = -3.0e38f; int bi = 0;
#pragma unroll
                for (int e = 0; e < 32; ++e) { const bool up = lv[e] > best; best = up ? lv[e] : best; bi = up ? e : bi; }
                tv[k] = best; te[k] = bi;
#pragma unroll
                for (int e = 0; e < 32; ++e) lv[e] = (e == bi) ? -3.0e38f : lv[e];
            }
            const float e1 = __expf(tv[1] - tv[0]), e2 = __expf(tv[2] - tv[0]), e3 = __expf(tv[3] - tv[0]);
            const float inv = 1.0f / (1.0f + e1 + e2 + e3);
            tw[0] = inv; tw[1] = e1 * inv; tw[2] = e2 * inv; tw[3] = e3 * inv;
#pragma unroll
            for (int k = 0; k < 4; ++k) rk[k] = atomicAdd((int*)&lcnt[te[k]], 1);
        }
        __syncthreads();
        if (tid < 32) { const int c = lcnt[tid]; lbase[tid] = c ? (int)atomicAdd(&cursor[tid], (unsigned)c) : 0; }
        __syncthreads();
        if (tid < 32) {
            const int tok = tok0 + tid; u32x4 ts;
#pragma unroll
            for (int k = 0; k < 4; ++k) { const int pos = lbase[te[k]] + rk[k]; slot_tok[(size_t)te[k] * T + pos] = tok; slot_w[(size_t)te[k] * T + pos] = tw[k]; ts[k] = ((unsigned)te[k] << 16) | (unsigned)pos; }
            *(u32x4*)(tokslot + (size_t)tok * 4) = ts;
            lcnt[tid] = 0;
        }
        __syncthreads();
    }
}

struct AttnPtrs { const bf16_t* P; const bf16_t* QM; const bf16_t* KVM; unsigned char* MIX; const float* sink; const float* subg; float lam_full, one_m_li; };
constexpr int KB_OFF0 = 0, KB_STRIDE = 16384, VB_OFF0 = 32768, VB_STRIDE = 12288, XCH_OFF = 81920;
#define ATT_PIN(x) asm volatile("" : "+v"(x))
#define ATT_SBAR() __builtin_amdgcn_sched_barrier(0)
#define ATT_THR 8.0f
#ifndef ATT_WSLICE
#define ATT_WSLICE 10
#endif
#ifndef ATT_PF
#define ATT_PF 2
#endif
template <int KIND> __device__ __forceinline__ void attn_unit(const AttnPtrs& A, int b, int h, int qblk, LAS unsigned char* lds, unsigned& qnext) {
    constexpr int DQK = KIND == 0 ? 96 : (KIND == 1 ? 32 : 64);
    constexpr int NF = DQK / 16, RSK = DQK * 2 + 16, RSV = 192, NMF = 8 + 2 * NF;
    const int tid = opaque_tid(), lane = tid & 63, r32 = lane & 31, hi = lane >> 5, wid = __builtin_amdgcn_readfirstlane(tid >> 6);
    const size_t tokb = (size_t)b * NTK;
    const int mp = KIND == 1 ? (wid >> 2) : 0;
    const int qrow0 = KIND == 1 ? qblk * 128 + (wid & 3) * 32 : qblk * 256 + wid * 32;
    const bool ctxunit = KIND == 1 ? (qblk < 2) : (qblk == 0);
    const size_t tokq = tokb + qrow0 + r32;
    const int kvh = h >> 2;
    bf16x8 qf[NF];
#pragma unroll
    for (int d0 = 0; d0 < NF; ++d0) {
        const bf16_t* src = KIND == 0 ? A.QM + tokq * 384 + h * 96 + d0 * 16 + hi * 8
                          : KIND == 1 ? A.P + tokq * PW + 512 + (2 * h + mp) * 32 + d0 * 16 + hi * 8
                                      : A.P + tokq * PW + 1280 + h * 64 + d0 * 16 + hi * 8;
        qf[d0] = *(const bf16x8*)src;
    }
    float mrun = 0.f, lrun = 0.f; f32x16 o[2]; o[0] = f32x16{}; o[1] = f32x16{};
    f32x16 negm = f32x16{};
    const int T0 = KIND == 2 ? (qblk - 1) * 256 : 0;
    int ntile, ttlo = 0;
    if (ctxunit) ntile = 4;
    else if (KIND == 2) { ttlo = max(0, (T0 >> 6) - 2); const int tthi = min(31, (T0 >> 6) + 5); ntile = 4 + (tthi - ttlo + 1); }
    else ntile = 36;
#define TILE_OF(i) ((KIND == 2 && (i) >= 4) ? 4 + ttlo + ((i) - 4) : (i))
    u32x4 krA0, krA1, vrA, krB0, krB1, vrB;
    const char* kp0; const char* kp1 = nullptr; const char* vp; unsigned ks0, ks1 = 0u, vs;
    if (KIND == 0) {
        { const int row = tid / 12, ch = tid - row * 12; const size_t tok = tokb + row;
          kp0 = ch < 8 ? (const char*)(A.KVM + tok * 512 + h * 128 + ch * 8) : (const char*)(A.P + tok * PW + 384 + (ch - 8) * 8); ks0 = ch < 8 ? 64u * 512u * 2u : 64u * PW * 2u; }
        { const int q = (tid & 255) + 512, row = q / 12, ch = q - row * 12; const size_t tok = tokb + row;
          kp1 = ch < 8 ? (const char*)(A.KVM + tok * 512 + h * 128 + ch * 8) : (const char*)(A.P + tok * PW + 384 + (ch - 8) * 8); ks1 = ch < 8 ? 64u * 512u * 2u : 64u * PW * 2u; }
        { const int row = tid >> 3, ch = tid & 7; vp = (const char*)(A.KVM + (tokb + row) * 512 + h * 128 + 64 + ch * 8); vs = 64u * 512u * 2u; }
    } else if (KIND == 1) {
        { const int m2 = tid >> 8, row = (tid & 255) >> 2, ch = tid & 3; kp0 = (const char*)(A.P + (tokb + row) * PW + 768 + (2 * h + m2) * 32 + ch * 8); ks0 = 64u * PW * 2u; }
        { const int row = tid >> 3, ch = tid & 7; vp = (const char*)(A.P + (tokb + row) * PW + 1024 + h * 64 + ch * 8); vs = 64u * PW * 2u; }
    } else {
        const int row = tid >> 3, ch = tid & 7;
        kp0 = (const char*)(A.P + (tokb + row) * PW + 1792 + kvh * 64 + ch * 8); ks0 = 64u * PW * 2u;
        vp = (const char*)(A.P + (tokb + row) * PW + 1920 + kvh * 64 + ch * 8); vs = 64u * PW * 2u;
    }
    auto gload = [&](int tt, u32x4& kr0, u32x4& kr1, u32x4& vr) {
        kr0 = *(const u32x4*)(kp0 + (size_t)tt * ks0);
        if (KIND == 0) kr1 = *(const u32x4*)(kp1 + (size_t)tt * ks1);
        vr = *(const u32x4*)(vp + (size_t)tt * vs);
    };
    auto lstore = [&](int i, const u32x4& kr0, const u32x4& kr1, const u32x4& vr) {
        LAS unsigned char* kb = lds + KB_OFF0 + (i & 1) * KB_STRIDE; LAS unsigned char* vb = lds + VB_OFF0 + (i & 3) * VB_STRIDE;
        if (KIND == 0) {
            { const int row = tid / 12, ch = tid - row * 12; *(LAS u32x4*)(kb + row * RSK + ch * 16) = kr0; }
            if (tid < 256) { const int q = tid + 512, row = q / 12, ch = q - row * 12; *(LAS u32x4*)(kb + row * RSK + ch * 16) = kr1; }
        } else if (KIND == 1) {
            const int m2 = tid >> 8, row = (tid & 255) >> 2, ch = tid & 3; *(LAS u32x4*)(kb + m2 * 8192 + row * RSK + ch * 16) = kr0;
        } else { const int row = tid >> 3, ch = tid & 7; *(LAS u32x4*)(kb + row * RSK + ch * 16) = kr0; }
        { const int row = tid >> 3, ch = tid & 7; *(LAS u32x4*)(vb + row * RSV + ch * 16) = vr; }
    };
    const int qpos = T0 + wid * 32 + r32;
    const int koff = (KIND == 1 ? mp * 8192 : 0) + r32 * RSK + hi * 16;
    const int voff = ((lane >> 4) & 1) * 32 + (lane & 3) * 8 + (4 * hi + ((lane & 15) >> 2)) * RSV;
    auto fetch = [&](int j, const LAS unsigned char* vb, const LAS unsigned char* kb) -> bf16x8 {
        if (j < 8) {
            const int sI = j >> 1, d0 = j & 1;
            const v4i16_t lo = __builtin_amdgcn_ds_read_tr16_b64_v4i16((LAS v4i16_t*)(vb + voff + (16 * sI) * RSV + d0 * 64));
            const v4i16_t hh = __builtin_amdgcn_ds_read_tr16_b64_v4i16((LAS v4i16_t*)(vb + voff + (16 * sI + 8) * RSV + d0 * 64));
            return (bf16x8){lo[0], lo[1], lo[2], lo[3], hh[0], hh[1], hh[2], hh[3]};
        } else {
            const int d0 = (j - 8) >> 1, half = (j - 8) & 1;
            return *(const LAS bf16x8*)(kb + koff + half * 32 * RSK + d0 * 32);
        }
    };
    gload(TILE_OF(0), krA0, krA1, vrA); gload(TILE_OF(1), krB0, krB1, vrB);
    lstore(0, krA0, krA1, vrA); lstore(1, krB0, krB1, vrB);
    gload(TILE_OF(2), krA0, krA1, vrA);
    qnext = (unsigned)__builtin_amdgcn_readfirstlane((int)qnext);
    __syncthreads();
    f32x16 pA0 = f32x16{}, pA1 = f32x16{}, pB0, pB1;
    {
        const LAS unsigned char* kb = lds + KB_OFF0;
#pragma unroll
        for (int d0 = 0; d0 < NF; ++d0) {
            const bf16x8 k0 = *(const LAS bf16x8*)(kb + koff + d0 * 32), k1 = *(const LAS bf16x8*)(kb + koff + 32 * RSK + d0 * 32);
            pA0 = __builtin_amdgcn_mfma_f32_32x32x16_bf16(k0, qf[d0], pA0, 0, 0, 0);
            pA1 = __builtin_amdgcn_mfma_f32_32x32x16_bf16(k1, qf[d0], pA1, 0, 0, 0);
        }
    }
    bf16x8 paX[4], paY[4];
#pragma unroll
    for (int sI = 0; sI < 4; ++sI) { paX[sI] = (bf16x8){0, 0, 0, 0, 0, 0, 0, 0}; paY[sI] = (bf16x8){0, 0, 0, 0, 0, 0, 0, 0}; }
    __syncthreads();
#define ATT_STEP(C0, C1, N0, N1, PP, PC, i, KR0, KR1, VR) do { \
        const int tt_ = TILE_OF(i); \
        if (KIND == 2 && !ctxunit && tt_ >= 4) { \
            const int k0_ = (tt_ - 4) * 64, tw_ = T0 + wid * 32; \
            if (k0_ + 63 - tw_ > 128 || k0_ - (tw_ + 31) < -128) {     \
                const int kbase_ = k0_ + 4 * hi - qpos; \
                _Pragma("unroll") for (int r = 0; r < 16; ++r) { const int dk = kbase_ + (r & 3) + 8 * (r >> 2); if (dk > 128 || dk < -128) C0[r] = -1.0e30f; if (dk + 32 > 128 || dk + 32 < -128) C1[r] = -1.0e30f; } \
            } \
        } \
        const LAS unsigned char* vb_ = lds + VB_OFF0 + (((i) == 0 ? 0 : (i) - 1) & 3) * VB_STRIDE;                  \
        const LAS unsigned char* kb_ = lds + KB_OFF0 + (((i) + 1 < ntile ? (i) + 1 : (i)) & 1) * KB_STRIDE;       \
        bf16x8 op_[ATT_PF + 1]; _Pragma("unroll") for (int j = 0; j < ATT_PF; ++j) op_[j] = fetch(j, vb_, kb_); \
        float mx_ = -3.0e38f, alpha_ = 1.f; f32x2 ls2_ = {0.f, 0.f}; bool grow_ = false; \
        ATT_SBAR(); \
        _Pragma("unroll") for (int k = 0; k < 20; ++k) { \
            if (k == ATT_WSLICE) { if ((i) + 2 < ntile) lstore((i) + 2, KR0, KR1, VR); }     \
            if (k + ATT_PF < NMF) op_[(k + ATT_PF) % (ATT_PF + 1)] = fetch(k + ATT_PF, vb_, kb_); \
            if (k < 8) { o[k & 1] = __builtin_amdgcn_mfma_f32_32x32x16_bf16(op_[k % (ATT_PF + 1)], PP[k >> 1], o[k & 1], 0, 0, 0); } \
            else if (k < NMF) { const int j_ = k - 8; \
                if (j_ == 0) N0 = __builtin_amdgcn_mfma_f32_32x32x16_bf16(op_[k % (ATT_PF + 1)], qf[0], negm, 0, 0, 0); \
                else if (j_ == 1) N1 = __builtin_amdgcn_mfma_f32_32x32x16_bf16(op_[k % (ATT_PF + 1)], qf[0], negm, 0, 0, 0); \
                else if (j_ & 1) N1 = __builtin_amdgcn_mfma_f32_32x32x16_bf16(op_[k % (ATT_PF + 1)], qf[j_ >> 1], N1, 0, 0, 0); \
                else N0 = __builtin_amdgcn_mfma_f32_32x32x16_bf16(op_[k % (ATT_PF + 1)], qf[j_ >> 1], N0, 0, 0, 0); } \
            if (k < 4) { float a_ = fmaxf(fmaxf(C0[4 * k], C0[4 * k + 1]), C0[4 * k + 2]); a_ = fmaxf(fmaxf(a_, C0[4 * k + 3]), C1[4 * k]); a_ = fmaxf(fmaxf(a_, C1[4 * k + 1]), C1[4 * k + 2]); a_ = fmaxf(a_, C1[4 * k + 3]); mx_ = fmaxf(mx_, a_); ATT_PIN(mx_); } \
            else if (k == 4) { auto rr_ = __builtin_amdgcn_permlane32_swap(__float_as_uint(mx_), __float_as_uint(mx_), false, false); mx_ = fmaxf(__uint_as_float(rr_[0]), __uint_as_float(rr_[1])); \
                  \
                const bool far_ = ((i) == 0) ? (fabsf(mx_) > ATT_THR) : (mx_ > ATT_THR); \
                grow_ = __builtin_amdgcn_ballot_w64(far_) != 0ull; \
                if (grow_) { const float dl_ = ((i) == 0) ? mx_ : fmaxf(mx_, 0.f); \
                    _Pragma("unroll") for (int r = 0; r < 16; ++r) { C0[r] -= dl_; C1[r] -= dl_; } \
                    mrun += dl_; alpha_ = ((i) == 0) ? 1.0f : __builtin_amdgcn_exp2f(-dl_); \
                    _Pragma("unroll") for (int r = 0; r < 16; ++r) negm[r] = -mrun; ATT_PIN(negm); ATT_PIN(alpha_); } } \
            else if (k < 13) { const int e_ = k - 5; \
                C0[2 * e_] = __builtin_amdgcn_exp2f(C0[2 * e_]); C0[2 * e_ + 1] = __builtin_amdgcn_exp2f(C0[2 * e_ + 1]); \
                C1[2 * e_] = __builtin_amdgcn_exp2f(C1[2 * e_]); C1[2 * e_ + 1] = __builtin_amdgcn_exp2f(C1[2 * e_ + 1]); \
                ls2_ += (f32x2){C0[2 * e_], C0[2 * e_ + 1]}; ls2_ += (f32x2){C1[2 * e_], C1[2 * e_ + 1]}; ATT_PIN(ls2_); } \
            else if (k < 17) { const int c_ = k - 13; u32x4 w_; \
                if (c_ < 2) { w_.x = cvtpk(C0[8 * c_ + 0], C0[8 * c_ + 1]); w_.y = cvtpk(C0[8 * c_ + 2], C0[8 * c_ + 3]); w_.z = cvtpk(C0[8 * c_ + 4], C0[8 * c_ + 5]); w_.w = cvtpk(C0[8 * c_ + 6], C0[8 * c_ + 7]); } \
                else { const int c2_ = c_ - 2; w_.x = cvtpk(C1[8 * c2_ + 0], C1[8 * c2_ + 1]); w_.y = cvtpk(C1[8 * c2_ + 2], C1[8 * c2_ + 3]); w_.z = cvtpk(C1[8 * c2_ + 4], C1[8 * c2_ + 5]); w_.w = cvtpk(C1[8 * c2_ + 6], C1[8 * c2_ + 7]); } \
                ATT_PIN(w_); PC[c_] = __builtin_bit_cast(bf16x8, w_); } \
            else if (k == 17) { lrun = lrun * alpha_ + (ls2_[0] + ls2_[1]); if (grow_) { _Pragma("unroll") for (int r = 0; r < 16; ++r) o[0][r] *= alpha_; ATT_PIN(o[0]); } } \
            else if (k == 18) { if (grow_) { _Pragma("unroll") for (int r = 0; r < 16; ++r) o[1][r] *= alpha_; ATT_PIN(o[1]); } } \
            ATT_SBAR(); \
        } \
    } while (0)
#ifndef ATT_PRIO
#define ATT_PRIO 1
#endif
    if (ATT_PRIO && wid >= 4) __builtin_amdgcn_s_setprio(1);
    for (int i = 0; i < ntile; i += 2) {
        { const int j3 = min(i + 3, ntile - 1); gload(TILE_OF(j3), krB0, krB1, vrB); }
        ATT_STEP(pA0, pA1, pB0, pB1, paY, paX, i, krA0, krA1, vrA);
        __syncthreads();
        { const int j4 = min(i + 4, ntile - 1); gload(TILE_OF(j4), krA0, krA1, vrA); }
        ATT_STEP(pB0, pB1, pA0, pA1, paX, paY, i + 1, krB0, krB1, vrB);
        __syncthreads();
    }
#undef ATT_STEP
#undef TILE_OF
    if (ATT_PRIO) __builtin_amdgcn_s_setprio(0);
    {
        const LAS unsigned char* vb = lds + VB_OFF0 + ((ntile - 1) & 3) * VB_STRIDE;
#pragma unroll
        for (int j = 0; j < 8; ++j) { const bf16x8 vfr = fetch(j, vb, vb); o[j & 1] = __builtin_amdgcn_mfma_f32_32x32x16_bf16(vfr, paY[j >> 1], o[j & 1], 0, 0, 0); }
    }
    float lt = lrun + __shfl_xor(lrun, 32);
    if (KIND == 2) lt += __builtin_amdgcn_exp2f(A.sink[h] * LOG2E - mrun);
    const float inv = 1.0f / lt;
    const int colbase = (KIND == 0 ? 0 : (KIND == 1 ? 256 : 512)) + h * 64;
    unsigned char* orow = A.MIX + tokq * D + colbase;
    unsigned W8[2][4];
    auto store_rows = [&]() {
#pragma unroll
        for (int d0 = 0; d0 < 2; ++d0) {
            const auto s0 = __builtin_amdgcn_permlane32_swap(W8[d0][0], W8[d0][1], false, false), s1 = __builtin_amdgcn_permlane32_swap(W8[d0][2], W8[d0][3], false, false);
            const auto t0 = __builtin_amdgcn_permlane32_swap(s0[0], s1[0], false, false), t1 = __builtin_amdgcn_permlane32_swap(s0[1], s1[1], false, false);
            u32x4 w; w.x = t0[0]; w.y = t1[0]; w.z = t0[1]; w.w = t1[1];
            *(u32x4*)(orow + 32 * d0 + 16 * hi) = w;
        }
    };
    if (KIND == 1) {
        LAS float* xch = (LAS float*)(lds + XCH_OFF) + (wid & 3) * 2048 + lane;
        if (wid >= 4) {
#pragma unroll
            for (int d0 = 0; d0 < 2; ++d0)
#pragma unroll
                for (int r = 0; r < 16; ++r) xch[(d0 * 16 + r) * 64] = o[d0][r] * inv;
        }
        __syncthreads();
        if (wid < 4) {
            float ss = 0.f;
#pragma unroll
            for (int d0 = 0; d0 < 2; ++d0)
#pragma unroll
                for (int r = 0; r < 16; ++r) { const float x = o[d0][r] * inv - A.lam_full * xch[(d0 * 16 + r) * 64]; o[d0][r] = x; ss += x * x; }
            ss += __shfl_xor(ss, 32);
            const float rs = (1.0f / sqrtf(ss * (1.f / 64.f) + EPS)) * A.one_m_li;
#pragma unroll
            for (int d0 = 0; d0 < 2; ++d0)
#pragma unroll
                for (int g4 = 0; g4 < 4; ++g4) {
                    const int dd = 32 * d0 + 8 * g4 + 4 * hi;
                    const f32x4 gg = *(const f32x4*)(A.subg + dd);
                    const float rs8 = rs * F8_SM;
                    W8[d0][g4] = (unsigned)__builtin_amdgcn_cvt_pk_fp8_f32(o[d0][4 * g4 + 2] * rs8 * gg[2], o[d0][4 * g4 + 3] * rs8 * gg[3], __builtin_amdgcn_cvt_pk_fp8_f32(o[d0][4 * g4 + 0] * rs8 * gg[0], o[d0][4 * g4 + 1] * rs8 * gg[1], 0, false), true);
                }
            store_rows();
        }
    } else {
#pragma unroll
        for (int d0 = 0; d0 < 2; ++d0)
#pragma unroll
            for (int g4 = 0; g4 < 4; ++g4) {
                const float inv8 = inv * F8_SM;
                W8[d0][g4] = (unsigned)__builtin_amdgcn_cvt_pk_fp8_f32(o[d0][4 * g4 + 2] * inv8, o[d0][4 * g4 + 3] * inv8, __builtin_amdgcn_cvt_pk_fp8_f32(o[d0][4 * g4 + 0] * inv8, o[d0][4 * g4 + 1] * inv8, 0, false), true);
            }
        store_rows();
    }
    __syncthreads();
}
__device__ __forceinline__ void attn_phase(Frame& F, const Args& a, int l) {
    unsigned char* ws = F.ws;
    AttnPtrs A;
    A.P = (const bf16_t*)(ws + WS_P); A.QM = (const bf16_t*)(ws + WS_QM); A.KVM = (const bf16_t*)(ws + WS_KVM); A.MIX = (unsigned char*)(ws + WS_MIX);
    A.sink = a.in[14] + l * 8; A.subg = a.in[13] + l * 64;
    A.lam_full = ((const float*)(ws + WS_CTL))[CW_LAM + l]; A.one_m_li = 1.0f - a.lam_init[l];
    const int n1 = NB * 4 * 8, n2 = n1 + NB * 4 * 16, n3 = n2 + NB * 8 * 8;
    const int n4 = (l == NL - 1) ? n3 : n3 + NB * 4, n5 = (l == NL - 1) ? n3 : n4 + NB * 4 * 2, n6 = (l == NL - 1) ? n3 : n5 + NB * 8;
    unsigned* ctr = (unsigned*)(ws + WS_CTL) + CW_ATTQ + l;
    volatile LAS unsigned* qslot = (volatile LAS unsigned*)(F.lds + MISC_OFF + 1024);
#ifndef ATT_DUP
#define ATT_DUP 0
#endif
    const int ndup = ATT_DUP == 1 ? n1 : (ATT_DUP == 2 ? n2 - n1 : (ATT_DUP == 3 ? n3 - n2 : 0));
    const int nconv = CONV_NCHUNK, total = n6 + nconv + ndup;
    if (opaque_tid() == 0) qslot[0] = atomicAdd(ctr, 1u);
    __syncthreads();
    int u = (int)qslot[0];
    while (u < total) {
        unsigned nxt = 0u;
        if (opaque_tid() == 0) nxt = atomicAdd((unsigned*)(ws + WS_CTL) + CW_ATTQ + l, 1u);
        if ((u & 3) == 3 && (u >> 2) < nconv) {
            nxt = (unsigned)__builtin_amdgcn_readfirstlane((int)nxt);
            const int ch = u >> 2, base = l * FAST_PER_LAYER + ch * CONV_CHUNK;
            fast_convert(F, a, opaque_tid(), base, base + CONV_CHUNK, F.wave, NWAVES);
        } else {
            int ua = u - min(nconv, u >> 2);
            if (ua >= n6) ua = (ATT_DUP == 1 ? 0 : (ATT_DUP == 2 ? n1 : n2)) + (ua - n6);
            int kind, ub, uh, uq;
            if (ua < n1) { kind = 0; ub = ua >> 5; uh = (ua >> 3) & 3; uq = 1 + (ua & 7); }
            else if (ua < n2) { const int v = ua - n1; kind = 1; ub = v >> 6; uh = (v >> 4) & 3; uq = 2 + (v & 15); }
            else if (ua < n3) { const int v = ua - n2; kind = 2; ub = v >> 6; uh = (v >> 3) & 7; uq = 1 + (v & 7); }
            else if (ua < n4) { const int v = ua - n3; kind = 0; ub = v >> 2; uh = v & 3; uq = 0; }
            else if (ua < n5) { const int v = ua - n4; kind = 1; ub = v >> 3; uh = (v >> 1) & 3; uq = v & 1; }
            else { const int v = ua - n5; kind = 2; ub = v >> 3; uh = v & 7; uq = 0; }
            if (kind == 0) attn_unit<0>(A, ub, uh, uq, F.lds, nxt);
            else if (kind == 1) attn_unit<1>(A, ub, uh, uq, F.lds, nxt);
            else attn_unit<2>(A, ub, uh, uq, F.lds, nxt);
        }
        if (opaque_tid() == 0) qslot[0] = nxt;
        __syncthreads();
        u = (int)qslot[0];
    }
}

constexpr int PH_PER_LAYER = 8, N_PHASES = 2 + NL * PH_PER_LAYER;
__global__ void __launch_bounds__(NTHR, 2) trunk_fwd(Args args) {
    extern __shared__ __attribute__((aligned(16))) unsigned char lds_raw[];
    Frame F;
    F.lds = (LAS unsigned char*)lds_raw; F.ws = args.ws;
    F.tid = threadIdx.x; F.lane = F.tid & 63; F.wave = __builtin_amdgcn_readfirstlane(F.tid >> 6);
    F.G = gridDim.x; { const int bx = blockIdx.x; F.vcu = (F.G % 8 == 0) ? (bx % 8) * (F.G / 8) + bx / 8 : bx; }
    volatile LAS unsigned* MISC = (volatile LAS unsigned*)(F.lds + MISC_OFF);
    if (F.tid < 64) MISC[F.tid] = 0u;
    __syncthreads();
    const int lo = args.ph_lo, hi = args.ph_hi;
    const bool multi = (hi - lo) > 1;
    XcdBarrier bar; bar.bar = (unsigned*)(F.ws + WS_CTL) + CW_BAR; bar.x = 0; bar.st = MISC;
    if (multi) bar = xcd_barrier_post((unsigned*)(F.ws + WS_CTL) + CW_BAR, MISC);
    unsigned char* ws = F.ws;
#ifndef DIAG_KINDS
#define DIAG_KINDS 0x3ff
#endif
#ifndef REP_PRO
#define REP_PRO 1
#define REP_WIN 1
#define REP_UP 1
#define REP_ATT 1
#define REP_GU 1
#define REP_DOWN 1
#endif
#define KON(x) (((DIAG_KINDS) >> (x)) & 1)
#define IN(k) (lo <= (k) && (k) < hi)
#define SEAM(k) do { if (IN(k) && IN((k) + 1)) xcd_barrier(bar); } while (0)
    if (KON(0) && IN(0)) { asm volatile("; PHASE_MARK 0"); for (int rep = 0; rep < REP_PRO; ++rep) prologue_phase(F, args); }
    SEAM(0);
    for (int l = 0; l < NL; ++l) {
        const int pb = 1 + l * PH_PER_LAYER;
        const bool last = (l == NL - 1);
        if (KON(1) && IN(pb + 0)) { asm volatile("; PHASE_MARK 1");
#ifndef REP_N1
#define REP_N1 1
#endif
            for (int rep = 1; rep < REP_N1; ++rep) norm1_phase<0, false>(F, args, l, true);
            if (l == 0) norm1_phase<0, true>(F, args, l); else norm1_phase<0, false>(F, args, l); }
        SEAM(pb + 0);
        const bool chain = (F.G == 256);
        const pg8::ChainMap CM{(int)blockIdx.x & 7, (int)blockIdx.x >> 3};
        if (KON(2) && IN(pb + 1)) { asm volatile("; PHASE_MARK 2");
            pg8::EpiWin E{(bf16_t*)(ws + WS_P), (float*)(ws + WS_SSQ), (const float*)(ws + WS_ROPER), (const float*)(ws + WS_ROPEW)};
            if (chain) {
                pg8::WinChainSched S{(const char*)(ws + WS_H), (const char*)(ws + WS_WIN) + (size_t)l * PW * D, D / 2, D / 2, CM};
                for (int rep = 0; rep < REP_WIN; ++rep) pg8::gemm_phase<pg8::EpiWin, pg8::WinChainSched, true, true>(F.lds, D / 2, D / 2, D / 2, S, E);
            } else {
                pg8::DenseSched S{(const char*)(ws + WS_H), (const char*)(ws + WS_WIN) + (size_t)l * PW * D, D / 2, D / 2, NPAN, PW / 256, F.G, (int)blockIdx.x, 0};
                for (int rep = 0; rep < REP_WIN; ++rep) pg8::gemm_phase<pg8::EpiWin, pg8::DenseSched, true, true>(F.lds, D / 2, D / 2, D / 2, S, E);
            }
        }
        if (!chain) SEAM(pb + 1);
        else {
            __builtin_amdgcn_fence(__ATOMIC_ACQUIRE, "agent"); asm volatile("s_waitcnt vmcnt(0)" ::: "memory"); __syncthreads();
        }
        if (KON(3) && IN(pb + 2)) { asm volatile("; PHASE_MARK 3");
            pg8::EpiUp E{(bf16_t*)(ws + WS_QM), (bf16_t*)(ws + WS_KVM), (const float*)(ws + WS_SSQ), (const float*)(ws + WS_ROPER)};
            if (chain) {
                pg8::UpChainSched S{(const char*)(ws + WS_P), (const char*)(ws + WS_WUQ) + (size_t)l * 512 * 256 * 2, (const char*)(ws + WS_WUKV) + (size_t)l * 512 * 256 * 2, CM};
                for (int rep = 0; rep < REP_UP; ++rep) pg8::gemm_phase<pg8::EpiUp, pg8::UpChainSched, true>(F.lds, 256, PW, 256, S, E);
            } else {
                pg8::UpSched S{(const char*)(ws + WS_P), (const char*)(ws + WS_WUQ) + (size_t)l * 512 * 256 * 2, (const char*)(ws + WS_WUKV) + (size_t)l * 512 * 256 * 2, F.G, (int)blockIdx.x};
                for (int rep = 0; rep < REP_UP; ++rep) pg8::gemm_phase<pg8::EpiUp, pg8::UpSched, true>(F.lds, 256, PW, 256, S, E);
            }
        }
        SEAM(pb + 2);
        if (KON(4) && IN(pb + 3)) { asm volatile("; PHASE_MARK 4"); for (int rep = 0; rep < REP_ATT; ++rep) attn_phase(F, args, l); }
        SEAM(pb + 3);
        if (KON(5) && IN(pb + 4)) { asm volatile("; PHASE_MARK 5");
            pg8::DenseSched S{(const char*)(ws + WS_MIX), (const char*)(ws + WS_WOUT) + (size_t)l * D * D, D / 2, D / 2, last ? NB * 8 : NPAN, D / 256, F.G, (int)blockIdx.x, last ? 1 : 0};
            pg8::EpiWout E{(bf16_t*)(ws + WS_X), (const float*)(ws + WS_MOD) + (size_t)l * 17 * 6144};
            pg8::gemm_phase<pg8::EpiWout, pg8::DenseSched, true, true>(F.lds, D / 2, D / 2, D / 2, S, E);
        }
        SEAM(pb + 4);
        if (KON(6) && IN(pb + 5)) { asm volatile("; PHASE_MARK 6"); norm2_router_phase(F, args, l); }
        SEAM(pb + 5);
        if (KON(7) && IN(pb + 6)) { asm volatile("; PHASE_MARK 7");
            load_counts(F, l);
            pg8::MoeSched<true> S{(const char*)(ws + WS_H), (const char*)(ws + WS_WGU) + (size_t)l * NE * 2048 * D, (const int*)(ws + WS_SLOTTOK),
                                  (volatile LAS int*)(F.lds + MISC_OFF + 256), (volatile LAS int*)(F.lds + MISC_OFF + 512), 8, F.G, (int)blockIdx.x, (size_t)2048 * D, opaque_tid() & 31};
            pg8::EpiGateUp E{(unsigned char*)(ws + WS_ACT), args.in[20] + (size_t)l * NE * D, args.in[22] + (size_t)l * NE * D};
            for (int rep = 0; rep < REP_GU; ++rep) pg8::gemm_phase<pg8::EpiGateUp, pg8::MoeSched<true>, true, true>(F.lds, D / 2, D / 2, D / 2, S, E);
        }
        SEAM(pb + 6);
        if (KON(8) && IN(pb + 7)) { asm volatile("; PHASE_MARK 8");
            load_counts(F, l);
            pg8::MoeSched<false> S{(const char*)(ws + WS_ACT), (const char*)(ws + WS_WD) + (size_t)l * NE * D * D, (const int*)(ws + WS_SLOTTOK),
                                   (volatile LAS int*)(F.lds + MISC_OFF + 256), (volatile LAS int*)(F.lds + MISC_OFF + 512), 4, F.G, (int)blockIdx.x, (size_t)D * D, opaque_tid() & 31};
            pg8::EpiDown E{(bf16_t*)(ws + WS_Y), args.in[24] + (size_t)l * NE * D, (const float*)(ws + WS_SLOTW)};
            for (int rep = 0; rep < REP_DOWN; ++rep) pg8::gemm_phase<pg8::EpiDown, pg8::MoeSched<false>, true, true>(F.lds, D / 2, D / 2, D / 2, S, E);
        }
        SEAM(pb + 7);
    }
    if (KON(9) && IN(N_PHASES - 1)) { asm volatile("; PHASE_MARK 9"); norm1_phase<1, false>(F, args, NL); }
#undef IN
#undef SEAM
}

extern "C" void kernel_launch(void* const* d_in, const int* in_sizes, int n_in, void* d_out, int out_size, void* d_ws, size_t ws_size, hipStream_t stream) {
    static int grid = 0;
    if (grid == 0) {
        if (n_in != 26 || ws_size < WS_END) { fprintf(stderr, "kernel_launch: unexpected inputs (n_in %d, ws %zu)\n", n_in, ws_size); grid = -1; return; }
        int dev = 0, cus = 0, per_cu = 0;
        if (hipGetDevice(&dev) != hipSuccess || hipDeviceGetAttribute(&cus, hipDeviceAttributeMultiprocessorCount, dev) != hipSuccess) { grid = -1; return; }
        if (hipFuncSetAttribute((const void*)trunk_fwd, hipFuncAttributeMaxDynamicSharedMemorySize, LDS_BYTES) != hipSuccess) { fprintf(stderr, "kernel_launch: hipFuncSetAttribute failed\n"); grid = -1; return; }
        if (hipOccupancyMaxActiveBlocksPerMultiprocessor(&per_cu, (const void*)trunk_fwd, NTHR, LDS_BYTES) != hipSuccess || per_cu < 1)
            fprintf(stderr, "kernel_launch: occupancy query reports %d workgroups per CU\n", per_cu);
        (void)hipGetLastError();
        grid = cus;
    }
    if (grid < 0) return;
    if (hipMemsetAsync((char*)d_ws + WS_CTL, 0, CTL_ZERO_BYTES, stream) != hipSuccess) return;
    Args a{};
    for (int i = 0; i < 26; ++i) a.in[i] = (const float*)d_in[i];
    a.out = (float*)d_out; a.ws = (unsigned char*)d_ws;
    for (int i = 0; i < 8; ++i) a.invf8[i] = pow(10000.0, -(double)i / 8.0);
    for (int i = 0; i < 16; ++i) a.invf16[i] = pow(10000.0, -(double)i / 16.0);
    for (int i = 0; i < 4; ++i) a.lam_init[i] = (float)(0.8 - 0.6 * exp(-0.3 * (double)i));
#if MK_ONE_LAUNCH
    a.ph_lo = 0; a.ph_hi = N_PHASES;
    hipLaunchKernelGGL(trunk_fwd, dim3(grid), dim3(NTHR), LDS_BYTES, stream, a);
#else
    for (int p = 0; p < N_PHASES; ++p) { a.ph_lo = p; a.ph_hi = p + 1; hipLaunchKernelGGL(trunk_fwd, dim3(grid), dim3(NTHR), LDS_BYTES, stream, a); }
#endif
}
```

```cpp
#include <hip/hip_runtime.h>
#include <cstdio>
#include <cstdint>
#include <cmath>

#ifndef MK_ONE_LAUNCH
#define MK_ONE_LAUNCH 1
#endif

#define LAS __attribute__((address_space(3)))
#define GAS __attribute__((address_space(1)))
typedef unsigned short bf16_t;
typedef short bf16x8 __attribute__((ext_vector_type(8)));
typedef short v4i16_t __attribute__((ext_vector_type(4)));
typedef float f32x4 __attribute__((ext_vector_type(4)));
typedef float f32x2 __attribute__((ext_vector_type(2)));
typedef float f32x16 __attribute__((ext_vector_type(16)));
typedef unsigned u32x4 __attribute__((ext_vector_type(4)));
typedef unsigned u32x2 __attribute__((ext_vector_type(2)));
typedef __bf16 bf16x2_t __attribute__((ext_vector_type(2)));

constexpr int NB = 16, SEQ = 2048, CTX = 256, NTK = SEQ + CTX, T = NB * NTK, D = 1024, NL = 4, NE = 32;
constexpr int PW = 2048;
constexpr int NPAN = T / 256;
constexpr int MAXPAN = 608;
constexpr int NWAVES = 8, NTHR = 512;
constexpr float EPS = 1e-6f;
constexpr float LOG2E = 1.4426950408889634f;
constexpr float SC_MLA = 0.10206207261596577f * LOG2E;
constexpr float SC_DIFF = 0.17677669529663687f * LOG2E;
constexpr float SC_SWA = 0.125f * LOG2E;
constexpr float F8_SW = 64.0f, F8_SA = 4.0f;
constexpr float F8_INV = 1.0f / (F8_SW * F8_SA);
constexpr float F8_SM = 16.0f, F8_INVM = 1.0f / (F8_SW * F8_SM);
constexpr float F8_SY = 64.0f;

constexpr size_t MiB = 1u << 20;
constexpr size_t WS_CTL = 0, CTL_ZERO_BYTES = 1 * MiB;
constexpr size_t WS_MOD = 1 * MiB;
constexpr size_t WS_ROPER = 3 * MiB;
constexpr size_t WS_ROPEW = WS_ROPER + 262144;
constexpr size_t WS_SSQ = 4 * MiB;
constexpr size_t WS_TOKSLOT = 6 * MiB;
constexpr size_t WS_SLOTTOK = 7 * MiB;
constexpr size_t WS_SLOTW = 12 * MiB;
constexpr size_t WS_WR = 17 * MiB;
constexpr size_t WS_WUQ = 18 * MiB;
constexpr size_t WS_WUKV = 19 * MiB;
constexpr size_t WS_WIN = 20 * MiB;
constexpr size_t WS_WOUT = 36 * MiB;
constexpr size_t WS_WGU = 44 * MiB;
constexpr size_t WS_WD = 556 * MiB;
constexpr size_t WS_X = 812 * MiB;
constexpr size_t WS_H = 956 * MiB;
constexpr size_t WS_ACT = 1028 * MiB;
constexpr size_t WS_P = WS_ACT;
constexpr size_t WS_QM = WS_ACT + 144 * MiB;
constexpr size_t WS_KVM = WS_ACT + 171 * MiB;
constexpr size_t WS_MIX = WS_ACT + 207 * MiB;
constexpr size_t WS_Y = 1332 * MiB;
constexpr size_t WS_END = 1636 * MiB;
constexpr int CW_LAM = 64;
constexpr int CW_ATTQ = 2048;
constexpr int CW_CUR = 1024;
constexpr int CW_BAR = 4096;

constexpr int RING_BYTES = 131072;
constexpr int MISC_OFF = RING_BYTES;
constexpr int GOFF_OFF = RING_BYTES + 4096;
constexpr int LDS_BYTES = RING_BYTES + 4096 + 8192;

__device__ __forceinline__ unsigned cvtpk(float lo, float hi) { f32x2 v = {lo, hi}; bf16x2_t b = __builtin_convertvector(v, bf16x2_t); return __builtin_bit_cast(unsigned, b); }
__device__ __forceinline__ float bf2f(unsigned short b) { return __uint_as_float(((unsigned)b) << 16); }
__device__ __forceinline__ float bflo(unsigned w) { return __uint_as_float(w << 16); }
__device__ __forceinline__ float bfhi(unsigned w) { return __uint_as_float(w & 0xffff0000u); }
__device__ __forceinline__ float wave_sum(float v) {
#pragma unroll
    for (int o = 1; o < 64; o <<= 1) v += __shfl_xor(v, o);
    return v;
}
__device__ __forceinline__ int opaque_tid() { int t = threadIdx.x; asm volatile("" : "+v"(t)); return t; }
__device__ __forceinline__ int il(int i, int hd) { return (i & 1) ? (i >> 1) + (hd >> 1) : (i >> 1); }

#define XB_TMO      128
#define XB_XCNT(j)  (256  + 64 * (j))
#define XB_XSUB(j)  (1280 + 64 * (j))
#define XB_XGEN(j)  (2304 + 64 * (j))
#define XB_TOP      3328
#define XB_TOPGEN   3392
#define XCD_BAR_WORDS 3456
#define XB_SPIN_CAP (1u << 20)
__device__ __forceinline__ unsigned xb_ld(unsigned* p)              { return __hip_atomic_load(p, __ATOMIC_RELAXED, __HIP_MEMORY_SCOPE_AGENT); }
__device__ __forceinline__ unsigned xb_add(unsigned* p, unsigned v) { return __hip_atomic_fetch_add(p, v, __ATOMIC_RELAXED, __HIP_MEMORY_SCOPE_AGENT); }
__device__ __forceinline__ unsigned xb_xcc_id() { return (unsigned)__builtin_amdgcn_s_getreg((3 << 11) | 20) & 0xFu; }
#define XB_SPIN(cond, bar) do { unsigned _sp = 0; while (cond) { __builtin_amdgcn_s_sleep(1); \
    if ((++_sp & 255u) == 0u) { if (xb_ld(&(bar)[XB_TMO])) break; if (_sp > XB_SPIN_CAP) { atomicAdd(&(bar)[XB_TMO], 1u); break; } } } } while (0)
struct XcdBarrier { unsigned* bar; unsigned x; volatile LAS unsigned* st; };
__device__ __forceinline__ XcdBarrier xcd_barrier_post(unsigned* bar, volatile LAS unsigned* st) {
    XcdBarrier b; b.bar = bar; b.x = xb_xcc_id(); b.st = st;
    if (threadIdx.x == 0) (void)xb_add(&bar[XB_XCNT(b.x)], 1u);
    return b;
}
__device__ __forceinline__ void xcd_barrier_complete(unsigned* bar, unsigned x, unsigned& nloc, unsigned& nx) {
    const unsigned G = gridDim.x * gridDim.y * gridDim.z;
    unsigned sum, cnt, mine, sp = 0u;
    for (;;) {
        sum = 0u; cnt = 0u; mine = 0u;
#pragma unroll
        for (unsigned j = 0; j < 16; ++j) { const unsigned c = xb_ld(&bar[XB_XCNT(j)]); sum += c; cnt += (c > 0u) ? 1u : 0u; mine = (j == x) ? c : mine; }
        if (sum == G) break;
        __builtin_amdgcn_s_sleep(1);
        if ((++sp & 255u) == 0u) { if (xb_ld(&bar[XB_TMO])) break; if (sp > XB_SPIN_CAP) { atomicAdd(&bar[XB_TMO], 1u); break; } }
    }
    nloc = mine > 0u ? mine : 1u; nx = cnt > 0u ? cnt : 1u;
}
__device__ __forceinline__ void xcd_barrier(const XcdBarrier& b) {
    asm volatile("s_waitcnt vmcnt(0)" ::: "memory");
    __syncthreads();
    if (threadIdx.x == 0) {
        unsigned* bar = b.bar;
        __builtin_amdgcn_s_waitcnt(0);
        unsigned nloc = b.st[0], nx = b.st[1];
        if (nloc == 0u) { xcd_barrier_complete(bar, b.x, nloc, nx); b.st[0] = nloc; b.st[1] = nx; }
        const unsigned old = xb_add(&bar[XB_XSUB(b.x)], 1u);
        const unsigned gen = old / nloc;
        if (old + 1u == (gen + 1u) * nloc) {
            __builtin_amdgcn_fence(__ATOMIC_RELEASE, "agent");
            asm volatile("s_waitcnt vmcnt(0)" ::: "memory");
            const unsigned og = xb_add(&bar[XB_TOP], 1u);
            const unsigned tg = og / nx;
            if (og + 1u == (tg + 1u) * nx) xb_add(&bar[XB_TOPGEN], 1u);
            else XB_SPIN(xb_ld(&bar[XB_TOPGEN]) == tg, bar);
            __builtin_amdgcn_fence(__ATOMIC_ACQUIRE, "agent");
            xb_add(&bar[XB_XGEN(b.x)], 1u);
            asm volatile("s_waitcnt vmcnt(0)" ::: "memory");
        } else {
            XB_SPIN(xb_ld(&bar[XB_XGEN(b.x)]) == gen, bar);
            __builtin_amdgcn_fence(__ATOMIC_ACQUIRE, "agent");
            asm volatile("s_waitcnt vmcnt(0)" ::: "memory");
        }
    }
    __syncthreads();
}

struct Args {
    const float* in[26];
    float* out; unsigned char* ws;
    double invf8[8]; double invf16[16];
    float lam_init[4];
    int ph_lo, ph_hi;
};
struct Frame {
    LAS unsigned char* lds;
    unsigned char* ws;
    int tid, lane, wave, vcu, G;
};

namespace pg8 {
constexpr int BM = 256, BK = 64, HALF = 128, HTB = HALF * BK * 2, STAGE_BYTES = 8 * HTB;
__host__ __device__ __forceinline__ int lds_byte(int r, int c) { const int st = (r >> 4) * 2 + (c >> 5), rr = r & 15, cc = c & 31, ob = rr * 64 + cc * 2; return st * 1024 + (ob ^ (((ob >> 9) & 1) << 5)); }
__host__ __device__ __forceinline__ void stage_rc(int b, int& R, int& C) { const int st = b / 1024, sb = b % 1024, swz = sb ^ (((sb >> 9) & 1) << 5); R = (st >> 1) * 16 + swz / 64; C = (st & 1) * 32 + (swz % 64) / 2; }
__host__ __device__ __forceinline__ int perm32(int rho) { const int n = rho >> 4, i = rho & 15; return 8 * (i >> 2) + 4 * n + (i & 3); }

typedef int v8i32 __attribute__((ext_vector_type(8)));
typedef int u32x4i __attribute__((ext_vector_type(4)));
__device__ __forceinline__ v8i32 pk8(bf16x8 lo, bf16x8 hi) { const u32x4 a = __builtin_bit_cast(u32x4, lo), b = __builtin_bit_cast(u32x4, hi); return (v8i32){(int)a.x, (int)a.y, (int)a.z, (int)a.w, (int)b.x, (int)b.y, (int)b.z, (int)b.w}; }
struct Unit { const char* a; const char* b; int pm, pn, e, j, cnt; };

template <class Epi, class Sched, bool ALIGN_EPI, bool FP8 = false>
__device__ __forceinline__ void gemm_phase(LAS unsigned char* lds, const int K, const int lda, const int ldb, const Sched& S, const Epi& E) {
    const int tid = opaque_tid(), wid = __builtin_amdgcn_readfirstlane(tid >> 6), lane = tid & 63, wr = wid >> 2, wc = wid & 3, fr = lane & 15, fq = lane >> 4;
    const int nt = K / BK;
    int Rs[2], Cs[2]; unsigned voffBp[2];
#pragma unroll
    for (int i = 0; i < 2; ++i) { int R, C; stage_rc(tid * 16 + i * 8192, R, C); Rs[i] = R; Cs[i] = C; const int Rb = Epi::PERM ? ((R & ~31) + perm32(R & 31)) : R; voffBp[i] = (unsigned)(Rb * ldb + C) * 2u; }
    const size_t kstep = (size_t)(BK * 2);
    const size_t hstepB = (size_t)HALF * ldb * 2;
    const unsigned ldsw = (unsigned)wid * 1024u;
#define PG8_SA(b, h) (((b) * 2 + (h)) * HTB)
#define PG8_SB(b, h) ((4 + (b) * 2 + (h)) * HTB)
#define PG8_STAGE2(bufoff, gbase, o0, o1) do { \
        __builtin_amdgcn_global_load_lds((const unsigned*)((const char*)(gbase) + (o0)), (LAS unsigned*)(lds + (bufoff) + ldsw), 16, 0, 0); \
        __builtin_amdgcn_global_load_lds((const unsigned*)((const char*)(gbase) + (o1)), (LAS unsigned*)(lds + (bufoff) + ldsw + 8192), 16, 0, 0); } while (0)
#define PG8_STAGEB(bufoff, gbase) PG8_STAGE2(bufoff, gbase, voffB[0], voffB[1])
#define PG8_STAGEBP(bufoff, gbase) PG8_STAGE2(bufoff, gbase, voffBp[0], voffBp[1])
#define PG8_LD32(p) __builtin_shufflevector(*(const LAS u32x4i*)(p), *(const LAS u32x4i*)((p) + 1024), 0, 1, 2, 3, 4, 5, 6, 7)
#define PG8_LDA(dst, b, h) do { if constexpr (FP8) { _Pragma("unroll") for (int m = 0; m < 4; ++m) dst##8[m] = PG8_LD32(lds + PG8_SA(b, h) + aoff + m * 2048); } \
        else { _Pragma("unroll") for (int m = 0; m < 4; ++m) _Pragma("unroll") for (int k = 0; k < 2; ++k) dst[m][k] = *(const LAS bf16x8*)(lds + PG8_SA(b, h) + aoff + m * 2048 + k * 1024); } } while (0)
#define PG8_LDB(dst, b, h) do { if constexpr (FP8) { _Pragma("unroll") for (int n = 0; n < 2; ++n) dst##8[n] = PG8_LD32(lds + PG8_SB(b, h) + boff + n * 2048); } \
        else { _Pragma("unroll") for (int n = 0; n < 2; ++n) _Pragma("unroll") for (int k = 0; k < 2; ++k) dst[n][k] = *(const LAS bf16x8*)(lds + PG8_SB(b, h) + boff + n * 2048 + k * 1024); } } while (0)
  \

#define PG8_MMA(ai, bj, At, Bt) do { __builtin_amdgcn_s_setprio(1); _Pragma("unroll") for (int m = 0; m < 4; ++m) _Pragma("unroll") for (int n = 0; n < 2; ++n) { \
        if constexpr (FP8) { asm volatile("v_mfma_scale_f32_16x16x128_f8f6f4 %0, %1, %2, %0, %3, %3 op_sel_hi:[0,0,0]" : "+v"(acc[ai][bj][m][n]) : "v"(Bt##8[n]), "v"(At##8[m]), "v"(f8scale)); } \
        else { _Pragma("unroll") for (int k = 0; k < 2; ++k) acc[ai][bj][m][n] = __builtin_amdgcn_mfma_f32_16x16x32_bf16(Bt[n][k], At[m][k], acc[ai][bj][m][n], 0, 0, 0); } } \
        __builtin_amdgcn_s_setprio(0); } while (0)
#define PG8_WAIT_V(n) asm volatile("s_waitcnt vmcnt(" #n ")" ::: "memory")
#define PG8_WAIT_L(n) asm volatile("s_waitcnt lgkmcnt(" #n ")" ::: "memory")
#define PG8_BAR __builtin_amdgcn_s_barrier()
#define PG8_SCHED __builtin_amdgcn_sched_barrier(0)
    Unit cur, nxt; int ui = 0;
    if (!S.next(0, cur)) return;
    f32x4 acc[2][2][4][2];
#pragma unroll
    for (int a = 0; a < 2; ++a)
#pragma unroll
        for (int b = 0; b < 2; ++b)
#pragma unroll
            for (int m = 0; m < 4; ++m)
#pragma unroll
                for (int n = 0; n < 2; ++n) acc[a][b][m][n] = (f32x4){0.f, 0.f, 0.f, 0.f};
    bf16x8 At[4][2], B0[2][2], B1[2][2]; v8i32 At8[4], B08[2], B18[2];
    unsigned vc00, vc01, vc10, vc11, vn00, vn01, vn10, vn11;
    vc00 = (unsigned)(S.arow(cur, Rs[0]) * lda + Cs[0]) * 2u; vc01 = (unsigned)(S.arow(cur, Rs[1]) * lda + Cs[1]) * 2u;
    vc10 = (unsigned)(S.arow(cur, HALF + Rs[0]) * lda + Cs[0]) * 2u; vc11 = (unsigned)(S.arow(cur, HALF + Rs[1]) * lda + Cs[1]) * 2u;
    const char* cA = cur.a; const char* cB = cur.b;
    PG8_STAGEBP(PG8_SB(0, 0), cB); PG8_STAGEBP(PG8_SB(0, 1), cB + hstepB); PG8_STAGE2(PG8_SA(0, 0), cA, vc00, vc01); PG8_STAGE2(PG8_SA(0, 1), cA, vc10, vc11);
    if (wr == 1) PG8_BAR;
    PG8_WAIT_V(2); PG8_BAR;
    PG8_STAGEBP(PG8_SB(1, 0), cB + kstep); PG8_STAGE2(PG8_SA(1, 0), cA + kstep, vc00, vc01); PG8_STAGEBP(PG8_SB(1, 1), cB + hstepB + kstep);
    PG8_WAIT_V(6); PG8_BAR;
    bool has_next = S.next(1, nxt);
    if (Sched::GATHER && has_next) {
        int R0, C0, R1, C1; { const int t2_ = opaque_tid(); stage_rc(t2_ * 16, R0, C0); stage_rc(t2_ * 16 + 8192, R1, C1); }
        LAS unsigned* gp = (LAS unsigned*)(lds + GOFF_OFF) + (opaque_tid() << 2);
        gp[0] = (unsigned)(S.arow(nxt, R0) * lda + C0) * 2u; gp[1] = (unsigned)(S.arow(nxt, R1) * lda + C1) * 2u;
        gp[2] = (unsigned)(S.arow(nxt, HALF + R0) * lda + C0) * 2u; gp[3] = (unsigned)(S.arow(nxt, HALF + R1) * lda + C1) * 2u;
    }
    for (;;) {
        const char* nA = has_next ? nxt.a : cA; const char* nB = has_next ? nxt.b : cB;
        vn00 = vc00; vn01 = vc01; vn10 = vc10; vn11 = vc11;
#ifndef KREP
#define KREP 1
#endif
        constexpr int krep = (FP8 && Epi::PROBE) ? KREP : 1;
#pragma unroll 1
        for (int tq = 0; tq < krep * nt; tq += 2) {
            const int t = tq % nt;
            const bool last = (tq == krep * nt - 2);
            const int f8scale = (tq < nt) ? 0x7F7F7F7F : 0;
            unsigned voffB[2]; int aoff, boff;
            { const int t3_ = opaque_tid(), l3_ = t3_ & 63, fr3_ = l3_ & 15, fq3_ = l3_ >> 4;
#pragma unroll
              for (int i = 0; i < 2; ++i) { int R, C; stage_rc(t3_ * 16 + i * 8192, R, C); const int Rb = Epi::PERM ? ((R & ~31) + perm32(R & 31)) : R; voffB[i] = (unsigned)(Rb * ldb + C) * 2u; }
              aoff = lds_byte(wr * 64 + fr3_, fq3_ * 8); boff = lds_byte(wc * 32 + fr3_, fq3_ * 8); }
            if (Sched::GATHER && last) { const LAS unsigned* gp = (const LAS unsigned*)(lds + GOFF_OFF) + (opaque_tid() << 2); vn00 = gp[0]; vn01 = gp[1]; vn10 = gp[2]; vn11 = gp[3]; }
            const char* a1 = cA + (size_t)(t + 1) * kstep;
            const char* a2 = last ? nA : cA + (size_t)((t + 2) % nt) * kstep; const char* b2 = last ? nB : cB + (size_t)((t + 2) % nt) * kstep;
            const char* a3 = a2 + kstep; const char* b3 = b2 + kstep;
            const unsigned w00 = (Sched::GATHER && last) ? vn00 : vc00, w01 = (Sched::GATHER && last) ? vn01 : vc01, w10 = (Sched::GATHER && last) ? vn10 : vc10, w11 = (Sched::GATHER && last) ? vn11 : vc11;
            const bool relax = (Epi::NST > 0) && (tq == 0) && (ui > 0);
            PG8_LDB(B0, 0, 0); PG8_LDB(B1, 0, 1); PG8_SCHED; PG8_LDA(At, 0, 0); PG8_STAGE2(PG8_SA(1, 1), a1, vc10, vc11);
            if (relax) asm volatile("s_waitcnt vmcnt(%0)" :: "n"(8 + Epi::NST) : "memory"); else PG8_WAIT_V(8);
            PG8_WAIT_L(0); PG8_BAR; PG8_MMA(0, 0, At, B0); PG8_MMA(0, 1, At, B1); PG8_BAR; PG8_SCHED;
            PG8_LDA(At, 0, 1); PG8_STAGEB(PG8_SB(0, 0), b2); PG8_STAGEB(PG8_SB(0, 1), b2 + hstepB); PG8_STAGE2(PG8_SA(0, 0), a2, w00, w01);
            if (relax) asm volatile("s_waitcnt vmcnt(%0)" :: "n"(8 + Epi::NST) : "memory"); else PG8_WAIT_V(8);
            PG8_WAIT_L(0); PG8_BAR; PG8_MMA(1, 0, At, B0); PG8_MMA(1, 1, At, B1); PG8_BAR; PG8_SCHED;
            PG8_LDB(B0, 1, 0); PG8_LDB(B1, 1, 1); PG8_SCHED; PG8_LDA(At, 1, 0); PG8_STAGE2(PG8_SA(0, 1), a2, w10, w11);
            PG8_WAIT_V(8); PG8_WAIT_L(0); PG8_BAR; PG8_MMA(0, 0, At, B0); PG8_MMA(0, 1, At, B1); PG8_BAR; PG8_SCHED;
            PG8_LDA(At, 1, 1); PG8_STAGEB(PG8_SB(1, 0), b3); PG8_STAGEB(PG8_SB(1, 1), b3 + hstepB); PG8_STAGE2(PG8_SA(1, 0), a3, w00, w01);
            PG8_WAIT_V(8); PG8_WAIT_L(0); PG8_BAR; PG8_MMA(1, 0, At, B0); PG8_MMA(1, 1, At, B1); PG8_BAR; PG8_SCHED;
        }
        Unit nn; bool has_nn = has_next && S.next(ui + 2, nn);
        int gt0 = 0, gt1 = 0, gt2 = 0, gt3 = 0;
        if constexpr (Sched::GATHER) if (has_nn) {
            int R0, C0, R1, C1; { const int t2_ = opaque_tid(); stage_rc(t2_ * 16, R0, C0); stage_rc(t2_ * 16 + 8192, R1, C1); }
            gt0 = S.arow_raw(nn, R0); gt1 = S.arow_raw(nn, R1); gt2 = S.arow_raw(nn, HALF + R0); gt3 = S.arow_raw(nn, HALF + R1);
        }
        if constexpr (ALIGN_EPI) { if (wr == 0) PG8_BAR; }
#ifndef REP_EPI
#define REP_EPI 1
#endif
        if constexpr (FP8) asm volatile("s_nop 15\n\ts_nop 15" ::: "memory");
        { const int l2_ = opaque_tid() & 63; for (int rep_ = 0; rep_ < (Epi::PROBE ? REP_EPI : 1); ++rep_) E(acc, cur, wr, wc, l2_ & 15, l2_ >> 4); }
        if (!has_next) break;
#pragma unroll
        for (int a = 0; a < 2; ++a)
#pragma unroll
            for (int b = 0; b < 2; ++b)
#pragma unroll
                for (int m = 0; m < 4; ++m)
#pragma unroll
                    for (int n = 0; n < 2; ++n) acc[a][b][m][n] = (f32x4){0.f, 0.f, 0.f, 0.f};
        cur = nxt; cA = nA; cB = nB; ++ui; vc00 = vn00; vc01 = vn01; vc10 = vn10; vc11 = vn11;
        nxt = nn; has_next = has_nn;
        if constexpr (Sched::GATHER) asm volatile("" : "+v"(gt0), "+v"(gt1), "+v"(gt2), "+v"(gt3));
        if constexpr (Sched::GATHER) if (has_next) {
            int R0, C0, R1, C1; { const int t2_ = opaque_tid(); stage_rc(t2_ * 16, R0, C0); stage_rc(t2_ * 16 + 8192, R1, C1); }
            LAS unsigned* gp = (LAS unsigned*)(lds + GOFF_OFF) + (opaque_tid() << 2);
            gp[0] = (unsigned)(S.arow_fix(nxt, R0, gt0) * lda + C0) * 2u; gp[1] = (unsigned)(S.arow_fix(nxt, R1, gt1) * lda + C1) * 2u;
            gp[2] = (unsigned)(S.arow_fix(nxt, HALF + R0, gt2) * lda + C0) * 2u; gp[3] = (unsigned)(S.arow_fix(nxt, HALF + R1, gt3) * lda + C1) * 2u;
        }
        if constexpr (ALIGN_EPI) { if (wr == 1) PG8_BAR; }
    }
    PG8_WAIT_V(0);
    if constexpr (!ALIGN_EPI) { if (wr == 0) PG8_BAR; }
    PG8_BAR;
#undef PG8_SA
#undef PG8_SB
#undef PG8_STAGE2
#undef PG8_STAGEB
#undef PG8_LDA
#undef PG8_LD32
#undef PG8_LDB
#undef PG8_MMA
#undef PG8_WAIT_V
#undef PG8_WAIT_L
#undef PG8_BAR
#undef PG8_SCHED
}

__device__ __forceinline__ int xcd_remap(int L, int nwg) {
    const int q = nwg / 8, r = nwg % 8, xcd = L % 8, off = L / 8;
    return (xcd < r ? xcd * (q + 1) : r * (q + 1) + (xcd - r) * q) + off;
}

struct DenseSched {
    static constexpr bool GATHER = false;
    const char* A; const char* Bt; int lda, ldb, npan, nN, G, c, latent_only;
    __device__ __forceinline__ bool next(int i, Unit& u) const {
        const int L = i * G + c, nwg = npan * nN; if (L >= nwg) return false;
        const int w = xcd_remap(L, nwg), p = w / nN, pn = w % nN;
        const int pm = latent_only ? (p >> 3) * 9 + 1 + (p & 7) : p;
        u.pm = pm; u.pn = pn; u.e = 0; u.j = 0; u.cnt = 0;
        u.a = A + (size_t)pm * 256 * lda * 2; u.b = Bt + (size_t)pn * 256 * ldb * 2; return true;
    }
    __device__ __forceinline__ int arow(const Unit&, int r) const { return r; }
};
struct UpSched {
    static constexpr bool GATHER = false;
    const char* P; const char* Wuq; const char* Wukv; int G, c;
    __device__ __forceinline__ bool next(int i, Unit& u) const {
        const int L = i * G + c, nwg = NPAN * 4; if (L >= nwg) return false;
        const int w = xcd_remap(L, nwg), p = w >> 2, pn = w & 3;
        u.pm = p; u.pn = pn; u.e = 0; u.j = 0; u.cnt = 0;
        u.a = P + (size_t)p * 256 * PW * 2 + (pn >= 2 ? 512 : 0);
        u.b = (pn >= 2 ? Wukv : Wuq) + (size_t)(pn & 1) * 256 * 256 * 2; return true;
    }
    __device__ __forceinline__ int arow(const Unit&, int r) const { return r; }
};
struct ChainMap {
    int x, r;
    __device__ __forceinline__ int nchain() const { return r < 4 ? 2 : 1; }
    __device__ __forceinline__ int chain(int j) const { return r + 32 * j; }
    __device__ __forceinline__ int nplain() const { return r < 4 ? 1 : (r < 24 ? 4 : 3); }
    __device__ __forceinline__ int plain(int j) const { return r < 4 ? 56 + r : (j == 0 ? r - 4 : (j == 1 ? 24 + r : (j == 2 ? 56 + r : 84 + r))); }
};
struct WinChainSched {
    static constexpr bool GATHER = false;
    const char* A; const char* Bt; int lda, ldb; ChainMap M;
    __device__ __forceinline__ bool next(int i, Unit& u) const {
        const int nc = M.nchain(); if (i >= nc + M.nplain()) return false;
        int q, pn;
        if (i < nc) { const int ch = M.chain(i); q = ch >> 1; pn = ch & 1; } else { const int idx = M.plain(i - nc); q = idx / 6; pn = 2 + idx - q * 6; }
        const int pm = M.x + 8 * q;
        u.pm = pm; u.pn = pn; u.e = 0; u.j = 0; u.cnt = 0;
        u.a = A + (size_t)pm * 256 * lda * 2; u.b = Bt + (size_t)pn * 256 * ldb * 2; return true;
    }
    __device__ __forceinline__ int arow(const Unit&, int r) const { return r; }
};
struct UpChainSched {
    static constexpr bool GATHER = false;
    const char* P; const char* Wuq; const char* Wukv; ChainMap M;
    __device__ __forceinline__ bool next(int i, Unit& u) const {
        if (i >= 2 * M.nchain()) return false;
        const int ch = M.chain(i >> 1), q = ch >> 1, hf = ch & 1, pn = 2 * hf + (i & 1), pm = M.x + 8 * q;
        u.pm = pm; u.pn = pn; u.e = 0; u.j = 0; u.cnt = 0;
        u.a = P + (size_t)pm * 256 * PW * 2 + (hf ? 512 : 0);
        u.b = (hf ? Wukv : Wuq) + (size_t)(pn & 1) * 256 * 256 * 2; return true;
    }
    __device__ __forceinline__ int arow(const Unit&, int r) const { return r; }
};
template <bool GATHER_> struct MoeSched {
    static constexpr bool GATHER = GATHER_;
    const char* A; const char* Bt; const int* slot_tok; volatile LAS int* PB; volatile LAS int* CNT; int nN, G, c; size_t bexp; int ln;
    __device__ __forceinline__ bool next(int i, Unit& u) const {
        const int np = PB[32], nwg = np * nN; const int L = i * G + c; if (L >= nwg) return false;
        const int w = xcd_remap(L, nwg), p = w / nN, pn = w % nN;
        const unsigned long long bal = __ballot(PB[ln + 1] <= p);
        const int e = __builtin_popcount((unsigned)(bal & 0xffffffffull));
        u.pm = p; u.pn = pn; u.e = e; u.j = p - PB[e]; u.cnt = CNT[e];
        u.a = GATHER ? A : A + (size_t)p * 256 * D;
        u.b = Bt + (size_t)e * bexp + (size_t)pn * 256 * D; return true;
    }
    __device__ __forceinline__ int arow_raw(const Unit& u, int r) const { if constexpr (GATHER) return slot_tok[(size_t)u.e * T + min(u.j * 256 + r, u.cnt - 1)]; else return r; }
    __device__ __forceinline__ int arow_fix(const Unit& u, int r, int v) const { if constexpr (GATHER) return (u.j * 256 + r) < u.cnt ? v : 0; else return r; }
    __device__ __forceinline__ int arow(const Unit& u, int r) const {
        if constexpr (GATHER) { const int pos = u.j * 256 + r; const int v = slot_tok[(size_t)u.e * T + min(pos, u.cnt - 1)]; return pos < u.cnt ? v : 0; }
        else return r;
    }
};

__device__ __forceinline__ void rope4(f32x4& v0, f32x4& v1, const f32x4* tab) {
    const f32x4 t0 = tab[0], t1 = tab[1];
    f32x4 a, b;
    a[0] = v0[0] * t0[0] - v0[1] * t0[1]; a[1] = v0[1] * t0[0] + v0[0] * t0[1];
    a[2] = v0[2] * t0[2] - v0[3] * t0[3]; a[3] = v0[3] * t0[2] + v0[2] * t0[3];
    b[0] = v1[0] * t1[0] - v1[1] * t1[1]; b[1] = v1[1] * t1[0] + v1[0] * t1[1];
    b[2] = v1[2] * t1[2] - v1[3] * t1[3]; b[3] = v1[3] * t1[2] + v1[2] * t1[3];
    v0 = a; v1 = b;
}
__device__ __forceinline__ u32x4 pack8(const f32x4& v0, const f32x4& v1) { u32x4 w; w.x = cvtpk(v0[0], v0[1]); w.y = cvtpk(v0[2], v0[3]); w.z = cvtpk(v1[0], v1[1]); w.w = cvtpk(v1[2], v1[3]); return w; }

struct EpiWin {
    static constexpr bool PERM = true, PROBE = false; static constexpr int NST = 16;
    bf16_t* P; float* ssq; const float* ropeR; const float* ropeW;
    __device__ __forceinline__ void operator()(const f32x4 (&acc)[2][2][4][2], const Unit& u, int wr, int wc, int fr, int fq) const {
        const int pn = u.pn;
        int mode[2];
        mode[0] = (pn == 2 || pn == 3) ? 1 : ((pn == 5 || pn == 6 || pn == 7) ? 2 : 0);
        mode[1] = (pn == 2 || pn == 3) ? 1 : ((pn == 5 || pn == 6) ? 2 : ((pn == 1 && wc == 0) ? 1 : 0));
        const int iR = 4 * fq, iW = 16 * (wc & 1) + 4 * fq;
        f32x4 tb[2][2][2];
        auto rowof = [&](int g) { return u.pm * 256 + (g >> 2) * 128 + wr * 64 + (g & 3) * 16 + fr; };
        auto ldtab = [&](int g) {
            const int nb = rowof(g) % NTK; const int t = nb >= CTX ? nb - CTX : 0;
#pragma unroll
            for (int bj = 0; bj < 2; ++bj) {
                if (mode[bj] == 1) { const f32x4* p = (const f32x4*)(ropeR + ((size_t)t * 16 + iR) * 2); tb[g & 1][bj][0] = p[0]; tb[g & 1][bj][1] = p[1]; }
                else if (mode[bj] == 2) { const f32x4* p = (const f32x4*)(ropeW + ((size_t)t * 32 + iW) * 2); tb[g & 1][bj][0] = p[0]; tb[g & 1][bj][1] = p[1]; }
            }
        };
        ldtab(0);
#pragma unroll
        for (int g = 0; g < 8; ++g) {
            const int ai = g >> 2, m = g & 3;
            const int row = rowof(g);
            const bool latent = (row % NTK) >= CTX;
            if (g + 1 < 8) ldtab(g + 1);
            float ss = 0.f;
#pragma unroll
            for (int bj = 0; bj < 2; ++bj) {
                f32x4 v0 = acc[ai][bj][m][0] * F8_INV, v1 = acc[ai][bj][m][1] * F8_INV;
                if (pn == 0 || (pn == 1 && bj == 0)) ss += (v0[0] * v0[0] + v0[1] * v0[1]) + (v0[2] * v0[2] + v0[3] * v0[3]) + (v1[0] * v1[0] + v1[1] * v1[1]) + (v1[2] * v1[2] + v1[3] * v1[3]);
                if (mode[bj] != 0) {
                    f32x4 t0 = tb[g & 1][bj][0], t1 = tb[g & 1][bj][1];
                    if (!latent) { t0 = (f32x4){1.f, 0.f, 1.f, 0.f}; t1 = t0; }
                    const f32x4 tt[2] = {t0, t1};
                    rope4(v0, v1, tt);
                }
                *(u32x4*)(P + (size_t)row * PW + pn * 256 + bj * 128 + wc * 32 + fq * 8) = pack8(v0, v1);
            }
            if (pn < 2) { ss += __shfl_xor(ss, 16); ss += __shfl_xor(ss, 32); if (fq == 0) ssq[(size_t)row * 8 + pn * 4 + wc] = ss; }
        }
    }
};
struct EpiUp {
    static constexpr bool PERM = true, PROBE = false; static constexpr int NST = 0;
    bf16_t* QM; bf16_t* KVM; const float* ssq; const float* ropeR;
    __device__ __forceinline__ void operator()(const f32x4 (&acc)[2][2][4][2], const Unit& u, int wr, int wc, int fr, int fq) const {
        const bool isq = u.pn < 2;
        int col0[2], rp[2];
#pragma unroll
        for (int bj = 0; bj < 2; ++bj) { col0[bj] = (u.pn & 1) * 256 + bj * 128 + wc * 32 + fq * 8; const int hl = col0[bj] % 96; rp[bj] = (isq && col0[bj] < 384 && hl >= 64) ? ((hl - 64) >> 1) : -1; }
        f32x4 sq[2]; f32x4 tb[2][2][2];
        auto rowof = [&](int g) { return u.pm * 256 + (g >> 2) * 128 + wr * 64 + (g & 3) * 16 + fr; };
        auto ld = [&](int g) {
            const int row = rowof(g); const int nb = row % NTK; const int t = nb >= CTX ? nb - CTX : 0;
            sq[g & 1] = *(const f32x4*)(ssq + (size_t)row * 8 + (isq ? 0 : 4));
#pragma unroll
            for (int bj = 0; bj < 2; ++bj) if (rp[bj] >= 0) { const f32x4* p = (const f32x4*)(ropeR + ((size_t)t * 16 + rp[bj]) * 2); tb[g & 1][bj][0] = p[0]; tb[g & 1][bj][1] = p[1]; }
        };
        ld(0);
#pragma unroll
        for (int g = 0; g < 8; ++g) {
            const int ai = g >> 2, m = g & 3;
            const int row = rowof(g);
            const bool latent = (row % NTK) >= CTX;
            if (g + 1 < 8) ld(g + 1);
            const f32x4 s4 = sq[g & 1];
            const float ssum = (s4[0] + s4[1]) + (s4[2] + s4[3]);
            const float rstd = __builtin_amdgcn_rsqf(ssum * (isq ? (1.f / 256.f) : (1.f / 128.f)) + EPS);
#pragma unroll
            for (int bj = 0; bj < 2; ++bj) {
                f32x4 v0 = acc[ai][bj][m][0] * rstd, v1 = acc[ai][bj][m][1] * rstd;
                if (isq) {
                    if (col0[bj] < 384) {
                        if (rp[bj] >= 0) {
                            f32x4 t0 = tb[g & 1][bj][0], t1 = tb[g & 1][bj][1];
                            if (!latent) { t0 = (f32x4){1.f, 0.f, 1.f, 0.f}; t1 = t0; }
                            const f32x4 tt[2] = {t0, t1};
                            rope4(v0, v1, tt);
                        }
                        *(u32x4*)(QM + (size_t)row * 384 + col0[bj]) = pack8(v0, v1);
                    }
                } else *(u32x4*)(KVM + (size_t)row * 512 + col0[bj]) = pack8(v0, v1);
            }
        }
    }
};
struct EpiWout {
    static constexpr bool PERM = true, PROBE = false; static constexpr int NST = 16;
    bf16_t* X; const float* modl;
    __device__ __forceinline__ void operator()(const f32x4 (&acc)[2][2][4][2], const Unit& u, int wr, int wc, int fr, int fq) const {
        const int b = u.pm / 9, modrow = (u.pm - b * 9 == 0) ? 16 : b;
        const float* gate = modl + (size_t)modrow * 6144 + 2 * D;
        const int col0 = u.pn * 256 + wc * 32 + 8 * fq;
        f32x4 gv[2][2];
#pragma unroll
        for (int bj = 0; bj < 2; ++bj)
#pragma unroll
            for (int n = 0; n < 2; ++n) gv[bj][n] = *(const f32x4*)(gate + col0 + bj * 128 + n * 4);
        u32x4 xq[2][2];
        auto rowp = [&](int g) { return X + (size_t)(u.pm * 256 + (g >> 2) * 128 + wr * 64 + (g & 3) * 16 + fr) * D + col0; };
        xq[0][0] = *(const u32x4*)(rowp(0)); xq[0][1] = *(const u32x4*)(rowp(0) + 128);
#pragma unroll
        for (int g = 0; g < 8; ++g) {
            const int ai = g >> 2, m = g & 3;
            if (g + 1 < 8) { xq[(g + 1) & 1][0] = *(const u32x4*)(rowp(g + 1)); xq[(g + 1) & 1][1] = *(const u32x4*)(rowp(g + 1) + 128); }
#pragma unroll
            for (int bj = 0; bj < 2; ++bj) {
                const u32x4 xw = xq[g & 1][bj];
                f32x4 x0 = {bflo(xw.x), bfhi(xw.x), bflo(xw.y), bfhi(xw.y)}, x1 = {bflo(xw.z), bfhi(xw.z), bflo(xw.w), bfhi(xw.w)};
                x0 += gv[bj][0] * (acc[ai][bj][m][0] * F8_INVM); x1 += gv[bj][1] * (acc[ai][bj][m][1] * F8_INVM);
                *(u32x4*)(rowp(g) + bj * 128) = pack8(x0, x1);
            }
        }
    }
};
__device__ __forceinline__ f32x4 swiglu4(f32x4 g, f32x4 up, float s) {
    g = __builtin_elementwise_min(g, (f32x4){7.0f, 7.0f, 7.0f, 7.0f});
    up = __builtin_elementwise_min(__builtin_elementwise_max(up, (f32x4){-7.0f, -7.0f, -7.0f, -7.0f}), (f32x4){7.0f, 7.0f, 7.0f, 7.0f});
    const f32x4 t = g * (-1.702f * LOG2E);
    f32x4 e; e[0] = __builtin_amdgcn_exp2f(t[0]); e[1] = __builtin_amdgcn_exp2f(t[1]); e[2] = __builtin_amdgcn_exp2f(t[2]); e[3] = __builtin_amdgcn_exp2f(t[3]);
    const f32x4 d = e + 1.0f;
    f32x4 r; r[0] = __builtin_amdgcn_rcpf(d[0]); r[1] = __builtin_amdgcn_rcpf(d[1]); r[2] = __builtin_amdgcn_rcpf(d[2]); r[3] = __builtin_amdgcn_rcpf(d[3]);
    return (g * r) * (up * s + s);
}
struct EpiGateUp {
    static constexpr bool PERM = true, PROBE = true; static constexpr int NST = 4;
    unsigned char* ACT; const float* bg; const float* bu;
    __device__ __forceinline__ void operator()(const f32x4 (&acc)[2][2][4][2], const Unit& u, int wr, int wc, int fr, int fq) const {
        const int colL = u.pn * 128 + wc * 32 + fq * 8;
        const f32x4 g0 = *(const f32x4*)(bg + (size_t)u.e * D + colL), g1 = *(const f32x4*)(bg + (size_t)u.e * D + colL + 4);
        const f32x4 u0 = *(const f32x4*)(bu + (size_t)u.e * D + colL), u1 = *(const f32x4*)(bu + (size_t)u.e * D + colL + 4);
#pragma unroll
        for (int ai = 0; ai < 2; ++ai)
#pragma unroll
            for (int mp = 0; mp < 2; ++mp) {
                u32x2 w8[2];
#pragma unroll
                for (int h = 0; h < 2; ++h) {
                    const int m = 2 * mp + h;
                    const f32x4 ga = acc[ai][0][m][0] * F8_INV + g0, gb = acc[ai][0][m][1] * F8_INV + g1, ua = acc[ai][1][m][0] * F8_INV + u0, ub = acc[ai][1][m][1] * F8_INV + u1;
                    const f32x4 ra = swiglu4(ga, ua, F8_SA), rb = swiglu4(gb, ub, F8_SA);
                    w8[h].x = (unsigned)__builtin_amdgcn_cvt_pk_fp8_f32(ra[2], ra[3], __builtin_amdgcn_cvt_pk_fp8_f32(ra[0], ra[1], 0, false), true);
                    w8[h].y = (unsigned)__builtin_amdgcn_cvt_pk_fp8_f32(rb[2], rb[3], __builtin_amdgcn_cvt_pk_fp8_f32(rb[0], rb[1], 0, false), true);
                }
                const auto sx = __builtin_amdgcn_permlane16_swap(w8[0].x, w8[1].x, false, false), sy = __builtin_amdgcn_permlane16_swap(w8[0].y, w8[1].y, false, false);
                const int srow = u.pm * 256 + ai * 128 + wr * 64 + (2 * mp + (fq & 1)) * 16 + fr;
                u32x4 w16; w16.x = sx[0]; w16.y = sy[0]; w16.z = sx[1]; w16.w = sy[1];
                *(u32x4*)(ACT + (size_t)srow * D + (u.pn * 128 + wc * 32 + (fq & 2) * 8)) = w16;
            }
    }
};
struct EpiDown {
    static constexpr bool PERM = true, PROBE = true; static constexpr int NST = 8;
    bf16_t* Y; const float* bd; const float* slot_w;
    __device__ __forceinline__ void operator()(const f32x4 (&acc)[2][2][4][2], const Unit& u, int wr, int wc, int fr, int fq) const {
        const int col0 = u.pn * 256 + wc * 32 + fq * 8;
        f32x4 bv[2][2];
#pragma unroll
        for (int bj = 0; bj < 2; ++bj)
#pragma unroll
            for (int n = 0; n < 2; ++n) bv[bj][n] = *(const f32x4*)(bd + (size_t)u.e * D + col0 + bj * 128 + n * 4);
        float wv[8];
#pragma unroll
        for (int g = 0; g < 8; ++g) { const int pos = u.j * 256 + (g >> 2) * 128 + wr * 64 + (g & 3) * 16 + fr; wv[g] = slot_w[(size_t)u.e * T + min(pos, u.cnt - 1)]; }
#pragma unroll
        for (int g = 0; g < 8; ++g) { const int pos = u.j * 256 + (g >> 2) * 128 + wr * 64 + (g & 3) * 16 + fr; wv[g] = pos < u.cnt ? wv[g] : 0.f; }
#pragma unroll
        for (int ai = 0; ai < 2; ++ai)
#pragma unroll
            for (int mp = 0; mp < 2; ++mp) {
                const int rl = ai * 128 + wr * 64 + (2 * mp + (fq & 1)) * 16 + fr;
#pragma unroll
                for (int bj = 0; bj < 2; ++bj) {
                    u32x2 w8[2];
#pragma unroll
                    for (int h = 0; h < 2; ++h) {
                        const int m = 2 * mp + h; const float w = wv[ai * 4 + m];
                        const f32x4 v0 = (acc[ai][bj][m][0] * F8_INV + bv[bj][0]) * (w * F8_SY), v1 = (acc[ai][bj][m][1] * F8_INV + bv[bj][1]) * (w * F8_SY);
                        w8[h].x = (unsigned)__builtin_amdgcn_cvt_pk_fp8_f32(v0[2], v0[3], __builtin_amdgcn_cvt_pk_fp8_f32(v0[0], v0[1], 0, false), true);
                        w8[h].y = (unsigned)__builtin_amdgcn_cvt_pk_fp8_f32(v1[2], v1[3], __builtin_amdgcn_cvt_pk_fp8_f32(v1[0], v1[1], 0, false), true);
                    }
                    const auto sx = __builtin_amdgcn_permlane16_swap(w8[0].x, w8[1].x, false, false), sy = __builtin_amdgcn_permlane16_swap(w8[0].y, w8[1].y, false, false);
                    u32x4 w16; w16.x = sx[0]; w16.y = sy[0]; w16.z = sx[1]; w16.w = sy[1];
                    *(u32x4*)((unsigned char*)Y + (size_t)(u.pm * 256 + rl) * D + (u.pn * 256 + wc * 32 + (fq & 2) * 8) + bj * 128) = w16;
                }
            }
    }
};
}

__device__ __forceinline__ int winmap(int p, float& sc) {
    sc = 1.f;
    if (p < 384) return p;
    if (p < 416) return 384 + il(p - 384, 32);
    if (p < 512) return -1;
    if (p < 768)  { const int q = p - 512;  sc = SC_DIFF; return 416 + (q & ~31) + il(q & 31, 32); }
    if (p < 1024) { const int q = p - 768;  return 672 + (q & ~31) + il(q & 31, 32); }
    if (p < 1280) return 928 + (p - 1024);
    if (p < 1792) { const int q = p - 1280; sc = SC_SWA; return 1184 + (q & ~63) + il(q & 63, 64); }
    if (p < 1920) { const int q = p - 1792; return 1696 + (q & ~63) + il(q & 63, 64); }
    return 1824 + (p - 1920);
}
__device__ __forceinline__ int uqmap(int n) {
    if (n >= 384) return -1;
    const int h = n / 96, i = n - h * 96;
    return h * 96 + (i < 64 ? i : 64 + il(i - 64, 32));
}
struct CvtItem { const float* src; int ld, kvalid, k0, n0, nrows, mapkind, ldd; bf16_t* dst; const float* rowscale; };
constexpr int CVT_PER_LAYER = 256 + 16 + 16 + 8;
constexpr int CVT_ITEMS = NL * CVT_PER_LAYER;
__device__ __forceinline__ void cvt_decode(const Args& a, unsigned char* ws, int it, CvtItem& c) {
    const int l = it / CVT_PER_LAYER; int r = it - l * CVT_PER_LAYER;
    c.rowscale = nullptr; c.mapkind = 0; c.nrows = 64;
    if (r < 256) { c.src = a.in[7] + (size_t)l * D * 1952; c.ld = 1952; c.kvalid = D; c.k0 = (r >> 5) * 128; c.n0 = (r & 31) * 64; c.mapkind = 1; c.ldd = D;
        c.dst = (bf16_t*)(ws + WS_WIN + ((size_t)l * PW * D + (size_t)c.n0 * D)); return; }
    r -= 256;
    if (r < 16) { c.src = a.in[9] + (size_t)l * 256 * 384; c.ld = 384; c.kvalid = 256; c.k0 = (r >> 3) * 128; c.n0 = (r & 7) * 64; c.mapkind = 2; c.ldd = 256; c.rowscale = a.in[8] + l * 256;
        c.dst = (bf16_t*)(ws + WS_WUQ) + (size_t)l * 512 * 256 + (size_t)c.n0 * 256; return; }
    r -= 16;
    if (r < 16) { c.src = a.in[11] + (size_t)l * 128 * 512; c.ld = 512; c.kvalid = 128; c.k0 = (r >> 3) * 128; c.n0 = (r & 7) * 64; c.ldd = 256; c.rowscale = a.in[10] + l * 128;
        c.dst = (bf16_t*)(ws + WS_WUKV) + (size_t)l * 512 * 256 + (size_t)c.n0 * 256; return; }
    r -= 16;
    c.src = a.in[17] + (size_t)l * D * 32; c.ld = 32; c.kvalid = D; c.k0 = r * 128; c.n0 = 0; c.nrows = 32; c.mapkind = 3; c.ldd = D;
    c.dst = (bf16_t*)(ws + WS_WR) + (size_t)l * 32 * D;
}
constexpr int FAST_MATS = NL * (1 + 3 * NE);
constexpr int FAST_ITEMS = FAST_MATS * 256;
constexpr int FAST_PER_LAYER = (1 + 3 * NE) * 256;
constexpr int CONV_CHUNK = 64, CONV_NCHUNK = FAST_PER_LAYER / CONV_CHUNK;
__device__ __forceinline__ void fast_decode(const Args& a, unsigned char* ws, int it, const float*& src, unsigned char*& dst8, bool& f8) {
    const int mat = it >> 8, tile = it & 255, k0 = (tile >> 4) * 64, n0 = (tile & 15) * 64;
    const int l = mat / (1 + 3 * NE); int r = mat - l * (1 + 3 * NE);
    const float* sb;
    if (r == 0) { sb = a.in[15] + (size_t)l * D * D; dst8 = ws + WS_WOUT + ((size_t)l * D * D + (size_t)n0 * D + k0); f8 = true; }
    else { r -= 1; const int e = r / 3, which = r - e * 3; const size_t le = (size_t)l * NE + e; f8 = true;
        if (which == 0)      { sb = a.in[19] + le * D * D; dst8 = ws + WS_WGU + le * 2048 * D + (size_t)((n0 >> 7) * 256 + (n0 & 127)) * D + k0; }
        else if (which == 1) { sb = a.in[21] + le * D * D; dst8 = ws + WS_WGU + le * 2048 * D + (size_t)((n0 >> 7) * 256 + 128 + (n0 & 127)) * D + k0; }
        else                 { sb = a.in[23] + le * D * D; dst8 = ws + WS_WD + le * D * D + (size_t)n0 * D + k0; } }
    src = sb + (size_t)k0 * D + n0;
}
__device__ __forceinline__ void fast_convert(Frame& F, const Args& a, int tid, int it0, int it1, int gw, int NGW) {
    unsigned char* ws = F.ws;
    const int lane = tid & 63, q = lane >> 4, c4 = (lane & 15) * 4;
    LAS unsigned char* tl = F.lds + F.wave * 8704;
    f32x4 v[16]; const float* src; unsigned char* dst8; bool f8;
#define FAST_LOAD() do { _Pragma("unroll") for (int x = 0; x < 16; ++x) { const int kr = f8 ? 16 * (x >> 2) + 4 * q + (x & 3) : 8 * (x >> 1) + 2 * q + (x & 1); \
        v[x] = __builtin_nontemporal_load((const f32x4*)(src + (size_t)kr * D + c4)); } } while (0)
    int it = it0 + gw;
    if (it < it1) { fast_decode(a, ws, it, src, dst8, f8); FAST_LOAD(); }
    for (; it < it1; it += NGW) {
        unsigned char* cdst = dst8; const bool cf8 = f8;
        if (cf8) {
#pragma unroll
            for (int i = 0; i < 4; ++i)
#pragma unroll
                for (int j = 0; j < 4; ++j)
                    *(LAS unsigned*)(tl + (c4 + j) * 68 + 16 * i + 4 * q) = (unsigned)__builtin_amdgcn_cvt_pk_fp8_f32(v[4 * i + 2][j] * F8_SW, v[4 * i + 3][j] * F8_SW, __builtin_amdgcn_cvt_pk_fp8_f32(v[4 * i][j] * F8_SW, v[4 * i + 1][j] * F8_SW, 0, false), true);
        } else {
#pragma unroll
            for (int i = 0; i < 8; ++i)
#pragma unroll
                for (int j = 0; j < 4; ++j) *(LAS unsigned*)(tl + (c4 + j) * 136 + (8 * i + 2 * q) * 2) = cvtpk(v[2 * i][j], v[2 * i + 1][j]);
        }
        const int nx = it + NGW;
        if (nx < it1) { fast_decode(a, ws, nx, src, dst8, f8); FAST_LOAD(); }
        asm volatile("s_waitcnt lgkmcnt(0)" ::: "memory");
        if (cf8) {
#pragma unroll
            for (int p = 0; p < 4; ++p) {
                const int n = 16 * p + (lane >> 2), c = lane & 3;
                const LAS unsigned* t4 = (const LAS unsigned*)(tl + n * 68 + c * 16);
                u32x4 w; w.x = t4[0]; w.y = t4[1]; w.z = t4[2]; w.w = t4[3];
                __builtin_nontemporal_store(w, (u32x4*)(cdst + (size_t)n * D + c * 16));
            }
        } else {
#pragma unroll
            for (int p = 0; p < 8; ++p) {
                const int n = 8 * p + (lane >> 3), c = lane & 7;
                const u32x2 lo = *(const LAS u32x2*)(tl + n * 136 + c * 16), hi2 = *(const LAS u32x2*)(tl + n * 136 + c * 16 + 8);
                u32x4 w; w.x = lo.x; w.y = lo.y; w.z = hi2.x; w.w = hi2.y;
                __builtin_nontemporal_store(w, (u32x4*)(cdst + (size_t)n * D * 2 + c * 16));
            }
        }
        asm volatile("s_waitcnt lgkmcnt(0)" ::: "memory");
    }
#undef FAST_LOAD
}
__device__ __forceinline__ void cvt_load(const CvtItem& c, int tid, float (&v)[16]) {
    const int nn = tid & 63, kk = tid >> 6;
    float sc = 1.f; int sn;
    if (c.mapkind == 1) sn = winmap(c.n0 + nn, sc);
    else if (c.mapkind == 2) { sn = uqmap(c.n0 + nn); sc = SC_MLA; }
    else if (c.mapkind == 3) sn = nn < 32 ? nn : -1;
    else sn = c.n0 + nn;
#pragma unroll
    for (int i = 0; i < 16; ++i) {
        const int k = c.k0 + kk + 8 * i;
        float x = 0.f;
        if (sn >= 0 && k < c.kvalid) { x = c.src[(size_t)k * c.ld + sn] * sc; if (c.rowscale) x *= c.rowscale[k]; }
        v[i] = x;
    }
}
__device__ __forceinline__ void prologue_phase(Frame& F, const Args& a) {
    unsigned char* ws = F.ws;
    const int tid = opaque_tid();
    __syncthreads();
    {
        LAS unsigned short* tile = (LAS unsigned short*)F.lds;
        float v[16]; CvtItem c;
        int it = F.vcu;
        if (it < CVT_ITEMS) { cvt_decode(a, ws, it, c); cvt_load(c, tid, v); }
        for (; it < CVT_ITEMS; it += F.G) {
            const int nn = tid & 63, kk = tid >> 6;
            const bool f8 = (c.mapkind == 1);
            if (f8) {
                LAS unsigned char* t8 = (LAS unsigned char*)tile;
#pragma unroll
                for (int i = 0; i < 16; ++i) t8[nn * 132 + kk + 8 * i] = (unsigned char)(__builtin_amdgcn_cvt_pk_fp8_f32(v[i] * F8_SW, 0.f, 0, false) & 0xff);
            } else {
#pragma unroll
                for (int i = 0; i < 16; ++i) tile[nn * 130 + kk + 8 * i] = (unsigned short)(cvtpk(v[i], 0.f) & 0xffffu);
            }
            __syncthreads();
            const CvtItem cc = c;
            const int nx = it + F.G;
            if (nx < CVT_ITEMS) { cvt_decode(a, ws, nx, c); cvt_load(c, tid, v); }
            const LAS unsigned* t32 = (const LAS unsigned*)tile;
            if (f8) {
                const int n = tid >> 3, ch = tid & 7;
                u32x4 w; const LAS unsigned* s = t32 + n * 33 + ch * 4;
                w.x = s[0]; w.y = s[1]; w.z = s[2]; w.w = s[3];
                *(u32x4*)((unsigned char*)cc.dst + (size_t)n * cc.ldd + cc.k0 + ch * 16) = w;
            } else {
#pragma unroll
                for (int p = 0; p < 2; ++p) {
                    const int n = (tid >> 4) + 32 * p, ch = tid & 15;
                    if (n < cc.nrows) {
                        u32x4 w; const LAS unsigned* s = t32 + n * 65 + ch * 4;
                        w.x = s[0]; w.y = s[1]; w.z = s[2]; w.w = s[3];
                        *(u32x4*)(cc.dst + (size_t)n * cc.ldd + cc.k0 + ch * 8) = w;
                    }
                }
            }
            __syncthreads();
        }
    }
    {
        LAS float* sil = (LAS float*)F.lds;
        LAS float* part = (LAS float*)(F.lds + 1024 * 17 * 4);
        __syncthreads();
        for (int i = tid; i < 17 * D; i += NTHR) { const int r = i / D, k = i - r * D; const float x = r < 16 ? a.in[1][(size_t)r * D + k] : a.in[3][k]; sil[k * 17 + r] = x / (1.f + __expf(-x)); }
        __syncthreads();
        float* MOD = (float*)(ws + WS_MOD);
        const int col = tid & 63, kg = tid >> 6;
        for (int ch = F.vcu; ch < NL * 96; ch += F.G) {
            const int l = ch / 96, j0 = (ch - l * 96) * 64;
            const float* w = a.in[4] + (size_t)l * D * 6144 + j0 + col;
            float accv[17];
#pragma unroll
            for (int r = 0; r < 17; ++r) accv[r] = 0.f;
#pragma unroll 4
            for (int k = kg * 128; k < kg * 128 + 128; ++k) {
                const float wv = w[(size_t)k * 6144];
#pragma unroll
                for (int r = 0; r < 17; ++r) accv[r] += sil[k * 17 + r] * wv;
            }
#pragma unroll
            for (int r = 0; r < 17; ++r) part[(kg * 17 + r) * 64 + col] = accv[r];
            __syncthreads();
            for (int i = tid; i < 17 * 64; i += NTHR) {
                const int r = i >> 6, cc = i & 63; float s = 0.f;
#pragma unroll
                for (int g = 0; g < 8; ++g) s += part[(g * 17 + r) * 64 + cc];
                MOD[((size_t)l * 17 + r) * 6144 + j0 + cc] = s + a.in[5][(size_t)l * 6144 + j0 + cc];
            }
            __syncthreads();
        }
    }
    {
        const int gt = F.vcu * NTHR + tid, GT = F.G * NTHR;
        float* ropeR = (float*)(ws + WS_ROPER); float* ropeW = (float*)(ws + WS_ROPEW);
        for (int i = gt; i < SEQ * 48; i += GT) {
            int t, j; double f; float* dst;
            if (i < SEQ * 16) { t = i >> 4; j = i & 15; f = a.invf8[j & 7]; dst = ropeR + (size_t)i * 2; const int pos = (j < 8) ? (t >> 6) : (t & 63); f *= (double)pos; }
            else { const int ii = i - SEQ * 16; t = ii >> 5; j = ii & 31; f = a.invf16[j & 15]; dst = ropeW + (size_t)ii * 2; const int pos = (j < 16) ? (t >> 6) : (t & 63); f *= (double)pos; }
            const double n = __builtin_rint(f * 0.15915494309189535);
            const double r = (f - n * 6.283185307179586) - n * 2.4492935982947064e-16;
            const double r2 = r * r;
            double s = 1.0, cs = 1.0;
#pragma unroll
            for (int q = 27; q >= 3; q -= 2) s = 1.0 - s * r2 / (double)(q * (q - 1));
            s *= r;
#pragma unroll
            for (int q = 26; q >= 2; q -= 2) cs = 1.0 - cs * r2 / (double)(q * (q - 1));
            dst[0] = (float)cs; dst[1] = (float)s;
        }
        if (gt < NL) {
            const float* lam = a.in[12] + gt * 128; float s1 = 0.f, s2 = 0.f;
            for (int k = 0; k < 32; ++k) { s1 += lam[k] * lam[32 + k]; s2 += lam[64 + k] * lam[96 + k]; }
            ((float*)(ws + WS_CTL))[CW_LAM + gt] = expf(s1) - expf(s2) + a.lam_init[gt];
        }
    }
}

__device__ __forceinline__ void load_counts(Frame& F, int l) {
    volatile LAS int* PB = (volatile LAS int*)(F.lds + MISC_OFF + 256);
    volatile LAS int* CNT = (volatile LAS int*)(F.lds + MISC_OFF + 512);
    __syncthreads();
    const int tid = opaque_tid(), lane = tid & 63;
    if (tid < 64) {
        const unsigned* cur = (const unsigned*)(F.ws + WS_CTL) + CW_CUR + l * 32;
        const int c = lane < 32 ? (int)cur[lane] : 0;
        const int np = (c + 255) >> 8;
        int incl = np;
#pragma unroll
        for (int o = 1; o < 32; o <<= 1) { const int y = __shfl_up(incl, o); if ((lane & 31) >= o) incl += y; }
        if (lane < 32) { PB[lane + 1] = incl; CNT[lane] = c; }
        if (lane == 0) PB[0] = 0;
    }
    __syncthreads();
}
template <int MODE, bool FIRST> __device__ __forceinline__ void norm1_phase(Frame& F, const Args& a, int l, bool dummy = false) {
    unsigned char* ws = F.ws;
    bf16_t* X = (bf16_t*)(ws + WS_X); bf16_t* H = (bf16_t*)(ws + WS_H); const bf16_t* Y = (const bf16_t*)(ws + WS_Y);
    bf16_t* Xw = dummy ? (bf16_t*)(ws + WS_ACT + 160 * MiB) : X; if (dummy) H = (bf16_t*)(ws + WS_ACT + 232 * MiB);
    const float* MOD = (const float*)(ws + WS_MOD);
    const unsigned* tokslot = (const unsigned*)(ws + WS_TOKSLOT);
    constexpr bool comb = (MODE == 1) || !FIRST;
    constexpr int NR = FIRST ? 4 : 2;
    const int lp = (MODE == 1) ? NL - 1 : l - 1;
    if (comb) load_counts(F, lp);
    volatile LAS int* PB = (volatile LAS int*)(F.lds + MISC_OFF + 256);
    const int lane = opaque_tid() & 63;
    int vcu_ = F.vcu; asm volatile("" : "+s"(vcu_));
    const int gw = vcu_ * NWAVES + F.wave, NGW = F.G * NWAVES;
    const int nrows = (MODE == 1) ? NB * SEQ : T;
    const float* gvec = (MODE == 1) ? a.in[25] : a.in[6] + (size_t)l * D;
    f32x4 gv[4];
#pragma unroll
    for (int j = 0; j < 4; ++j) gv[j] = *(const f32x4*)(gvec + 16 * lane + 4 * j);
    auto rowinfo = [&](int ri, int& tok, int& bb, int& nb) { if (MODE == 1) { bb = ri >> 11; nb = CTX + (ri & 2047); tok = bb * NTK + nb; } else { tok = ri; bb = tok / NTK; nb = tok - bb * NTK; } };
    auto stageA = [&](int ri, u32x4 (&raw)[NR], u32x4& ts) {
        int tok, bb, nb; rowinfo(ri, tok, bb, nb);
        if constexpr (FIRST) {
            const float* src = nb < CTX ? a.in[2] + ((size_t)bb * CTX + nb) * D : a.in[0] + ((size_t)bb * SEQ + (nb - CTX)) * D;
#pragma unroll
            for (int j = 0; j < 4; ++j) raw[j] = *(const u32x4*)(src + 16 * lane + 4 * j);
        } else {
            const u32x4* xp = (const u32x4*)(X + (size_t)tok * D + 16 * lane); raw[0] = xp[0]; raw[1] = xp[1];
        }
        if (comb) ts = *(const u32x4*)(tokslot + (size_t)tok * 4);
    };
    auto stageB = [&](const u32x4& ts, u32x4 (&yv)[4]) {
#pragma unroll
        for (int k = 0; k < 4; ++k) {
            const unsigned w = ts[k]; const int e = (int)(w >> 16), pos = (int)(w & 0xffffu);
            const unsigned char* yr = (const unsigned char*)Y + ((size_t)PB[e] * 256 + pos) * D;
            yv[k] = *(const u32x4*)(yr + 16 * lane);
        }
    };
    auto stageC = [&](int ri, const u32x4 (&raw)[NR], const u32x4 (&yv)[4]) {
        __builtin_amdgcn_sched_barrier(0);
        int tok, bb, nb; rowinfo(ri, tok, bb, nb);
        const int modrow = nb < CTX ? 16 : bb;
        f32x4 v[4];
#pragma unroll
        for (int j = 0; j < 4; ++j) {
            if constexpr (FIRST) v[j] = __builtin_bit_cast(f32x4, raw[j]);
            else { const unsigned w0 = (j & 1) ? raw[j >> 1].z : raw[j >> 1].x, w1 = (j & 1) ? raw[j >> 1].w : raw[j >> 1].y; v[j] = (f32x4){bflo(w0), bfhi(w0), bflo(w1), bfhi(w1)}; }
        }
        if (comb) {
            const float* g5 = MOD + ((size_t)lp * 17 + modrow) * 6144 + 5 * D;
#pragma unroll
            for (int j = 0; j < 4; ++j) {
                f32x4 sj = (f32x4){0.f, 0.f, 0.f, 0.f};
#pragma unroll
                for (int k = 0; k < 4; ++k) { const unsigned y = yv[k][j]; const f32x2 lo = __builtin_amdgcn_cvt_pk_f32_fp8((int)y, false), hi2 = __builtin_amdgcn_cvt_pk_f32_fp8((int)y, true); sj[0] += lo[0]; sj[1] += lo[1]; sj[2] += hi2[0]; sj[3] += hi2[1]; }
                v[j] += *(const f32x4*)(g5 + 16 * lane + 4 * j) * (sj * (1.0f / F8_SY));
            }
        }
        float ss = 0.f;
#pragma unroll
        for (int j = 0; j < 4; ++j) ss += (v[j][0] * v[j][0] + v[j][1] * v[j][1]) + (v[j][2] * v[j][2] + v[j][3] * v[j][3]);
        const float rstd = 1.0f / sqrtf(wave_sum(ss) * (1.f / D) + EPS);
        if (MODE == 1) {
            float* o = a.out + (size_t)ri * D;
#pragma unroll
            for (int j = 0; j < 4; ++j) *(f32x4*)(o + 16 * lane + 4 * j) = v[j] * rstd * gv[j];
        } else {
            const float* mr = MOD + ((size_t)l * 17 + modrow) * 6144;
            u32x4 xb[2], h8;
#pragma unroll
            for (int j = 0; j < 4; ++j) {
                const unsigned p0 = cvtpk(v[j][0], v[j][1]), p1 = cvtpk(v[j][2], v[j][3]);
                if (j & 1) { xb[j >> 1].z = p0; xb[j >> 1].w = p1; } else { xb[j >> 1].x = p0; xb[j >> 1].y = p1; }
                const f32x4 sh = *(const f32x4*)(mr + 16 * lane + 4 * j), sc = *(const f32x4*)(mr + D + 16 * lane + 4 * j);
                const f32x4 h = (v[j] * rstd * gv[j] * (sc + 1.0f) + sh) * F8_SA;
                h8[j] = (unsigned)__builtin_amdgcn_cvt_pk_fp8_f32(h[2], h[3], __builtin_amdgcn_cvt_pk_fp8_f32(h[0], h[1], 0, false), true);
            }
            { u32x4* xp = (u32x4*)(Xw + (size_t)tok * D + 16 * lane); xp[0] = xb[0]; xp[1] = xb[1]; }
            *(u32x4*)((unsigned char*)H + (size_t)tok * D + 16 * lane) = h8;
        }
    };
    u32x4 rawC[NR], rawN[NR], rawF[NR]; u32x4 tsN = {0u, 0u, 0u, 0u}, tsF = {0u, 0u, 0u, 0u}, tsC = {0u, 0u, 0u, 0u}; u32x4 yC[4], yN[4];
    if (gw < nrows) stageA(gw, rawC, tsC);
    if (gw + NGW < nrows) stageA(gw + NGW, rawN, tsN);
    if (comb && gw < nrows) stageB(tsC, yC);
    for (int ri = gw; ri < nrows; ri += NGW) {
        if (ri + 2 * NGW < nrows) stageA(ri + 2 * NGW, rawF, tsF);
        if (comb && ri + NGW < nrows) stageB(tsN, yN);
        stageC(ri, rawC, yC);
#pragma unroll
        for (int j = 0; j < NR; ++j) { rawC[j] = rawN[j]; rawN[j] = rawF[j]; }
        tsN = tsF;
#pragma unroll
        for (int k = 0; k < 4; ++k) yC[k] = yN[k];
    }
}
__device__ __forceinline__ void norm2_router_phase(Frame& F, const Args& a, int l) {
    unsigned char* ws = F.ws;
    const bf16_t* X = (const bf16_t*)(ws + WS_X); unsigned char* H8 = (unsigned char*)(ws + WS_H);
    const float* MOD = (const float*)(ws + WS_MOD);
    unsigned* tokslot = (unsigned*)(ws + WS_TOKSLOT); int* slot_tok = (int*)(ws + WS_SLOTTOK); float* slot_w = (float*)(ws + WS_SLOTW);
    unsigned* cursor = (unsigned*)(ws + WS_CTL) + CW_CUR + l * 32;
    const bf16_t* Wr = (const bf16_t*)(ws + WS_WR) + (size_t)l * 32 * D;
    const bool last = (l == NL - 1);
    const int ngroups = last ? NB * SEQ / 32 : T / 32;
    const int tid = opaque_tid(), lane = tid & 63, wave = F.wave, r32 = lane & 31, hi = lane >> 5;
    constexpr int FT_RS = 2064;
    LAS unsigned char* FT = F.lds;
    LAS float* LP = (LAS float*)(F.lds + 32 * FT_RS);
    LAS float* LG = LP + 8 * 32 * 33;
    LAS int* lcnt = (LAS int*)(LG + 32 * 33);
    LAS int* lbase = lcnt + 32;
    bf16x8 wf[8];
#pragma unroll
    for (int s = 0; s < 8; ++s) wf[s] = *(const bf16x8*)(Wr + (size_t)r32 * D + (8 * wave + s) * 16 + hi * 8);
    const float* gvec = a.in[16] + (size_t)l * D;
    f32x4 gv[4];
#pragma unroll
    for (int j = 0; j < 4; ++j) gv[j] = *(const f32x4*)(gvec + 16 * lane + 4 * j);
    if (tid < 32) lcnt[tid] = 0;
    __syncthreads();
    auto ginfo = [&](int g, int& tok0, int& modrow) {
        int b; bool isctx;
        if (last) { b = g >> 6; tok0 = b * NTK + CTX + (g & 63) * 32; isctx = false; } else { tok0 = g * 32; b = tok0 / NTK; isctx = (tok0 - b * NTK) < CTX; }
        modrow = isctx ? 16 : b;
    };
    u32x4 xq[4][2], xn[4][2]; f32x4 shv[4], scv[4], shn[4], scn[4];
    auto gload = [&](int g, u32x4 (&x)[4][2], f32x4 (&sh)[4], f32x4 (&sc)[4]) {
        int tok0, modrow; ginfo(g, tok0, modrow);
        const float* mr = MOD + ((size_t)l * 17 + modrow) * 6144;
#pragma unroll
        for (int q = 0; q < 4; ++q) { const u32x4* xp = (const u32x4*)(X + (size_t)(tok0 + wave * 4 + q) * D + 16 * lane); x[q][0] = xp[0]; x[q][1] = xp[1]; }
#pragma unroll
        for (int j = 0; j < 4; ++j) { sh[j] = *(const f32x4*)(mr + 3 * D + 16 * lane + 4 * j); sc[j] = *(const f32x4*)(mr + 4 * D + 16 * lane + 4 * j); }
    };
    if ((int)F.vcu >= ngroups) return;
    const int glast = F.vcu + ((ngroups - 1 - F.vcu) / F.G) * F.G;
    gload(F.vcu, xq, shv, scv);
    for (int g = F.vcu; g < ngroups; g += F.G) {
        int tok0, modrow_; ginfo(g, tok0, modrow_);
        gload(min(g + F.G, glast), xn, shn, scn);
#pragma unroll
        for (int q = 0; q < 4; ++q) {
            const int rl = wave * 4 + q, tok = tok0 + rl;
            f32x4 v[4]; float ss = 0.f;
#pragma unroll
            for (int j = 0; j < 4; ++j) { const unsigned w0 = (j & 1) ? xq[q][j >> 1].z : xq[q][j >> 1].x, w1 = (j & 1) ? xq[q][j >> 1].w : xq[q][j >> 1].y;
                v[j] = (f32x4){bflo(w0), bfhi(w0), bflo(w1), bfhi(w1)}; ss += (v[j][0] * v[j][0] + v[j][1] * v[j][1]) + (v[j][2] * v[j][2] + v[j][3] * v[j][3]); }
            const float rstd = 1.0f / sqrtf(wave_sum(ss) * (1.f / D) + EPS);
            u32x4 h8; u32x4 hb[2];
#pragma unroll
            for (int j = 0; j < 4; ++j) {
                const f32x4 h = v[j] * rstd * gv[j] * (scv[j] + 1.0f) + shv[j];
                const unsigned p0 = cvtpk(h[0], h[1]), p1 = cvtpk(h[2], h[3]);
                if (j & 1) { hb[j >> 1].z = p0; hb[j >> 1].w = p1; } else { hb[j >> 1].x = p0; hb[j >> 1].y = p1; }
                h8[j] = (unsigned)__builtin_amdgcn_cvt_pk_fp8_f32(h[2] * F8_SA, h[3] * F8_SA, __builtin_amdgcn_cvt_pk_fp8_f32(h[0] * F8_SA, h[1] * F8_SA, 0, false), true);
            }
            *(u32x4*)(H8 + (size_t)tok * D + 16 * lane) = h8;
            LAS u32x4* fp = (LAS u32x4*)(FT + rl * FT_RS + 32 * lane); fp[0] = hb[0]; fp[1] = hb[1];
        }
#pragma unroll
        for (int q = 0; q < 4; ++q) { xq[q][0] = xn[q][0]; xq[q][1] = xn[q][1]; }
#pragma unroll
        for (int j = 0; j < 4; ++j) { shv[j] = shn[j]; scv[j] = scn[j]; }
        __syncthreads();
        {
            f32x16 acc = {};
#pragma unroll
            for (int s = 0; s < 8; ++s) {
                const bf16x8 af = *(const LAS bf16x8*)(FT + r32 * FT_RS + ((8 * wave + s) * 16 + hi * 8) * 2);
                acc = __builtin_amdgcn_mfma_f32_32x32x16_bf16(af, wf[s], acc, 0, 0, 0);
            }
#pragma unroll
            for (int r = 0; r < 16; ++r) { const int row = (r & 3) + 8 * (r >> 2) + 4 * hi; LP[(wave * 32 + row) * 33 + r32] = acc[r]; }
        }
        __syncthreads();
        for (int i = tid; i < 1024; i += NTHR) {
            const int row = i >> 5, e = i & 31; float s = a.in[18][l * 32 + e];
#pragma unroll
            for (int w = 0; w < 8; ++w) s += LP[(w * 32 + row) * 33 + e];
            LG[row * 33 + e] = s;
        }
        __syncthreads();
        int te[4]; float tw[4]; int rk[4];
        if (tid < 32) {
            float lv[32];
#pragma unroll
            for (int e = 0; e < 32; ++e) lv[e] = LG[tid * 33 + e];
            float tv[4];
#pragma unroll
            for (int k = 0; k < 4; ++k) {
                float best = -3.0e38f; int bi = 0;
#pragma unroll
                for (int e = 0; e < 32; ++e) { const bool up = lv[e] > best; best = up ? lv[e] : best; bi = up ? e : bi; }
                tv[k] = best; te[k] = bi;
#pragma unroll
                for (int e = 0; e < 32; ++e) lv[e] = (e == bi) ? -3.0e38f : lv[e];
            }
            const float e1 = __expf(tv[1] - tv[0]), e2 = __expf(tv[2] - tv[0]), e3 = __expf(tv[3] - tv[0]);
            const float inv = 1.0f / (1.0f + e1 + e2 + e3);
            tw[0] = inv; tw[1] = e1 * inv; tw[2] = e2 * inv; tw[3] = e3 * inv;
#pragma unroll
            for (int k = 0; k < 4; ++k) rk[k] = atomicAdd((int*)&lcnt[te[k]], 1);
        }
        __syncthreads();
        if (tid < 32) { const int c = lcnt[tid]; lbase[tid] = c ? (int)atomicAdd(&cursor[tid], (unsigned)c) : 0; }
        __syncthreads();
        if (tid < 32) {
            const int tok = tok0 + tid; u32x4 ts;
#pragma unroll
            for (int k = 0; k < 4; ++k) { const int pos = lbase[te[k]] + rk[k]; slot_tok[(size_t)te[k] * T + pos] = tok; slot_w[(size_t)te[k] * T + pos] = tw[k]; ts[k] = ((unsigned)te[k] << 16) | (unsigned)pos; }
            *(u32x4*)(tokslot + (size_t)tok * 4) = ts;
            lcnt[tid] = 0;
        }
        __syncthreads();
    }
}

struct AttnPtrs { const bf16_t* P; const bf16_t* QM; const bf16_t* KVM; unsigned char* MIX; const float* sink; const float* subg; float lam_full, one_m_li; };
constexpr int KB_OFF0 = 0, KB_STRIDE = 16384, VB_OFF0 = 32768, VB_STRIDE = 12288, XCH_OFF = 81920;
#define ATT_PIN(x) asm volatile("" : "+v"(x))
#define ATT_SBAR() __builtin_amdgcn_sched_barrier(0)
#define ATT_THR 8.0f
#ifndef ATT_WSLICE
#define ATT_WSLICE 10
#endif
#ifndef ATT_PF
#define ATT_PF 2
#endif
template <int KIND> __device__ __forceinline__ void attn_unit(const AttnPtrs& A, int b, int h, int qblk, LAS unsigned char* lds, unsigned& qnext) {
    constexpr int DQK = KIND == 0 ? 96 : (KIND == 1 ? 32 : 64);
    constexpr int NF = DQK / 16, RSK = DQK * 2 + 16, RSV = 192, NMF = 8 + 2 * NF;
    const int tid = opaque_tid(), lane = tid & 63, r32 = lane & 31, hi = lane >> 5, wid = __builtin_amdgcn_readfirstlane(tid >> 6);
    const size_t tokb = (size_t)b * NTK;
    const int mp = KIND == 1 ? (wid >> 2) : 0;
    const int qrow0 = KIND == 1 ? qblk * 128 + (wid & 3) * 32 : qblk * 256 + wid * 32;
    const bool ctxunit = KIND == 1 ? (qblk < 2) : (qblk == 0);
    const size_t tokq = tokb + qrow0 + r32;
    const int kvh = h >> 2;
    bf16x8 qf[NF];
#pragma unroll
    for (int d0 = 0; d0 < NF; ++d0) {
        const bf16_t* src = KIND == 0 ? A.QM + tokq * 384 + h * 96 + d0 * 16 + hi * 8
                          : KIND == 1 ? A.P + tokq * PW + 512 + (2 * h + mp) * 32 + d0 * 16 + hi * 8
                                      : A.P + tokq * PW + 1280 + h * 64 + d0 * 16 + hi * 8;
        qf[d0] = *(const bf16x8*)src;
    }
    float mrun = 0.f; f32x2 lrun2 = {0.f, 0.f}; f32x16 o[2]; o[0] = f32x16{}; o[1] = f32x16{};
    f32x16 negm = f32x16{};
    const int T0 = KIND == 2 ? (qblk - 1) * 256 : 0;
    int ntile, ttlo = 0;
    if (ctxunit) ntile = 4;
    else if (KIND == 2) { ttlo = max(0, (T0 >> 6) - 2); const int tthi = min(31, (T0 >> 6) + 5); ntile = 4 + (tthi - ttlo + 1); }
    else ntile = 36;
#define TILE_OF(i) ((KIND == 2 && (i) >= 4) ? 4 + ttlo + ((i) - 4) : (i))
    u32x4 krA0, krA1, vrA, krB0, krB1, vrB;
    const char* kp0; const char* kp1 = nullptr; const char* vp; unsigned ks0, ks1 = 0u, vs;
    if (KIND == 0) {
        { const int row = tid / 12, ch = tid - row * 12; const size_t tok = tokb + row;
          kp0 = ch < 8 ? (const char*)(A.KVM + tok * 512 + h * 128 + ch * 8) : (const char*)(A.P + tok * PW + 384 + (ch - 8) * 8); ks0 = ch < 8 ? 64u * 512u * 2u : 64u * PW * 2u; }
        { const int q = (tid & 255) + 512, row = q / 12, ch = q - row * 12; const size_t tok = tokb + row;
          kp1 = ch < 8 ? (const char*)(A.KVM + tok * 512 + h * 128 + ch * 8) : (const char*)(A.P + tok * PW + 384 + (ch - 8) * 8); ks1 = ch < 8 ? 64u * 512u * 2u : 64u * PW * 2u; }
        { const int row = tid >> 3, ch = tid & 7; vp = (const char*)(A.KVM + (tokb + row) * 512 + h * 128 + 64 + ch * 8); vs = 64u * 512u * 2u; }
    } else if (KIND == 1) {
        { const int m2 = tid >> 8, row = (tid & 255) >> 2, ch = tid & 3; kp0 = (const char*)(A.P + (tokb + row) * PW + 768 + (2 * h + m2) * 32 + ch * 8); ks0 = 64u * PW * 2u; }
        { const int row = tid >> 3, ch = tid & 7; vp = (const char*)(A.P + (tokb + row) * PW + 1024 + h * 64 + ch * 8); vs = 64u * PW * 2u; }
    } else {
        const int row = tid >> 3, ch = tid & 7;
        kp0 = (const char*)(A.P + (tokb + row) * PW + 1792 + kvh * 64 + ch * 8); ks0 = 64u * PW * 2u;
        vp = (const char*)(A.P + (tokb + row) * PW + 1920 + kvh * 64 + ch * 8); vs = 64u * PW * 2u;
    }
    const char* gb = (const char*)A.P;
    const unsigned ko0 = (unsigned)(kp0 - gb), ko1 = (KIND == 0) ? (unsigned)(kp1 - gb) : 0u, vo = (unsigned)(vp - gb);
    const unsigned ksh0 = ks0 == 65536u ? 16u : 18u, ksh1 = ks1 == 65536u ? 16u : 18u, vsh = vs == 65536u ? 16u : 18u;
    auto gload = [&](int tt, u32x4& kr0, u32x4& kr1, u32x4& vr) {
        kr0 = *(const u32x4*)(gb + (size_t)(((unsigned)tt << ksh0) + ko0));
        if (KIND == 0) kr1 = *(const u32x4*)(gb + (size_t)(((unsigned)tt << ksh1) + ko1));
        vr = *(const u32x4*)(gb + (size_t)(((unsigned)tt << vsh) + vo));
    };
    auto lstore = [&](int i, const u32x4& kr0, const u32x4& kr1, const u32x4& vr) {
        LAS unsigned char* kb = lds + KB_OFF0 + (i & 1) * KB_STRIDE; LAS unsigned char* vb = lds + VB_OFF0 + (i & 3) * VB_STRIDE;
        if (KIND == 0) {
            { const int row = tid / 12, ch = tid - row * 12; *(LAS u32x4*)(kb + row * RSK + ch * 16) = kr0; }
            if (tid < 256) { const int q = tid + 512, row = q / 12, ch = q - row * 12; *(LAS u32x4*)(kb + row * RSK + ch * 16) = kr1; }
        } else if (KIND == 1) {
            const int m2 = tid >> 8, row = (tid & 255) >> 2, ch = tid & 3; *(LAS u32x4*)(kb + m2 * 8192 + row * RSK + ch * 16) = kr0;
        } else { const int row = tid >> 3, ch = tid & 7; *(LAS u32x4*)(kb + row * RSK + ch * 16) = kr0; }
        { const int row = tid >> 3, ch = tid & 7; *(LAS u32x4*)(vb + row * RSV + ch * 16) = vr; }
    };
    const int qpos = T0 + wid * 32 + r32;
    const int koff = (KIND == 1 ? mp * 8192 : 0) + r32 * RSK + hi * 16;
    const int voff = ((lane >> 4) & 1) * 32 + (lane & 3) * 8 + (4 * hi + ((lane & 15) >> 2)) * RSV;
    auto fetch = [&](int j, const LAS unsigned char* vb, const LAS unsigned char* kb) -> bf16x8 {
        if (j < 8) {
            const int sI = j >> 1, d0 = j & 1;
            const v4i16_t lo = __builtin_amdgcn_ds_read_tr16_b64_v4i16((LAS v4i16_t*)(vb + voff + (16 * sI) * RSV + d0 * 64));
            const v4i16_t hh = __builtin_amdgcn_ds_read_tr16_b64_v4i16((LAS v4i16_t*)(vb + voff + (16 * sI + 8) * RSV + d0 * 64));
            return (bf16x8){lo[0], lo[1], lo[2], lo[3], hh[0], hh[1], hh[2], hh[3]};
        } else {
            const int d0 = (j - 8) >> 1, half = (j - 8) & 1;
            return *(const LAS bf16x8*)(kb + koff + half * 32 * RSK + d0 * 32);
        }
    };
    gload(TILE_OF(0), krA0, krA1, vrA); gload(TILE_OF(1), krB0, krB1, vrB);
    lstore(0, krA0, krA1, vrA); lstore(1, krB0, krB1, vrB);
    gload(TILE_OF(2), krA0, krA1, vrA);
    qnext = (unsigned)__builtin_amdgcn_readfirstlane((int)qnext);
    __syncthreads();
    f32x16 pA0 = f32x16{}, pA1 = f32x16{}, pB0, pB1;
    {
        const LAS unsigned char* kb = lds + KB_OFF0;
#pragma unroll
        for (int d0 = 0; d0 < NF; ++d0) {
            const bf16x8 k0 = *(const LAS bf16x8*)(kb + koff + d0 * 32), k1 = *(const LAS bf16x8*)(kb + koff + 32 * RSK + d0 * 32);
            pA0 = __builtin_amdgcn_mfma_f32_32x32x16_bf16(k0, qf[d0], pA0, 0, 0, 0);
            pA1 = __builtin_amdgcn_mfma_f32_32x32x16_bf16(k1, qf[d0], pA1, 0, 0, 0);
        }
    }
    bf16x8 paX[4], paY[4];
#pragma unroll
    for (int sI = 0; sI < 4; ++sI) { paX[sI] = (bf16x8){0, 0, 0, 0, 0, 0, 0, 0}; paY[sI] = (bf16x8){0, 0, 0, 0, 0, 0, 0, 0}; }
    __syncthreads();
#define ATT_STEP(C0, C1, N0, N1, PP, PC, i, KR0, KR1, VR) do { \
        const int tt_ = TILE_OF(i); \
        if (KIND == 2 && !ctxunit && tt_ >= 4) { \
            const int k0_ = (tt_ - 4) * 64, tw_ = T0 + wid * 32; \
            if (k0_ + 63 - tw_ > 128 || k0_ - (tw_ + 31) < -128) {     \
                const int kbase_ = k0_ + 4 * hi - qpos; \
                _Pragma("unroll") for (int r = 0; r < 16; ++r) { const int dk = kbase_ + (r & 3) + 8 * (r >> 2); if (dk > 128 || dk < -128) C0[r] = -1.0e30f; if (dk + 32 > 128 || dk + 32 < -128) C1[r] = -1.0e30f; } \
            } \
        } \
        const LAS unsigned char* vb_ = lds + VB_OFF0 + (((i) + 3 + ((i) == 0 ? 1 : 0)) & 3) * VB_STRIDE;                  \
        const LAS unsigned char* kb_ = lds + KB_OFF0 + (((i) + 1 < ntile ? (i) + 1 : (i)) & 1) * KB_STRIDE;       \
        bf16x8 op_[ATT_PF + 1]; _Pragma("unroll") for (int j = 0; j < ATT_PF; ++j) op_[j] = fetch(j, vb_, kb_); \
        float mx_ = -3.0e38f, alpha_ = 1.f; f32x2 ls2_ = {0.f, 0.f}; unsigned long long gbal_ = 0ull;     \
        ATT_SBAR(); \
        _Pragma("unroll") for (int k = 0; k < 20; ++k) { \
            if (k == ATT_WSLICE) { if ((i) + 2 < ntile) lstore((i) + 2, KR0, KR1, VR); }     \
            if (k + ATT_PF < NMF) op_[(k + ATT_PF) % (ATT_PF + 1)] = fetch(k + ATT_PF, vb_, kb_); \
            if (k < 8) { o[k & 1] = __builtin_amdgcn_mfma_f32_32x32x16_bf16(op_[k % (ATT_PF + 1)], PP[k >> 1], o[k & 1], 0, 0, 0); } \
            else if (k < NMF) { const int j_ = k - 8; \
                if (j_ == 0) N0 = __builtin_amdgcn_mfma_f32_32x32x16_bf16(op_[k % (ATT_PF + 1)], qf[0], negm, 0, 0, 0); \
                else if (j_ == 1) N1 = __builtin_amdgcn_mfma_f32_32x32x16_bf16(op_[k % (ATT_PF + 1)], qf[0], negm, 0, 0, 0); \
                else if (j_ & 1) N1 = __builtin_amdgcn_mfma_f32_32x32x16_bf16(op_[k % (ATT_PF + 1)], qf[j_ >> 1], N1, 0, 0, 0); \
                else N0 = __builtin_amdgcn_mfma_f32_32x32x16_bf16(op_[k % (ATT_PF + 1)], qf[j_ >> 1], N0, 0, 0, 0); } \
            if (k < 4) { float a_ = fmaxf(fmaxf(C0[4 * k], C0[4 * k + 1]), C0[4 * k + 2]); const float b_ = fmaxf(fmaxf(C0[4 * k + 3], C1[4 * k]), C1[4 * k + 1]); a_ = fmaxf(fmaxf(a_, C1[4 * k + 2]), C1[4 * k + 3]); mx_ = fmaxf(fmaxf(mx_, a_), b_); ATT_PIN(mx_); }     \
            else if (k == 4) { auto rr_ = __builtin_amdgcn_permlane32_swap(__float_as_uint(mx_), __float_as_uint(mx_), false, false); { const float ma_ = __uint_as_float(rr_[0]), mb_ = __uint_as_float(rr_[1]); asm("v_max_f32 %0, %1, %2" : "=v"(mx_) : "v"(ma_), "v"(mb_)); }     \
                  \
                const bool far_ = ((i) == 0) ? (fabsf(mx_) > ATT_THR) : (mx_ > ATT_THR); \
                gbal_ = __builtin_amdgcn_ballot_w64(far_); \
                if (gbal_ != 0ull) { const float dl_ = ((i) == 0) ? mx_ : fmaxf(mx_, 0.f); \
                    _Pragma("unroll") for (int r = 0; r < 16; ++r) { C0[r] -= dl_; C1[r] -= dl_; } \
                    mrun += dl_; alpha_ = ((i) == 0) ? 1.0f : __builtin_amdgcn_exp2f(-dl_); \
                    _Pragma("unroll") for (int r = 0; r < 16; ++r) negm[r] = -mrun; ATT_PIN(negm); ATT_PIN(alpha_); } } \
            else if (k < 13) { const int e_ = k - 5; \
                C0[2 * e_] = __builtin_amdgcn_exp2f(C0[2 * e_]); C0[2 * e_ + 1] = __builtin_amdgcn_exp2f(C0[2 * e_ + 1]); \
                C1[2 * e_] = __builtin_amdgcn_exp2f(C1[2 * e_]); C1[2 * e_ + 1] = __builtin_amdgcn_exp2f(C1[2 * e_ + 1]); \
                ls2_ += (f32x2){C0[2 * e_], C0[2 * e_ + 1]}; ls2_ += (f32x2){C1[2 * e_], C1[2 * e_ + 1]}; ATT_PIN(ls2_); } \
            else if (k < 17) { const int c_ = k - 13; u32x4 w_; \
                if (c_ < 2) { w_.x = cvtpk(C0[8 * c_ + 0], C0[8 * c_ + 1]); w_.y = cvtpk(C0[8 * c_ + 2], C0[8 * c_ + 3]); w_.z = cvtpk(C0[8 * c_ + 4], C0[8 * c_ + 5]); w_.w = cvtpk(C0[8 * c_ + 6], C0[8 * c_ + 7]); } \
                else { const int c2_ = c_ - 2; w_.x = cvtpk(C1[8 * c2_ + 0], C1[8 * c2_ + 1]); w_.y = cvtpk(C1[8 * c2_ + 2], C1[8 * c2_ + 3]); w_.z = cvtpk(C1[8 * c2_ + 4], C1[8 * c2_ + 5]); w_.w = cvtpk(C1[8 * c2_ + 6], C1[8 * c2_ + 7]); } \
                ATT_PIN(w_); PC[c_] = __builtin_bit_cast(bf16x8, w_); } \
            else if (k == 17) { if (gbal_ != 0ull) { lrun2 *= alpha_; _Pragma("unroll") for (int r = 0; r < 16; ++r) o[0][r] *= alpha_; ATT_PIN(o[0]); } lrun2 += ls2_; ATT_PIN(lrun2); } \
            else if (k == 18) { if (gbal_ != 0ull) { _Pragma("unroll") for (int r = 0; r < 16; ++r) o[1][r] *= alpha_; ATT_PIN(o[1]); } } \
            ATT_SBAR(); \
        } \
    } while (0)
#ifndef ATT_PRIO
#define ATT_PRIO 1
#endif
    if (ATT_PRIO && wid >= 4) __builtin_amdgcn_s_setprio(1);
    for (int i = 0; i < ntile; i += 2) {
        { const int j3 = min(i + 3, ntile - 1); gload(TILE_OF(j3), krB0, krB1, vrB); }
        ATT_STEP(pA0, pA1, pB0, pB1, paY, paX, i, krA0, krA1, vrA);
        __syncthreads();
        { const int j4 = min(i + 4, ntile - 1); gload(TILE_OF(j4), krA0, krA1, vrA); }
        ATT_STEP(pB0, pB1, pA0, pA1, paX, paY, i + 1, krB0, krB1, vrB);
        __syncthreads();
    }
#undef ATT_STEP
#undef TILE_OF
    if (ATT_PRIO) __builtin_amdgcn_s_setprio(0);
    {
        const LAS unsigned char* vb = lds + VB_OFF0 + ((ntile - 1) & 3) * VB_STRIDE;
#pragma unroll
        for (int j = 0; j < 8; ++j) { const bf16x8 vfr = fetch(j, vb, vb); o[j & 1] = __builtin_amdgcn_mfma_f32_32x32x16_bf16(vfr, paY[j >> 1], o[j & 1], 0, 0, 0); }
    }
    const float lrun = lrun2[0] + lrun2[1];
    float lt = lrun + __shfl_xor(lrun, 32);
    if (KIND == 2) lt += __builtin_amdgcn_exp2f(A.sink[h] * LOG2E - mrun);
    const float inv = 1.0f / lt;
    const int colbase = (KIND == 0 ? 0 : (KIND == 1 ? 256 : 512)) + h * 64;
    unsigned char* orow = A.MIX + tokq * D + colbase;
    unsigned W8[2][4];
    auto store_rows = [&]() {
#pragma unroll
        for (int d0 = 0; d0 < 2; ++d0) {
            const auto s0 = __builtin_amdgcn_permlane32_swap(W8[d0][0], W8[d0][1], false, false), s1 = __builtin_amdgcn_permlane32_swap(W8[d0][2], W8[d0][3], false, false);
            const auto t0 = __builtin_amdgcn_permlane32_swap(s0[0], s1[0], false, false), t1 = __builtin_amdgcn_permlane32_swap(s0[1], s1[1], false, false);
            u32x4 w; w.x = t0[0]; w.y = t1[0]; w.z = t0[1]; w.w = t1[1];
            *(u32x4*)(orow + 32 * d0 + 16 * hi) = w;
        }
    };
    if (KIND == 1) {
        LAS float* xch = (LAS float*)(lds + XCH_OFF) + (wid & 3) * 2048 + lane;
        if (wid >= 4) {
#pragma unroll
            for (int d0 = 0; d0 < 2; ++d0)
#pragma unroll
                for (int r = 0; r < 16; ++r) xch[(d0 * 16 + r) * 64] = o[d0][r] * inv;
        }
        __syncthreads();
        if (wid < 4) {
            float ss = 0.f;
#pragma unroll
            for (int d0 = 0; d0 < 2; ++d0)
#pragma unroll
                for (int r = 0; r < 16; ++r) { const float x = o[d0][r] * inv - A.lam_full * xch[(d0 * 16 + r) * 64]; o[d0][r] = x; ss += x * x; }
            ss += __shfl_xor(ss, 32);
            const float rs = (1.0f / sqrtf(ss * (1.f / 64.f) + EPS)) * A.one_m_li;
#pragma unroll
            for (int d0 = 0; d0 < 2; ++d0)
#pragma unroll
                for (int g4 = 0; g4 < 4; ++g4) {
                    const int dd = 32 * d0 + 8 * g4 + 4 * hi;
                    const f32x4 gg = *(const f32x4*)(A.subg + dd);
                    const float rs8 = rs * F8_SM;
                    W8[d0][g4] = (unsigned)__builtin_amdgcn_cvt_pk_fp8_f32(o[d0][4 * g4 + 2] * rs8 * gg[2], o[d0][4 * g4 + 3] * rs8 * gg[3], __builtin_amdgcn_cvt_pk_fp8_f32(o[d0][4 * g4 + 0] * rs8 * gg[0], o[d0][4 * g4 + 1] * rs8 * gg[1], 0, false), true);
                }
            store_rows();
        }
    } else {
#pragma unroll
        for (int d0 = 0; d0 < 2; ++d0)
#pragma unroll
            for (int g4 = 0; g4 < 4; ++g4) {
                const float inv8 = inv * F8_SM;
                W8[d0][g4] = (unsigned)__builtin_amdgcn_cvt_pk_fp8_f32(o[d0][4 * g4 + 2] * inv8, o[d0][4 * g4 + 3] * inv8, __builtin_amdgcn_cvt_pk_fp8_f32(o[d0][4 * g4 + 0] * inv8, o[d0][4 * g4 + 1] * inv8, 0, false), true);
            }
        store_rows();
    }
    __syncthreads();
}
__device__ __forceinline__ void attn_phase(Frame& F, const Args& a, int l) {
    unsigned char* ws = F.ws;
    AttnPtrs A;
    A.P = (const bf16_t*)(ws + WS_P); A.QM = (const bf16_t*)(ws + WS_QM); A.KVM = (const bf16_t*)(ws + WS_KVM); A.MIX = (unsigned char*)(ws + WS_MIX);
    A.sink = a.in[14] + l * 8; A.subg = a.in[13] + l * 64;
    A.lam_full = ((const float*)(ws + WS_CTL))[CW_LAM + l]; A.one_m_li = 1.0f - a.lam_init[l];
    const int n1 = NB * 4 * 8, n2 = n1 + NB * 4 * 16, n3 = n2 + NB * 8 * 8;
    const int n4 = (l == NL - 1) ? n3 : n3 + NB * 4, n5 = (l == NL - 1) ? n3 : n4 + NB * 4 * 2, n6 = (l == NL - 1) ? n3 : n5 + NB * 8;
    unsigned* ctr = (unsigned*)(ws + WS_CTL) + CW_ATTQ + l;
    volatile LAS unsigned* qslot = (volatile LAS unsigned*)(F.lds + MISC_OFF + 1024);
#ifndef ATT_DUP
#define ATT_DUP 0
#endif
    const int ndup = ATT_DUP == 1 ? n1 : (ATT_DUP == 2 ? n2 - n1 : (ATT_DUP == 3 ? n3 - n2 : 0));
    const int nconv = CONV_NCHUNK, total = n6 + nconv + ndup;
    if (opaque_tid() == 0) qslot[0] = atomicAdd(ctr, 1u);
    __syncthreads();
    int u = (int)qslot[0];
    while (u < total) {
        unsigned nxt = 0u;
        if (opaque_tid() == 0) nxt = atomicAdd((unsigned*)(ws + WS_CTL) + CW_ATTQ + l, 1u);
        if ((u & 3) == 3 && (u >> 2) < nconv) {
            nxt = (unsigned)__builtin_amdgcn_readfirstlane((int)nxt);
            const int ch = u >> 2, base = l * FAST_PER_LAYER + ch * CONV_CHUNK;
            fast_convert(F, a, opaque_tid(), base, base + CONV_CHUNK, F.wave, NWAVES);
        } else {
            int ua = u - min(nconv, u >> 2);
            if (ua >= n6) ua = (ATT_DUP == 1 ? 0 : (ATT_DUP == 2 ? n1 : n2)) + (ua - n6);
            int kind, ub, uh, uq;
            if (ua < n1) { kind = 0; ub = ua >> 5; uh = (ua >> 3) & 3; uq = 1 + (ua & 7); }
            else if (ua < n2) { const int v = ua - n1; kind = 1; ub = v >> 6; uh = (v >> 4) & 3; uq = 2 + (v & 15); }
            else if (ua < n3) { const int v = ua - n2; kind = 2; ub = v >> 6; uh = (v >> 3) & 7; uq = 1 + (v & 7); }
            else if (ua < n4) { const int v = ua - n3; kind = 0; ub = v >> 2; uh = v & 3; uq = 0; }
            else if (ua < n5) { const int v = ua - n4; kind = 1; ub = v >> 3; uh = (v >> 1) & 3; uq = v & 1; }
            else { const int v = ua - n5; kind = 2; ub = v >> 3; uh = v & 7; uq = 0; }
            if (kind == 0) attn_unit<0>(A, ub, uh, uq, F.lds, nxt);
            else if (kind == 1) attn_unit<1>(A, ub, uh, uq, F.lds, nxt);
            else attn_unit<2>(A, ub, uh, uq, F.lds, nxt);
        }
        if (opaque_tid() == 0) qslot[0] = nxt;
        __syncthreads();
        u = (int)qslot[0];
    }
}

constexpr int PH_PER_LAYER = 8, N_PHASES = 2 + NL * PH_PER_LAYER;
__global__ void __launch_bounds__(NTHR, 2) trunk_fwd(Args args) {
    extern __shared__ __attribute__((aligned(16))) unsigned char lds_raw[];
    Frame F;
    F.lds = (LAS unsigned char*)lds_raw; F.ws = args.ws;
    F.tid = threadIdx.x; F.lane = F.tid & 63; F.wave = __builtin_amdgcn_readfirstlane(F.tid >> 6);
    F.G = gridDim.x; { const int bx = blockIdx.x; F.vcu = (F.G % 8 == 0) ? (bx % 8) * (F.G / 8) + bx / 8 : bx; }
    volatile LAS unsigned* MISC = (volatile LAS unsigned*)(F.lds + MISC_OFF);
    if (F.tid < 64) MISC[F.tid] = 0u;
    __syncthreads();
    const int lo = args.ph_lo, hi = args.ph_hi;
    const bool multi = (hi - lo) > 1;
    XcdBarrier bar; bar.bar = (unsigned*)(F.ws + WS_CTL) + CW_BAR; bar.x = 0; bar.st = MISC;
    if (multi) bar = xcd_barrier_post((unsigned*)(F.ws + WS_CTL) + CW_BAR, MISC);
    unsigned char* ws = F.ws;
#ifndef DIAG_KINDS
#define DIAG_KINDS 0x3ff
#endif
#ifndef REP_PRO
#define REP_PRO 1
#define REP_WIN 1
#define REP_UP 1
#define REP_ATT 1
#define REP_GU 1
#define REP_DOWN 1
#endif
#define KON(x) (((DIAG_KINDS) >> (x)) & 1)
#define IN(k) (lo <= (k) && (k) < hi)
#define SEAM(k) do { if (IN(k) && IN((k) + 1)) xcd_barrier(bar); } while (0)
    if (KON(0) && IN(0)) { asm volatile("; PHASE_MARK 0"); for (int rep = 0; rep < REP_PRO; ++rep) prologue_phase(F, args); }
    SEAM(0);
    for (int l = 0; l < NL; ++l) {
        const int pb = 1 + l * PH_PER_LAYER;
        const bool last = (l == NL - 1);
        if (KON(1) && IN(pb + 0)) { asm volatile("; PHASE_MARK 1");
#ifndef REP_N1
#define REP_N1 1
#endif
            for (int rep = 1; rep < REP_N1; ++rep) norm1_phase<0, false>(F, args, l, true);
            if (l == 0) norm1_phase<0, true>(F, args, l); else norm1_phase<0, false>(F, args, l); }
        SEAM(pb + 0);
        const bool chain = (F.G == 256);
        const pg8::ChainMap CM{(int)blockIdx.x & 7, (int)blockIdx.x >> 3};
        if (KON(2) && IN(pb + 1)) { asm volatile("; PHASE_MARK 2");
            pg8::EpiWin E{(bf16_t*)(ws + WS_P), (float*)(ws + WS_SSQ), (const float*)(ws + WS_ROPER), (const float*)(ws + WS_ROPEW)};
            if (chain) {
                pg8::WinChainSched S{(const char*)(ws + WS_H), (const char*)(ws + WS_WIN) + (size_t)l * PW * D, D / 2, D / 2, CM};
                for (int rep = 0; rep < REP_WIN; ++rep) pg8::gemm_phase<pg8::EpiWin, pg8::WinChainSched, true, true>(F.lds, D / 2, D / 2, D / 2, S, E);
            } else {
                pg8::DenseSched S{(const char*)(ws + WS_H), (const char*)(ws + WS_WIN) + (size_t)l * PW * D, D / 2, D / 2, NPAN, PW / 256, F.G, (int)blockIdx.x, 0};
                for (int rep = 0; rep < REP_WIN; ++rep) pg8::gemm_phase<pg8::EpiWin, pg8::DenseSched, true, true>(F.lds, D / 2, D / 2, D / 2, S, E);
            }
        }
        if (!chain) SEAM(pb + 1);
        else {
            __builtin_amdgcn_fence(__ATOMIC_ACQUIRE, "agent"); asm volatile("s_waitcnt vmcnt(0)" ::: "memory"); __syncthreads();
        }
        if (KON(3) && IN(pb + 2)) { asm volatile("; PHASE_MARK 3");
            pg8::EpiUp E{(bf16_t*)(ws + WS_QM), (bf16_t*)(ws + WS_KVM), (const float*)(ws + WS_SSQ), (const float*)(ws + WS_ROPER)};
            if (chain) {
                pg8::UpChainSched S{(const char*)(ws + WS_P), (const char*)(ws + WS_WUQ) + (size_t)l * 512 * 256 * 2, (const char*)(ws + WS_WUKV) + (size_t)l * 512 * 256 * 2, CM};
                for (int rep = 0; rep < REP_UP; ++rep) pg8::gemm_phase<pg8::EpiUp, pg8::UpChainSched, true>(F.lds, 256, PW, 256, S, E);
            } else {
                pg8::UpSched S{(const char*)(ws + WS_P), (const char*)(ws + WS_WUQ) + (size_t)l * 512 * 256 * 2, (const char*)(ws + WS_WUKV) + (size_t)l * 512 * 256 * 2, F.G, (int)blockIdx.x};
                for (int rep = 0; rep < REP_UP; ++rep) pg8::gemm_phase<pg8::EpiUp, pg8::UpSched, true>(F.lds, 256, PW, 256, S, E);
            }
        }
        SEAM(pb + 2);
        if (KON(4) && IN(pb + 3)) { asm volatile("; PHASE_MARK 4"); for (int rep = 0; rep < REP_ATT; ++rep) attn_phase(F, args, l); }
        SEAM(pb + 3);
        if (KON(5) && IN(pb + 4)) { asm volatile("; PHASE_MARK 5");
            pg8::DenseSched S{(const char*)(ws + WS_MIX), (const char*)(ws + WS_WOUT) + (size_t)l * D * D, D / 2, D / 2, last ? NB * 8 : NPAN, D / 256, F.G, (int)blockIdx.x, last ? 1 : 0};
            pg8::EpiWout E{(bf16_t*)(ws + WS_X), (const float*)(ws + WS_MOD) + (size_t)l * 17 * 6144};
            pg8::gemm_phase<pg8::EpiWout, pg8::DenseSched, true, true>(F.lds, D / 2, D / 2, D / 2, S, E);
        }
        SEAM(pb + 4);
        if (KON(6) && IN(pb + 5)) { asm volatile("; PHASE_MARK 6"); norm2_router_phase(F, args, l); }
        SEAM(pb + 5);
        if (KON(7) && IN(pb + 6)) { asm volatile("; PHASE_MARK 7");
            load_counts(F, l);
            pg8::MoeSched<true> S{(const char*)(ws + WS_H), (const char*)(ws + WS_WGU) + (size_t)l * NE * 2048 * D, (const int*)(ws + WS_SLOTTOK),
                                  (volatile LAS int*)(F.lds + MISC_OFF + 256), (volatile LAS int*)(F.lds + MISC_OFF + 512), 8, F.G, (int)blockIdx.x, (size_t)2048 * D, opaque_tid() & 31};
            pg8::EpiGateUp E{(unsigned char*)(ws + WS_ACT), args.in[20] + (size_t)l * NE * D, args.in[22] + (size_t)l * NE * D};
            for (int rep = 0; rep < REP_GU; ++rep) pg8::gemm_phase<pg8::EpiGateUp, pg8::MoeSched<true>, true, true>(F.lds, D / 2, D / 2, D / 2, S, E);
        }
        SEAM(pb + 6);
        if (KON(8) && IN(pb + 7)) { asm volatile("; PHASE_MARK 8");
            load_counts(F, l);
            pg8::MoeSched<false> S{(const char*)(ws + WS_ACT), (const char*)(ws + WS_WD) + (size_t)l * NE * D * D, (const int*)(ws + WS_SLOTTOK),
                                   (volatile LAS int*)(F.lds + MISC_OFF + 256), (volatile LAS int*)(F.lds + MISC_OFF + 512), 4, F.G, (int)blockIdx.x, (size_t)D * D, opaque_tid() & 31};
            pg8::EpiDown E{(bf16_t*)(ws + WS_Y), args.in[24] + (size_t)l * NE * D, (const float*)(ws + WS_SLOTW)};
            for (int rep = 0; rep < REP_DOWN; ++rep) pg8::gemm_phase<pg8::EpiDown, pg8::MoeSched<false>, true, true>(F.lds, D / 2, D / 2, D / 2, S, E);
        }
        SEAM(pb + 7);
    }
    if (KON(9) && IN(N_PHASES - 1)) { asm volatile("; PHASE_MARK 9"); norm1_phase<1, false>(F, args, NL); }
#undef IN
#undef SEAM
}

extern "C" void kernel_launch(void* const* d_in, const int* in_sizes, int n_in, void* d_out, int out_size, void* d_ws, size_t ws_size, hipStream_t stream) {
    static int grid = 0;
    if (grid == 0) {
        if (n_in != 26 || ws_size < WS_END) { fprintf(stderr, "kernel_launch: unexpected inputs (n_in %d, ws %zu)\n", n_in, ws_size); grid = -1; return; }
        int dev = 0, cus = 0, per_cu = 0;
        if (hipGetDevice(&dev) != hipSuccess || hipDeviceGetAttribute(&cus, hipDeviceAttributeMultiprocessorCount, dev) != hipSuccess) { grid = -1; return; }
        if (hipFuncSetAttribute((const void*)trunk_fwd, hipFuncAttributeMaxDynamicSharedMemorySize, LDS_BYTES) != hipSuccess) { fprintf(stderr, "kernel_launch: hipFuncSetAttribute failed\n"); grid = -1; return; }
        if (hipOccupancyMaxActiveBlocksPerMultiprocessor(&per_cu, (const void*)trunk_fwd, NTHR, LDS_BYTES) != hipSuccess || per_cu < 1)
            fprintf(stderr, "kernel_launch: occupancy query reports %d workgroups per CU\n", per_cu);
        (void)hipGetLastError();
        grid = cus;
    }
    if (grid < 0) return;
    if (hipMemsetAsync((char*)d_ws + WS_CTL, 0, CTL_ZERO_BYTES, stream) != hipSuccess) return;
    Args a{};
    for (int i = 0; i < 26; ++i) a.in[i] = (const float*)d_in[i];
    a.out = (float*)d_out; a.ws = (unsigned char*)d_ws;
    for (int i = 0; i < 8; ++i) a.invf8[i] = pow(10000.0, -(double)i / 8.0);
    for (int i = 0; i < 16; ++i) a.invf16[i] = pow(10000.0, -(double)i / 16.0);
    for (int i = 0; i < 4; ++i) a.lam_init[i] = (float)(0.8 - 0.6 * exp(-0.3 * (double)i));
#if MK_ONE_LAUNCH
    a.ph_lo = 0; a.ph_hi = N_PHASES;
    hipLaunchKernelGGL(trunk_fwd, dim3(grid), dim3(NTHR), LDS_BYTES, stream, a);
#else
    for (int p = 0; p < N_PHASES; ++p) { a.ph_lo = p; a.ph_hi = p + 1; hipLaunchKernelGGL(trunk_fwd, dim3(grid), dim3(NTHR), LDS_BYTES, stream, a); }
#endif
}
```

```cpp
#include <hip/hip_runtime.h>
#include <cstdio>
#include <cstdint>
#include <cmath>

#ifndef MK_ONE_LAUNCH
#define MK_ONE_LAUNCH 1
#endif

#define LAS __attribute__((address_space(3)))
#define GAS __attribute__((address_space(1)))
typedef unsigned short bf16_t;
typedef short bf16x8 __attribute__((ext_vector_type(8)));
typedef short v4i16_t __attribute__((ext_vector_type(4)));
typedef float f32x4 __attribute__((ext_vector_type(4)));
typedef float f32x2 __attribute__((ext_vector_type(2)));
typedef float f32x16 __attribute__((ext_vector_type(16)));
typedef unsigned u32x4 __attribute__((ext_vector_type(4)));
typedef unsigned u32x2 __attribute__((ext_vector_type(2)));
typedef __bf16 bf16x2_t __attribute__((ext_vector_type(2)));

constexpr int NB = 16, SEQ = 2048, CTX = 256, NTK = SEQ + CTX, T = NB * NTK, D = 1024, NL = 4, NE = 32;
constexpr int PW = 2048;
constexpr int NPAN = T / 256;
constexpr int MAXPAN = 608;
constexpr int NWAVES = 8, NTHR = 512;
constexpr float EPS = 1e-6f;
constexpr float LOG2E = 1.4426950408889634f;
constexpr float SC_MLA = 0.10206207261596577f * LOG2E;
constexpr float SC_DIFF = 0.17677669529663687f * LOG2E;
constexpr float SC_SWA = 0.125f * LOG2E;
constexpr float F8_SW = 64.0f, F8_SA = 4.0f;
constexpr float F8_INV = 1.0f / (F8_SW * F8_SA);
constexpr float F8_SM = 16.0f, F8_INVM = 1.0f / (F8_SW * F8_SM);
constexpr float F8_SY = 64.0f;

constexpr size_t MiB = 1u << 20;
constexpr size_t WS_CTL = 0, CTL_ZERO_BYTES = 1 * MiB;
constexpr size_t WS_MOD = 1 * MiB;
constexpr size_t WS_ROPER = 3 * MiB;
constexpr size_t WS_ROPEW = WS_ROPER + 262144;
constexpr size_t WS_SSQ = 4 * MiB;
constexpr size_t WS_TOKSLOT = 6 * MiB;
constexpr size_t WS_SLOTTOK = 7 * MiB;
constexpr size_t WS_SLOTW = 12 * MiB;
constexpr size_t WS_WR = 17 * MiB;
constexpr size_t WS_WUQ = 18 * MiB;
constexpr size_t WS_WUKV = 19 * MiB;
constexpr size_t WS_WIN = 20 * MiB;
constexpr size_t WS_WOUT = 36 * MiB;
constexpr size_t WS_WGU = 44 * MiB;
constexpr size_t WS_WD = 556 * MiB;
constexpr size_t WS_X = 812 * MiB;
constexpr size_t WS_H = 956 * MiB;
constexpr size_t WS_ACT = 1028 * MiB;
constexpr size_t WS_P = WS_ACT;
constexpr size_t WS_QM = WS_ACT + 144 * MiB;
constexpr size_t WS_KVM = WS_ACT + 171 * MiB;
constexpr size_t WS_MIX = WS_ACT + 207 * MiB;
constexpr size_t WS_Y = 1332 * MiB;
constexpr size_t WS_END = 1636 * MiB;
constexpr int CW_LAM = 64;
constexpr int CW_ATTQ = 2048;
constexpr int CW_CUR = 1024;
constexpr int CW_BAR = 4096;

constexpr int RING_BYTES = 131072;
constexpr int MISC_OFF = RING_BYTES;
constexpr int GOFF_OFF = RING_BYTES + 4096;
constexpr int LDS_BYTES = RING_BYTES + 4096 + 8192;

__device__ __forceinline__ unsigned cvtpk(float lo, float hi) { f32x2 v = {lo, hi}; bf16x2_t b = __builtin_convertvector(v, bf16x2_t); return __builtin_bit_cast(unsigned, b); }
__device__ __forceinline__ float bf2f(unsigned short b) { return __uint_as_float(((unsigned)b) << 16); }
__device__ __forceinline__ float bflo(unsigned w) { return __uint_as_float(w << 16); }
__device__ __forceinline__ float bfhi(unsigned w) { return __uint_as_float(w & 0xffff0000u); }
__device__ __forceinline__ float wave_sum(float v) {
#pragma unroll
    for (int o = 1; o < 64; o <<= 1) v += __shfl_xor(v, o);
    return v;
}
__device__ __forceinline__ int opaque_tid() { int t = threadIdx.x; asm volatile("" : "+v"(t)); return t; }
__device__ __forceinline__ int il(int i, int hd) { return (i & 1) ? (i >> 1) + (hd >> 1) : (i >> 1); }

#define XB_TMO      128
#define XB_XCNT(j)  (256  + 64 * (j))
#define XB_XSUB(j)  (1280 + 64 * (j))
#define XB_XGEN(j)  (2304 + 64 * (j))
#define XB_TOP      3328
#define XB_TOPGEN   3392
#define XCD_BAR_WORDS 3456
#define XB_SPIN_CAP (1u << 20)
__device__ __forceinline__ unsigned xb_ld(unsigned* p)              { return __hip_atomic_load(p, __ATOMIC_RELAXED, __HIP_MEMORY_SCOPE_AGENT); }
__device__ __forceinline__ unsigned xb_add(unsigned* p, unsigned v) { return __hip_atomic_fetch_add(p, v, __ATOMIC_RELAXED, __HIP_MEMORY_SCOPE_AGENT); }
__device__ __forceinline__ unsigned xb_xcc_id() { return (unsigned)__builtin_amdgcn_s_getreg((3 << 11) | 20) & 0xFu; }
#define XB_SPIN(cond, bar) do { unsigned _sp = 0; while (cond) { __builtin_amdgcn_s_sleep(1); \
    if ((++_sp & 255u) == 0u) { if (xb_ld(&(bar)[XB_TMO])) break; if (_sp > XB_SPIN_CAP) { atomicAdd(&(bar)[XB_TMO], 1u); break; } } } } while (0)
struct XcdBarrier { unsigned* bar; unsigned x; volatile LAS unsigned* st; };
__device__ __forceinline__ XcdBarrier xcd_barrier_post(unsigned* bar, volatile LAS unsigned* st) {
    XcdBarrier b; b.bar = bar; b.x = xb_xcc_id(); b.st = st;
    if (threadIdx.x == 0) (void)xb_add(&bar[XB_XCNT(b.x)], 1u);
    return b;
}
__device__ __forceinline__ void xcd_barrier_complete(unsigned* bar, unsigned x, unsigned& nloc, unsigned& nx) {
    const unsigned G = gridDim.x * gridDim.y * gridDim.z;
    unsigned sum, cnt, mine, sp = 0u;
    for (;;) {
        sum = 0u; cnt = 0u; mine = 0u;
#pragma unroll
        for (unsigned j = 0; j < 16; ++j) { const unsigned c = xb_ld(&bar[XB_XCNT(j)]); sum += c; cnt += (c > 0u) ? 1u : 0u; mine = (j == x) ? c : mine; }
        if (sum == G) break;
        __builtin_amdgcn_s_sleep(1);
        if ((++sp & 255u) == 0u) { if (xb_ld(&bar[XB_TMO])) break; if (sp > XB_SPIN_CAP) { atomicAdd(&bar[XB_TMO], 1u); break; } }
    }
    nloc = mine > 0u ? mine : 1u; nx = cnt > 0u ? cnt : 1u;
}
__device__ __forceinline__ void xcd_barrier(const XcdBarrier& b) {
    asm volatile("s_waitcnt vmcnt(0)" ::: "memory");
    __syncthreads();
    if (threadIdx.x == 0) {
        unsigned* bar = b.bar;
        __builtin_amdgcn_s_waitcnt(0);
        unsigned nloc = b.st[0], nx = b.st[1];
        if (nloc == 0u) { xcd_barrier_complete(bar, b.x, nloc, nx); b.st[0] = nloc; b.st[1] = nx; }
        const unsigned old = xb_add(&bar[XB_XSUB(b.x)], 1u);
        const unsigned gen = old / nloc;
        if (old + 1u == (gen + 1u) * nloc) {
            __builtin_amdgcn_fence(__ATOMIC_RELEASE, "agent");
            asm volatile("s_waitcnt vmcnt(0)" ::: "memory");
            const unsigned og = xb_add(&bar[XB_TOP], 1u);
            const unsigned tg = og / nx;
            if (og + 1u == (tg + 1u) * nx) xb_add(&bar[XB_TOPGEN], 1u);
            else XB_SPIN(xb_ld(&bar[XB_TOPGEN]) == tg, bar);
            __builtin_amdgcn_fence(__ATOMIC_ACQUIRE, "agent");
            xb_add(&bar[XB_XGEN(b.x)], 1u);
            asm volatile("s_waitcnt vmcnt(0)" ::: "memory");
        } else {
            XB_SPIN(xb_ld(&bar[XB_XGEN(b.x)]) == gen, bar);
            __builtin_amdgcn_fence(__ATOMIC_ACQUIRE, "agent");
            asm volatile("s_waitcnt vmcnt(0)" ::: "memory");
        }
    }
    __syncthreads();
}

struct Args {
    const float* in[26];
    float* out; unsigned char* ws;
    double invf8[8]; double invf16[16];
    float lam_init[4];
    int ph_lo, ph_hi;
};
struct Frame {
    LAS unsigned char* lds;
    unsigned char* ws;
    int tid, lane, wave, vcu, G;
};

namespace pg8 {
constexpr int BM = 256, BK = 64, HALF = 128, HTB = HALF * BK * 2, STAGE_BYTES = 8 * HTB;
__host__ __device__ __forceinline__ int lds_byte(int r, int c) { const int st = (r >> 4) * 2 + (c >> 5), rr = r & 15, cc = c & 31, ob = rr * 64 + cc * 2; return st * 1024 + (ob ^ (((ob >> 9) & 1) << 5)); }
__host__ __device__ __forceinline__ void stage_rc(int b, int& R, int& C) { const int st = b / 1024, sb = b % 1024, swz = sb ^ (((sb >> 9) & 1) << 5); R = (st >> 1) * 16 + swz / 64; C = (st & 1) * 32 + (swz % 64) / 2; }
__host__ __device__ __forceinline__ int perm32(int rho) { const int n = rho >> 4, i = rho & 15; return 8 * (i >> 2) + 4 * n + (i & 3); }

typedef int v8i32 __attribute__((ext_vector_type(8)));
typedef int u32x4i __attribute__((ext_vector_type(4)));
__device__ __forceinline__ v8i32 pk8(bf16x8 lo, bf16x8 hi) { const u32x4 a = __builtin_bit_cast(u32x4, lo), b = __builtin_bit_cast(u32x4, hi); return (v8i32){(int)a.x, (int)a.y, (int)a.z, (int)a.w, (int)b.x, (int)b.y, (int)b.z, (int)b.w}; }
struct Unit { const char* a; const char* b; int pm, pn, e, j, cnt; };

template <class Epi, class Sched, bool ALIGN_EPI, bool FP8 = false>
__device__ __forceinline__ void gemm_phase(LAS unsigned char* lds, const int K, const int lda, const int ldb, const Sched& S, const Epi& E) {
    const int tid = opaque_tid(), wid = __builtin_amdgcn_readfirstlane(tid >> 6), lane = tid & 63, wr = wid >> 2, wc = wid & 3, fr = lane & 15, fq = lane >> 4;
    const int nt = K / BK;
    int Rs[2], Cs[2]; unsigned voffBp[2];
#pragma unroll
    for (int i = 0; i < 2; ++i) { int R, C; stage_rc(tid * 16 + i * 8192, R, C); Rs[i] = R; Cs[i] = C; const int Rb = Epi::PERM ? ((R & ~31) + perm32(R & 31)) : R; voffBp[i] = (unsigned)(Rb * ldb + C) * 2u; }
    const size_t kstep = (size_t)(BK * 2);
    const size_t hstepB = (size_t)HALF * ldb * 2;
    const unsigned ldsw = (unsigned)wid * 1024u;
#define PG8_SA(b, h) (((b) * 2 + (h)) * HTB)
#define PG8_SB(b, h) ((4 + (b) * 2 + (h)) * HTB)
#define PG8_STAGE2(bufoff, gbase, o0, o1) do { \
        __builtin_amdgcn_global_load_lds((const unsigned*)((const char*)(gbase) + (o0)), (LAS unsigned*)(lds + (bufoff) + ldsw), 16, 0, 0); \
        __builtin_amdgcn_global_load_lds((const unsigned*)((const char*)(gbase) + (o1)), (LAS unsigned*)(lds + (bufoff) + ldsw + 8192), 16, 0, 0); } while (0)
#define PG8_STAGEB(bufoff, gbase) PG8_STAGE2(bufoff, gbase, voffB[0], voffB[1])
#define PG8_STAGEBP(bufoff, gbase) PG8_STAGE2(bufoff, gbase, voffBp[0], voffBp[1])
#define PG8_LD32(p) __builtin_shufflevector(*(const LAS u32x4i*)(p), *(const LAS u32x4i*)((p) + 1024), 0, 1, 2, 3, 4, 5, 6, 7)
#define PG8_LDA(dst, b, h) do { if constexpr (FP8) { _Pragma("unroll") for (int m = 0; m < 4; ++m) dst##8[m] = PG8_LD32(lds + PG8_SA(b, h) + aoff + m * 2048); } \
        else { _Pragma("unroll") for (int m = 0; m < 4; ++m) _Pragma("unroll") for (int k = 0; k < 2; ++k) dst[m][k] = *(const LAS bf16x8*)(lds + PG8_SA(b, h) + aoff + m * 2048 + k * 1024); } } while (0)
#define PG8_LDB(dst, b, h) do { if constexpr (FP8) { _Pragma("unroll") for (int n = 0; n < 2; ++n) dst##8[n] = PG8_LD32(lds + PG8_SB(b, h) + boff + n * 2048); } \
        else { _Pragma("unroll") for (int n = 0; n < 2; ++n) _Pragma("unroll") for (int k = 0; k < 2; ++k) dst[n][k] = *(const LAS bf16x8*)(lds + PG8_SB(b, h) + boff + n * 2048 + k * 1024); } } while (0)
  \

#define PG8_MMA(ai, bj, At, Bt) do { __builtin_amdgcn_s_setprio(1); _Pragma("unroll") for (int m = 0; m < 4; ++m) _Pragma("unroll") for (int n = 0; n < 2; ++n) { \
        if constexpr (FP8) { asm volatile("v_mfma_scale_f32_16x16x128_f8f6f4 %0, %1, %2, %0, %3, %3 op_sel_hi:[0,0,0]" : "+v"(acc[ai][bj][m][n]) : "v"(Bt##8[n]), "v"(At##8[m]), "v"(f8scale)); } \
        else { _Pragma("unroll") for (int k = 0; k < 2; ++k) acc[ai][bj][m][n] = __builtin_amdgcn_mfma_f32_16x16x32_bf16(Bt[n][k], At[m][k], acc[ai][bj][m][n], 0, 0, 0); } } \
        __builtin_amdgcn_s_setprio(0); } while (0)
#define PG8_WAIT_V(n) asm volatile("s_waitcnt vmcnt(" #n ")" ::: "memory")
#define PG8_WAIT_L(n) asm volatile("s_waitcnt lgkmcnt(" #n ")" ::: "memory")
#define PG8_BAR __builtin_amdgcn_s_barrier()
#define PG8_SCHED __builtin_amdgcn_sched_barrier(0)
    Unit cur, nxt; int ui = 0;
    if (!S.next(0, cur)) return;
    f32x4 acc[2][2][4][2];
#pragma unroll
    for (int a = 0; a < 2; ++a)
#pragma unroll
        for (int b = 0; b < 2; ++b)
#pragma unroll
            for (int m = 0; m < 4; ++m)
#pragma unroll
                for (int n = 0; n < 2; ++n) acc[a][b][m][n] = (f32x4){0.f, 0.f, 0.f, 0.f};
    bf16x8 At[4][2], B0[2][2], B1[2][2]; v8i32 At8[4], B08[2], B18[2];
    unsigned vc00, vc01, vc10, vc11, vn00, vn01, vn10, vn11;
    vc00 = (unsigned)(S.arow(cur, Rs[0]) * lda + Cs[0]) * 2u; vc01 = (unsigned)(S.arow(cur, Rs[1]) * lda + Cs[1]) * 2u;
    vc10 = (unsigned)(S.arow(cur, HALF + Rs[0]) * lda + Cs[0]) * 2u; vc11 = (unsigned)(S.arow(cur, HALF + Rs[1]) * lda + Cs[1]) * 2u;
    const char* cA = cur.a; const char* cB = cur.b;
    PG8_STAGEBP(PG8_SB(0, 0), cB); PG8_STAGEBP(PG8_SB(0, 1), cB + hstepB); PG8_STAGE2(PG8_SA(0, 0), cA, vc00, vc01); PG8_STAGE2(PG8_SA(0, 1), cA, vc10, vc11);
    if (wr == 1) PG8_BAR;
    PG8_WAIT_V(2); PG8_BAR;
    PG8_STAGEBP(PG8_SB(1, 0), cB + kstep); PG8_STAGE2(PG8_SA(1, 0), cA + kstep, vc00, vc01); PG8_STAGEBP(PG8_SB(1, 1), cB + hstepB + kstep);
    PG8_WAIT_V(6); PG8_BAR;
    bool has_next = S.next(1, nxt);
    if (Sched::GATHER && has_next) {
        int R0, C0, R1, C1; { const int t2_ = opaque_tid(); stage_rc(t2_ * 16, R0, C0); stage_rc(t2_ * 16 + 8192, R1, C1); }
        LAS unsigned* gp = (LAS unsigned*)(lds + GOFF_OFF) + (opaque_tid() << 2);
        gp[0] = (unsigned)(S.arow(nxt, R0) * lda + C0) * 2u; gp[1] = (unsigned)(S.arow(nxt, R1) * lda + C1) * 2u;
        gp[2] = (unsigned)(S.arow(nxt, HALF + R0) * lda + C0) * 2u; gp[3] = (unsigned)(S.arow(nxt, HALF + R1) * lda + C1) * 2u;
    }
    for (;;) {
        const char* nA = has_next ? nxt.a : cA; const char* nB = has_next ? nxt.b : cB;
        vn00 = vc00; vn01 = vc01; vn10 = vc10; vn11 = vc11;
#ifndef KREP
#define KREP 1
#endif
        constexpr int krep = (FP8 && Epi::PROBE) ? KREP : 1;
#pragma unroll 1
        for (int tq = 0; tq < krep * nt; tq += 2) {
            const int t = tq % nt;
            const bool last = (tq == krep * nt - 2);
            const int f8scale = (tq < nt) ? 0x7F7F7F7F : 0;
            unsigned voffB[2]; int aoff, boff;
            { const int t3_ = opaque_tid(), l3_ = t3_ & 63, fr3_ = l3_ & 15, fq3_ = l3_ >> 4;
#pragma unroll
              for (int i = 0; i < 2; ++i) { int R, C; stage_rc(t3_ * 16 + i * 8192, R, C); const int Rb = Epi::PERM ? ((R & ~31) + perm32(R & 31)) : R; voffB[i] = (unsigned)(Rb * ldb + C) * 2u; }
              aoff = lds_byte(wr * 64 + fr3_, fq3_ * 8); boff = lds_byte(wc * 32 + fr3_, fq3_ * 8); }
            if (Sched::GATHER && last) { const LAS unsigned* gp = (const LAS unsigned*)(lds + GOFF_OFF) + (opaque_tid() << 2); vn00 = gp[0]; vn01 = gp[1]; vn10 = gp[2]; vn11 = gp[3]; }
            const char* a1 = cA + (size_t)(t + 1) * kstep;
            const char* a2 = last ? nA : cA + (size_t)((t + 2) % nt) * kstep; const char* b2 = last ? nB : cB + (size_t)((t + 2) % nt) * kstep;
            const char* a3 = a2 + kstep; const char* b3 = b2 + kstep;
            const unsigned w00 = (Sched::GATHER && last) ? vn00 : vc00, w01 = (Sched::GATHER && last) ? vn01 : vc01, w10 = (Sched::GATHER && last) ? vn10 : vc10, w11 = (Sched::GATHER && last) ? vn11 : vc11;
            const bool relax = (Epi::NST > 0) && (tq == 0) && (ui > 0);
            PG8_LDB(B0, 0, 0); PG8_LDB(B1, 0, 1); PG8_SCHED; PG8_LDA(At, 0, 0); PG8_STAGE2(PG8_SA(1, 1), a1, vc10, vc11);
            if (relax) asm volatile("s_waitcnt vmcnt(%0)" :: "n"(8 + Epi::NST) : "memory"); else PG8_WAIT_V(8);
            PG8_WAIT_L(0); PG8_BAR; PG8_MMA(0, 0, At, B0); PG8_MMA(0, 1, At, B1); PG8_BAR; PG8_SCHED;
            PG8_LDA(At, 0, 1); PG8_STAGEB(PG8_SB(0, 0), b2); PG8_STAGEB(PG8_SB(0, 1), b2 + hstepB); PG8_STAGE2(PG8_SA(0, 0), a2, w00, w01);
            if (relax) asm volatile("s_waitcnt vmcnt(%0)" :: "n"(8 + Epi::NST) : "memory"); else PG8_WAIT_V(8);
            PG8_WAIT_L(0); PG8_BAR; PG8_MMA(1, 0, At, B0); PG8_MMA(1, 1, At, B1); PG8_BAR; PG8_SCHED;
            PG8_LDB(B0, 1, 0); PG8_LDB(B1, 1, 1); PG8_SCHED; PG8_LDA(At, 1, 0); PG8_STAGE2(PG8_SA(0, 1), a2, w10, w11);
            PG8_WAIT_V(8); PG8_WAIT_L(0); PG8_BAR; PG8_MMA(0, 0, At, B0); PG8_MMA(0, 1, At, B1); PG8_BAR; PG8_SCHED;
            PG8_LDA(At, 1, 1); PG8_STAGEB(PG8_SB(1, 0), b3); PG8_STAGEB(PG8_SB(1, 1), b3 + hstepB); PG8_STAGE2(PG8_SA(1, 0), a3, w00, w01);
            PG8_WAIT_V(8); PG8_WAIT_L(0); PG8_BAR; PG8_MMA(1, 0, At, B0); PG8_MMA(1, 1, At, B1); PG8_BAR; PG8_SCHED;
        }
        Unit nn; bool has_nn = has_next && S.next(ui + 2, nn);
        int gt0 = 0, gt1 = 0, gt2 = 0, gt3 = 0;
        if constexpr (Sched::GATHER) if (has_nn) {
            int R0, C0, R1, C1; { const int t2_ = opaque_tid(); stage_rc(t2_ * 16, R0, C0); stage_rc(t2_ * 16 + 8192, R1, C1); }
            gt0 = S.arow_raw(nn, R0); gt1 = S.arow_raw(nn, R1); gt2 = S.arow_raw(nn, HALF + R0); gt3 = S.arow_raw(nn, HALF + R1);
        }
        if constexpr (ALIGN_EPI) { if (wr == 0) PG8_BAR; }
#ifndef REP_EPI
#define REP_EPI 1
#endif
        if constexpr (FP8) asm volatile("s_nop 15\n\ts_nop 15" ::: "memory");
        { const int l2_ = opaque_tid() & 63; for (int rep_ = 0; rep_ < (Epi::PROBE ? REP_EPI : 1); ++rep_) E(acc, cur, wr, wc, l2_ & 15, l2_ >> 4); }
        if (!has_next) break;
#pragma unroll
        for (int a = 0; a < 2; ++a)
#pragma unroll
            for (int b = 0; b < 2; ++b)
#pragma unroll
                for (int m = 0; m < 4; ++m)
#pragma unroll
                    for (int n = 0; n < 2; ++n) { double z0_, z1_; asm volatile("v_mov_b64 %0, 0\n\tv_mov_b64 %1, 0" : "=v"(z0_), "=v"(z1_));
                        typedef double f64x2_t __attribute__((ext_vector_type(2))); const f64x2_t zz_ = {z0_, z1_}; acc[a][b][m][n] = __builtin_bit_cast(f32x4, zz_); }
        cur = nxt; cA = nA; cB = nB; ++ui; vc00 = vn00; vc01 = vn01; vc10 = vn10; vc11 = vn11;
        nxt = nn; has_next = has_nn;
        if constexpr (Sched::GATHER) asm volatile("" : "+v"(gt0), "+v"(gt1), "+v"(gt2), "+v"(gt3));
        if constexpr (Sched::GATHER) if (has_next) {
            int R0, C0, R1, C1; { const int t2_ = opaque_tid(); stage_rc(t2_ * 16, R0, C0); stage_rc(t2_ * 16 + 8192, R1, C1); }
            LAS unsigned* gp = (LAS unsigned*)(lds + GOFF_OFF) + (opaque_tid() << 2);
            gp[0] = (unsigned)(S.arow_fix(nxt, R0, gt0) * lda + C0) * 2u; gp[1] = (unsigned)(S.arow_fix(nxt, R1, gt1) * lda + C1) * 2u;
            gp[2] = (unsigned)(S.arow_fix(nxt, HALF + R0, gt2) * lda + C0) * 2u; gp[3] = (unsigned)(S.arow_fix(nxt, HALF + R1, gt3) * lda + C1) * 2u;
        }
        if constexpr (ALIGN_EPI) { if (wr == 1) PG8_BAR; }
    }
    PG8_WAIT_V(0);
    if constexpr (!ALIGN_EPI) { if (wr == 0) PG8_BAR; }
    PG8_BAR;
#undef PG8_SA
#undef PG8_SB
#undef PG8_STAGE2
#undef PG8_STAGEB
#undef PG8_LDA
#undef PG8_LD32
#undef PG8_LDB
#undef PG8_MMA
#undef PG8_WAIT_V
#undef PG8_WAIT_L
#undef PG8_BAR
#undef PG8_SCHED
}

__device__ __forceinline__ int xcd_remap(int L, int nwg) {
    const int q = nwg / 8, r = nwg % 8, xcd = L % 8, off = L / 8;
    return (xcd < r ? xcd * (q + 1) : r * (q + 1) + (xcd - r) * q) + off;
}

struct DenseSched {
    static constexpr bool GATHER = false;
    const char* A; const char* Bt; int lda, ldb, npan, nN, G, c, latent_only;
    __device__ __forceinline__ bool next(int i, Unit& u) const {
        const int L = i * G + c, nwg = npan * nN; if (L >= nwg) return false;
        const int w = xcd_remap(L, nwg), p = w / nN, pn = w % nN;
        const int pm = latent_only ? (p >> 3) * 9 + 1 + (p & 7) : p;
        u.pm = pm; u.pn = pn; u.e = 0; u.j = 0; u.cnt = 0;
        u.a = A + (size_t)pm * 256 * lda * 2; u.b = Bt + (size_t)pn * 256 * ldb * 2; return true;
    }
    __device__ __forceinline__ int arow(const Unit&, int r) const { return r; }
};
struct UpSched {
    static constexpr bool GATHER = false;
    const char* P; const char* Wuq; const char* Wukv; int G, c;
    __device__ __forceinline__ bool next(int i, Unit& u) const {
        const int L = i * G + c, nwg = NPAN * 4; if (L >= nwg) return false;
        const int w = xcd_remap(L, nwg), p = w >> 2, pn = w & 3;
        u.pm = p; u.pn = pn; u.e = 0; u.j = 0; u.cnt = 0;
        u.a = P + (size_t)p * 256 * PW * 2 + (pn >= 2 ? 512 : 0);
        u.b = (pn >= 2 ? Wukv : Wuq) + (size_t)(pn & 1) * 256 * 256 * 2; return true;
    }
    __device__ __forceinline__ int arow(const Unit&, int r) const { return r; }
};
struct ChainMap {
    int x, r;
    __device__ __forceinline__ int nchain() const { return r < 4 ? 2 : 1; }
    __device__ __forceinline__ int chain(int j) const { return r + 32 * j; }
    __device__ __forceinline__ int nplain() const { return r < 4 ? 1 : (r < 24 ? 4 : 3); }
    __device__ __forceinline__ int plain(int j) const { return r < 4 ? 56 + r : (j == 0 ? r - 4 : (j == 1 ? 24 + r : (j == 2 ? 56 + r : 84 + r))); }
};
struct WinChainSched {
    static constexpr bool GATHER = false;
    const char* A; const char* Bt; int lda, ldb; ChainMap M;
    __device__ __forceinline__ bool next(int i, Unit& u) const {
        const int nc = M.nchain(); if (i >= nc + M.nplain()) return false;
        int q, pn;
        if (i < nc) { const int ch = M.chain(i); q = ch >> 1; pn = ch & 1; } else { const int idx = M.plain(i - nc); q = idx / 6; pn = 2 + idx - q * 6; }
        const int pm = M.x + 8 * q;
        u.pm = pm; u.pn = pn; u.e = 0; u.j = 0; u.cnt = 0;
        u.a = A + (size_t)pm * 256 * lda * 2; u.b = Bt + (size_t)pn * 256 * ldb * 2; return true;
    }
    __device__ __forceinline__ int arow(const Unit&, int r) const { return r; }
};
struct UpChainSched {
    static constexpr bool GATHER = false;
    const char* P; const char* Wuq; const char* Wukv; ChainMap M;
    __device__ __forceinline__ bool next(int i, Unit& u) const {
        if (i >= 2 * M.nchain()) return false;
        const int ch = M.chain(i >> 1), q = ch >> 1, hf = ch & 1, pn = 2 * hf + (i & 1), pm = M.x + 8 * q;
        u.pm = pm; u.pn = pn; u.e = 0; u.j = 0; u.cnt = 0;
        u.a = P + (size_t)pm * 256 * PW * 2 + (hf ? 512 : 0);
        u.b = (hf ? Wukv : Wuq) + (size_t)(pn & 1) * 256 * 256 * 2; return true;
    }
    __device__ __forceinline__ int arow(const Unit&, int r) const { return r; }
};
template <bool GATHER_> struct MoeSched {
    static constexpr bool GATHER = GATHER_;
    const char* A; const char* Bt; const int* slot_tok; volatile LAS int* PB; volatile LAS int* CNT; int nN, G, c; size_t bexp; int ln;
    __device__ __forceinline__ bool next(int i, Unit& u) const {
        const int np = PB[32], nwg = np * nN; const int L = i * G + c; if (L >= nwg) return false;
        const int w = xcd_remap(L, nwg), p = w / nN, pn = w % nN;
        const unsigned long long bal = __ballot(PB[ln + 1] <= p);
        const int e = __builtin_popcount((unsigned)(bal & 0xffffffffull));
        u.pm = p; u.pn = pn; u.e = e; u.j = p - PB[e]; u.cnt = CNT[e];
        u.a = GATHER ? A : A + (size_t)p * 256 * D;
        u.b = Bt + (size_t)e * bexp + (size_t)pn * 256 * D; return true;
    }
    __device__ __forceinline__ int arow_raw(const Unit& u, int r) const { if constexpr (GATHER) return slot_tok[(size_t)u.e * T + min(u.j * 256 + r, u.cnt - 1)]; else return r; }
    __device__ __forceinline__ int arow_fix(const Unit& u, int r, int v) const { if constexpr (GATHER) return (u.j * 256 + r) < u.cnt ? v : 0; else return r; }
    __device__ __forceinline__ int arow(const Unit& u, int r) const {
        if constexpr (GATHER) { const int pos = u.j * 256 + r; const int v = slot_tok[(size_t)u.e * T + min(pos, u.cnt - 1)]; return pos < u.cnt ? v : 0; }
        else return r;
    }
};

__device__ __forceinline__ void rope4(f32x4& v0, f32x4& v1, const f32x4* tab) {
    const f32x4 t0 = tab[0], t1 = tab[1];
    f32x4 a, b;
    a[0] = v0[0] * t0[0] - v0[1] * t0[1]; a[1] = v0[1] * t0[0] + v0[0] * t0[1];
    a[2] = v0[2] * t0[2] - v0[3] * t0[3]; a[3] = v0[3] * t0[2] + v0[2] * t0[3];
    b[0] = v1[0] * t1[0] - v1[1] * t1[1]; b[1] = v1[1] * t1[0] + v1[0] * t1[1];
    b[2] = v1[2] * t1[2] - v1[3] * t1[3]; b[3] = v1[3] * t1[2] + v1[2] * t1[3];
    v0 = a; v1 = b;
}
__device__ __forceinline__ u32x4 pack8(const f32x4& v0, const f32x4& v1) { u32x4 w; w.x = cvtpk(v0[0], v0[1]); w.y = cvtpk(v0[2], v0[3]); w.z = cvtpk(v1[0], v1[1]); w.w = cvtpk(v1[2], v1[3]); return w; }

struct EpiWin {
    static constexpr bool PERM = true, PROBE = false; static constexpr int NST = 16;
    bf16_t* P; float* ssq; const float* ropeR; const float* ropeW;
    __device__ __forceinline__ void operator()(const f32x4 (&acc)[2][2][4][2], const Unit& u, int wr, int wc, int fr, int fq) const {
        const int pn = u.pn;
        int mode[2];
        mode[0] = (pn == 2 || pn == 3) ? 1 : ((pn == 5 || pn == 6 || pn == 7) ? 2 : 0);
        mode[1] = (pn == 2 || pn == 3) ? 1 : ((pn == 5 || pn == 6) ? 2 : ((pn == 1 && wc == 0) ? 1 : 0));
        const int iR = 4 * fq, iW = 16 * (wc & 1) + 4 * fq;
        f32x4 tb[2][2][2];
        auto rowof = [&](int g) { return u.pm * 256 + (g >> 2) * 128 + wr * 64 + (g & 3) * 16 + fr; };
        auto ldtab = [&](int g) {
            const int nb = rowof(g) % NTK; const int t = nb >= CTX ? nb - CTX : 0;
#pragma unroll
            for (int bj = 0; bj < 2; ++bj) {
                if (mode[bj] == 1) { const f32x4* p = (const f32x4*)(ropeR + ((size_t)t * 16 + iR) * 2); tb[g & 1][bj][0] = p[0]; tb[g & 1][bj][1] = p[1]; }
                else if (mode[bj] == 2) { const f32x4* p = (const f32x4*)(ropeW + ((size_t)t * 32 + iW) * 2); tb[g & 1][bj][0] = p[0]; tb[g & 1][bj][1] = p[1]; }
            }
        };
        ldtab(0);
#pragma unroll
        for (int g = 0; g < 8; ++g) {
            const int ai = g >> 2, m = g & 3;
            const int row = rowof(g);
            const bool latent = (row % NTK) >= CTX;
            if (g + 1 < 8) ldtab(g + 1);
            float ss = 0.f;
#pragma unroll
            for (int bj = 0; bj < 2; ++bj) {
                f32x4 v0 = acc[ai][bj][m][0] * F8_INV, v1 = acc[ai][bj][m][1] * F8_INV;
                if (pn == 0 || (pn == 1 && bj == 0)) ss += (v0[0] * v0[0] + v0[1] * v0[1]) + (v0[2] * v0[2] + v0[3] * v0[3]) + (v1[0] * v1[0] + v1[1] * v1[1]) + (v1[2] * v1[2] + v1[3] * v1[3]);
                if (mode[bj] != 0) {
                    f32x4 t0 = tb[g & 1][bj][0], t1 = tb[g & 1][bj][1];
                    if (!latent) { t0 = (f32x4){1.f, 0.f, 1.f, 0.f}; t1 = t0; }
                    const f32x4 tt[2] = {t0, t1};
                    rope4(v0, v1, tt);
                }
                *(u32x4*)(P + (size_t)row * PW + pn * 256 + bj * 128 + wc * 32 + fq * 8) = pack8(v0, v1);
            }
            if (pn < 2) { ss += __shfl_xor(ss, 16); ss += __shfl_xor(ss, 32); if (fq == 0) ssq[(size_t)row * 8 + pn * 4 + wc] = ss; }
        }
    }
};
struct EpiUp {
    static constexpr bool PERM = true, PROBE = false; static constexpr int NST = 0;
    bf16_t* QM; bf16_t* KVM; const float* ssq; const float* ropeR;
    __device__ __forceinline__ void operator()(const f32x4 (&acc)[2][2][4][2], const Unit& u, int wr, int wc, int fr, int fq) const {
        const bool isq = u.pn < 2;
        int col0[2], rp[2];
#pragma unroll
        for (int bj = 0; bj < 2; ++bj) { col0[bj] = (u.pn & 1) * 256 + bj * 128 + wc * 32 + fq * 8; const int hl = col0[bj] % 96; rp[bj] = (isq && col0[bj] < 384 && hl >= 64) ? ((hl - 64) >> 1) : -1; }
        f32x4 sq[2]; f32x4 tb[2][2][2];
        auto rowof = [&](int g) { return u.pm * 256 + (g >> 2) * 128 + wr * 64 + (g & 3) * 16 + fr; };
        auto ld = [&](int g) {
            const int row = rowof(g); const int nb = row % NTK; const int t = nb >= CTX ? nb - CTX : 0;
            sq[g & 1] = *(const f32x4*)(ssq + (size_t)row * 8 + (isq ? 0 : 4));
#pragma unroll
            for (int bj = 0; bj < 2; ++bj) if (rp[bj] >= 0) { const f32x4* p = (const f32x4*)(ropeR + ((size_t)t * 16 + rp[bj]) * 2); tb[g & 1][bj][0] = p[0]; tb[g & 1][bj][1] = p[1]; }
        };
        ld(0);
#pragma unroll
        for (int g = 0; g < 8; ++g) {
            const int ai = g >> 2, m = g & 3;
            const int row = rowof(g);
            const bool latent = (row % NTK) >= CTX;
            if (g + 1 < 8) ld(g + 1);
            const f32x4 s4 = sq[g & 1];
            const float ssum = (s4[0] + s4[1]) + (s4[2] + s4[3]);
            const float rstd = __builtin_amdgcn_rsqf(ssum * (isq ? (1.f / 256.f) : (1.f / 128.f)) + EPS);
#pragma unroll
            for (int bj = 0; bj < 2; ++bj) {
                f32x4 v0 = acc[ai][bj][m][0] * rstd, v1 = acc[ai][bj][m][1] * rstd;
                if (isq) {
                    if (col0[bj] < 384) {
                        if (rp[bj] >= 0) {
                            f32x4 t0 = tb[g & 1][bj][0], t1 = tb[g & 1][bj][1];
                            if (!latent) { t0 = (f32x4){1.f, 0.f, 1.f, 0.f}; t1 = t0; }
                            const f32x4 tt[2] = {t0, t1};
                            rope4(v0, v1, tt);
                        }
                        *(u32x4*)(QM + (size_t)row * 384 + col0[bj]) = pack8(v0, v1);
                    }
                } else *(u32x4*)(KVM + (size_t)row * 512 + col0[bj]) = pack8(v0, v1);
            }
        }
    }
};
struct EpiWout {
    static constexpr bool PERM = true, PROBE = false; static constexpr int NST = 16;
    bf16_t* X; const float* modl;
    __device__ __forceinline__ void operator()(const f32x4 (&acc)[2][2][4][2], const Unit& u, int wr, int wc, int fr, int fq) const {
        const int b = u.pm / 9, modrow = (u.pm - b * 9 == 0) ? 16 : b;
        const float* gate = modl + (size_t)modrow * 6144 + 2 * D;
        const int col0 = u.pn * 256 + wc * 32 + 8 * fq;
        f32x4 gv[2][2];
#pragma unroll
        for (int bj = 0; bj < 2; ++bj)
#pragma unroll
            for (int n = 0; n < 2; ++n) gv[bj][n] = *(const f32x4*)(gate + col0 + bj * 128 + n * 4);
        u32x4 xq[2][2];
        auto rowp = [&](int g) { return X + (size_t)(u.pm * 256 + (g >> 2) * 128 + wr * 64 + (g & 3) * 16 + fr) * D + col0; };
        xq[0][0] = *(const u32x4*)(rowp(0)); xq[0][1] = *(const u32x4*)(rowp(0) + 128);
#pragma unroll
        for (int g = 0; g < 8; ++g) {
            const int ai = g >> 2, m = g & 3;
            if (g + 1 < 8) { xq[(g + 1) & 1][0] = *(const u32x4*)(rowp(g + 1)); xq[(g + 1) & 1][1] = *(const u32x4*)(rowp(g + 1) + 128); }
#pragma unroll
            for (int bj = 0; bj < 2; ++bj) {
                const u32x4 xw = xq[g & 1][bj];
                f32x4 x0 = {bflo(xw.x), bfhi(xw.x), bflo(xw.y), bfhi(xw.y)}, x1 = {bflo(xw.z), bfhi(xw.z), bflo(xw.w), bfhi(xw.w)};
                x0 += gv[bj][0] * (acc[ai][bj][m][0] * F8_INVM); x1 += gv[bj][1] * (acc[ai][bj][m][1] * F8_INVM);
                *(u32x4*)(rowp(g) + bj * 128) = pack8(x0, x1);
            }
        }
    }
};
__device__ __forceinline__ f32x4 swiglu4(f32x4 g, f32x4 up, float s) {
    g = __builtin_elementwise_min(g, (f32x4){7.0f, 7.0f, 7.0f, 7.0f});
    up = __builtin_elementwise_min(__builtin_elementwise_max(up, (f32x4){-7.0f, -7.0f, -7.0f, -7.0f}), (f32x4){7.0f, 7.0f, 7.0f, 7.0f});
    const f32x4 t = g * (-1.702f * LOG2E);
    f32x4 e; e[0] = __builtin_amdgcn_exp2f(t[0]); e[1] = __builtin_amdgcn_exp2f(t[1]); e[2] = __builtin_amdgcn_exp2f(t[2]); e[3] = __builtin_amdgcn_exp2f(t[3]);
    const f32x4 d = e + 1.0f;
    f32x4 r; r[0] = __builtin_amdgcn_rcpf(d[0]); r[1] = __builtin_amdgcn_rcpf(d[1]); r[2] = __builtin_amdgcn_rcpf(d[2]); r[3] = __builtin_amdgcn_rcpf(d[3]);
    return (g * r) * (up * s + s);
}
struct EpiGateUp {
    static constexpr bool PERM = true, PROBE = true; static constexpr int NST = 4;
    unsigned char* ACT; const float* bg; const float* bu;
    __device__ __forceinline__ void operator()(const f32x4 (&acc)[2][2][4][2], const Unit& u, int wr, int wc, int fr, int fq) const {
        const int colL = u.pn * 128 + wc * 32 + fq * 8;
        const f32x4 g0 = *(const f32x4*)(bg + (size_t)u.e * D + colL), g1 = *(const f32x4*)(bg + (size_t)u.e * D + colL + 4);
        const f32x4 u0 = *(const f32x4*)(bu + (size_t)u.e * D + colL), u1 = *(const f32x4*)(bu + (size_t)u.e * D + colL + 4);
#pragma unroll
        for (int ai = 0; ai < 2; ++ai)
#pragma unroll
            for (int mp = 0; mp < 2; ++mp) {
                u32x2 w8[2];
#pragma unroll
                for (int h = 0; h < 2; ++h) {
                    const int m = 2 * mp + h;
                    const f32x4 ga = acc[ai][0][m][0] * F8_INV + g0, gb = acc[ai][0][m][1] * F8_INV + g1, ua = acc[ai][1][m][0] * F8_INV + u0, ub = acc[ai][1][m][1] * F8_INV + u1;
                    const f32x4 ra = swiglu4(ga, ua, F8_SA), rb = swiglu4(gb, ub, F8_SA);
                    w8[h].x = (unsigned)__builtin_amdgcn_cvt_pk_fp8_f32(ra[2], ra[3], __builtin_amdgcn_cvt_pk_fp8_f32(ra[0], ra[1], 0, false), true);
                    w8[h].y = (unsigned)__builtin_amdgcn_cvt_pk_fp8_f32(rb[2], rb[3], __builtin_amdgcn_cvt_pk_fp8_f32(rb[0], rb[1], 0, false), true);
                }
                const auto sx = __builtin_amdgcn_permlane16_swap(w8[0].x, w8[1].x, false, false), sy = __builtin_amdgcn_permlane16_swap(w8[0].y, w8[1].y, false, false);
                const int srow = u.pm * 256 + ai * 128 + wr * 64 + (2 * mp + (fq & 1)) * 16 + fr;
                u32x4 w16; w16.x = sx[0]; w16.y = sy[0]; w16.z = sx[1]; w16.w = sy[1];
                *(u32x4*)(ACT + (size_t)srow * D + (u.pn * 128 + wc * 32 + (fq & 2) * 8)) = w16;
            }
    }
};
struct EpiDown {
    static constexpr bool PERM = true, PROBE = true; static constexpr int NST = 8;
    bf16_t* Y; const float* bd; const float* slot_w;
    __device__ __forceinline__ void operator()(const f32x4 (&acc)[2][2][4][2], const Unit& u, int wr, int wc, int fr, int fq) const {
        const int col0 = u.pn * 256 + wc * 32 + fq * 8;
        f32x4 bv[2][2];
#pragma unroll
        for (int bj = 0; bj < 2; ++bj)
#pragma unroll
            for (int n = 0; n < 2; ++n) bv[bj][n] = *(const f32x4*)(bd + (size_t)u.e * D + col0 + bj * 128 + n * 4);
        float wv[8];
#pragma unroll
        for (int g = 0; g < 8; ++g) { const int pos = u.j * 256 + (g >> 2) * 128 + wr * 64 + (g & 3) * 16 + fr; wv[g] = slot_w[(size_t)u.e * T + min(pos, u.cnt - 1)]; }
#pragma unroll
        for (int g = 0; g < 8; ++g) { const int pos = u.j * 256 + (g >> 2) * 128 + wr * 64 + (g & 3) * 16 + fr; wv[g] = pos < u.cnt ? wv[g] : 0.f; }
#pragma unroll
        for (int ai = 0; ai < 2; ++ai)
#pragma unroll
            for (int mp = 0; mp < 2; ++mp) {
                const int rl = ai * 128 + wr * 64 + (2 * mp + (fq & 1)) * 16 + fr;
#pragma unroll
                for (int bj = 0; bj < 2; ++bj) {
                    u32x2 w8[2];
#pragma unroll
                    for (int h = 0; h < 2; ++h) {
                        const int m = 2 * mp + h; const float w = wv[ai * 4 + m];
                        const f32x4 v0 = (acc[ai][bj][m][0] * F8_INV + bv[bj][0]) * (w * F8_SY), v1 = (acc[ai][bj][m][1] * F8_INV + bv[bj][1]) * (w * F8_SY);
                        w8[h].x = (unsigned)__builtin_amdgcn_cvt_pk_fp8_f32(v0[2], v0[3], __builtin_amdgcn_cvt_pk_fp8_f32(v0[0], v0[1], 0, false), true);
                        w8[h].y = (unsigned)__builtin_amdgcn_cvt_pk_fp8_f32(v1[2], v1[3], __builtin_amdgcn_cvt_pk_fp8_f32(v1[0], v1[1], 0, false), true);
                    }
                    const auto sx = __builtin_amdgcn_permlane16_swap(w8[0].x, w8[1].x, false, false), sy = __builtin_amdgcn_permlane16_swap(w8[0].y, w8[1].y, false, false);
                    u32x4 w16; w16.x = sx[0]; w16.y = sy[0]; w16.z = sx[1]; w16.w = sy[1];
                    *(u32x4*)((unsigned char*)Y + (size_t)(u.pm * 256 + rl) * D + (u.pn * 256 + wc * 32 + (fq & 2) * 8) + bj * 128) = w16;
                }
            }
    }
};
}

__device__ __forceinline__ int winmap(int p, float& sc) {
    sc = 1.f;
    if (p < 384) return p;
    if (p < 416) return 384 + il(p - 384, 32);
    if (p < 512) return -1;
    if (p < 768)  { const int q = p - 512;  sc = SC_DIFF; return 416 + (q & ~31) + il(q & 31, 32); }
    if (p < 1024) { const int q = p - 768;  return 672 + (q & ~31) + il(q & 31, 32); }
    if (p < 1280) return 928 + (p - 1024);
    if (p < 1792) { const int q = p - 1280; sc = SC_SWA; return 1184 + (q & ~63) + il(q & 63, 64); }
    if (p < 1920) { const int q = p - 1792; return 1696 + (q & ~63) + il(q & 63, 64); }
    return 1824 + (p - 1920);
}
__device__ __forceinline__ int uqmap(int n) {
    if (n >= 384) return -1;
    const int h = n / 96, i = n - h * 96;
    return h * 96 + (i < 64 ? i : 64 + il(i - 64, 32));
}
struct CvtItem { const float* src; int ld, kvalid, k0, n0, nrows, mapkind, ldd; bf16_t* dst; const float* rowscale; };
constexpr int CVT_PER_LAYER = 256 + 16 + 16 + 8;
constexpr int CVT_ITEMS = NL * CVT_PER_LAYER;
__device__ __forceinline__ void cvt_decode(const Args& a, unsigned char* ws, int it, CvtItem& c) {
    const int l = it / CVT_PER_LAYER; int r = it - l * CVT_PER_LAYER;
    c.rowscale = nullptr; c.mapkind = 0; c.nrows = 64;
    if (r < 256) { c.src = a.in[7] + (size_t)l * D * 1952; c.ld = 1952; c.kvalid = D; c.k0 = (r >> 5) * 128; c.n0 = (r & 31) * 64; c.mapkind = 1; c.ldd = D;
        c.dst = (bf16_t*)(ws + WS_WIN + ((size_t)l * PW * D + (size_t)c.n0 * D)); return; }
    r -= 256;
    if (r < 16) { c.src = a.in[9] + (size_t)l * 256 * 384; c.ld = 384; c.kvalid = 256; c.k0 = (r >> 3) * 128; c.n0 = (r & 7) * 64; c.mapkind = 2; c.ldd = 256; c.rowscale = a.in[8] + l * 256;
        c.dst = (bf16_t*)(ws + WS_WUQ) + (size_t)l * 512 * 256 + (size_t)c.n0 * 256; return; }
    r -= 16;
    if (r < 16) { c.src = a.in[11] + (size_t)l * 128 * 512; c.ld = 512; c.kvalid = 128; c.k0 = (r >> 3) * 128; c.n0 = (r & 7) * 64; c.ldd = 256; c.rowscale = a.in[10] + l * 128;
        c.dst = (bf16_t*)(ws + WS_WUKV) + (size_t)l * 512 * 256 + (size_t)c.n0 * 256; return; }
    r -= 16;
    c.src = a.in[17] + (size_t)l * D * 32; c.ld = 32; c.kvalid = D; c.k0 = r * 128; c.n0 = 0; c.nrows = 32; c.mapkind = 3; c.ldd = D;
    c.dst = (bf16_t*)(ws + WS_WR) + (size_t)l * 32 * D;
}
constexpr int FAST_MATS = NL * (1 + 3 * NE);
constexpr int FAST_ITEMS = FAST_MATS * 256;
constexpr int FAST_PER_LAYER = (1 + 3 * NE) * 256;
constexpr int CONV_CHUNK = 64, CONV_NCHUNK = FAST_PER_LAYER / CONV_CHUNK;
__device__ __forceinline__ void fast_decode(const Args& a, unsigned char* ws, int it, const float*& src, unsigned char*& dst8, bool& f8) {
    const int mat = it >> 8, tile = it & 255, k0 = (tile >> 4) * 64, n0 = (tile & 15) * 64;
    const int l = mat / (1 + 3 * NE); int r = mat - l * (1 + 3 * NE);
    const float* sb;
    if (r == 0) { sb = a.in[15] + (size_t)l * D * D; dst8 = ws + WS_WOUT + ((size_t)l * D * D + (size_t)n0 * D + k0); f8 = true; }
    else { r -= 1; const int e = r / 3, which = r - e * 3; const size_t le = (size_t)l * NE + e; f8 = true;
        if (which == 0)      { sb = a.in[19] + le * D * D; dst8 = ws + WS_WGU + le * 2048 * D + (size_t)((n0 >> 7) * 256 + (n0 & 127)) * D + k0; }
        else if (which == 1) { sb = a.in[21] + le * D * D; dst8 = ws + WS_WGU + le * 2048 * D + (size_t)((n0 >> 7) * 256 + 128 + (n0 & 127)) * D + k0; }
        else                 { sb = a.in[23] + le * D * D; dst8 = ws + WS_WD + le * D * D + (size_t)n0 * D + k0; } }
    src = sb + (size_t)k0 * D + n0;
}
__device__ __forceinline__ void fast_convert(Frame& F, const Args& a, int tid, int it0, int it1, int gw, int NGW) {
    unsigned char* ws = F.ws;
    const int lane = tid & 63, q = lane >> 4, c4 = (lane & 15) * 4;
    LAS unsigned char* tl = F.lds + F.wave * 8704;
    f32x4 v[16]; const float* src; unsigned char* dst8; bool f8;
#define FAST_LOAD() do { _Pragma("unroll") for (int x = 0; x < 16; ++x) { const int kr = f8 ? 16 * (x >> 2) + 4 * q + (x & 3) : 8 * (x >> 1) + 2 * q + (x & 1); \
        v[x] = __builtin_nontemporal_load((const f32x4*)(src + (size_t)kr * D + c4)); } } while (0)
    int it = it0 + gw;
    if (it < it1) { fast_decode(a, ws, it, src, dst8, f8); FAST_LOAD(); }
    for (; it < it1; it += NGW) {
        unsigned char* cdst = dst8; const bool cf8 = f8;
        if (cf8) {
#pragma unroll
            for (int i = 0; i < 4; ++i)
#pragma unroll
                for (int j = 0; j < 4; ++j)
                    *(LAS unsigned*)(tl + (c4 + j) * 68 + 16 * i + 4 * q) = (unsigned)__builtin_amdgcn_cvt_pk_fp8_f32(v[4 * i + 2][j] * F8_SW, v[4 * i + 3][j] * F8_SW, __builtin_amdgcn_cvt_pk_fp8_f32(v[4 * i][j] * F8_SW, v[4 * i + 1][j] * F8_SW, 0, false), true);
        } else {
#pragma unroll
            for (int i = 0; i < 8; ++i)
#pragma unroll
                for (int j = 0; j < 4; ++j) *(LAS unsigned*)(tl + (c4 + j) * 136 + (8 * i + 2 * q) * 2) = cvtpk(v[2 * i][j], v[2 * i + 1][j]);
        }
        const int nx = it + NGW;
        if (nx < it1) { fast_decode(a, ws, nx, src, dst8, f8); FAST_LOAD(); }
        asm volatile("s_waitcnt lgkmcnt(0)" ::: "memory");
        if (cf8) {
#pragma unroll
            for (int p = 0; p < 4; ++p) {
                const int n = 16 * p + (lane >> 2), c = lane & 3;
                const LAS unsigned* t4 = (const LAS unsigned*)(tl + n * 68 + c * 16);
                u32x4 w; w.x = t4[0]; w.y = t4[1]; w.z = t4[2]; w.w = t4[3];
                __builtin_nontemporal_store(w, (u32x4*)(cdst + (size_t)n * D + c * 16));
            }
        } else {
#pragma unroll
            for (int p = 0; p < 8; ++p) {
                const int n = 8 * p + (lane >> 3), c = lane & 7;
                const u32x2 lo = *(const LAS u32x2*)(tl + n * 136 + c * 16), hi2 = *(const LAS u32x2*)(tl + n * 136 + c * 16 + 8);
                u32x4 w; w.x = lo.x; w.y = lo.y; w.z = hi2.x; w.w = hi2.y;
                __builtin_nontemporal_store(w, (u32x4*)(cdst + (size_t)n * D * 2 + c * 16));
            }
        }
        asm volatile("s_waitcnt lgkmcnt(0)" ::: "memory");
    }
#undef FAST_LOAD
}
__device__ __forceinline__ void cvt_load(const CvtItem& c, int tid, float (&v)[16]) {
    const int nn = tid & 63, kk = tid >> 6;
    float sc = 1.f; int sn;
    if (c.mapkind == 1) sn = winmap(c.n0 + nn, sc);
    else if (c.mapkind == 2) { sn = uqmap(c.n0 + nn); sc = SC_MLA; }
    else if (c.mapkind == 3) sn = nn < 32 ? nn : -1;
    else sn = c.n0 + nn;
#pragma unroll
    for (int i = 0; i < 16; ++i) {
        const int k = c.k0 + kk + 8 * i;
        float x = 0.f;
        if (sn >= 0 && k < c.kvalid) { x = c.src[(size_t)k * c.ld + sn] * sc; if (c.rowscale) x *= c.rowscale[k]; }
        v[i] = x;
    }
}
__device__ __forceinline__ void prologue_phase(Frame& F, const Args& a) {
    unsigned char* ws = F.ws;
    const int tid = opaque_tid();
    __syncthreads();
    {
        LAS unsigned short* tile = (LAS unsigned short*)F.lds;
        float v[16]; CvtItem c;
        int it = F.vcu;
        if (it < CVT_ITEMS) { cvt_decode(a, ws, it, c); cvt_load(c, tid, v); }
        for (; it < CVT_ITEMS; it += F.G) {
            const int nn = tid & 63, kk = tid >> 6;
            const bool f8 = (c.mapkind == 1);
            if (f8) {
                LAS unsigned char* t8 = (LAS unsigned char*)tile;
#pragma unroll
                for (int i = 0; i < 16; ++i) t8[nn * 132 + kk + 8 * i] = (unsigned char)(__builtin_amdgcn_cvt_pk_fp8_f32(v[i] * F8_SW, 0.f, 0, false) & 0xff);
            } else {
#pragma unroll
                for (int i = 0; i < 16; ++i) tile[nn * 130 + kk + 8 * i] = (unsigned short)(cvtpk(v[i], 0.f) & 0xffffu);
            }
            __syncthreads();
            const CvtItem cc = c;
            const int nx = it + F.G;
            if (nx < CVT_ITEMS) { cvt_decode(a, ws, nx, c); cvt_load(c, tid, v); }
            const LAS unsigned* t32 = (const LAS unsigned*)tile;
            if (f8) {
                const int n = tid >> 3, ch = tid & 7;
                u32x4 w; const LAS unsigned* s = t32 + n * 33 + ch * 4;
                w.x = s[0]; w.y = s[1]; w.z = s[2]; w.w = s[3];
                *(u32x4*)((unsigned char*)cc.dst + (size_t)n * cc.ldd + cc.k0 + ch * 16) = w;
            } else {
#pragma unroll
                for (int p = 0; p < 2; ++p) {
                    const int n = (tid >> 4) + 32 * p, ch = tid & 15;
                    if (n < cc.nrows) {
                        u32x4 w; const LAS unsigned* s = t32 + n * 65 + ch * 4;
                        w.x = s[0]; w.y = s[1]; w.z = s[2]; w.w = s[3];
                        *(u32x4*)(cc.dst + (size_t)n * cc.ldd + cc.k0 + ch * 8) = w;
                    }
                }
            }
            __syncthreads();
        }
    }
    {
        LAS float* sil = (LAS float*)F.lds;
        LAS float* part = (LAS float*)(F.lds + 1024 * 17 * 4);
        __syncthreads();
        for (int i = tid; i < 17 * D; i += NTHR) { const int r = i / D, k = i - r * D; const float x = r < 16 ? a.in[1][(size_t)r * D + k] : a.in[3][k]; sil[k * 17 + r] = x / (1.f + __expf(-x)); }
        __syncthreads();
        float* MOD = (float*)(ws + WS_MOD);
        const int col = tid & 63, kg = tid >> 6;
        for (int ch = F.vcu; ch < NL * 96; ch += F.G) {
            const int l = ch / 96, j0 = (ch - l * 96) * 64;
            const float* w = a.in[4] + (size_t)l * D * 6144 + j0 + col;
            float accv[17];
#pragma unroll
            for (int r = 0; r < 17; ++r) accv[r] = 0.f;
#pragma unroll 4
            for (int k = kg * 128; k < kg * 128 + 128; ++k) {
                const float wv = w[(size_t)k * 6144];
#pragma unroll
                for (int r = 0; r < 17; ++r) accv[r] += sil[k * 17 + r] * wv;
            }
#pragma unroll
            for (int r = 0; r < 17; ++r) part[(kg * 17 + r) * 64 + col] = accv[r];
            __syncthreads();
            for (int i = tid; i < 17 * 64; i += NTHR) {
                const int r = i >> 6, cc = i & 63; float s = 0.f;
#pragma unroll
                for (int g = 0; g < 8; ++g) s += part[(g * 17 + r) * 64 + cc];
                MOD[((size_t)l * 17 + r) * 6144 + j0 + cc] = s + a.in[5][(size_t)l * 6144 + j0 + cc];
            }
            __syncthreads();
        }
    }
    {
        const int gt = F.vcu * NTHR + tid, GT = F.G * NTHR;
        float* ropeR = (float*)(ws + WS_ROPER); float* ropeW = (float*)(ws + WS_ROPEW);
        for (int i = gt; i < SEQ * 48; i += GT) {
            int t, j; double f; float* dst;
            if (i < SEQ * 16) { t = i >> 4; j = i & 15; f = a.invf8[j & 7]; dst = ropeR + (size_t)i * 2; const int pos = (j < 8) ? (t >> 6) : (t & 63); f *= (double)pos; }
            else { const int ii = i - SEQ * 16; t = ii >> 5; j = ii & 31; f = a.invf16[j & 15]; dst = ropeW + (size_t)ii * 2; const int pos = (j < 16) ? (t >> 6) : (t & 63); f *= (double)pos; }
            const double n = __builtin_rint(f * 0.15915494309189535);
            const double r = (f - n * 6.283185307179586) - n * 2.4492935982947064e-16;
            const double r2 = r * r;
            double s = 1.0, cs = 1.0;
#pragma unroll
            for (int q = 27; q >= 3; q -= 2) s = 1.0 - s * r2 / (double)(q * (q - 1));
            s *= r;
#pragma unroll
            for (int q = 26; q >= 2; q -= 2) cs = 1.0 - cs * r2 / (double)(q * (q - 1));
            dst[0] = (float)cs; dst[1] = (float)s;
        }
        if (gt < NL) {
            const float* lam = a.in[12] + gt * 128; float s1 = 0.f, s2 = 0.f;
            for (int k = 0; k < 32; ++k) { s1 += lam[k] * lam[32 + k]; s2 += lam[64 + k] * lam[96 + k]; }
            ((float*)(ws + WS_CTL))[CW_LAM + gt] = expf(s1) - expf(s2) + a.lam_init[gt];
        }
    }
}

__device__ __forceinline__ void load_counts(Frame& F, int l) {
    volatile LAS int* PB = (volatile LAS int*)(F.lds + MISC_OFF + 256);
    volatile LAS int* CNT = (volatile LAS int*)(F.lds + MISC_OFF + 512);
    __syncthreads();
    const int tid = opaque_tid(), lane = tid & 63;
    if (tid < 64) {
        const unsigned* cur = (const unsigned*)(F.ws + WS_CTL) + CW_CUR + l * 32;
        const int c = lane < 32 ? (int)cur[lane] : 0;
        const int np = (c + 255) >> 8;
        int incl = np;
#pragma unroll
        for (int o = 1; o < 32; o <<= 1) { const int y = __shfl_up(incl, o); if ((lane & 31) >= o) incl += y; }
        if (lane < 32) { PB[lane + 1] = incl; CNT[lane] = c; }
        if (lane == 0) PB[0] = 0;
    }
    __syncthreads();
}
template <int MODE, bool FIRST> __device__ __forceinline__ void norm1_phase(Frame& F, const Args& a, int l, bool dummy = false) {
    unsigned char* ws = F.ws;
    bf16_t* X = (bf16_t*)(ws + WS_X); bf16_t* H = (bf16_t*)(ws + WS_H); const bf16_t* Y = (const bf16_t*)(ws + WS_Y);
    bf16_t* Xw = dummy ? (bf16_t*)(ws + WS_ACT + 160 * MiB) : X; if (dummy) H = (bf16_t*)(ws + WS_ACT + 232 * MiB);
    const float* MOD = (const float*)(ws + WS_MOD);
    const unsigned* tokslot = (const unsigned*)(ws + WS_TOKSLOT);
    constexpr bool comb = (MODE == 1) || !FIRST;
    constexpr int NR = FIRST ? 4 : 2;
    const int lp = (MODE == 1) ? NL - 1 : l - 1;
    if (comb) load_counts(F, lp);
    volatile LAS int* PB = (volatile LAS int*)(F.lds + MISC_OFF + 256);
    const int lane = opaque_tid() & 63;
    int vcu_ = F.vcu; asm volatile("" : "+s"(vcu_));
    const int gw = vcu_ * NWAVES + F.wave, NGW = F.G * NWAVES;
    const int nrows = (MODE == 1) ? NB * SEQ : T;
    const float* gvec = (MODE == 1) ? a.in[25] : a.in[6] + (size_t)l * D;
    f32x4 gv[4];
#pragma unroll
    for (int j = 0; j < 4; ++j) gv[j] = *(const f32x4*)(gvec + 16 * lane + 4 * j);
    auto rowinfo = [&](int ri, int& tok, int& bb, int& nb) { if (MODE == 1) { bb = ri >> 11; nb = CTX + (ri & 2047); tok = bb * NTK + nb; } else { tok = ri; bb = tok / NTK; nb = tok - bb * NTK; } };
    auto stageA = [&](int ri, u32x4 (&raw)[NR], u32x4& ts) {
        int tok, bb, nb; rowinfo(ri, tok, bb, nb);
        if constexpr (FIRST) {
            const float* src = nb < CTX ? a.in[2] + ((size_t)bb * CTX + nb) * D : a.in[0] + ((size_t)bb * SEQ + (nb - CTX)) * D;
#pragma unroll
            for (int j = 0; j < 4; ++j) raw[j] = *(const u32x4*)(src + 16 * lane + 4 * j);
        } else {
            const u32x4* xp = (const u32x4*)(X + (size_t)tok * D + 16 * lane); raw[0] = xp[0]; raw[1] = xp[1];
        }
        if (comb) ts = *(const u32x4*)(tokslot + (size_t)tok * 4);
    };
    auto stageB = [&](const u32x4& ts, u32x4 (&yv)[4]) {
#pragma unroll
        for (int k = 0; k < 4; ++k) {
            const unsigned w = ts[k]; const int e = (int)(w >> 16), pos = (int)(w & 0xffffu);
            const unsigned char* yr = (const unsigned char*)Y + ((size_t)PB[e] * 256 + pos) * D;
            yv[k] = *(const u32x4*)(yr + 16 * lane);
        }
    };
    auto stageC = [&](int ri, const u32x4 (&raw)[NR], const u32x4 (&yv)[4]) {
        __builtin_amdgcn_sched_barrier(0);
        int tok, bb, nb; rowinfo(ri, tok, bb, nb);
        const int modrow = nb < CTX ? 16 : bb;
        f32x4 v[4];
#pragma unroll
        for (int j = 0; j < 4; ++j) {
            if constexpr (FIRST) v[j] = __builtin_bit_cast(f32x4, raw[j]);
            else { const unsigned w0 = (j & 1) ? raw[j >> 1].z : raw[j >> 1].x, w1 = (j & 1) ? raw[j >> 1].w : raw[j >> 1].y; v[j] = (f32x4){bflo(w0), bfhi(w0), bflo(w1), bfhi(w1)}; }
        }
        if (comb) {
            const float* g5 = MOD + ((size_t)lp * 17 + modrow) * 6144 + 5 * D;
#pragma unroll
            for (int j = 0; j < 4; ++j) {
                f32x4 sj = (f32x4){0.f, 0.f, 0.f, 0.f};
#pragma unroll
                for (int k = 0; k < 4; ++k) { const unsigned y = yv[k][j]; const f32x2 lo = __builtin_amdgcn_cvt_pk_f32_fp8((int)y, false), hi2 = __builtin_amdgcn_cvt_pk_f32_fp8((int)y, true); sj[0] += lo[0]; sj[1] += lo[1]; sj[2] += hi2[0]; sj[3] += hi2[1]; }
                v[j] += *(const f32x4*)(g5 + 16 * lane + 4 * j) * (sj * (1.0f / F8_SY));
            }
        }
        float ss = 0.f;
#pragma unroll
        for (int j = 0; j < 4; ++j) ss += (v[j][0] * v[j][0] + v[j][1] * v[j][1]) + (v[j][2] * v[j][2] + v[j][3] * v[j][3]);
        const float rstd = 1.0f / sqrtf(wave_sum(ss) * (1.f / D) + EPS);
        if (MODE == 1) {
            float* o = a.out + (size_t)ri * D;
#pragma unroll
            for (int j = 0; j < 4; ++j) *(f32x4*)(o + 16 * lane + 4 * j) = v[j] * rstd * gv[j];
        } else {
            const float* mr = MOD + ((size_t)l * 17 + modrow) * 6144;
            u32x4 xb[2], h8;
#pragma unroll
            for (int j = 0; j < 4; ++j) {
                const unsigned p0 = cvtpk(v[j][0], v[j][1]), p1 = cvtpk(v[j][2], v[j][3]);
                if (j & 1) { xb[j >> 1].z = p0; xb[j >> 1].w = p1; } else { xb[j >> 1].x = p0; xb[j >> 1].y = p1; }
                const f32x4 sh = *(const f32x4*)(mr + 16 * lane + 4 * j), sc = *(const f32x4*)(mr + D + 16 * lane + 4 * j);
                const f32x4 h = (v[j] * rstd * gv[j] * (sc + 1.0f) + sh) * F8_SA;
                h8[j] = (unsigned)__builtin_amdgcn_cvt_pk_fp8_f32(h[2], h[3], __builtin_amdgcn_cvt_pk_fp8_f32(h[0], h[1], 0, false), true);
            }
            { u32x4* xp = (u32x4*)(Xw + (size_t)tok * D + 16 * lane); xp[0] = xb[0]; xp[1] = xb[1]; }
            *(u32x4*)((unsigned char*)H + (size_t)tok * D + 16 * lane) = h8;
        }
    };
    u32x4 rawC[NR], rawN[NR], rawF[NR]; u32x4 tsN = {0u, 0u, 0u, 0u}, tsF = {0u, 0u, 0u, 0u}, tsC = {0u, 0u, 0u, 0u}; u32x4 yC[4], yN[4];
    if (gw < nrows) stageA(gw, rawC, tsC);
    if (gw + NGW < nrows) stageA(gw + NGW, rawN, tsN);
    if (comb && gw < nrows) stageB(tsC, yC);
    for (int ri = gw; ri < nrows; ri += NGW) {
        if (ri + 2 * NGW < nrows) stageA(ri + 2 * NGW, rawF, tsF);
        if (comb && ri + NGW < nrows) stageB(tsN, yN);
        stageC(ri, rawC, yC);
#pragma unroll
        for (int j = 0; j < NR; ++j) { rawC[j] = rawN[j]; rawN[j] = rawF[j]; }
        tsN = tsF;
#pragma unroll
        for (int k = 0; k < 4; ++k) yC[k] = yN[k];
    }
}
__device__ __forceinline__ void norm2_router_phase(Frame& F, const Args& a, int l) {
    unsigned char* ws = F.ws;
    const bf16_t* X = (const bf16_t*)(ws + WS_X); unsigned char* H8 = (unsigned char*)(ws + WS_H);
    const float* MOD = (const float*)(ws + WS_MOD);
    unsigned* tokslot = (unsigned*)(ws + WS_TOKSLOT); int* slot_tok = (int*)(ws + WS_SLOTTOK); float* slot_w = (float*)(ws + WS_SLOTW);
    unsigned* cursor = (unsigned*)(ws + WS_CTL) + CW_CUR + l * 32;
    const bf16_t* Wr = (const bf16_t*)(ws + WS_WR) + (size_t)l * 32 * D;
    const bool last = (l == NL - 1);
    const int ngroups = last ? NB * SEQ / 32 : T / 32;
    const int tid = opaque_tid(), lane = tid & 63, wave = F.wave, r32 = lane & 31, hi = lane >> 5;
    constexpr int FT_RS = 2064;
    LAS unsigned char* FT = F.lds;
    LAS float* LP = (LAS float*)(F.lds + 32 * FT_RS);
    LAS float* LG = LP + 8 * 32 * 33;
    LAS int* lcnt = (LAS int*)(LG + 32 * 33);
    LAS int* lbase = lcnt + 32;
    bf16x8 wf[8];
#pragma unroll
    for (int s = 0; s < 8; ++s) wf[s] = *(const bf16x8*)(Wr + (size_t)r32 * D + (8 * wave + s) * 16 + hi * 8);
    const float* gvec = a.in[16] + (size_t)l * D;
    f32x4 gv[4];
#pragma unroll
    for (int j = 0; j < 4; ++j) gv[j] = *(const f32x4*)(gvec + 16 * lane + 4 * j);
    if (tid < 32) lcnt[tid] = 0;
    __syncthreads();
    auto ginfo = [&](int g, int& tok0, int& modrow) {
        int b; bool isctx;
        if (last) { b = g >> 6; tok0 = b * NTK + CTX + (g & 63) * 32; isctx = false; } else { tok0 = g * 32; b = tok0 / NTK; isctx = (tok0 - b * NTK) < CTX; }
        modrow = isctx ? 16 : b;
    };
    u32x4 xq[4][2], xn[4][2]; f32x4 shv[4], scv[4], shn[4], scn[4];
    auto gload = [&](int g, u32x4 (&x)[4][2], f32x4 (&sh)[4], f32x4 (&sc)[4]) {
        int tok0, modrow; ginfo(g, tok0, modrow);
        const float* mr = MOD + ((size_t)l * 17 + modrow) * 6144;
#pragma unroll
        for (int q = 0; q < 4; ++q) { const u32x4* xp = (const u32x4*)(X + (size_t)(tok0 + wave * 4 + q) * D + 16 * lane); x[q][0] = xp[0]; x[q][1] = xp[1]; }
#pragma unroll
        for (int j = 0; j < 4; ++j) { sh[j] = *(const f32x4*)(mr + 3 * D + 16 * lane + 4 * j); sc[j] = *(const f32x4*)(mr + 4 * D + 16 * lane + 4 * j); }
    };
    if ((int)F.vcu >= ngroups) return;
    const int glast = F.vcu + ((ngroups - 1 - F.vcu) / F.G) * F.G;
    gload(F.vcu, xq, shv, scv);
    for (int g = F.vcu; g < ngroups; g += F.G) {
        int tok0, modrow_; ginfo(g, tok0, modrow_);
        gload(min(g + F.G, glast), xn, shn, scn);
#pragma unroll
        for (int q = 0; q < 4; ++q) {
            const int rl = wave * 4 + q, tok = tok0 + rl;
            f32x4 v[4]; float ss = 0.f;
#pragma unroll
            for (int j = 0; j < 4; ++j) { const unsigned w0 = (j & 1) ? xq[q][j >> 1].z : xq[q][j >> 1].x, w1 = (j & 1) ? xq[q][j >> 1].w : xq[q][j >> 1].y;
                v[j] = (f32x4){bflo(w0), bfhi(w0), bflo(w1), bfhi(w1)}; ss += (v[j][0] * v[j][0] + v[j][1] * v[j][1]) + (v[j][2] * v[j][2] + v[j][3] * v[j][3]); }
            const float rstd = 1.0f / sqrtf(wave_sum(ss) * (1.f / D) + EPS);
            u32x4 h8; u32x4 hb[2];
#pragma unroll
            for (int j = 0; j < 4; ++j) {
                const f32x4 h = v[j] * rstd * gv[j] * (scv[j] + 1.0f) + shv[j];
                const unsigned p0 = cvtpk(h[0], h[1]), p1 = cvtpk(h[2], h[3]);
                if (j & 1) { hb[j >> 1].z = p0; hb[j >> 1].w = p1; } else { hb[j >> 1].x = p0; hb[j >> 1].y = p1; }
                h8[j] = (unsigned)__builtin_amdgcn_cvt_pk_fp8_f32(h[2] * F8_SA, h[3] * F8_SA, __builtin_amdgcn_cvt_pk_fp8_f32(h[0] * F8_SA, h[1] * F8_SA, 0, false), true);
            }
            *(u32x4*)(H8 + (size_t)tok * D + 16 * lane) = h8;
            LAS u32x4* fp = (LAS u32x4*)(FT + rl * FT_RS + 32 * lane); fp[0] = hb[0]; fp[1] = hb[1];
        }
#pragma unroll
        for (int q = 0; q < 4; ++q) { xq[q][0] = xn[q][0]; xq[q][1] = xn[q][1]; }
#pragma unroll
        for (int j = 0; j < 4; ++j) { shv[j] = shn[j]; scv[j] = scn[j]; }
        __syncthreads();
        {
            f32x16 acc = {};
#pragma unroll
            for (int s = 0; s < 8; ++s) {
                const bf16x8 af = *(const LAS bf16x8*)(FT + r32 * FT_RS + ((8 * wave + s) * 16 + hi * 8) * 2);
                acc = __builtin_amdgcn_mfma_f32_32x32x16_bf16(af, wf[s], acc, 0, 0, 0);
            }
#pragma unroll
            for (int r = 0; r < 16; ++r) { const int row = (r & 3) + 8 * (r >> 2) + 4 * hi; LP[(wave * 32 + row) * 33 + r32] = acc[r]; }
        }
        __syncthreads();
        for (int i = tid; i < 1024; i += NTHR) {
            const int row = i >> 5, e = i & 31; float s = a.in[18][l * 32 + e];
#pragma unroll
            for (int w = 0; w < 8; ++w) s += LP[(w * 32 + row) * 33 + e];
            LG[row * 33 + e] = s;
        }
        __syncthreads();
        int te[4]; float tw[4]; int rk[4];
        if (tid < 32) {
            float lv[32];
#pragma unroll
            for (int e = 0; e < 32; ++e) lv[e] = LG[tid * 33 + e];
            float tv[4];
#pragma unroll
            for (int k = 0; k < 4; ++k) {
                float best = -3.0e38f; int bi = 0;
#pragma unroll
                for (int e = 0; e < 32; ++e) { const bool up = lv[e] > best; best = up ? lv[e] : best; bi = up ? e : bi; }
                tv[k] = best; te[k] = bi;
#pragma unroll
                for (int e = 0; e < 32; ++e) lv[e] = (e == bi) ? -3.0e38f : lv[e];
            }
            const float e1 = __expf(tv[1] - tv[0]), e2 = __expf(tv[2] - tv[0]), e3 = __expf(tv[3] - tv[0]);
            const float inv = 1.0f / (1.0f + e1 + e2 + e3);
            tw[0] = inv; tw[1] = e1 * inv; tw[2] = e2 * inv; tw[3] = e3 * inv;
#pragma unroll
            for (int k = 0; k < 4; ++k) rk[k] = atomicAdd((int*)&lcnt[te[k]], 1);
        }
        __syncthreads();
        if (tid < 32) { const int c = lcnt[tid]; lbase[tid] = c ? (int)atomicAdd(&cursor[tid], (unsigned)c) : 0; }
        __syncthreads();
        if (tid < 32) {
            const int tok = tok0 + tid; u32x4 ts;
#pragma unroll
            for (int k = 0; k < 4; ++k) { const int pos = lbase[te[k]] + rk[k]; slot_tok[(size_t)te[k] * T + pos] = tok; slot_w[(size_t)te[k] * T + pos] = tw[k]; ts[k] = ((unsigned)te[k] << 16) | (unsigned)pos; }
            *(u32x4*)(tokslot + (size_t)tok * 4) = ts;
            lcnt[tid] = 0;
        }
        __syncthreads();
    }
}

struct AttnPtrs { const bf16_t* P; const bf16_t* QM; const bf16_t* KVM; unsigned char* MIX; const float* sink; const float* subg; float lam_full, one_m_li; };
constexpr int KB_OFF0 = 0, KB_STRIDE = 16384, VB_OFF0 = 32768, VB_STRIDE = 12288, XCH_OFF = 81920;
#define ATT_PIN(x) asm volatile("" : "+v"(x))
#define ATT_SBAR() __builtin_amdgcn_sched_barrier(0)
#define ATT_THR 8.0f
#ifndef ATT_WSLICE
#define ATT_WSLICE 10
#endif
#ifndef ATT_PF
#define ATT_PF 2
#endif
template <int KIND> __device__ __forceinline__ void attn_unit(const AttnPtrs& A, int b, int h, int qblk, LAS unsigned char* lds, unsigned& qnext) {
    constexpr int DQK = KIND == 0 ? 96 : (KIND == 1 ? 32 : 64);
    constexpr int NF = DQK / 16, RSK = DQK * 2 + 16, RSV = 192, NMF = 8 + 2 * NF;
    const int tid = opaque_tid(), lane = tid & 63, r32 = lane & 31, hi = lane >> 5, wid = __builtin_amdgcn_readfirstlane(tid >> 6);
    const size_t tokb = (size_t)b * NTK;
    const int mp = KIND == 1 ? (wid >> 2) : 0;
    const int qrow0 = KIND == 1 ? qblk * 128 + (wid & 3) * 32 : qblk * 256 + wid * 32;
    const bool ctxunit = KIND == 1 ? (qblk < 2) : (qblk == 0);
    const size_t tokq = tokb + qrow0 + r32;
    const int kvh = h >> 2;
    bf16x8 qf[NF];
#pragma unroll
    for (int d0 = 0; d0 < NF; ++d0) {
        const bf16_t* src = KIND == 0 ? A.QM + tokq * 384 + h * 96 + d0 * 16 + hi * 8
                          : KIND == 1 ? A.P + tokq * PW + 512 + (2 * h + mp) * 32 + d0 * 16 + hi * 8
                                      : A.P + tokq * PW + 1280 + h * 64 + d0 * 16 + hi * 8;
        qf[d0] = *(const bf16x8*)src;
    }
    float mrun = 0.f; f32x2 lrun2 = {0.f, 0.f}; f32x16 o[2]; o[0] = f32x16{}; o[1] = f32x16{};
    f32x16 negm = f32x16{};
    const int T0 = KIND == 2 ? (qblk - 1) * 256 : 0;
    int ntile, ttlo = 0;
    if (ctxunit) ntile = 4;
    else if (KIND == 2) { ttlo = max(0, (T0 >> 6) - 2); const int tthi = min(31, (T0 >> 6) + 5); ntile = 4 + (tthi - ttlo + 1); }
    else ntile = 36;
#define TILE_OF(i) ((KIND == 2 && (i) >= 4) ? 4 + ttlo + ((i) - 4) : (i))
    u32x4 krA0, krA1, vrA, krB0, krB1, vrB;
    const char* kp0; const char* kp1 = nullptr; const char* vp; unsigned ks0, ks1 = 0u, vs;
    if (KIND == 0) {
        { const int row = tid / 12, ch = tid - row * 12; const size_t tok = tokb + row;
          kp0 = ch < 8 ? (const char*)(A.KVM + tok * 512 + h * 128 + ch * 8) : (const char*)(A.P + tok * PW + 384 + (ch - 8) * 8); ks0 = ch < 8 ? 64u * 512u * 2u : 64u * PW * 2u; }
        { const int q = (tid & 255) + 512, row = q / 12, ch = q - row * 12; const size_t tok = tokb + row;
          kp1 = ch < 8 ? (const char*)(A.KVM + tok * 512 + h * 128 + ch * 8) : (const char*)(A.P + tok * PW + 384 + (ch - 8) * 8); ks1 = ch < 8 ? 64u * 512u * 2u : 64u * PW * 2u; }
        { const int row = tid >> 3, ch = tid & 7; vp = (const char*)(A.KVM + (tokb + row) * 512 + h * 128 + 64 + ch * 8); vs = 64u * 512u * 2u; }
    } else if (KIND == 1) {
        { const int m2 = tid >> 8, row = (tid & 255) >> 2, ch = tid & 3; kp0 = (const char*)(A.P + (tokb + row) * PW + 768 + (2 * h + m2) * 32 + ch * 8); ks0 = 64u * PW * 2u; }
        { const int row = tid >> 3, ch = tid & 7; vp = (const char*)(A.P + (tokb + row) * PW + 1024 + h * 64 + ch * 8); vs = 64u * PW * 2u; }
    } else {
        const int row = tid >> 3, ch = tid & 7;
        kp0 = (const char*)(A.P + (tokb + row) * PW + 1792 + kvh * 64 + ch * 8); ks0 = 64u * PW * 2u;
        vp = (const char*)(A.P + (tokb + row) * PW + 1920 + kvh * 64 + ch * 8); vs = 64u * PW * 2u;
    }
    const char* gb = (const char*)A.P;
    const unsigned ko0 = (unsigned)(kp0 - gb), ko1 = (KIND == 0) ? (unsigned)(kp1 - gb) : 0u, vo = (unsigned)(vp - gb);
    const unsigned ksh0 = ks0 == 65536u ? 16u : 18u, ksh1 = ks1 == 65536u ? 16u : 18u, vsh = vs == 65536u ? 16u : 18u;
    auto gload = [&](int tt, u32x4& kr0, u32x4& kr1, u32x4& vr) {
        kr0 = *(const u32x4*)(gb + (size_t)(((unsigned)tt << ksh0) + ko0));
        if (KIND == 0) kr1 = *(const u32x4*)(gb + (size_t)(((unsigned)tt << ksh1) + ko1));
        vr = *(const u32x4*)(gb + (size_t)(((unsigned)tt << vsh) + vo));
    };
    auto lstore = [&](int i, const u32x4& kr0, const u32x4& kr1, const u32x4& vr) {
        LAS unsigned char* kb = lds + KB_OFF0 + (i & 1) * KB_STRIDE; LAS unsigned char* vb = lds + VB_OFF0 + (i & 3) * VB_STRIDE;
        if (KIND == 0) {
            { const int row = tid / 12, ch = tid - row * 12; *(LAS u32x4*)(kb + row * RSK + ch * 16) = kr0; }
            if (tid < 256) { const int q = tid + 512, row = q / 12, ch = q - row * 12; *(LAS u32x4*)(kb + row * RSK + ch * 16) = kr1; }
        } else if (KIND == 1) {
            const int m2 = tid >> 8, row = (tid & 255) >> 2, ch = tid & 3; *(LAS u32x4*)(kb + m2 * 8192 + row * RSK + ch * 16) = kr0;
        } else { const int row = tid >> 3, ch = tid & 7; *(LAS u32x4*)(kb + row * RSK + ch * 16) = kr0; }
        { const int row = tid >> 3, ch = tid & 7; *(LAS u32x4*)(vb + row * RSV + ch * 16) = vr; }
    };
    const int qpos = T0 + wid * 32 + r32;
    const int koff = (KIND == 1 ? mp * 8192 : 0) + r32 * RSK + hi * 16;
    const int voff = ((lane >> 4) & 1) * 32 + (lane & 3) * 8 + (4 * hi + ((lane & 15) >> 2)) * RSV;
    auto fetch = [&](int j, const LAS unsigned char* vb, const LAS unsigned char* kb) -> bf16x8 {
        if (j < 8) {
            const int sI = j >> 1, d0 = j & 1;
            const v4i16_t lo = __builtin_amdgcn_ds_read_tr16_b64_v4i16((LAS v4i16_t*)(vb + voff + (16 * sI) * RSV + d0 * 64));
            const v4i16_t hh = __builtin_amdgcn_ds_read_tr16_b64_v4i16((LAS v4i16_t*)(vb + voff + (16 * sI + 8) * RSV + d0 * 64));
            return (bf16x8){lo[0], lo[1], lo[2], lo[3], hh[0], hh[1], hh[2], hh[3]};
        } else {
            const int d0 = (j - 8) >> 1, half = (j - 8) & 1;
            return *(const LAS bf16x8*)(kb + koff + half * 32 * RSK + d0 * 32);
        }
    };
    gload(TILE_OF(0), krA0, krA1, vrA); gload(TILE_OF(1), krB0, krB1, vrB);
    lstore(0, krA0, krA1, vrA); lstore(1, krB0, krB1, vrB);
    gload(TILE_OF(2), krA0, krA1, vrA);
    qnext = (unsigned)__builtin_amdgcn_readfirstlane((int)qnext);
    __syncthreads();
    f32x16 pA0 = f32x16{}, pA1 = f32x16{}, pB0, pB1;
    {
        const LAS unsigned char* kb = lds + KB_OFF0;
#pragma unroll
        for (int d0 = 0; d0 < NF; ++d0) {
            const bf16x8 k0 = *(const LAS bf16x8*)(kb + koff + d0 * 32), k1 = *(const LAS bf16x8*)(kb + koff + 32 * RSK + d0 * 32);
            pA0 = __builtin_amdgcn_mfma_f32_32x32x16_bf16(k0, qf[d0], pA0, 0, 0, 0);
            pA1 = __builtin_amdgcn_mfma_f32_32x32x16_bf16(k1, qf[d0], pA1, 0, 0, 0);
        }
    }
    bf16x8 paX[4], paY[4];
#pragma unroll
    for (int sI = 0; sI < 4; ++sI) { paX[sI] = (bf16x8){0, 0, 0, 0, 0, 0, 0, 0}; paY[sI] = (bf16x8){0, 0, 0, 0, 0, 0, 0, 0}; }
    __syncthreads();
#define ATT_STEP(C0, C1, N0, N1, PP, PC, i, KR0, KR1, VR) do { \
        const int tt_ = TILE_OF(i); \
        if (KIND == 2 && !ctxunit && tt_ >= 4) { \
            const int k0_ = (tt_ - 4) * 64, tw_ = T0 + wid * 32; \
            if (k0_ + 63 - tw_ > 128 || k0_ - (tw_ + 31) < -128) {     \
                const int kbase_ = k0_ + 4 * hi - qpos; \
                _Pragma("unroll") for (int r = 0; r < 16; ++r) { const int dk = kbase_ + (r & 3) + 8 * (r >> 2); if (dk > 128 || dk < -128) C0[r] = -1.0e30f; if (dk + 32 > 128 || dk + 32 < -128) C1[r] = -1.0e30f; } \
            } \
        } \
        const LAS unsigned char* vb_ = lds + VB_OFF0 + (((i) + 3 + ((i) == 0 ? 1 : 0)) & 3) * VB_STRIDE;                  \
        const LAS unsigned char* kb_ = lds + KB_OFF0 + (((i) + 1 < ntile ? (i) + 1 : (i)) & 1) * KB_STRIDE;       \
        bf16x8 op_[ATT_PF + 1]; _Pragma("unroll") for (int j = 0; j < ATT_PF; ++j) op_[j] = fetch(j, vb_, kb_); \
        float mx_ = -3.0e38f, alpha_ = 1.f; f32x2 ls2_ = {0.f, 0.f}; unsigned long long gbal_ = 0ull;     \
        ATT_SBAR(); \
        _Pragma("unroll") for (int k = 0; k < 20; ++k) { \
            if (k == ATT_WSLICE) { if ((i) + 2 < ntile) lstore((i) + 2, KR0, KR1, VR); }     \
            if (k + ATT_PF < NMF) op_[(k + ATT_PF) % (ATT_PF + 1)] = fetch(k + ATT_PF, vb_, kb_); \
            if (k < 8) { o[k & 1] = __builtin_amdgcn_mfma_f32_32x32x16_bf16(op_[k % (ATT_PF + 1)], PP[k >> 1], o[k & 1], 0, 0, 0); } \
            else if (k < NMF) { const int j_ = k - 8; \
                if (j_ == 0) N0 = __builtin_amdgcn_mfma_f32_32x32x16_bf16(op_[k % (ATT_PF + 1)], qf[0], negm, 0, 0, 0); \
                else if (j_ == 1) N1 = __builtin_amdgcn_mfma_f32_32x32x16_bf16(op_[k % (ATT_PF + 1)], qf[0], negm, 0, 0, 0); \
                else if (j_ & 1) N1 = __builtin_amdgcn_mfma_f32_32x32x16_bf16(op_[k % (ATT_PF + 1)], qf[j_ >> 1], N1, 0, 0, 0); \
                else N0 = __builtin_amdgcn_mfma_f32_32x32x16_bf16(op_[k % (ATT_PF + 1)], qf[j_ >> 1], N0, 0, 0, 0); } \
            if (k < 4) { float a_ = fmaxf(fmaxf(C0[4 * k], C0[4 * k + 1]), C0[4 * k + 2]); const float b_ = fmaxf(fmaxf(C0[4 * k + 3], C1[4 * k]), C1[4 * k + 1]); a_ = fmaxf(fmaxf(a_, C1[4 * k + 2]), C1[4 * k + 3]); mx_ = fmaxf(fmaxf(mx_, a_), b_); ATT_PIN(mx_); }     \
            else if (k == 4) { auto rr_ = __builtin_amdgcn_permlane32_swap(__float_as_uint(mx_), __float_as_uint(mx_), false, false); { const float ma_ = __uint_as_float(rr_[0]), mb_ = __uint_as_float(rr_[1]); asm("v_max_f32 %0, %1, %2" : "=v"(mx_) : "v"(ma_), "v"(mb_)); }     \
                  \
                const bool far_ = ((i) == 0) ? (fabsf(mx_) > ATT_THR) : (mx_ > ATT_THR); \
                gbal_ = __builtin_amdgcn_ballot_w64(far_); \
                if (gbal_ != 0ull) { const float dl_ = ((i) == 0) ? mx_ : fmaxf(mx_, 0.f); \
                    _Pragma("unroll") for (int r = 0; r < 16; ++r) { C0[r] -= dl_; C1[r] -= dl_; } \
                    mrun += dl_; alpha_ = ((i) == 0) ? 1.0f : __builtin_amdgcn_exp2f(-dl_); \
                    _Pragma("unroll") for (int r = 0; r < 16; ++r) negm[r] = -mrun; ATT_PIN(negm); ATT_PIN(alpha_); } } \
            else if (k < 13) { const int e_ = k - 5; \
                C0[2 * e_] = __builtin_amdgcn_exp2f(C0[2 * e_]); C0[2 * e_ + 1] = __builtin_amdgcn_exp2f(C0[2 * e_ + 1]); \
                C1[2 * e_] = __builtin_amdgcn_exp2f(C1[2 * e_]); C1[2 * e_ + 1] = __builtin_amdgcn_exp2f(C1[2 * e_ + 1]); \
                ls2_ += (f32x2){C0[2 * e_], C0[2 * e_ + 1]}; ls2_ += (f32x2){C1[2 * e_], C1[2 * e_ + 1]}; ATT_PIN(ls2_); } \
            else if (k < 17) { const int c_ = k - 13; u32x4 w_; \
                if (c_ < 2) { w_.x = cvtpk(C0[8 * c_ + 0], C0[8 * c_ + 1]); w_.y = cvtpk(C0[8 * c_ + 2], C0[8 * c_ + 3]); w_.z = cvtpk(C0[8 * c_ + 4], C0[8 * c_ + 5]); w_.w = cvtpk(C0[8 * c_ + 6], C0[8 * c_ + 7]); } \
                else { const int c2_ = c_ - 2; w_.x = cvtpk(C1[8 * c2_ + 0], C1[8 * c2_ + 1]); w_.y = cvtpk(C1[8 * c2_ + 2], C1[8 * c2_ + 3]); w_.z = cvtpk(C1[8 * c2_ + 4], C1[8 * c2_ + 5]); w_.w = cvtpk(C1[8 * c2_ + 6], C1[8 * c2_ + 7]); } \
                ATT_PIN(w_); PC[c_] = __builtin_bit_cast(bf16x8, w_); } \
            else if (k == 17) { if (gbal_ != 0ull) { lrun2 *= alpha_; _Pragma("unroll") for (int r = 0; r < 16; ++r) o[0][r] *= alpha_; ATT_PIN(o[0]); } lrun2 += ls2_; ATT_PIN(lrun2); } \
            else if (k == 18) { if (gbal_ != 0ull) { _Pragma("unroll") for (int r = 0; r < 16; ++r) o[1][r] *= alpha_; ATT_PIN(o[1]); } } \
            ATT_SBAR(); \
        } \
    } while (0)
#ifndef ATT_PRIO
#define ATT_PRIO 1
#endif
    if (ATT_PRIO && wid >= 4) __builtin_amdgcn_s_setprio(1);
    for (int i = 0; i < ntile; i += 2) {
        { const int j3 = min(i + 3, ntile - 1); gload(TILE_OF(j3), krB0, krB1, vrB); }
        ATT_STEP(pA0, pA1, pB0, pB1, paY, paX, i, krA0, krA1, vrA);
        __syncthreads();
        { const int j4 = min(i + 4, ntile - 1); gload(TILE_OF(j4), krA0, krA1, vrA); }
        ATT_STEP(pB0, pB1, pA0, pA1, paX, paY, i + 1, krB0, krB1, vrB);
        __syncthreads();
    }
#undef ATT_STEP
#undef TILE_OF
    if (ATT_PRIO) __builtin_amdgcn_s_setprio(0);
    {
        const LAS unsigned char* vb = lds + VB_OFF0 + ((ntile - 1) & 3) * VB_STRIDE;
#pragma unroll
        for (int j = 0; j < 8; ++j) { const bf16x8 vfr = fetch(j, vb, vb); o[j & 1] = __builtin_amdgcn_mfma_f32_32x32x16_bf16(vfr, paY[j >> 1], o[j & 1], 0, 0, 0); }
    }
    const float lrun = lrun2[0] + lrun2[1];
    float lt = lrun + __shfl_xor(lrun, 32);
    if (KIND == 2) lt += __builtin_amdgcn_exp2f(A.sink[h] * LOG2E - mrun);
    const float inv = 1.0f / lt;
    const int colbase = (KIND == 0 ? 0 : (KIND == 1 ? 256 : 512)) + h * 64;
    unsigned char* orow = A.MIX + tokq * D + colbase;
    unsigned W8[2][4];
    auto store_rows = [&]() {
#pragma unroll
        for (int d0 = 0; d0 < 2; ++d0) {
            const auto s0 = __builtin_amdgcn_permlane32_swap(W8[d0][0], W8[d0][1], false, false), s1 = __builtin_amdgcn_permlane32_swap(W8[d0][2], W8[d0][3], false, false);
            const auto t0 = __builtin_amdgcn_permlane32_swap(s0[0], s1[0], false, false), t1 = __builtin_amdgcn_permlane32_swap(s0[1], s1[1], false, false);
            u32x4 w; w.x = t0[0]; w.y = t1[0]; w.z = t0[1]; w.w = t1[1];
            *(u32x4*)(orow + 32 * d0 + 16 * hi) = w;
        }
    };
    if (KIND == 1) {
        LAS float* xch = (LAS float*)(lds + XCH_OFF) + (wid & 3) * 2048 + lane;
        if (wid >= 4) {
#pragma unroll
            for (int d0 = 0; d0 < 2; ++d0)
#pragma unroll
                for (int r = 0; r < 16; ++r) xch[(d0 * 16 + r) * 64] = o[d0][r] * inv;
        }
        __syncthreads();
        if (wid < 4) {
            float ss = 0.f;
#pragma unroll
            for (int d0 = 0; d0 < 2; ++d0)
#pragma unroll
                for (int r = 0; r < 16; ++r) { const float x = o[d0][r] * inv - A.lam_full * xch[(d0 * 16 + r) * 64]; o[d0][r] = x; ss += x * x; }
            ss += __shfl_xor(ss, 32);
            const float rs = (1.0f / sqrtf(ss * (1.f / 64.f) + EPS)) * A.one_m_li;
#pragma unroll
            for (int d0 = 0; d0 < 2; ++d0)
#pragma unroll
                for (int g4 = 0; g4 < 4; ++g4) {
                    const int dd = 32 * d0 + 8 * g4 + 4 * hi;
                    const f32x4 gg = *(const f32x4*)(A.subg + dd);
                    const float rs8 = rs * F8_SM;
                    W8[d0][g4] = (unsigned)__builtin_amdgcn_cvt_pk_fp8_f32(o[d0][4 * g4 + 2] * rs8 * gg[2], o[d0][4 * g4 + 3] * rs8 * gg[3], __builtin_amdgcn_cvt_pk_fp8_f32(o[d0][4 * g4 + 0] * rs8 * gg[0], o[d0][4 * g4 + 1] * rs8 * gg[1], 0, false), true);
                }
            store_rows();
        }
    } else {
#pragma unroll
        for (int d0 = 0; d0 < 2; ++d0)
#pragma unroll
            for (int g4 = 0; g4 < 4; ++g4) {
                const float inv8 = inv * F8_SM;
                W8[d0][g4] = (unsigned)__builtin_amdgcn_cvt_pk_fp8_f32(o[d0][4 * g4 + 2] * inv8, o[d0][4 * g4 + 3] * inv8, __builtin_amdgcn_cvt_pk_fp8_f32(o[d0][4 * g4 + 0] * inv8, o[d0][4 * g4 + 1] * inv8, 0, false), true);
            }
        store_rows();
    }
    __syncthreads();
}
__device__ __forceinline__ void attn_phase(Frame& F, const Args& a, int l) {
    unsigned char* ws = F.ws;
    AttnPtrs A;
    A.P = (const bf16_t*)(ws + WS_P); A.QM = (const bf16_t*)(ws + WS_QM); A.KVM = (const bf16_t*)(ws + WS_KVM); A.MIX = (unsigned char*)(ws + WS_MIX);
    A.sink = a.in[14] + l * 8; A.subg = a.in[13] + l * 64;
    A.lam_full = ((const float*)(ws + WS_CTL))[CW_LAM + l]; A.one_m_li = 1.0f - a.lam_init[l];
    const int n1 = NB * 4 * 8, n2 = n1 + NB * 4 * 16, n3 = n2 + NB * 8 * 8;
    const int n4 = (l == NL - 1) ? n3 : n3 + NB * 4, n5 = (l == NL - 1) ? n3 : n4 + NB * 4 * 2, n6 = (l == NL - 1) ? n3 : n5 + NB * 8;
    unsigned* ctr = (unsigned*)(ws + WS_CTL) + CW_ATTQ + l;
    volatile LAS unsigned* qslot = (volatile LAS unsigned*)(F.lds + MISC_OFF + 1024);
#ifndef ATT_DUP
#define ATT_DUP 0
#endif
    const int ndup = ATT_DUP == 1 ? n1 : (ATT_DUP == 2 ? n2 - n1 : (ATT_DUP == 3 ? n3 - n2 : 0));
    const int nconv = CONV_NCHUNK, total = n6 + nconv + ndup;
    if (opaque_tid() == 0) qslot[0] = atomicAdd(ctr, 1u);
    __syncthreads();
    int u = (int)qslot[0];
    while (u < total) {
        unsigned nxt = 0u;
        if (opaque_tid() == 0) nxt = atomicAdd((unsigned*)(ws + WS_CTL) + CW_ATTQ + l, 1u);
        if ((u & 3) == 3 && (u >> 2) < nconv) {
            nxt = (unsigned)__builtin_amdgcn_readfirstlane((int)nxt);
            const int ch = u >> 2, base = l * FAST_PER_LAYER + ch * CONV_CHUNK;
            fast_convert(F, a, opaque_tid(), base, base + CONV_CHUNK, F.wave, NWAVES);
        } else {
            int ua = u - min(nconv, u >> 2);
            if (ua >= n6) ua = (ATT_DUP == 1 ? 0 : (ATT_DUP == 2 ? n1 : n2)) + (ua - n6);
            int kind, ub, uh, uq;
            if (ua < n1) { kind = 0; ub = ua >> 5; uh = (ua >> 3) & 3; uq = 1 + (ua & 7); }
            else if (ua < n2) { const int v = ua - n1; kind = 1; ub = v >> 6; uh = (v >> 4) & 3; uq = 2 + (v & 15); }
            else if (ua < n3) { const int v = ua - n2; kind = 2; ub = v >> 6; uh = (v >> 3) & 7; uq = 1 + (v & 7); }
            else if (ua < n4) { const int v = ua - n3; kind = 0; ub = v >> 2; uh = v & 3; uq = 0; }
            else if (ua < n5) { const int v = ua - n4; kind = 1; ub = v >> 3; uh = (v >> 1) & 3; uq = v & 1; }
            else { const int v = ua - n5; kind = 2; ub = v >> 3; uh = v & 7; uq = 0; }
            if (kind == 0) attn_unit<0>(A, ub, uh, uq, F.lds, nxt);
            else if (kind == 1) attn_unit<1>(A, ub, uh, uq, F.lds, nxt);
            else attn_unit<2>(A, ub, uh, uq, F.lds, nxt);
        }
        if (opaque_tid() == 0) qslot[0] = nxt;
        __syncthreads();
        u = (int)qslot[0];
    }
}

constexpr int PH_PER_LAYER = 8, N_PHASES = 2 + NL * PH_PER_LAYER;
__global__ void __launch_bounds__(NTHR, 2) trunk_fwd(Args args) {
    extern __shared__ __attribute__((aligned(16))) unsigned char lds_raw[];
    Frame F;
    F.lds = (LAS unsigned char*)lds_raw; F.ws = args.ws;
    F.tid = threadIdx.x; F.lane = F.tid & 63; F.wave = __builtin_amdgcn_readfirstlane(F.tid >> 6);
    F.G = gridDim.x; { const int bx = blockIdx.x; F.vcu = (F.G % 8 == 0) ? (bx % 8) * (F.G / 8) + bx / 8 : bx; }
    volatile LAS unsigned* MISC = (volatile LAS unsigned*)(F.lds + MISC_OFF);
    if (F.tid < 64) MISC[F.tid] = 0u;
    __syncthreads();
    const int lo = args.ph_lo, hi = args.ph_hi;
    const bool multi = (hi - lo) > 1;
    XcdBarrier bar; bar.bar = (unsigned*)(F.ws + WS_CTL) + CW_BAR; bar.x = 0; bar.st = MISC;
    if (multi) bar = xcd_barrier_post((unsigned*)(F.ws + WS_CTL) + CW_BAR, MISC);
    unsigned char* ws = F.ws;
#ifndef DIAG_KINDS
#define DIAG_KINDS 0x3ff
#endif
#ifndef REP_PRO
#define REP_PRO 1
#define REP_WIN 1
#define REP_UP 1
#define REP_ATT 1
#define REP_GU 1
#define REP_DOWN 1
#endif
#define KON(x) (((DIAG_KINDS) >> (x)) & 1)
#define IN(k) (lo <= (k) && (k) < hi)
#define SEAM(k) do { if (IN(k) && IN((k) + 1)) xcd_barrier(bar); } while (0)
    if (KON(0) && IN(0)) { asm volatile("; PHASE_MARK 0"); for (int rep = 0; rep < REP_PRO; ++rep) prologue_phase(F, args); }
    SEAM(0);
    for (int l = 0; l < NL; ++l) {
        const int pb = 1 + l * PH_PER_LAYER;
        const bool last = (l == NL - 1);
        if (KON(1) && IN(pb + 0)) { asm volatile("; PHASE_MARK 1");
#ifndef REP_N1
#define REP_N1 1
#endif
            for (int rep = 1; rep < REP_N1; ++rep) norm1_phase<0, false>(F, args, l, true);
            if (l == 0) norm1_phase<0, true>(F, args, l); else norm1_phase<0, false>(F, args, l); }
        SEAM(pb + 0);
        const bool chain = (F.G == 256);
        const pg8::ChainMap CM{(int)blockIdx.x & 7, (int)blockIdx.x >> 3};
        if (KON(2) && IN(pb + 1)) { asm volatile("; PHASE_MARK 2");
            pg8::EpiWin E{(bf16_t*)(ws + WS_P), (float*)(ws + WS_SSQ), (const float*)(ws + WS_ROPER), (const float*)(ws + WS_ROPEW)};
            if (chain) {
                pg8::WinChainSched S{(const char*)(ws + WS_H), (const char*)(ws + WS_WIN) + (size_t)l * PW * D, D / 2, D / 2, CM};
                for (int rep = 0; rep < REP_WIN; ++rep) pg8::gemm_phase<pg8::EpiWin, pg8::WinChainSched, true, true>(F.lds, D / 2, D / 2, D / 2, S, E);
            } else {
                pg8::DenseSched S{(const char*)(ws + WS_H), (const char*)(ws + WS_WIN) + (size_t)l * PW * D, D / 2, D / 2, NPAN, PW / 256, F.G, (int)blockIdx.x, 0};
                for (int rep = 0; rep < REP_WIN; ++rep) pg8::gemm_phase<pg8::EpiWin, pg8::DenseSched, true, true>(F.lds, D / 2, D / 2, D / 2, S, E);
            }
        }
        if (!chain) SEAM(pb + 1);
        else {
            __builtin_amdgcn_fence(__ATOMIC_ACQUIRE, "agent"); asm volatile("s_waitcnt vmcnt(0)" ::: "memory"); __syncthreads();
        }
        if (KON(3) && IN(pb + 2)) { asm volatile("; PHASE_MARK 3");
            pg8::EpiUp E{(bf16_t*)(ws + WS_QM), (bf16_t*)(ws + WS_KVM), (const float*)(ws + WS_SSQ), (const float*)(ws + WS_ROPER)};
            if (chain) {
                pg8::UpChainSched S{(const char*)(ws + WS_P), (const char*)(ws + WS_WUQ) + (size_t)l * 512 * 256 * 2, (const char*)(ws + WS_WUKV) + (size_t)l * 512 * 256 * 2, CM};
                for (int rep = 0; rep < REP_UP; ++rep) pg8::gemm_phase<pg8::EpiUp, pg8::UpChainSched, true>(F.lds, 256, PW, 256, S, E);
            } else {
                pg8::UpSched S{(const char*)(ws + WS_P), (const char*)(ws + WS_WUQ) + (size_t)l * 512 * 256 * 2, (const char*)(ws + WS_WUKV) + (size_t)l * 512 * 256 * 2, F.G, (int)blockIdx.x};
                for (int rep = 0; rep < REP_UP; ++rep) pg8::gemm_phase<pg8::EpiUp, pg8::UpSched, true>(F.lds, 256, PW, 256, S, E);
            }
        }
        SEAM(pb + 2);
        if (KON(4) && IN(pb + 3)) { asm volatile("; PHASE_MARK 4"); for (int rep = 0; rep < REP_ATT; ++rep) attn_phase(F, args, l); }
        SEAM(pb + 3);
        if (KON(5) && IN(pb + 4)) { asm volatile("; PHASE_MARK 5");
            pg8::DenseSched S{(const char*)(ws + WS_MIX), (const char*)(ws + WS_WOUT) + (size_t)l * D * D, D / 2, D / 2, last ? NB * 8 : NPAN, D / 256, F.G, (int)blockIdx.x, last ? 1 : 0};
            pg8::EpiWout E{(bf16_t*)(ws + WS_X), (const float*)(ws + WS_MOD) + (size_t)l * 17 * 6144};
            pg8::gemm_phase<pg8::EpiWout, pg8::DenseSched, true, true>(F.lds, D / 2, D / 2, D / 2, S, E);
        }
        SEAM(pb + 4);
        if (KON(6) && IN(pb + 5)) { asm volatile("; PHASE_MARK 6"); norm2_router_phase(F, args, l); }
        SEAM(pb + 5);
        if (KON(7) && IN(pb + 6)) { asm volatile("; PHASE_MARK 7");
            load_counts(F, l);
            pg8::MoeSched<true> S{(const char*)(ws + WS_H), (const char*)(ws + WS_WGU) + (size_t)l * NE * 2048 * D, (const int*)(ws + WS_SLOTTOK),
                                  (volatile LAS int*)(F.lds + MISC_OFF + 256), (volatile LAS int*)(F.lds + MISC_OFF + 512), 8, F.G, (int)blockIdx.x, (size_t)2048 * D, opaque_tid() & 31};
            pg8::EpiGateUp E{(unsigned char*)(ws + WS_ACT), args.in[20] + (size_t)l * NE * D, args.in[22] + (size_t)l * NE * D};
            for (int rep = 0; rep < REP_GU; ++rep) pg8::gemm_phase<pg8::EpiGateUp, pg8::MoeSched<true>, true, true>(F.lds, D / 2, D / 2, D / 2, S, E);
        }
        SEAM(pb + 6);
        if (KON(8) && IN(pb + 7)) { asm volatile("; PHASE_MARK 8");
            load_counts(F, l);
            pg8::MoeSched<false> S{(const char*)(ws + WS_ACT), (const char*)(ws + WS_WD) + (size_t)l * NE * D * D, (const int*)(ws + WS_SLOTTOK),
                                   (volatile LAS int*)(F.lds + MISC_OFF + 256), (volatile LAS int*)(F.lds + MISC_OFF + 512), 4, F.G, (int)blockIdx.x, (size_t)D * D, opaque_tid() & 31};
            pg8::EpiDown E{(bf16_t*)(ws + WS_Y), args.in[24] + (size_t)l * NE * D, (const float*)(ws + WS_SLOTW)};
            for (int rep = 0; rep < REP_DOWN; ++rep) pg8::gemm_phase<pg8::EpiDown, pg8::MoeSched<false>, true, true>(F.lds, D / 2, D / 2, D / 2, S, E);
        }
        SEAM(pb + 7);
    }
    if (KON(9) && IN(N_PHASES - 1)) { asm volatile("; PHASE_MARK 9"); norm1_phase<1, false>(F, args, NL); }
#undef IN
#undef SEAM
}

extern "C" void kernel_launch(void* const* d_in, const int* in_sizes, int n_in, void* d_out, int out_size, void* d_ws, size_t ws_size, hipStream_t stream) {
    static int grid = 0;
    if (grid == 0) {
        if (n_in != 26 || ws_size < WS_END) { fprintf(stderr, "kernel_launch: unexpected inputs (n_in %d, ws %zu)\n", n_in, ws_size); grid = -1; return; }
        int dev = 0, cus = 0, per_cu = 0;
        if (hipGetDevice(&dev) != hipSuccess || hipDeviceGetAttribute(&cus, hipDeviceAttributeMultiprocessorCount, dev) != hipSuccess) { grid = -1; return; }
        if (hipFuncSetAttribute((const void*)trunk_fwd, hipFuncAttributeMaxDynamicSharedMemorySize, LDS_BYTES) != hipSuccess) { fprintf(stderr, "kernel_launch: hipFuncSetAttribute failed\n"); grid = -1; return; }
        if (hipOccupancyMaxActiveBlocksPerMultiprocessor(&per_cu, (const void*)trunk_fwd, NTHR, LDS_BYTES) != hipSuccess || per_cu < 1)
            fprintf(stderr, "kernel_launch: occupancy query reports %d workgroups per CU\n", per_cu);
        (void)hipGetLastError();
        grid = cus;
    }
    if (grid < 0) return;
    if (hipMemsetAsync((char*)d_ws + WS_CTL, 0, CTL_ZERO_BYTES, stream) != hipSuccess) return;
    Args a{};
    for (int i = 0; i < 26; ++i) a.in[i] = (const float*)d_in[i];
    a.out = (float*)d_out; a.ws = (unsigned char*)d_ws;
    for (int i = 0; i < 8; ++i) a.invf8[i] = pow(10000.0, -(double)i / 8.0);
    for (int i = 0; i < 16; ++i) a.invf16[i] = pow(10000.0, -(double)i / 16.0);
    for (int i = 0; i < 4; ++i) a.lam_init[i] = (float)(0.8 - 0.6 * exp(-0.3 * (double)i));
#if MK_ONE_LAUNCH
    a.ph_lo = 0; a.ph_hi = N_PHASES;
    hipLaunchKernelGGL(trunk_fwd, dim3(grid), dim3(NTHR), LDS_BYTES, stream, a);
#else
    for (int p = 0; p < N_PHASES; ++p) { a.ph_lo = p; a.ph_hi = p + 1; hipLaunchKernelGGL(trunk_fwd, dim3(grid), dim3(NTHR), LDS_BYTES, stream, a); }
#endif
}
```

```cpp
#include <hip/hip_runtime.h>
#include <cstdio>
#include <cstdint>
#include <cmath>

#ifndef MK_ONE_LAUNCH
#define MK_ONE_LAUNCH 1
#endif

#define LAS __attribute__((address_space(3)))
#define GAS __attribute__((address_space(1)))
typedef unsigned short bf16_t;
typedef short bf16x8 __attribute__((ext_vector_type(8)));
typedef short v4i16_t __attribute__((ext_vector_type(4)));
typedef float f32x4 __attribute__((ext_vector_type(4)));
typedef float f32x2 __attribute__((ext_vector_type(2)));
typedef float f32x16 __attribute__((ext_vector_type(16)));
typedef unsigned u32x4 __attribute__((ext_vector_type(4)));
typedef unsigned u32x2 __attribute__((ext_vector_type(2)));
typedef __bf16 bf16x2_t __attribute__((ext_vector_type(2)));

constexpr int NB = 16, SEQ = 2048, CTX = 256, NTK = SEQ + CTX, T = NB * NTK, D = 1024, NL = 4, NE = 32;
constexpr int PW = 2048;
constexpr int NPAN = T / 256;
constexpr int MAXPAN = 608;
constexpr int NWAVES = 8, NTHR = 512;
constexpr float EPS = 1e-6f;
constexpr float LOG2E = 1.4426950408889634f;
constexpr float SC_MLA = 0.10206207261596577f * LOG2E;
constexpr float SC_DIFF = 0.17677669529663687f * LOG2E;
constexpr float SC_SWA = 0.125f * LOG2E;
constexpr float F8_SW = 64.0f, F8_SA = 4.0f;
constexpr float F8_INV = 1.0f / (F8_SW * F8_SA);
constexpr float F8_SM = 16.0f, F8_INVM = 1.0f / (F8_SW * F8_SM);
constexpr float F8_SY = 64.0f;

constexpr size_t MiB = 1u << 20;
constexpr size_t WS_CTL = 0, CTL_ZERO_BYTES = 1 * MiB;
constexpr size_t WS_MOD = 1 * MiB;
constexpr size_t WS_ROPER = 3 * MiB;
constexpr size_t WS_ROPEW = WS_ROPER + 262144;
constexpr size_t WS_SSQ = 4 * MiB;
constexpr size_t WS_TOKSLOT = 6 * MiB;
constexpr size_t WS_SLOTTOK = 7 * MiB;
constexpr size_t WS_SLOTW = 12 * MiB;
constexpr size_t WS_WR = 17 * MiB;
constexpr size_t WS_WUQ = 18 * MiB;
constexpr size_t WS_WUKV = 19 * MiB;
constexpr size_t WS_WIN = 20 * MiB;
constexpr size_t WS_WOUT = 36 * MiB;
constexpr size_t WS_WGU = 44 * MiB;
constexpr size_t WS_WD = 556 * MiB;
constexpr size_t WS_X = 812 * MiB;
constexpr size_t WS_H = 956 * MiB;
constexpr size_t WS_ACT = 1028 * MiB;
constexpr size_t WS_P = WS_ACT;
constexpr size_t WS_QM = WS_ACT + 144 * MiB;
constexpr size_t WS_KVM = WS_ACT + 171 * MiB;
constexpr size_t WS_MIX = WS_ACT + 207 * MiB;
constexpr size_t WS_Y = 1332 * MiB;
constexpr size_t WS_END = 1636 * MiB;
constexpr int CW_LAM = 64;
constexpr int CW_ATTQ = 2048;
constexpr int CW_CUR = 1024;
constexpr int CW_BAR = 4096;

constexpr int RING_BYTES = 131072;
constexpr int MISC_OFF = RING_BYTES;
constexpr int GOFF_OFF = RING_BYTES + 4096;
constexpr int LCONST_OFF = RING_BYTES + 4096 + 8192;
constexpr int LDS_BYTES = RING_BYTES + 4096 + 8192 + 8192;

__device__ __forceinline__ unsigned cvtpk(float lo, float hi) { f32x2 v = {lo, hi}; bf16x2_t b = __builtin_convertvector(v, bf16x2_t); return __builtin_bit_cast(unsigned, b); }
__device__ __forceinline__ float bf2f(unsigned short b) { return __uint_as_float(((unsigned)b) << 16); }
__device__ __forceinline__ float bflo(unsigned w) { return __uint_as_float(w << 16); }
__device__ __forceinline__ float bfhi(unsigned w) { return __uint_as_float(w & 0xffff0000u); }
__device__ __forceinline__ float wave_sum(float v) {
#pragma unroll
    for (int o = 1; o < 64; o <<= 1) v += __shfl_xor(v, o);
    return v;
}
__device__ __forceinline__ int opaque_tid() { int t = threadIdx.x; asm volatile("" : "+v"(t)); return t; }
__device__ __forceinline__ int il(int i, int hd) { return (i & 1) ? (i >> 1) + (hd >> 1) : (i >> 1); }

#define XB_TMO      128
#define XB_XCNT(j)  (256  + 64 * (j))
#define XB_XSUB(j)  (1280 + 64 * (j))
#define XB_XGEN(j)  (2304 + 64 * (j))
#define XB_TOP      3328
#define XB_TOPGEN   3392
#define XCD_BAR_WORDS 3456
#define XB_SPIN_CAP (1u << 20)
__device__ __forceinline__ unsigned xb_ld(unsigned* p)              { return __hip_atomic_load(p, __ATOMIC_RELAXED, __HIP_MEMORY_SCOPE_AGENT); }
__device__ __forceinline__ unsigned xb_add(unsigned* p, unsigned v) { return __hip_atomic_fetch_add(p, v, __ATOMIC_RELAXED, __HIP_MEMORY_SCOPE_AGENT); }
__device__ __forceinline__ unsigned xb_xcc_id() { return (unsigned)__builtin_amdgcn_s_getreg((3 << 11) | 20) & 0xFu; }
#define XB_SPIN(cond, bar) do { unsigned _sp = 0; while (cond) { __builtin_amdgcn_s_sleep(1); \
    if ((++_sp & 255u) == 0u) { if (xb_ld(&(bar)[XB_TMO])) break; if (_sp > XB_SPIN_CAP) { atomicAdd(&(bar)[XB_TMO], 1u); break; } } } } while (0)
struct XcdBarrier { unsigned* bar; unsigned x; volatile LAS unsigned* st; };
__device__ __forceinline__ XcdBarrier xcd_barrier_post(unsigned* bar, volatile LAS unsigned* st) {
    XcdBarrier b; b.bar = bar; b.x = xb_xcc_id(); b.st = st;
    if (threadIdx.x == 0) (void)xb_add(&bar[XB_XCNT(b.x)], 1u);
    return b;
}
__device__ __forceinline__ void xcd_barrier_complete(unsigned* bar, unsigned x, unsigned& nloc, unsigned& nx) {
    const unsigned G = gridDim.x * gridDim.y * gridDim.z;
    unsigned sum, cnt, mine, sp = 0u;
    for (;;) {
        sum = 0u; cnt = 0u; mine = 0u;
#pragma unroll
        for (unsigned j = 0; j < 16; ++j) { const unsigned c = xb_ld(&bar[XB_XCNT(j)]); sum += c; cnt += (c > 0u) ? 1u : 0u; mine = (j == x) ? c : mine; }
        if (sum == G) break;
        __builtin_amdgcn_s_sleep(1);
        if ((++sp & 255u) == 0u) { if (xb_ld(&bar[XB_TMO])) break; if (sp > XB_SPIN_CAP) { atomicAdd(&bar[XB_TMO], 1u); break; } }
    }
    nloc = mine > 0u ? mine : 1u; nx = cnt > 0u ? cnt : 1u;
}
__device__ __forceinline__ void xcd_barrier(const XcdBarrier& b) {
    asm volatile("s_waitcnt vmcnt(0)" ::: "memory");
    __syncthreads();
    if (threadIdx.x == 0) {
        unsigned* bar = b.bar;
        __builtin_amdgcn_s_waitcnt(0);
        unsigned nloc = b.st[0], nx = b.st[1];
        if (nloc == 0u) { xcd_barrier_complete(bar, b.x, nloc, nx); b.st[0] = nloc; b.st[1] = nx; }
        const unsigned old = xb_add(&bar[XB_XSUB(b.x)], 1u);
        const unsigned gen = old / nloc;
        if (old + 1u == (gen + 1u) * nloc) {
            __builtin_amdgcn_fence(__ATOMIC_RELEASE, "agent");
            asm volatile("s_waitcnt vmcnt(0)" ::: "memory");
            const unsigned og = xb_add(&bar[XB_TOP], 1u);
            const unsigned tg = og / nx;
            if (og + 1u == (tg + 1u) * nx) xb_add(&bar[XB_TOPGEN], 1u);
            else XB_SPIN(xb_ld(&bar[XB_TOPGEN]) == tg, bar);
            __builtin_amdgcn_fence(__ATOMIC_ACQUIRE, "agent");
            xb_add(&bar[XB_XGEN(b.x)], 1u);
            asm volatile("s_waitcnt vmcnt(0)" ::: "memory");
        } else {
            XB_SPIN(xb_ld(&bar[XB_XGEN(b.x)]) == gen, bar);
            __builtin_amdgcn_fence(__ATOMIC_ACQUIRE, "agent");
            asm volatile("s_waitcnt vmcnt(0)" ::: "memory");
        }
    }
    __syncthreads();
}

struct Args {
    const float* in[26];
    float* out; unsigned char* ws;
    double invf8[8]; double invf16[16];
    float lam_init[4];
    int ph_lo, ph_hi;
};
struct Frame {
    LAS unsigned char* lds;
    unsigned char* ws;
    int tid, lane, wave, vcu, G;
};

namespace pg8 {
constexpr int BM = 256, BK = 64, HALF = 128, HTB = HALF * BK * 2, STAGE_BYTES = 8 * HTB;
__host__ __device__ __forceinline__ int lds_byte(int r, int c) { const int st = (r >> 4) * 2 + (c >> 5), rr = r & 15, cc = c & 31, ob = rr * 64 + cc * 2; return st * 1024 + (ob ^ (((ob >> 9) & 1) << 5)); }
__host__ __device__ __forceinline__ void stage_rc(int b, int& R, int& C) { const int st = b / 1024, sb = b % 1024, swz = sb ^ (((sb >> 9) & 1) << 5); R = (st >> 1) * 16 + swz / 64; C = (st & 1) * 32 + (swz % 64) / 2; }
__host__ __device__ __forceinline__ int perm32(int rho) { const int n = rho >> 4, i = rho & 15; return 8 * (i >> 2) + 4 * n + (i & 3); }

typedef int v8i32 __attribute__((ext_vector_type(8)));
typedef int u32x4i __attribute__((ext_vector_type(4)));
__device__ __forceinline__ v8i32 pk8(bf16x8 lo, bf16x8 hi) { const u32x4 a = __builtin_bit_cast(u32x4, lo), b = __builtin_bit_cast(u32x4, hi); return (v8i32){(int)a.x, (int)a.y, (int)a.z, (int)a.w, (int)b.x, (int)b.y, (int)b.z, (int)b.w}; }
struct Unit { const char* a; const char* b; int pm, pn, e, j, cnt; };

template <class Epi, class Sched, bool ALIGN_EPI, bool FP8 = false>
__device__ __forceinline__ void gemm_phase(LAS unsigned char* lds, const int K, const int lda, const int ldb, const Sched& S, const Epi& E) {
    const int tid = opaque_tid(), wid = __builtin_amdgcn_readfirstlane(tid >> 6), lane = tid & 63, wr = wid >> 2, wc = wid & 3, fr = lane & 15, fq = lane >> 4;
    const int nt = K / BK;
    int Rs[2], Cs[2]; unsigned voffBp[2];
#pragma unroll
    for (int i = 0; i < 2; ++i) { int R, C; stage_rc(tid * 16 + i * 8192, R, C); Rs[i] = R; Cs[i] = C; const int Rb = Epi::PERM ? ((R & ~31) + perm32(R & 31)) : R; voffBp[i] = (unsigned)(Rb * ldb + C) * 2u; }
    const size_t kstep = (size_t)(BK * 2);
    const size_t hstepB = (size_t)HALF * ldb * 2;
    const unsigned ldsw = (unsigned)wid * 1024u;
#define PG8_SA(b, h) (((b) * 2 + (h)) * HTB)
#define PG8_SB(b, h) ((4 + (b) * 2 + (h)) * HTB)
#define PG8_STAGE2(bufoff, gbase, o0, o1) do { \
        __builtin_amdgcn_global_load_lds((const unsigned*)((const char*)(gbase) + (o0)), (LAS unsigned*)(lds + (bufoff) + ldsw), 16, 0, 0); \
        __builtin_amdgcn_global_load_lds((const unsigned*)((const char*)(gbase) + (o1)), (LAS unsigned*)(lds + (bufoff) + ldsw + 8192), 16, 0, 0); } while (0)
#define PG8_STAGEB(bufoff, gbase) PG8_STAGE2(bufoff, gbase, voffB[0], voffB[1])
#define PG8_STAGEBP(bufoff, gbase) PG8_STAGE2(bufoff, gbase, voffBp[0], voffBp[1])
#define PG8_LD32(p) __builtin_shufflevector(*(const LAS u32x4i*)(p), *(const LAS u32x4i*)((p) + 1024), 0, 1, 2, 3, 4, 5, 6, 7)
#define PG8_LDA(dst, b, h) do { if constexpr (FP8) { _Pragma("unroll") for (int m = 0; m < 4; ++m) dst##8[m] = PG8_LD32(lds + PG8_SA(b, h) + aoff + m * 2048); } \
        else { _Pragma("unroll") for (int m = 0; m < 4; ++m) _Pragma("unroll") for (int k = 0; k < 2; ++k) dst[m][k] = *(const LAS bf16x8*)(lds + PG8_SA(b, h) + aoff + m * 2048 + k * 1024); } } while (0)
#define PG8_LDB(dst, b, h) do { if constexpr (FP8) { _Pragma("unroll") for (int n = 0; n < 2; ++n) dst##8[n] = PG8_LD32(lds + PG8_SB(b, h) + boff + n * 2048); } \
        else { _Pragma("unroll") for (int n = 0; n < 2; ++n) _Pragma("unroll") for (int k = 0; k < 2; ++k) dst[n][k] = *(const LAS bf16x8*)(lds + PG8_SB(b, h) + boff + n * 2048 + k * 1024); } } while (0)
  \

#define PG8_MMA(ai, bj, At, Bt) do { __builtin_amdgcn_s_setprio(1); _Pragma("unroll") for (int m = 0; m < 4; ++m) _Pragma("unroll") for (int n = 0; n < 2; ++n) { \
        if constexpr (FP8) { asm volatile("v_mfma_scale_f32_16x16x128_f8f6f4 %0, %1, %2, %0, %3, %3 op_sel_hi:[0,0,0]" : "+v"(acc[ai][bj][m][n]) : "v"(Bt##8[n]), "v"(At##8[m]), "v"(f8scale)); } \
        else { _Pragma("unroll") for (int k = 0; k < 2; ++k) acc[ai][bj][m][n] = __builtin_amdgcn_mfma_f32_16x16x32_bf16(Bt[n][k], At[m][k], acc[ai][bj][m][n], 0, 0, 0); } } \
        __builtin_amdgcn_s_setprio(0); } while (0)
#define PG8_WAIT_V(n) asm volatile("s_waitcnt vmcnt(" #n ")" ::: "memory")
#define PG8_WAIT_L(n) asm volatile("s_waitcnt lgkmcnt(" #n ")" ::: "memory")
#define PG8_BAR __builtin_amdgcn_s_barrier()
#define PG8_SCHED __builtin_amdgcn_sched_barrier(0)
    Unit cur, nxt; int ui = 0;
    if (!S.next(0, cur)) return;
    f32x4 acc[2][2][4][2];
#pragma unroll
    for (int a = 0; a < 2; ++a)
#pragma unroll
        for (int b = 0; b < 2; ++b)
#pragma unroll
            for (int m = 0; m < 4; ++m)
#pragma unroll
                for (int n = 0; n < 2; ++n) acc[a][b][m][n] = (f32x4){0.f, 0.f, 0.f, 0.f};
    bf16x8 At[4][2], B0[2][2], B1[2][2]; v8i32 At8[4], B08[2], B18[2];
    unsigned vc00, vc01, vc10, vc11, vn00, vn01, vn10, vn11;
    vc00 = (unsigned)(S.arow(cur, Rs[0]) * lda + Cs[0]) * 2u; vc01 = (unsigned)(S.arow(cur, Rs[1]) * lda + Cs[1]) * 2u;
    vc10 = (unsigned)(S.arow(cur, HALF + Rs[0]) * lda + Cs[0]) * 2u; vc11 = (unsigned)(S.arow(cur, HALF + Rs[1]) * lda + Cs[1]) * 2u;
    const char* cA = cur.a; const char* cB = cur.b;
    { const int t3_ = opaque_tid(), l3_ = t3_ & 63, fr3_ = l3_ & 15, fq3_ = l3_ >> 4; u32x4 lc_;
      { int R, C; stage_rc(t3_ * 16, R, C); const int Rb = Epi::PERM ? ((R & ~31) + perm32(R & 31)) : R; lc_.x = (unsigned)(Rb * ldb + C) * 2u; }
      { int R, C; stage_rc(t3_ * 16 + 8192, R, C); const int Rb = Epi::PERM ? ((R & ~31) + perm32(R & 31)) : R; lc_.y = (unsigned)(Rb * ldb + C) * 2u; }
      lc_.z = (unsigned)lds_byte(wr * 64 + fr3_, fq3_ * 8); lc_.w = (unsigned)lds_byte(wc * 32 + fr3_, fq3_ * 8);
      *(LAS u32x4*)(lds + LCONST_OFF + (t3_ << 4)) = lc_; }
    PG8_STAGEBP(PG8_SB(0, 0), cB); PG8_STAGEBP(PG8_SB(0, 1), cB + hstepB); PG8_STAGE2(PG8_SA(0, 0), cA, vc00, vc01); PG8_STAGE2(PG8_SA(0, 1), cA, vc10, vc11);
    if (wr == 1) PG8_BAR;
    PG8_WAIT_V(2); PG8_BAR;
    PG8_STAGEBP(PG8_SB(1, 0), cB + kstep); PG8_STAGE2(PG8_SA(1, 0), cA + kstep, vc00, vc01); PG8_STAGEBP(PG8_SB(1, 1), cB + hstepB + kstep);
    PG8_WAIT_V(6); PG8_BAR;
    bool has_next = S.next(1, nxt);
    if (Sched::GATHER && has_next) {
        int R0, C0, R1, C1; { const int t2_ = opaque_tid(); stage_rc(t2_ * 16, R0, C0); stage_rc(t2_ * 16 + 8192, R1, C1); }
        LAS unsigned* gp = (LAS unsigned*)(lds + GOFF_OFF) + (opaque_tid() << 2);
        gp[0] = (unsigned)(S.arow(nxt, R0) * lda + C0) * 2u; gp[1] = (unsigned)(S.arow(nxt, R1) * lda + C1) * 2u;
        gp[2] = (unsigned)(S.arow(nxt, HALF + R0) * lda + C0) * 2u; gp[3] = (unsigned)(S.arow(nxt, HALF + R1) * lda + C1) * 2u;
    }
    for (;;) {
        const char* nA = has_next ? nxt.a : cA; const char* nB = has_next ? nxt.b : cB;
        vn00 = vc00; vn01 = vc01; vn10 = vc10; vn11 = vc11;
#ifndef KREP
#define KREP 1
#endif
        constexpr int krep = (FP8 && Epi::PROBE) ? KREP : 1;
#pragma unroll 1
        for (int tq = 0; tq < krep * nt; tq += 2) {
            const int t = tq % nt;
            const bool last = (tq == krep * nt - 2);
            const int f8scale = (tq < nt) ? 0x7F7F7F7F : 0;
            unsigned voffB[2]; int aoff, boff;
            { const u32x4 lc_ = *(const LAS u32x4*)(lds + LCONST_OFF + (opaque_tid() << 4)); voffB[0] = lc_.x; voffB[1] = lc_.y; aoff = (int)lc_.z; boff = (int)lc_.w; }
            if (Sched::GATHER && last) { const LAS unsigned* gp = (const LAS unsigned*)(lds + GOFF_OFF) + (opaque_tid() << 2); vn00 = gp[0]; vn01 = gp[1]; vn10 = gp[2]; vn11 = gp[3]; }
            const char* a1 = cA + (size_t)(t + 1) * kstep;
            const char* a2 = last ? nA : cA + (size_t)((t + 2) % nt) * kstep; const char* b2 = last ? nB : cB + (size_t)((t + 2) % nt) * kstep;
            const char* a3 = a2 + kstep; const char* b3 = b2 + kstep;
            const unsigned w00 = (Sched::GATHER && last) ? vn00 : vc00, w01 = (Sched::GATHER && last) ? vn01 : vc01, w10 = (Sched::GATHER && last) ? vn10 : vc10, w11 = (Sched::GATHER && last) ? vn11 : vc11;
            const bool relax = (Epi::NST > 0) && (tq == 0) && (ui > 0);
            PG8_LDB(B0, 0, 0); PG8_LDB(B1, 0, 1); PG8_SCHED; PG8_LDA(At, 0, 0); PG8_STAGE2(PG8_SA(1, 1), a1, vc10, vc11);
            if (relax) asm volatile("s_waitcnt vmcnt(%0)" :: "n"(8 + Epi::NST) : "memory"); else PG8_WAIT_V(8);
            PG8_WAIT_L(0); PG8_BAR; PG8_MMA(0, 0, At, B0); PG8_MMA(0, 1, At, B1); PG8_BAR; PG8_SCHED;
            PG8_LDA(At, 0, 1); PG8_STAGEB(PG8_SB(0, 0), b2); PG8_STAGEB(PG8_SB(0, 1), b2 + hstepB); PG8_STAGE2(PG8_SA(0, 0), a2, w00, w01);
            if (relax) asm volatile("s_waitcnt vmcnt(%0)" :: "n"(8 + Epi::NST) : "memory"); else PG8_WAIT_V(8);
            PG8_WAIT_L(0); PG8_BAR; PG8_MMA(1, 0, At, B0); PG8_MMA(1, 1, At, B1); PG8_BAR; PG8_SCHED;
            PG8_LDB(B0, 1, 0); PG8_LDB(B1, 1, 1); PG8_SCHED; PG8_LDA(At, 1, 0); PG8_STAGE2(PG8_SA(0, 1), a2, w10, w11);
            PG8_WAIT_V(8); PG8_WAIT_L(0); PG8_BAR; PG8_MMA(0, 0, At, B0); PG8_MMA(0, 1, At, B1); PG8_BAR; PG8_SCHED;
            PG8_LDA(At, 1, 1); PG8_STAGEB(PG8_SB(1, 0), b3); PG8_STAGEB(PG8_SB(1, 1), b3 + hstepB); PG8_STAGE2(PG8_SA(1, 0), a3, w00, w01);
            PG8_WAIT_V(8); PG8_WAIT_L(0); PG8_BAR; PG8_MMA(1, 0, At, B0); PG8_MMA(1, 1, At, B1); PG8_BAR; PG8_SCHED;
        }
        Unit nn; bool has_nn = has_next && S.next(ui + 2, nn);
        int gt0 = 0, gt1 = 0, gt2 = 0, gt3 = 0;
        if constexpr (Sched::GATHER) if (has_nn) {
            int R0, C0, R1, C1; { const int t2_ = opaque_tid(); stage_rc(t2_ * 16, R0, C0); stage_rc(t2_ * 16 + 8192, R1, C1); }
            gt0 = S.arow_raw(nn, R0); gt1 = S.arow_raw(nn, R1); gt2 = S.arow_raw(nn, HALF + R0); gt3 = S.arow_raw(nn, HALF + R1);
        }
        if constexpr (ALIGN_EPI) { if (wr == 0) PG8_BAR; }
#ifndef REP_EPI
#define REP_EPI 1
#endif
        if constexpr (FP8) asm volatile("s_nop 15\n\ts_nop 15" ::: "memory");
        { const int l2_ = opaque_tid() & 63; for (int rep_ = 0; rep_ < (Epi::PROBE ? REP_EPI : 1); ++rep_) E(acc, cur, wr, wc, l2_ & 15, l2_ >> 4); }
        if (!has_next) break;
#pragma unroll
        for (int a = 0; a < 2; ++a)
#pragma unroll
            for (int b = 0; b < 2; ++b)
#pragma unroll
                for (int m = 0; m < 4; ++m)
#pragma unroll
                    for (int n = 0; n < 2; ++n) { double z0_, z1_; asm volatile("v_mov_b64 %0, 0\n\tv_mov_b64 %1, 0" : "=v"(z0_), "=v"(z1_));
                        typedef double f64x2_t __attribute__((ext_vector_type(2))); const f64x2_t zz_ = {z0_, z1_}; acc[a][b][m][n] = __builtin_bit_cast(f32x4, zz_); }
        cur = nxt; cA = nA; cB = nB; ++ui; vc00 = vn00; vc01 = vn01; vc10 = vn10; vc11 = vn11;
        nxt = nn; has_next = has_nn;
        if constexpr (Sched::GATHER) asm volatile("" : "+v"(gt0), "+v"(gt1), "+v"(gt2), "+v"(gt3));
        if constexpr (Sched::GATHER) if (has_next) {
            int R0, C0, R1, C1; { const int t2_ = opaque_tid(); stage_rc(t2_ * 16, R0, C0); stage_rc(t2_ * 16 + 8192, R1, C1); }
            LAS unsigned* gp = (LAS unsigned*)(lds + GOFF_OFF) + (opaque_tid() << 2);
            gp[0] = (unsigned)(S.arow_fix(nxt, R0, gt0) * lda + C0) * 2u; gp[1] = (unsigned)(S.arow_fix(nxt, R1, gt1) * lda + C1) * 2u;
            gp[2] = (unsigned)(S.arow_fix(nxt, HALF + R0, gt2) * lda + C0) * 2u; gp[3] = (unsigned)(S.arow_fix(nxt, HALF + R1, gt3) * lda + C1) * 2u;
        }
        if constexpr (ALIGN_EPI) { if (wr == 1) PG8_BAR; }
    }
    PG8_WAIT_V(0);
    if constexpr (!ALIGN_EPI) { if (wr == 0) PG8_BAR; }
    PG8_BAR;
#undef PG8_SA
#undef PG8_SB
#undef PG8_STAGE2
#undef PG8_STAGEB
#undef PG8_LDA
#undef PG8_LD32
#undef PG8_LDB
#undef PG8_MMA
#undef PG8_WAIT_V
#undef PG8_WAIT_L
#undef PG8_BAR
#undef PG8_SCHED
}

__device__ __forceinline__ int xcd_remap(int L, int nwg) {
    const int q = nwg / 8, r = nwg % 8, xcd = L % 8, off = L / 8;
    return (xcd < r ? xcd * (q + 1) : r * (q + 1) + (xcd - r) * q) + off;
}

struct DenseSched {
    static constexpr bool GATHER = false;
    const char* A; const char* Bt; int lda, ldb, npan, nN, G, c, latent_only;
    __device__ __forceinline__ bool next(int i, Unit& u) const {
        const int L = i * G + c, nwg = npan * nN; if (L >= nwg) return false;
        const int w = xcd_remap(L, nwg), p = w / nN, pn = w % nN;
        const int pm = latent_only ? (p >> 3) * 9 + 1 + (p & 7) : p;
        u.pm = pm; u.pn = pn; u.e = 0; u.j = 0; u.cnt = 0;
        u.a = A + (size_t)pm * 256 * lda * 2; u.b = Bt + (size_t)pn * 256 * ldb * 2; return true;
    }
    __device__ __forceinline__ int arow(const Unit&, int r) const { return r; }
};
struct UpSched {
    static constexpr bool GATHER = false;
    const char* P; const char* Wuq; const char* Wukv; int G, c;
    __device__ __forceinline__ bool next(int i, Unit& u) const {
        const int L = i * G + c, nwg = NPAN * 4; if (L >= nwg) return false;
        const int w = xcd_remap(L, nwg), p = w >> 2, pn = w & 3;
        u.pm = p; u.pn = pn; u.e = 0; u.j = 0; u.cnt = 0;
        u.a = P + (size_t)p * 256 * PW * 2 + (pn >= 2 ? 512 : 0);
        u.b = (pn >= 2 ? Wukv : Wuq) + (size_t)(pn & 1) * 256 * 256 * 2; return true;
    }
    __device__ __forceinline__ int arow(const Unit&, int r) const { return r; }
};
struct ChainMap {
    int x, r;
    __device__ __forceinline__ int nchain() const { return r < 4 ? 2 : 1; }
    __device__ __forceinline__ int chain(int j) const { return r + 32 * j; }
    __device__ __forceinline__ int nplain() const { return r < 4 ? 1 : (r < 24 ? 4 : 3); }
    __device__ __forceinline__ int plain(int j) const { return r < 4 ? 56 + r : (j == 0 ? r - 4 : (j == 1 ? 24 + r : (j == 2 ? 56 + r : 84 + r))); }
};
struct WinChainSched {
    static constexpr bool GATHER = false;
    const char* A; const char* Bt; int lda, ldb; ChainMap M;
    __device__ __forceinline__ bool next(int i, Unit& u) const {
        const int nc = M.nchain(); if (i >= nc + M.nplain()) return false;
        int q, pn;
        if (i < nc) { const int ch = M.chain(i); q = ch >> 1; pn = ch & 1; } else { const int idx = M.plain(i - nc); q = idx / 6; pn = 2 + idx - q * 6; }
        const int pm = M.x + 8 * q;
        u.pm = pm; u.pn = pn; u.e = 0; u.j = 0; u.cnt = 0;
        u.a = A + (size_t)pm * 256 * lda * 2; u.b = Bt + (size_t)pn * 256 * ldb * 2; return true;
    }
    __device__ __forceinline__ int arow(const Unit&, int r) const { return r; }
};
struct UpChainSched {
    static constexpr bool GATHER = false;
    const char* P; const char* Wuq; const char* Wukv; ChainMap M;
    __device__ __forceinline__ bool next(int i, Unit& u) const {
        if (i >= 2 * M.nchain()) return false;
        const int ch = M.chain(i >> 1), q = ch >> 1, hf = ch & 1, pn = 2 * hf + (i & 1), pm = M.x + 8 * q;
        u.pm = pm; u.pn = pn; u.e = 0; u.j = 0; u.cnt = 0;
        u.a = P + (size_t)pm * 256 * PW * 2 + (hf ? 512 : 0);
        u.b = (hf ? Wukv : Wuq) + (size_t)(pn & 1) * 256 * 256 * 2; return true;
    }
    __device__ __forceinline__ int arow(const Unit&, int r) const { return r; }
};
template <bool GATHER_> struct MoeSched {
    static constexpr bool GATHER = GATHER_;
    const char* A; const char* Bt; const int* slot_tok; volatile LAS int* PB; volatile LAS int* CNT; int nN, G, c; size_t bexp; int ln;
    __device__ __forceinline__ bool next(int i, Unit& u) const {
        const int np = PB[32], nwg = np * nN; const int L = i * G + c; if (L >= nwg) return false;
        const int w = xcd_remap(L, nwg), p = w / nN, pn = w % nN;
        const unsigned long long bal = __ballot(PB[ln + 1] <= p);
        const int e = __builtin_popcount((unsigned)(bal & 0xffffffffull));
        u.pm = p; u.pn = pn; u.e = e; u.j = p - PB[e]; u.cnt = CNT[e];
        u.a = GATHER ? A : A + (size_t)p * 256 * D;
        u.b = Bt + (size_t)e * bexp + (size_t)pn * 256 * D; return true;
    }
    __device__ __forceinline__ int arow_raw(const Unit& u, int r) const { if constexpr (GATHER) return slot_tok[(size_t)u.e * T + min(u.j * 256 + r, u.cnt - 1)]; else return r; }
    __device__ __forceinline__ int arow_fix(const Unit& u, int r, int v) const { if constexpr (GATHER) return (u.j * 256 + r) < u.cnt ? v : 0; else return r; }
    __device__ __forceinline__ int arow(const Unit& u, int r) const {
        if constexpr (GATHER) { const int pos = u.j * 256 + r; const int v = slot_tok[(size_t)u.e * T + min(pos, u.cnt - 1)]; return pos < u.cnt ? v : 0; }
        else return r;
    }
};

__device__ __forceinline__ void rope4(f32x4& v0, f32x4& v1, const f32x4* tab) {
    const f32x4 t0 = tab[0], t1 = tab[1];
    f32x4 a, b;
    a[0] = v0[0] * t0[0] - v0[1] * t0[1]; a[1] = v0[1] * t0[0] + v0[0] * t0[1];
    a[2] = v0[2] * t0[2] - v0[3] * t0[3]; a[3] = v0[3] * t0[2] + v0[2] * t0[3];
    b[0] = v1[0] * t1[0] - v1[1] * t1[1]; b[1] = v1[1] * t1[0] + v1[0] * t1[1];
    b[2] = v1[2] * t1[2] - v1[3] * t1[3]; b[3] = v1[3] * t1[2] + v1[2] * t1[3];
    v0 = a; v1 = b;
}
__device__ __forceinline__ u32x4 pack8(const f32x4& v0, const f32x4& v1) { u32x4 w; w.x = cvtpk(v0[0], v0[1]); w.y = cvtpk(v0[2], v0[3]); w.z = cvtpk(v1[0], v1[1]); w.w = cvtpk(v1[2], v1[3]); return w; }

struct EpiWin {
    static constexpr bool PERM = true, PROBE = false; static constexpr int NST = 16;
    bf16_t* P; float* ssq; const float* ropeR; const float* ropeW;
    __device__ __forceinline__ void operator()(const f32x4 (&acc)[2][2][4][2], const Unit& u, int wr, int wc, int fr, int fq) const {
        const int pn = u.pn;
        int mode[2];
        mode[0] = (pn == 2 || pn == 3) ? 1 : ((pn == 5 || pn == 6 || pn == 7) ? 2 : 0);
        mode[1] = (pn == 2 || pn == 3) ? 1 : ((pn == 5 || pn == 6) ? 2 : ((pn == 1 && wc == 0) ? 1 : 0));
        const int iR = 4 * fq, iW = 16 * (wc & 1) + 4 * fq;
        f32x4 tb[2][2][2];
        auto rowof = [&](int g) { return u.pm * 256 + (g >> 2) * 128 + wr * 64 + (g & 3) * 16 + fr; };
        auto ldtab = [&](int g) {
            const int nb = rowof(g) % NTK; const int t = nb >= CTX ? nb - CTX : 0;
#pragma unroll
            for (int bj = 0; bj < 2; ++bj) {
                if (mode[bj] == 1) { const f32x4* p = (const f32x4*)(ropeR + ((size_t)t * 16 + iR) * 2); tb[g & 1][bj][0] = p[0]; tb[g & 1][bj][1] = p[1]; }
                else if (mode[bj] == 2) { const f32x4* p = (const f32x4*)(ropeW + ((size_t)t * 32 + iW) * 2); tb[g & 1][bj][0] = p[0]; tb[g & 1][bj][1] = p[1]; }
            }
        };
        ldtab(0);
#pragma unroll
        for (int g = 0; g < 8; ++g) {
            const int ai = g >> 2, m = g & 3;
            const int row = rowof(g);
            const bool latent = (row % NTK) >= CTX;
            if (g + 1 < 8) ldtab(g + 1);
            float ss = 0.f;
#pragma unroll
            for (int bj = 0; bj < 2; ++bj) {
                f32x4 v0 = acc[ai][bj][m][0] * F8_INV, v1 = acc[ai][bj][m][1] * F8_INV;
                if (pn == 0 || (pn == 1 && bj == 0)) ss += (v0[0] * v0[0] + v0[1] * v0[1]) + (v0[2] * v0[2] + v0[3] * v0[3]) + (v1[0] * v1[0] + v1[1] * v1[1]) + (v1[2] * v1[2] + v1[3] * v1[3]);
                if (mode[bj] != 0) {
                    f32x4 t0 = tb[g & 1][bj][0], t1 = tb[g & 1][bj][1];
                    if (!latent) { t0 = (f32x4){1.f, 0.f, 1.f, 0.f}; t1 = t0; }
                    const f32x4 tt[2] = {t0, t1};
                    rope4(v0, v1, tt);
                }
                *(u32x4*)(P + (size_t)row * PW + pn * 256 + bj * 128 + wc * 32 + fq * 8) = pack8(v0, v1);
            }
            if (pn < 2) { ss += __shfl_xor(ss, 16); ss += __shfl_xor(ss, 32); if (fq == 0) ssq[(size_t)row * 8 + pn * 4 + wc] = ss; }
        }
    }
};
struct EpiUp {
    static constexpr bool PERM = true, PROBE = false; static constexpr int NST = 0;
    bf16_t* QM; bf16_t* KVM; const float* ssq; const float* ropeR;
    __device__ __forceinline__ void operator()(const f32x4 (&acc)[2][2][4][2], const Unit& u, int wr, int wc, int fr, int fq) const {
        const bool isq = u.pn < 2;
        int col0[2], rp[2];
#pragma unroll
        for (int bj = 0; bj < 2; ++bj) { col0[bj] = (u.pn & 1) * 256 + bj * 128 + wc * 32 + fq * 8; const int hl = col0[bj] % 96; rp[bj] = (isq && col0[bj] < 384 && hl >= 64) ? ((hl - 64) >> 1) : -1; }
        f32x4 sq[2]; f32x4 tb[2][2][2];
        auto rowof = [&](int g) { return u.pm * 256 + (g >> 2) * 128 + wr * 64 + (g & 3) * 16 + fr; };
        auto ld = [&](int g) {
            const int row = rowof(g); const int nb = row % NTK; const int t = nb >= CTX ? nb - CTX : 0;
            sq[g & 1] = *(const f32x4*)(ssq + (size_t)row * 8 + (isq ? 0 : 4));
#pragma unroll
            for (int bj = 0; bj < 2; ++bj) if (rp[bj] >= 0) { const f32x4* p = (const f32x4*)(ropeR + ((size_t)t * 16 + rp[bj]) * 2); tb[g & 1][bj][0] = p[0]; tb[g & 1][bj][1] = p[1]; }
        };
        ld(0);
#pragma unroll
        for (int g = 0; g < 8; ++g) {
            const int ai = g >> 2, m = g & 3;
            const int row = rowof(g);
            const bool latent = (row % NTK) >= CTX;
            if (g + 1 < 8) ld(g + 1);
            const f32x4 s4 = sq[g & 1];
            const float ssum = (s4[0] + s4[1]) + (s4[2] + s4[3]);
            const float rstd = __builtin_amdgcn_rsqf(ssum * (isq ? (1.f / 256.f) : (1.f / 128.f)) + EPS);
#pragma unroll
            for (int bj = 0; bj < 2; ++bj) {
                f32x4 v0 = acc[ai][bj][m][0] * rstd, v1 = acc[ai][bj][m][1] * rstd;
                if (isq) {
                    if (col0[bj] < 384) {
                        if (rp[bj] >= 0) {
                            f32x4 t0 = tb[g & 1][bj][0], t1 = tb[g & 1][bj][1];
                            if (!latent) { t0 = (f32x4){1.f, 0.f, 1.f, 0.f}; t1 = t0; }
                            const f32x4 tt[2] = {t0, t1};
                            rope4(v0, v1, tt);
                        }
                        *(u32x4*)(QM + (size_t)row * 384 + col0[bj]) = pack8(v0, v1);
                    }
                } else *(u32x4*)(KVM + (size_t)row * 512 + col0[bj]) = pack8(v0, v1);
            }
        }
    }
};
struct EpiWout {
    static constexpr bool PERM = true, PROBE = false; static constexpr int NST = 16;
    bf16_t* X; const float* modl;
    __device__ __forceinline__ void operator()(const f32x4 (&acc)[2][2][4][2], const Unit& u, int wr, int wc, int fr, int fq) const {
        const int b = u.pm / 9, modrow = (u.pm - b * 9 == 0) ? 16 : b;
        const float* gate = modl + (size_t)modrow * 6144 + 2 * D;
        const int col0 = u.pn * 256 + wc * 32 + 8 * fq;
        f32x4 gv[2][2];
#pragma unroll
        for (int bj = 0; bj < 2; ++bj)
#pragma unroll
            for (int n = 0; n < 2; ++n) gv[bj][n] = *(const f32x4*)(gate + col0 + bj * 128 + n * 4);
        u32x4 xq[2][2];
        auto rowp = [&](int g) { return X + (size_t)(u.pm * 256 + (g >> 2) * 128 + wr * 64 + (g & 3) * 16 + fr) * D + col0; };
        xq[0][0] = *(const u32x4*)(rowp(0)); xq[0][1] = *(const u32x4*)(rowp(0) + 128);
#pragma unroll
        for (int g = 0; g < 8; ++g) {
            const int ai = g >> 2, m = g & 3;
            if (g + 1 < 8) { xq[(g + 1) & 1][0] = *(const u32x4*)(rowp(g + 1)); xq[(g + 1) & 1][1] = *(const u32x4*)(rowp(g + 1) + 128); }
#pragma unroll
            for (int bj = 0; bj < 2; ++bj) {
                const u32x4 xw = xq[g & 1][bj];
                f32x4 x0 = {bflo(xw.x), bfhi(xw.x), bflo(xw.y), bfhi(xw.y)}, x1 = {bflo(xw.z), bfhi(xw.z), bflo(xw.w), bfhi(xw.w)};
                x0 += gv[bj][0] * (acc[ai][bj][m][0] * F8_INVM); x1 += gv[bj][1] * (acc[ai][bj][m][1] * F8_INVM);
                *(u32x4*)(rowp(g) + bj * 128) = pack8(x0, x1);
            }
        }
    }
};
__device__ __forceinline__ f32x4 swiglu4(f32x4 g, f32x4 up, float s) {
    g = __builtin_elementwise_min(g, (f32x4){7.0f, 7.0f, 7.0f, 7.0f});
    up = __builtin_elementwise_min(__builtin_elementwise_max(up, (f32x4){-7.0f, -7.0f, -7.0f, -7.0f}), (f32x4){7.0f, 7.0f, 7.0f, 7.0f});
    const f32x4 t = g * (-1.702f * LOG2E);
    f32x4 e; e[0] = __builtin_amdgcn_exp2f(t[0]); e[1] = __builtin_amdgcn_exp2f(t[1]); e[2] = __builtin_amdgcn_exp2f(t[2]); e[3] = __builtin_amdgcn_exp2f(t[3]);
    const f32x4 d = e + 1.0f;
    f32x4 r; r[0] = __builtin_amdgcn_rcpf(d[0]); r[1] = __builtin_amdgcn_rcpf(d[1]); r[2] = __builtin_amdgcn_rcpf(d[2]); r[3] = __builtin_amdgcn_rcpf(d[3]);
    return (g * r) * (up * s + s);
}
struct EpiGateUp {
    static constexpr bool PERM = true, PROBE = true; static constexpr int NST = 4;
    unsigned char* ACT; const float* bg; const float* bu;
    __device__ __forceinline__ void operator()(const f32x4 (&acc)[2][2][4][2], const Unit& u, int wr, int wc, int fr, int fq) const {
        const int colL = u.pn * 128 + wc * 32 + fq * 8;
        const f32x4 g0 = *(const f32x4*)(bg + (size_t)u.e * D + colL), g1 = *(const f32x4*)(bg + (size_t)u.e * D + colL + 4);
        const f32x4 u0 = *(const f32x4*)(bu + (size_t)u.e * D + colL), u1 = *(const f32x4*)(bu + (size_t)u.e * D + colL + 4);
#pragma unroll
        for (int ai = 0; ai < 2; ++ai)
#pragma unroll
            for (int mp = 0; mp < 2; ++mp) {
                u32x2 w8[2];
#pragma unroll
                for (int h = 0; h < 2; ++h) {
                    const int m = 2 * mp + h;
                    const f32x4 ga = acc[ai][0][m][0] * F8_INV + g0, gb = acc[ai][0][m][1] * F8_INV + g1, ua = acc[ai][1][m][0] * F8_INV + u0, ub = acc[ai][1][m][1] * F8_INV + u1;
                    const f32x4 ra = swiglu4(ga, ua, F8_SA), rb = swiglu4(gb, ub, F8_SA);
                    w8[h].x = (unsigned)__builtin_amdgcn_cvt_pk_fp8_f32(ra[2], ra[3], __builtin_amdgcn_cvt_pk_fp8_f32(ra[0], ra[1], 0, false), true);
                    w8[h].y = (unsigned)__builtin_amdgcn_cvt_pk_fp8_f32(rb[2], rb[3], __builtin_amdgcn_cvt_pk_fp8_f32(rb[0], rb[1], 0, false), true);
                }
                const auto sx = __builtin_amdgcn_permlane16_swap(w8[0].x, w8[1].x, false, false), sy = __builtin_amdgcn_permlane16_swap(w8[0].y, w8[1].y, false, false);
                const int srow = u.pm * 256 + ai * 128 + wr * 64 + (2 * mp + (fq & 1)) * 16 + fr;
                u32x4 w16; w16.x = sx[0]; w16.y = sy[0]; w16.z = sx[1]; w16.w = sy[1];
                *(u32x4*)(ACT + (size_t)srow * D + (u.pn * 128 + wc * 32 + (fq & 2) * 8)) = w16;
            }
    }
};
struct EpiDown {
    static constexpr bool PERM = true, PROBE = true; static constexpr int NST = 8;
    bf16_t* Y; const float* bd; const float* slot_w;
    __device__ __forceinline__ void operator()(const f32x4 (&acc)[2][2][4][2], const Unit& u, int wr, int wc, int fr, int fq) const {
        const int col0 = u.pn * 256 + wc * 32 + fq * 8;
        f32x4 bv[2][2];
#pragma unroll
        for (int bj = 0; bj < 2; ++bj)
#pragma unroll
            for (int n = 0; n < 2; ++n) bv[bj][n] = *(const f32x4*)(bd + (size_t)u.e * D + col0 + bj * 128 + n * 4);
        float wv[8];
#pragma unroll
        for (int g = 0; g < 8; ++g) { const int pos = u.j * 256 + (g >> 2) * 128 + wr * 64 + (g & 3) * 16 + fr; wv[g] = slot_w[(size_t)u.e * T + min(pos, u.cnt - 1)]; }
#pragma unroll
        for (int g = 0; g < 8; ++g) { const int pos = u.j * 256 + (g >> 2) * 128 + wr * 64 + (g & 3) * 16 + fr; wv[g] = pos < u.cnt ? wv[g] : 0.f; }
#pragma unroll
        for (int ai = 0; ai < 2; ++ai)
#pragma unroll
            for (int mp = 0; mp < 2; ++mp) {
                const int rl = ai * 128 + wr * 64 + (2 * mp + (fq & 1)) * 16 + fr;
#pragma unroll
                for (int bj = 0; bj < 2; ++bj) {
                    u32x2 w8[2];
#pragma unroll
                    for (int h = 0; h < 2; ++h) {
                        const int m = 2 * mp + h; const float w = wv[ai * 4 + m];
                        const f32x4 v0 = (acc[ai][bj][m][0] * F8_INV + bv[bj][0]) * (w * F8_SY), v1 = (acc[ai][bj][m][1] * F8_INV + bv[bj][1]) * (w * F8_SY);
                        w8[h].x = (unsigned)__builtin_amdgcn_cvt_pk_fp8_f32(v0[2], v0[3], __builtin_amdgcn_cvt_pk_fp8_f32(v0[0], v0[1], 0, false), true);
                        w8[h].y = (unsigned)__builtin_amdgcn_cvt_pk_fp8_f32(v1[2], v1[3], __builtin_amdgcn_cvt_pk_fp8_f32(v1[0], v1[1], 0, false), true);
                    }
                    const auto sx = __builtin_amdgcn_permlane16_swap(w8[0].x, w8[1].x, false, false), sy = __builtin_amdgcn_permlane16_swap(w8[0].y, w8[1].y, false, false);
                    u32x4 w16; w16.x = sx[0]; w16.y = sy[0]; w16.z = sx[1]; w16.w = sy[1];
                    *(u32x4*)((unsigned char*)Y + (size_t)(u.pm * 256 + rl) * D + (u.pn * 256 + wc * 32 + (fq & 2) * 8) + bj * 128) = w16;
                }
            }
    }
};
}

__device__ __forceinline__ int winmap(int p, float& sc) {
    sc = 1.f;
    if (p < 384) return p;
    if (p < 416) return 384 + il(p - 384, 32);
    if (p < 512) return -1;
    if (p < 768)  { const int q = p - 512;  sc = SC_DIFF; return 416 + (q & ~31) + il(q & 31, 32); }
    if (p < 1024) { const int q = p - 768;  return 672 + (q & ~31) + il(q & 31, 32); }
    if (p < 1280) return 928 + (p - 1024);
    if (p < 1792) { const int q = p - 1280; sc = SC_SWA; return 1184 + (q & ~63) + il(q & 63, 64); }
    if (p < 1920) { const int q = p - 1792; return 1696 + (q & ~63) + il(q & 63, 64); }
    return 1824 + (p - 1920);
}
__device__ __forceinline__ int uqmap(int n) {
    if (n >= 384) return -1;
    const int h = n / 96, i = n - h * 96;
    return h * 96 + (i < 64 ? i : 64 + il(i - 64, 32));
}
struct CvtItem { const float* src; int ld, kvalid, k0, n0, nrows, mapkind, ldd; bf16_t* dst; const float* rowscale; };
constexpr int CVT_PER_LAYER = 256 + 16 + 16 + 8;
constexpr int CVT_ITEMS = NL * CVT_PER_LAYER;
__device__ __forceinline__ void cvt_decode(const Args& a, unsigned char* ws, int it, CvtItem& c) {
    const int l = it / CVT_PER_LAYER; int r = it - l * CVT_PER_LAYER;
    c.rowscale = nullptr; c.mapkind = 0; c.nrows = 64;
    if (r < 256) { c.src = a.in[7] + (size_t)l * D * 1952; c.ld = 1952; c.kvalid = D; c.k0 = (r >> 5) * 128; c.n0 = (r & 31) * 64; c.mapkind = 1; c.ldd = D;
        c.dst = (bf16_t*)(ws + WS_WIN + ((size_t)l * PW * D + (size_t)c.n0 * D)); return; }
    r -= 256;
    if (r < 16) { c.src = a.in[9] + (size_t)l * 256 * 384; c.ld = 384; c.kvalid = 256; c.k0 = (r >> 3) * 128; c.n0 = (r & 7) * 64; c.mapkind = 2; c.ldd = 256; c.rowscale = a.in[8] + l * 256;
        c.dst = (bf16_t*)(ws + WS_WUQ) + (size_t)l * 512 * 256 + (size_t)c.n0 * 256; return; }
    r -= 16;
    if (r < 16) { c.src = a.in[11] + (size_t)l * 128 * 512; c.ld = 512; c.kvalid = 128; c.k0 = (r >> 3) * 128; c.n0 = (r & 7) * 64; c.ldd = 256; c.rowscale = a.in[10] + l * 128;
        c.dst = (bf16_t*)(ws + WS_WUKV) + (size_t)l * 512 * 256 + (size_t)c.n0 * 256; return; }
    r -= 16;
    c.src = a.in[17] + (size_t)l * D * 32; c.ld = 32; c.kvalid = D; c.k0 = r * 128; c.n0 = 0; c.nrows = 32; c.mapkind = 3; c.ldd = D;
    c.dst = (bf16_t*)(ws + WS_WR) + (size_t)l * 32 * D;
}
constexpr int FAST_MATS = NL * (1 + 3 * NE);
constexpr int FAST_ITEMS = FAST_MATS * 256;
constexpr int FAST_PER_LAYER = (1 + 3 * NE) * 256;
constexpr int CONV_CHUNK = 64, CONV_NCHUNK = FAST_PER_LAYER / CONV_CHUNK;
__device__ __forceinline__ void fast_decode(const Args& a, unsigned char* ws, int it, const float*& src, unsigned char*& dst8, bool& f8) {
    const int mat = it >> 8, tile = it & 255, k0 = (tile >> 4) * 64, n0 = (tile & 15) * 64;
    const int l = mat / (1 + 3 * NE); int r = mat - l * (1 + 3 * NE);
    const float* sb;
    if (r == 0) { sb = a.in[15] + (size_t)l * D * D; dst8 = ws + WS_WOUT + ((size_t)l * D * D + (size_t)n0 * D + k0); f8 = true; }
    else { r -= 1; const int e = r / 3, which = r - e * 3; const size_t le = (size_t)l * NE + e; f8 = true;
        if (which == 0)      { sb = a.in[19] + le * D * D; dst8 = ws + WS_WGU + le * 2048 * D + (size_t)((n0 >> 7) * 256 + (n0 & 127)) * D + k0; }
        else if (which == 1) { sb = a.in[21] + le * D * D; dst8 = ws + WS_WGU + le * 2048 * D + (size_t)((n0 >> 7) * 256 + 128 + (n0 & 127)) * D + k0; }
        else                 { sb = a.in[23] + le * D * D; dst8 = ws + WS_WD + le * D * D + (size_t)n0 * D + k0; } }
    src = sb + (size_t)k0 * D + n0;
}
__device__ __forceinline__ void fast_convert(Frame& F, const Args& a, int tid, int it0, int it1, int gw, int NGW) {
    unsigned char* ws = F.ws;
    const int lane = tid & 63, q = lane >> 4, c4 = (lane & 15) * 4;
    LAS unsigned char* tl = F.lds + F.wave * 8704;
    f32x4 v[16]; const float* src; unsigned char* dst8; bool f8;
#define FAST_LOAD() do { _Pragma("unroll") for (int x = 0; x < 16; ++x) { const int kr = f8 ? 16 * (x >> 2) + 4 * q + (x & 3) : 8 * (x >> 1) + 2 * q + (x & 1); \
        v[x] = __builtin_nontemporal_load((const f32x4*)(src + (size_t)kr * D + c4)); } } while (0)
    int it = it0 + gw;
    if (it < it1) { fast_decode(a, ws, it, src, dst8, f8); FAST_LOAD(); }
    for (; it < it1; it += NGW) {
        unsigned char* cdst = dst8; const bool cf8 = f8;
        if (cf8) {
#pragma unroll
            for (int i = 0; i < 4; ++i)
#pragma unroll
                for (int j = 0; j < 4; ++j)
                    *(LAS unsigned*)(tl + (c4 + j) * 68 + 16 * i + 4 * q) = (unsigned)__builtin_amdgcn_cvt_pk_fp8_f32(v[4 * i + 2][j] * F8_SW, v[4 * i + 3][j] * F8_SW, __builtin_amdgcn_cvt_pk_fp8_f32(v[4 * i][j] * F8_SW, v[4 * i + 1][j] * F8_SW, 0, false), true);
        } else {
#pragma unroll
            for (int i = 0; i < 8; ++i)
#pragma unroll
                for (int j = 0; j < 4; ++j) *(LAS unsigned*)(tl + (c4 + j) * 136 + (8 * i + 2 * q) * 2) = cvtpk(v[2 * i][j], v[2 * i + 1][j]);
        }
        const int nx = it + NGW;
        if (nx < it1) { fast_decode(a, ws, nx, src, dst8, f8); FAST_LOAD(); }
        asm volatile("s_waitcnt lgkmcnt(0)" ::: "memory");
        if (cf8) {
#pragma unroll
            for (int p = 0; p < 4; ++p) {
                const int n = 16 * p + (lane >> 2), c = lane & 3;
                const LAS unsigned* t4 = (const LAS unsigned*)(tl + n * 68 + c * 16);
                u32x4 w; w.x = t4[0]; w.y = t4[1]; w.z = t4[2]; w.w = t4[3];
                __builtin_nontemporal_store(w, (u32x4*)(cdst + (size_t)n * D + c * 16));
            }
        } else {
#pragma unroll
            for (int p = 0; p < 8; ++p) {
                const int n = 8 * p + (lane >> 3), c = lane & 7;
                const u32x2 lo = *(const LAS u32x2*)(tl + n * 136 + c * 16), hi2 = *(const LAS u32x2*)(tl + n * 136 + c * 16 + 8);
                u32x4 w; w.x = lo.x; w.y = lo.y; w.z = hi2.x; w.w = hi2.y;
                __builtin_nontemporal_store(w, (u32x4*)(cdst + (size_t)n * D * 2 + c * 16));
            }
        }
        asm volatile("s_waitcnt lgkmcnt(0)" ::: "memory");
    }
#undef FAST_LOAD
}
__device__ __forceinline__ void cvt_load(const CvtItem& c, int tid, float (&v)[16]) {
    const int nn = tid & 63, kk = tid >> 6;
    float sc = 1.f; int sn;
    if (c.mapkind == 1) sn = winmap(c.n0 + nn, sc);
    else if (c.mapkind == 2) { sn = uqmap(c.n0 + nn); sc = SC_MLA; }
    else if (c.mapkind == 3) sn = nn < 32 ? nn : -1;
    else sn = c.n0 + nn;
#pragma unroll
    for (int i = 0; i < 16; ++i) {
        const int k = c.k0 + kk + 8 * i;
        float x = 0.f;
        if (sn >= 0 && k < c.kvalid) { x = c.src[(size_t)k * c.ld + sn] * sc; if (c.rowscale) x *= c.rowscale[k]; }
        v[i] = x;
    }
}
__device__ __forceinline__ void prologue_phase(Frame& F, const Args& a) {
    unsigned char* ws = F.ws;
    const int tid = opaque_tid();
    __syncthreads();
    {
        LAS unsigned short* tile = (LAS unsigned short*)F.lds;
        float v[16]; CvtItem c;
        int it = F.vcu;
        if (it < CVT_ITEMS) { cvt_decode(a, ws, it, c); cvt_load(c, tid, v); }
        for (; it < CVT_ITEMS; it += F.G) {
            const int nn = tid & 63, kk = tid >> 6;
            const bool f8 = (c.mapkind == 1);
            if (f8) {
                LAS unsigned char* t8 = (LAS unsigned char*)tile;
#pragma unroll
                for (int i = 0; i < 16; ++i) t8[nn * 132 + kk + 8 * i] = (unsigned char)(__builtin_amdgcn_cvt_pk_fp8_f32(v[i] * F8_SW, 0.f, 0, false) & 0xff);
            } else {
#pragma unroll
                for (int i = 0; i < 16; ++i) tile[nn * 130 + kk + 8 * i] = (unsigned short)(cvtpk(v[i], 0.f) & 0xffffu);
            }
            __syncthreads();
            const CvtItem cc = c;
            const int nx = it + F.G;
            if (nx < CVT_ITEMS) { cvt_decode(a, ws, nx, c); cvt_load(c, tid, v); }
            const LAS unsigned* t32 = (const LAS unsigned*)tile;
            if (f8) {
                const int n = tid >> 3, ch = tid & 7;
                u32x4 w; const LAS unsigned* s = t32 + n * 33 + ch * 4;
                w.x = s[0]; w.y = s[1]; w.z = s[2]; w.w = s[3];
                *(u32x4*)((unsigned char*)cc.dst + (size_t)n * cc.ldd + cc.k0 + ch * 16) = w;
            } else {
#pragma unroll
                for (int p = 0; p < 2; ++p) {
                    const int n = (tid >> 4) + 32 * p, ch = tid & 15;
                    if (n < cc.nrows) {
                        u32x4 w; const LAS unsigned* s = t32 + n * 65 + ch * 4;
                        w.x = s[0]; w.y = s[1]; w.z = s[2]; w.w = s[3];
                        *(u32x4*)(cc.dst + (size_t)n * cc.ldd + cc.k0 + ch * 8) = w;
                    }
                }
            }
            __syncthreads();
        }
    }
    {
        LAS float* sil = (LAS float*)F.lds;
        LAS float* part = (LAS float*)(F.lds + 1024 * 17 * 4);
        __syncthreads();
        for (int i = tid; i < 17 * D; i += NTHR) { const int r = i / D, k = i - r * D; const float x = r < 16 ? a.in[1][(size_t)r * D + k] : a.in[3][k]; sil[k * 17 + r] = x / (1.f + __expf(-x)); }
        __syncthreads();
        float* MOD = (float*)(ws + WS_MOD);
        const int col = tid & 63, kg = tid >> 6;
        for (int ch = F.vcu; ch < NL * 96; ch += F.G) {
            const int l = ch / 96, j0 = (ch - l * 96) * 64;
            const float* w = a.in[4] + (size_t)l * D * 6144 + j0 + col;
            float accv[17];
#pragma unroll
            for (int r = 0; r < 17; ++r) accv[r] = 0.f;
#pragma unroll 4
            for (int k = kg * 128; k < kg * 128 + 128; ++k) {
                const float wv = w[(size_t)k * 6144];
#pragma unroll
                for (int r = 0; r < 17; ++r) accv[r] += sil[k * 17 + r] * wv;
            }
#pragma unroll
            for (int r = 0; r < 17; ++r) part[(kg * 17 + r) * 64 + col] = accv[r];
            __syncthreads();
            for (int i = tid; i < 17 * 64; i += NTHR) {
                const int r = i >> 6, cc = i & 63; float s = 0.f;
#pragma unroll
                for (int g = 0; g < 8; ++g) s += part[(g * 17 + r) * 64 + cc];
                MOD[((size_t)l * 17 + r) * 6144 + j0 + cc] = s + a.in[5][(size_t)l * 6144 + j0 + cc];
            }
            __syncthreads();
        }
    }
    {
        const int gt = F.vcu * NTHR + tid, GT = F.G * NTHR;
        float* ropeR = (float*)(ws + WS_ROPER); float* ropeW = (float*)(ws + WS_ROPEW);
        for (int i = gt; i < SEQ * 48; i += GT) {
            int t, j; double f; float* dst;
            if (i < SEQ * 16) { t = i >> 4; j = i & 15; f = a.invf8[j & 7]; dst = ropeR + (size_t)i * 2; const int pos = (j < 8) ? (t >> 6) : (t & 63); f *= (double)pos; }
            else { const int ii = i - SEQ * 16; t = ii >> 5; j = ii & 31; f = a.invf16[j & 15]; dst = ropeW + (size_t)ii * 2; const int pos = (j < 16) ? (t >> 6) : (t & 63); f *= (double)pos; }
            const double n = __builtin_rint(f * 0.15915494309189535);
            const double r = (f - n * 6.283185307179586) - n * 2.4492935982947064e-16;
            const double r2 = r * r;
            double s = 1.0, cs = 1.0;
#pragma unroll
            for (int q = 27; q >= 3; q -= 2) s = 1.0 - s * r2 / (double)(q * (q - 1));
            s *= r;
#pragma unroll
            for (int q = 26; q >= 2; q -= 2) cs = 1.0 - cs * r2 / (double)(q * (q - 1));
            dst[0] = (float)cs; dst[1] = (float)s;
        }
        if (gt < NL) {
            const float* lam = a.in[12] + gt * 128; float s1 = 0.f, s2 = 0.f;
            for (int k = 0; k < 32; ++k) { s1 += lam[k] * lam[32 + k]; s2 += lam[64 + k] * lam[96 + k]; }
            ((float*)(ws + WS_CTL))[CW_LAM + gt] = expf(s1) - expf(s2) + a.lam_init[gt];
        }
    }
}

__device__ __forceinline__ void load_counts(Frame& F, int l) {
    volatile LAS int* PB = (volatile LAS int*)(F.lds + MISC_OFF + 256);
    volatile LAS int* CNT = (volatile LAS int*)(F.lds + MISC_OFF + 512);
    __syncthreads();
    const int tid = opaque_tid(), lane = tid & 63;
    if (tid < 64) {
        const unsigned* cur = (const unsigned*)(F.ws + WS_CTL) + CW_CUR + l * 32;
        const int c = lane < 32 ? (int)cur[lane] : 0;
        const int np = (c + 255) >> 8;
        int incl = np;
#pragma unroll
        for (int o = 1; o < 32; o <<= 1) { const int y = __shfl_up(incl, o); if ((lane & 31) >= o) incl += y; }
        if (lane < 32) { PB[lane + 1] = incl; CNT[lane] = c; }
        if (lane == 0) PB[0] = 0;
    }
    __syncthreads();
}
template <int MODE, bool FIRST> __device__ __forceinline__ void norm1_phase(Frame& F, const Args& a, int l, bool dummy = false) {
    unsigned char* ws = F.ws;
    bf16_t* X = (bf16_t*)(ws + WS_X); bf16_t* H = (bf16_t*)(ws + WS_H); const bf16_t* Y = (const bf16_t*)(ws + WS_Y);
    bf16_t* Xw = dummy ? (bf16_t*)(ws + WS_ACT + 160 * MiB) : X; if (dummy) H = (bf16_t*)(ws + WS_ACT + 232 * MiB);
    const float* MOD = (const float*)(ws + WS_MOD);
    const unsigned* tokslot = (const unsigned*)(ws + WS_TOKSLOT);
    constexpr bool comb = (MODE == 1) || !FIRST;
    constexpr int NR = FIRST ? 4 : 2;
    const int lp = (MODE == 1) ? NL - 1 : l - 1;
    if (comb) load_counts(F, lp);
    volatile LAS int* PB = (volatile LAS int*)(F.lds + MISC_OFF + 256);
    const int lane = opaque_tid() & 63;
    int vcu_ = F.vcu; asm volatile("" : "+s"(vcu_));
    const int gw = vcu_ * NWAVES + F.wave, NGW = F.G * NWAVES;
    const int nrows = (MODE == 1) ? NB * SEQ : T;
    const float* gvec = (MODE == 1) ? a.in[25] : a.in[6] + (size_t)l * D;
    f32x4 gv[4];
#pragma unroll
    for (int j = 0; j < 4; ++j) gv[j] = *(const f32x4*)(gvec + 16 * lane + 4 * j);
    auto rowinfo = [&](int ri, int& tok, int& bb, int& nb) { if (MODE == 1) { bb = ri >> 11; nb = CTX + (ri & 2047); tok = bb * NTK + nb; } else { tok = ri; bb = tok / NTK; nb = tok - bb * NTK; } };
    auto stageA = [&](int ri, u32x4 (&raw)[NR], u32x4& ts) {
        int tok, bb, nb; rowinfo(ri, tok, bb, nb);
        if constexpr (FIRST) {
            const float* src = nb < CTX ? a.in[2] + ((size_t)bb * CTX + nb) * D : a.in[0] + ((size_t)bb * SEQ + (nb - CTX)) * D;
#pragma unroll
            for (int j = 0; j < 4; ++j) raw[j] = *(const u32x4*)(src + 16 * lane + 4 * j);
        } else {
            const u32x4* xp = (const u32x4*)(X + (size_t)tok * D + 16 * lane); raw[0] = xp[0]; raw[1] = xp[1];
        }
        if (comb) ts = *(const u32x4*)(tokslot + (size_t)tok * 4);
    };
    auto stageB = [&](const u32x4& ts, u32x4 (&yv)[4]) {
#pragma unroll
        for (int k = 0; k < 4; ++k) {
            const unsigned w = ts[k]; const int e = (int)(w >> 16), pos = (int)(w & 0xffffu);
            const unsigned char* yr = (const unsigned char*)Y + ((size_t)PB[e] * 256 + pos) * D;
            yv[k] = *(const u32x4*)(yr + 16 * lane);
        }
    };
    auto stageC = [&](int ri, const u32x4 (&raw)[NR], const u32x4 (&yv)[4]) {
        __builtin_amdgcn_sched_barrier(0);
        int tok, bb, nb; rowinfo(ri, tok, bb, nb);
        const int modrow = nb < CTX ? 16 : bb;
        f32x4 v[4];
#pragma unroll
        for (int j = 0; j < 4; ++j) {
            if constexpr (FIRST) v[j] = __builtin_bit_cast(f32x4, raw[j]);
            else { const unsigned w0 = (j & 1) ? raw[j >> 1].z : raw[j >> 1].x, w1 = (j & 1) ? raw[j >> 1].w : raw[j >> 1].y; v[j] = (f32x4){bflo(w0), bfhi(w0), bflo(w1), bfhi(w1)}; }
        }
        if (comb) {
            const float* g5 = MOD + ((size_t)lp * 17 + modrow) * 6144 + 5 * D;
#pragma unroll
            for (int j = 0; j < 4; ++j) {
                f32x4 sj = (f32x4){0.f, 0.f, 0.f, 0.f};
#pragma unroll
                for (int k = 0; k < 4; ++k) { const unsigned y = yv[k][j]; const f32x2 lo = __builtin_amdgcn_cvt_pk_f32_fp8((int)y, false), hi2 = __builtin_amdgcn_cvt_pk_f32_fp8((int)y, true); sj[0] += lo[0]; sj[1] += lo[1]; sj[2] += hi2[0]; sj[3] += hi2[1]; }
                v[j] += *(const f32x4*)(g5 + 16 * lane + 4 * j) * (sj * (1.0f / F8_SY));
            }
        }
        float ss = 0.f;
#pragma unroll
        for (int j = 0; j < 4; ++j) ss += (v[j][0] * v[j][0] + v[j][1] * v[j][1]) + (v[j][2] * v[j][2] + v[j][3] * v[j][3]);
        const float rstd = 1.0f / sqrtf(wave_sum(ss) * (1.f / D) + EPS);
        if (MODE == 1) {
            float* o = a.out + (size_t)ri * D;
#pragma unroll
            for (int j = 0; j < 4; ++j) *(f32x4*)(o + 16 * lane + 4 * j) = v[j] * rstd * gv[j];
        } else {
            const float* mr = MOD + ((size_t)l * 17 + modrow) * 6144;
            u32x4 xb[2], h8;
#pragma unroll
            for (int j = 0; j < 4; ++j) {
                const unsigned p0 = cvtpk(v[j][0], v[j][1]), p1 = cvtpk(v[j][2], v[j][3]);
                if (j & 1) { xb[j >> 1].z = p0; xb[j >> 1].w = p1; } else { xb[j >> 1].x = p0; xb[j >> 1].y = p1; }
                const f32x4 sh = *(const f32x4*)(mr + 16 * lane + 4 * j), sc = *(const f32x4*)(mr + D + 16 * lane + 4 * j);
                const f32x4 h = (v[j] * rstd * gv[j] * (sc + 1.0f) + sh) * F8_SA;
                h8[j] = (unsigned)__builtin_amdgcn_cvt_pk_fp8_f32(h[2], h[3], __builtin_amdgcn_cvt_pk_fp8_f32(h[0], h[1], 0, false), true);
            }
            { u32x4* xp = (u32x4*)(Xw + (size_t)tok * D + 16 * lane); xp[0] = xb[0]; xp[1] = xb[1]; }
            *(u32x4*)((unsigned char*)H + (size_t)tok * D + 16 * lane) = h8;
        }
    };
    u32x4 rawC[NR], rawN[NR], rawF[NR]; u32x4 tsN = {0u, 0u, 0u, 0u}, tsF = {0u, 0u, 0u, 0u}, tsC = {0u, 0u, 0u, 0u}; u32x4 yC[4], yN[4];
    if (gw < nrows) stageA(gw, rawC, tsC);
    if (gw + NGW < nrows) stageA(gw + NGW, rawN, tsN);
    if (comb && gw < nrows) stageB(tsC, yC);
    for (int ri = gw; ri < nrows; ri += NGW) {
        if (ri + 2 * NGW < nrows) stageA(ri + 2 * NGW, rawF, tsF);
        if (comb && ri + NGW < nrows) stageB(tsN, yN);
        stageC(ri, rawC, yC);
#pragma unroll
        for (int j = 0; j < NR; ++j) { rawC[j] = rawN[j]; rawN[j] = rawF[j]; }
        tsN = tsF;
#pragma unroll
        for (int k = 0; k < 4; ++k) yC[k] = yN[k];
    }
}
__device__ __forceinline__ void norm2_router_phase(Frame& F, const Args& a, int l) {
    unsigned char* ws = F.ws;
    const bf16_t* X = (const bf16_t*)(ws + WS_X); unsigned char* H8 = (unsigned char*)(ws + WS_H);
    const float* MOD = (const float*)(ws + WS_MOD);
    unsigned* tokslot = (unsigned*)(ws + WS_TOKSLOT); int* slot_tok = (int*)(ws + WS_SLOTTOK); float* slot_w = (float*)(ws + WS_SLOTW);
    unsigned* cursor = (unsigned*)(ws + WS_CTL) + CW_CUR + l * 32;
    const bf16_t* Wr = (const bf16_t*)(ws + WS_WR) + (size_t)l * 32 * D;
    const bool last = (l == NL - 1);
    const int ngroups = last ? NB * SEQ / 32 : T / 32;
    const int tid = opaque_tid(), lane = tid & 63, wave = F.wave, r32 = lane & 31, hi = lane >> 5;
    constexpr int FT_RS = 2064;
    LAS unsigned char* FT = F.lds;
    LAS float* LP = (LAS float*)(F.lds + 32 * FT_RS);
    LAS float* LG = LP + 8 * 32 * 33;
    LAS int* lcnt = (LAS int*)(LG + 32 * 33);
    LAS int* lbase = lcnt + 32;
    bf16x8 wf[8];
#pragma unroll
    for (int s = 0; s < 8; ++s) wf[s] = *(const bf16x8*)(Wr + (size_t)r32 * D + (8 * wave + s) * 16 + hi * 8);
    const float* gvec = a.in[16] + (size_t)l * D;
    f32x4 gv[4];
#pragma unroll
    for (int j = 0; j < 4; ++j) gv[j] = *(const f32x4*)(gvec + 16 * lane + 4 * j);
    if (tid < 32) lcnt[tid] = 0;
    __syncthreads();
    auto ginfo = [&](int g, int& tok0, int& modrow) {
        int b; bool isctx;
        if (last) { b = g >> 6; tok0 = b * NTK + CTX + (g & 63) * 32; isctx = false; } else { tok0 = g * 32; b = tok0 / NTK; isctx = (tok0 - b * NTK) < CTX; }
        modrow = isctx ? 16 : b;
    };
    u32x4 xq[4][2], xn[4][2]; f32x4 shv[4], scv[4], shn[4], scn[4];
    auto gload = [&](int g, u32x4 (&x)[4][2], f32x4 (&sh)[4], f32x4 (&sc)[4]) {
        int tok0, modrow; ginfo(g, tok0, modrow);
        const float* mr = MOD + ((size_t)l * 17 + modrow) * 6144;
#pragma unroll
        for (int q = 0; q < 4; ++q) { const u32x4* xp = (const u32x4*)(X + (size_t)(tok0 + wave * 4 + q) * D + 16 * lane); x[q][0] = xp[0]; x[q][1] = xp[1]; }
#pragma unroll
        for (int j = 0; j < 4; ++j) { sh[j] = *(const f32x4*)(mr + 3 * D + 16 * lane + 4 * j); sc[j] = *(const f32x4*)(mr + 4 * D + 16 * lane + 4 * j); }
    };
    if ((int)F.vcu >= ngroups) return;
    const int glast = F.vcu + ((ngroups - 1 - F.vcu) / F.G) * F.G;
    gload(F.vcu, xq, shv, scv);
    for (int g = F.vcu; g < ngroups; g += F.G) {
        int tok0, modrow_; ginfo(g, tok0, modrow_);
        gload(min(g + F.G, glast), xn, shn, scn);
#pragma unroll
        for (int q = 0; q < 4; ++q) {
            const int rl = wave * 4 + q, tok = tok0 + rl;
            f32x4 v[4]; float ss = 0.f;
#pragma unroll
            for (int j = 0; j < 4; ++j) { const unsigned w0 = (j & 1) ? xq[q][j >> 1].z : xq[q][j >> 1].x, w1 = (j & 1) ? xq[q][j >> 1].w : xq[q][j >> 1].y;
                v[j] = (f32x4){bflo(w0), bfhi(w0), bflo(w1), bfhi(w1)}; ss += (v[j][0] * v[j][0] + v[j][1] * v[j][1]) + (v[j][2] * v[j][2] + v[j][3] * v[j][3]); }
            const float rstd = 1.0f / sqrtf(wave_sum(ss) * (1.f / D) + EPS);
            u32x4 h8; u32x4 hb[2];
#pragma unroll
            for (int j = 0; j < 4; ++j) {
                const f32x4 h = v[j] * rstd * gv[j] * (scv[j] + 1.0f) + shv[j];
                const unsigned p0 = cvtpk(h[0], h[1]), p1 = cvtpk(h[2], h[3]);
                if (j & 1) { hb[j >> 1].z = p0; hb[j >> 1].w = p1; } else { hb[j >> 1].x = p0; hb[j >> 1].y = p1; }
                h8[j] = (unsigned)__builtin_amdgcn_cvt_pk_fp8_f32(h[2] * F8_SA, h[3] * F8_SA, __builtin_amdgcn_cvt_pk_fp8_f32(h[0] * F8_SA, h[1] * F8_SA, 0, false), true);
            }
            *(u32x4*)(H8 + (size_t)tok * D + 16 * lane) = h8;
            LAS u32x4* fp = (LAS u32x4*)(FT + rl * FT_RS + 32 * lane); fp[0] = hb[0]; fp[1] = hb[1];
        }
#pragma unroll
        for (int q = 0; q < 4; ++q) { xq[q][0] = xn[q][0]; xq[q][1] = xn[q][1]; }
#pragma unroll
        for (int j = 0; j < 4; ++j) { shv[j] = shn[j]; scv[j] = scn[j]; }
        __syncthreads();
        {
            f32x16 acc = {};
#pragma unroll
            for (int s = 0; s < 8; ++s) {
                const bf16x8 af = *(const LAS bf16x8*)(FT + r32 * FT_RS + ((8 * wave + s) * 16 + hi * 8) * 2);
                acc = __builtin_amdgcn_mfma_f32_32x32x16_bf16(af, wf[s], acc, 0, 0, 0);
            }
#pragma unroll
            for (int r = 0; r < 16; ++r) { const int row = (r & 3) + 8 * (r >> 2) + 4 * hi; LP[(wave * 32 + row) * 33 + r32] = acc[r]; }
        }
        __syncthreads();
        for (int i = tid; i < 1024; i += NTHR) {
            const int row = i >> 5, e = i & 31; float s = a.in[18][l * 32 + e];
#pragma unroll
            for (int w = 0; w < 8; ++w) s += LP[(w * 32 + row) * 33 + e];
            LG[row * 33 + e] = s;
        }
        __syncthreads();
        int te[4]; float tw[4]; int rk[4];
        if (tid < 32) {
            float lv[32];
#pragma unroll
            for (int e = 0; e < 32; ++e) lv[e] = LG[tid * 33 + e];
            float tv[4];
#pragma unroll
            for (int k = 0; k < 4; ++k) {
                float best = -3.0e38f; int bi = 0;
#pragma unroll
                for (int e = 0; e < 32; ++e) { const bool up = lv[e] > best; best = up ? lv[e] : best; bi = up ? e : bi; }
                tv[k] = best; te[k] = bi;
#pragma unroll
                for (int e = 0; e < 32; ++e) lv[e] = (e == bi) ? -3.0e38f : lv[e];
            }
            const float e1 = __expf(tv[1] - tv[0]), e2 = __expf(tv[2] - tv[0]), e3 = __expf(tv[3] - tv[0]);
            const float inv = 1.0f / (1.0f + e1 + e2 + e3);
            tw[0] = inv; tw[1] = e1 * inv; tw[2] = e2 * inv; tw[3] = e3 * inv;
#pragma unroll
            for (int k = 0; k < 4; ++k) rk[k] = atomicAdd((int*)&lcnt[te[k]], 1);
        }
        __syncthreads();
        if (tid < 32) { const int c = lcnt[tid]; lbase[tid] = c ? (int)atomicAdd(&cursor[tid], (unsigned)c) : 0; }
        __syncthreads();
        if (tid < 32) {
            const int tok = tok0 + tid; u32x4 ts;
#pragma unroll
            for (int k = 0; k < 4; ++k) { const int pos = lbase[te[k]] + rk[k]; slot_tok[(size_t)te[k] * T + pos] = tok; slot_w[(size_t)te[k] * T + pos] = tw[k]; ts[k] = ((unsigned)te[k] << 16) | (unsigned)pos; }
            *(u32x4*)(tokslot + (size_t)tok * 4) = ts;
            lcnt[tid] = 0;
        }
        __syncthreads();
    }
}

struct AttnPtrs { const bf16_t* P; const bf16_t* QM; const bf16_t* KVM; unsigned char* MIX; const float* sink; const float* subg; float lam_full, one_m_li; };
constexpr int KB_OFF0 = 0, KB_STRIDE = 16384, VB_OFF0 = 32768, VB_STRIDE = 12288, XCH_OFF = 81920;
#define ATT_PIN(x) asm volatile("" : "+v"(x))
#define ATT_SBAR() __builtin_amdgcn_sched_barrier(0)
#define ATT_THR 8.0f
#ifndef ATT_WSLICE
#define ATT_WSLICE 10
#endif
#ifndef ATT_PF
#define ATT_PF 2
#endif
template <int KIND> __device__ __forceinline__ void attn_unit(const AttnPtrs& A, int b, int h, int qblk, LAS unsigned char* lds, unsigned& qnext) {
    constexpr int DQK = KIND == 0 ? 96 : (KIND == 1 ? 32 : 64);
    constexpr int NF = DQK / 16, RSK = DQK * 2 + 16, RSV = 192, NMF = 8 + 2 * NF;
    const int tid = opaque_tid(), lane = tid & 63, r32 = lane & 31, hi = lane >> 5, wid = __builtin_amdgcn_readfirstlane(tid >> 6);
    const size_t tokb = (size_t)b * NTK;
    const int mp = KIND == 1 ? (wid >> 2) : 0;
    const int qrow0 = KIND == 1 ? qblk * 128 + (wid & 3) * 32 : qblk * 256 + wid * 32;
    const bool ctxunit = KIND == 1 ? (qblk < 2) : (qblk == 0);
    const size_t tokq = tokb + qrow0 + r32;
    const int kvh = h >> 2;
    bf16x8 qf[NF];
#pragma unroll
    for (int d0 = 0; d0 < NF; ++d0) {
        const bf16_t* src = KIND == 0 ? A.QM + tokq * 384 + h * 96 + d0 * 16 + hi * 8
                          : KIND == 1 ? A.P + tokq * PW + 512 + (2 * h + mp) * 32 + d0 * 16 + hi * 8
                                      : A.P + tokq * PW + 1280 + h * 64 + d0 * 16 + hi * 8;
        qf[d0] = *(const bf16x8*)src;
    }
    float mrun = 0.f; f32x2 lrun2 = {0.f, 0.f}; f32x16 o[2]; o[0] = f32x16{}; o[1] = f32x16{};
    f32x16 negm = f32x16{};
    const int T0 = KIND == 2 ? (qblk - 1) * 256 : 0;
    int ntile, ttlo = 0;
    if (ctxunit) ntile = 4;
    else if (KIND == 2) { ttlo = max(0, (T0 >> 6) - 2); const int tthi = min(31, (T0 >> 6) + 5); ntile = 4 + (tthi - ttlo + 1); }
    else ntile = 36;
#define TILE_OF(i) ((KIND == 2 && (i) >= 4) ? 4 + ttlo + ((i) - 4) : (i))
    u32x4 krA0, krA1, vrA, krB0, krB1, vrB;
    const char* kp0; const char* kp1 = nullptr; const char* vp; unsigned ks0, ks1 = 0u, vs;
    if (KIND == 0) {
        { const int row = tid / 12, ch = tid - row * 12; const size_t tok = tokb + row;
          kp0 = ch < 8 ? (const char*)(A.KVM + tok * 512 + h * 128 + ch * 8) : (const char*)(A.P + tok * PW + 384 + (ch - 8) * 8); ks0 = ch < 8 ? 64u * 512u * 2u : 64u * PW * 2u; }
        { const int q = (tid & 255) + 512, row = q / 12, ch = q - row * 12; const size_t tok = tokb + row;
          kp1 = ch < 8 ? (const char*)(A.KVM + tok * 512 + h * 128 + ch * 8) : (const char*)(A.P + tok * PW + 384 + (ch - 8) * 8); ks1 = ch < 8 ? 64u * 512u * 2u : 64u * PW * 2u; }
        { const int row = tid >> 3, ch = tid & 7; vp = (const char*)(A.KVM + (tokb + row) * 512 + h * 128 + 64 + ch * 8); vs = 64u * 512u * 2u; }
    } else if (KIND == 1) {
        { const int m2 = tid >> 8, row = (tid & 255) >> 2, ch = tid & 3; kp0 = (const char*)(A.P + (tokb + row) * PW + 768 + (2 * h + m2) * 32 + ch * 8); ks0 = 64u * PW * 2u; }
        { const int row = tid >> 3, ch = tid & 7; vp = (const char*)(A.P + (tokb + row) * PW + 1024 + h * 64 + ch * 8); vs = 64u * PW * 2u; }
    } else {
        const int row = tid >> 3, ch = tid & 7;
        kp0 = (const char*)(A.P + (tokb + row) * PW + 1792 + kvh * 64 + ch * 8); ks0 = 64u * PW * 2u;
        vp = (const char*)(A.P + (tokb + row) * PW + 1920 + kvh * 64 + ch * 8); vs = 64u * PW * 2u;
    }
    const char* gb = (const char*)A.P;
    const unsigned ko0 = (unsigned)(kp0 - gb), ko1 = (KIND == 0) ? (unsigned)(kp1 - gb) : 0u, vo = (unsigned)(vp - gb);
    const unsigned ksh0 = ks0 == 65536u ? 16u : 18u, ksh1 = ks1 == 65536u ? 16u : 18u, vsh = vs == 65536u ? 16u : 18u;
    auto gload = [&](int tt, u32x4& kr0, u32x4& kr1, u32x4& vr) {
        kr0 = *(const u32x4*)(gb + (size_t)(((unsigned)tt << ksh0) + ko0));
        if (KIND == 0) kr1 = *(const u32x4*)(gb + (size_t)(((unsigned)tt << ksh1) + ko1));
        vr = *(const u32x4*)(gb + (size_t)(((unsigned)tt << vsh) + vo));
    };
    auto lstore = [&](int i, const u32x4& kr0, const u32x4& kr1, const u32x4& vr) {
        LAS unsigned char* kb = lds + KB_OFF0 + (i & 1) * KB_STRIDE; LAS unsigned char* vb = lds + VB_OFF0 + (i & 3) * VB_STRIDE;
        if (KIND == 0) {
            { const int row = tid / 12, ch = tid - row * 12; *(LAS u32x4*)(kb + row * RSK + ch * 16) = kr0; }
            if (tid < 256) { const int q = tid + 512, row = q / 12, ch = q - row * 12; *(LAS u32x4*)(kb + row * RSK + ch * 16) = kr1; }
        } else if (KIND == 1) {
            const int m2 = tid >> 8, row = (tid & 255) >> 2, ch = tid & 3; *(LAS u32x4*)(kb + m2 * 8192 + row * RSK + ch * 16) = kr0;
        } else { const int row = tid >> 3, ch = tid & 7; *(LAS u32x4*)(kb + row * RSK + ch * 16) = kr0; }
        { const int row = tid >> 3, ch = tid & 7; *(LAS u32x4*)(vb + row * RSV + ch * 16) = vr; }
    };
    const int qpos = T0 + wid * 32 + r32;
    const int koff = (KIND == 1 ? mp * 8192 : 0) + r32 * RSK + hi * 16;
    const int voff = ((lane >> 4) & 1) * 32 + (lane & 3) * 8 + (4 * hi + ((lane & 15) >> 2)) * RSV;
    auto fetch = [&](int j, const LAS unsigned char* vb, const LAS unsigned char* kb) -> bf16x8 {
        if (j < 8) {
            const int sI = j >> 1, d0 = j & 1;
            const v4i16_t lo = __builtin_amdgcn_ds_read_tr16_b64_v4i16((LAS v4i16_t*)(vb + voff + (16 * sI) * RSV + d0 * 64));
            const v4i16_t hh = __builtin_amdgcn_ds_read_tr16_b64_v4i16((LAS v4i16_t*)(vb + voff + (16 * sI + 8) * RSV + d0 * 64));
            return (bf16x8){lo[0], lo[1], lo[2], lo[3], hh[0], hh[1], hh[2], hh[3]};
        } else {
            const int d0 = (j - 8) >> 1, half = (j - 8) & 1;
            return *(const LAS bf16x8*)(kb + koff + half * 32 * RSK + d0 * 32);
        }
    };
    gload(TILE_OF(0), krA0, krA1, vrA); gload(TILE_OF(1), krB0, krB1, vrB);
    lstore(0, krA0, krA1, vrA); lstore(1, krB0, krB1, vrB);
    gload(TILE_OF(2), krA0, krA1, vrA);
    qnext = (unsigned)__builtin_amdgcn_readfirstlane((int)qnext);
    __syncthreads();
    f32x16 pA0 = f32x16{}, pA1 = f32x16{}, pB0, pB1;
    {
        const LAS unsigned char* kb = lds + KB_OFF0;
#pragma unroll
        for (int d0 = 0; d0 < NF; ++d0) {
            const bf16x8 k0 = *(const LAS bf16x8*)(kb + koff + d0 * 32), k1 = *(const LAS bf16x8*)(kb + koff + 32 * RSK + d0 * 32);
            pA0 = __builtin_amdgcn_mfma_f32_32x32x16_bf16(k0, qf[d0], pA0, 0, 0, 0);
            pA1 = __builtin_amdgcn_mfma_f32_32x32x16_bf16(k1, qf[d0], pA1, 0, 0, 0);
        }
    }
    bf16x8 paX[4], paY[4];
#pragma unroll
    for (int sI = 0; sI < 4; ++sI) { paX[sI] = (bf16x8){0, 0, 0, 0, 0, 0, 0, 0}; paY[sI] = (bf16x8){0, 0, 0, 0, 0, 0, 0, 0}; }
    __syncthreads();
#define ATT_STEP(C0, C1, N0, N1, PP, PC, i, KR0, KR1, VR) do { \
        const int tt_ = TILE_OF(i); \
        if (KIND == 2 && !ctxunit && tt_ >= 4) { \
            const int k0_ = (tt_ - 4) * 64, tw_ = T0 + wid * 32; \
            if (k0_ + 63 - tw_ > 128 || k0_ - (tw_ + 31) < -128) {     \
                const int kbase_ = k0_ + 4 * hi - qpos; \
                _Pragma("unroll") for (int r = 0; r < 16; ++r) { const int dk = kbase_ + (r & 3) + 8 * (r >> 2); if (dk > 128 || dk < -128) C0[r] = -1.0e30f; if (dk + 32 > 128 || dk + 32 < -128) C1[r] = -1.0e30f; } \
            } \
        } \
        const LAS unsigned char* vb_ = lds + VB_OFF0 + (((i) + 3 + ((i) == 0 ? 1 : 0)) & 3) * VB_STRIDE;                  \
        const LAS unsigned char* kb_ = lds + KB_OFF0 + (((i) + 1 < ntile ? (i) + 1 : (i)) & 1) * KB_STRIDE;       \
        bf16x8 op_[ATT_PF + 1]; _Pragma("unroll") for (int j = 0; j < ATT_PF; ++j) op_[j] = fetch(j, vb_, kb_); \
        float mx_ = -3.0e38f, alpha_ = 1.f; f32x2 ls2_ = {0.f, 0.f}; unsigned long long gbal_ = 0ull;     \
        ATT_SBAR(); \
        _Pragma("unroll") for (int k = 0; k < 20; ++k) { \
            if (k == ATT_WSLICE) { if ((i) + 2 < ntile) lstore((i) + 2, KR0, KR1, VR); }     \
            if (k + ATT_PF < NMF) op_[(k + ATT_PF) % (ATT_PF + 1)] = fetch(k + ATT_PF, vb_, kb_); \
            if (k < 8) { o[k & 1] = __builtin_amdgcn_mfma_f32_32x32x16_bf16(op_[k % (ATT_PF + 1)], PP[k >> 1], o[k & 1], 0, 0, 0); } \
            else if (k < NMF) { const int j_ = k - 8; \
                if (j_ == 0) N0 = __builtin_amdgcn_mfma_f32_32x32x16_bf16(op_[k % (ATT_PF + 1)], qf[0], negm, 0, 0, 0); \
                else if (j_ == 1) N1 = __builtin_amdgcn_mfma_f32_32x32x16_bf16(op_[k % (ATT_PF + 1)], qf[0], negm, 0, 0, 0); \
                else if (j_ & 1) N1 = __builtin_amdgcn_mfma_f32_32x32x16_bf16(op_[k % (ATT_PF + 1)], qf[j_ >> 1], N1, 0, 0, 0); \
                else N0 = __builtin_amdgcn_mfma_f32_32x32x16_bf16(op_[k % (ATT_PF + 1)], qf[j_ >> 1], N0, 0, 0, 0); } \
            if (k < 4) { float a_ = fmaxf(fmaxf(C0[4 * k], C0[4 * k + 1]), C0[4 * k + 2]); const float b_ = fmaxf(fmaxf(C0[4 * k + 3], C1[4 * k]), C1[4 * k + 1]); a_ = fmaxf(fmaxf(a_, C1[4 * k + 2]), C1[4 * k + 3]); mx_ = fmaxf(fmaxf(mx_, a_), b_); ATT_PIN(mx_); }     \
            else if (k == 4) { auto rr_ = __builtin_amdgcn_permlane32_swap(__float_as_uint(mx_), __float_as_uint(mx_), false, false); { const float ma_ = __uint_as_float(rr_[0]), mb_ = __uint_as_float(rr_[1]); asm("v_max_f32 %0, %1, %2" : "=v"(mx_) : "v"(ma_), "v"(mb_)); }     \
                  \
                const bool far_ = ((i) == 0) ? (fabsf(mx_) > ATT_THR) : (mx_ > ATT_THR); \
                gbal_ = __builtin_amdgcn_ballot_w64(far_); \
                if (gbal_ != 0ull) { const float dl_ = ((i) == 0) ? mx_ : fmaxf(mx_, 0.f); \
                    _Pragma("unroll") for (int r = 0; r < 16; ++r) { C0[r] -= dl_; C1[r] -= dl_; } \
                    mrun += dl_; alpha_ = ((i) == 0) ? 1.0f : __builtin_amdgcn_exp2f(-dl_); \
                    _Pragma("unroll") for (int r = 0; r < 16; ++r) negm[r] = -mrun; ATT_PIN(negm); ATT_PIN(alpha_); } } \
            else if (k < 13) { const int e_ = k - 5; \
                C0[2 * e_] = __builtin_amdgcn_exp2f(C0[2 * e_]); C0[2 * e_ + 1] = __builtin_amdgcn_exp2f(C0[2 * e_ + 1]); \
                C1[2 * e_] = __builtin_amdgcn_exp2f(C1[2 * e_]); C1[2 * e_ + 1] = __builtin_amdgcn_exp2f(C1[2 * e_ + 1]); \
                ls2_ += (f32x2){C0[2 * e_], C0[2 * e_ + 1]}; ls2_ += (f32x2){C1[2 * e_], C1[2 * e_ + 1]}; ATT_PIN(ls2_); } \
            else if (k < 17) { const int c_ = k - 13; u32x4 w_; \
                if (c_ < 2) { w_.x = cvtpk(C0[8 * c_ + 0], C0[8 * c_ + 1]); w_.y = cvtpk(C0[8 * c_ + 2], C0[8 * c_ + 3]); w_.z = cvtpk(C0[8 * c_ + 4], C0[8 * c_ + 5]); w_.w = cvtpk(C0[8 * c_ + 6], C0[8 * c_ + 7]); } \
                else { const int c2_ = c_ - 2; w_.x = cvtpk(C1[8 * c2_ + 0], C1[8 * c2_ + 1]); w_.y = cvtpk(C1[8 * c2_ + 2], C1[8 * c2_ + 3]); w_.z = cvtpk(C1[8 * c2_ + 4], C1[8 * c2_ + 5]); w_.w = cvtpk(C1[8 * c2_ + 6], C1[8 * c2_ + 7]); } \
                ATT_PIN(w_); PC[c_] = __builtin_bit_cast(bf16x8, w_); } \
            else if (k == 17) { if (gbal_ != 0ull) { lrun2 *= alpha_; _Pragma("unroll") for (int r = 0; r < 16; ++r) o[0][r] *= alpha_; ATT_PIN(o[0]); } lrun2 += ls2_; ATT_PIN(lrun2); } \
            else if (k == 18) { if (gbal_ != 0ull) { _Pragma("unroll") for (int r = 0; r < 16; ++r) o[1][r] *= alpha_; ATT_PIN(o[1]); } } \
            ATT_SBAR(); \
        } \
    } while (0)
#ifndef ATT_PRIO
#define ATT_PRIO 1
#endif
    if (ATT_PRIO && wid >= 4) __builtin_amdgcn_s_setprio(1);
    for (int i = 0; i < ntile; i += 2) {
        { const int j3 = min(i + 3, ntile - 1); gload(TILE_OF(j3), krB0, krB1, vrB); }
        ATT_STEP(pA0, pA1, pB0, pB1, paY, paX, i, krA0, krA1, vrA);
        __syncthreads();
        { const int j4 = min(i + 4, ntile - 1); gload(TILE_OF(j4), krA0, krA1, vrA); }
        ATT_STEP(pB0, pB1, pA0, pA1, paX, paY, i + 1, krB0, krB1, vrB);
        __syncthreads();
    }
#undef ATT_STEP
#undef TILE_OF
    if (ATT_PRIO) __builtin_amdgcn_s_setprio(0);
    {
        const LAS unsigned char* vb = lds + VB_OFF0 + ((ntile - 1) & 3) * VB_STRIDE;
#pragma unroll
        for (int j = 0; j < 8; ++j) { const bf16x8 vfr = fetch(j, vb, vb); o[j & 1] = __builtin_amdgcn_mfma_f32_32x32x16_bf16(vfr, paY[j >> 1], o[j & 1], 0, 0, 0); }
    }
    const float lrun = lrun2[0] + lrun2[1];
    float lt = lrun + __shfl_xor(lrun, 32);
    if (KIND == 2) lt += __builtin_amdgcn_exp2f(A.sink[h] * LOG2E - mrun);
    const float inv = 1.0f / lt;
    const int colbase = (KIND == 0 ? 0 : (KIND == 1 ? 256 : 512)) + h * 64;
    unsigned char* orow = A.MIX + tokq * D + colbase;
    unsigned W8[2][4];
    auto store_rows = [&]() {
#pragma unroll
        for (int d0 = 0; d0 < 2; ++d0) {
            const auto s0 = __builtin_amdgcn_permlane32_swap(W8[d0][0], W8[d0][1], false, false), s1 = __builtin_amdgcn_permlane32_swap(W8[d0][2], W8[d0][3], false, false);
            const auto t0 = __builtin_amdgcn_permlane32_swap(s0[0], s1[0], false, false), t1 = __builtin_amdgcn_permlane32_swap(s0[1], s1[1], false, false);
            u32x4 w; w.x = t0[0]; w.y = t1[0]; w.z = t0[1]; w.w = t1[1];
            *(u32x4*)(orow + 32 * d0 + 16 * hi) = w;
        }
    };
    if (KIND == 1) {
        LAS float* xch = (LAS float*)(lds + XCH_OFF) + (wid & 3) * 2048 + lane;
        if (wid >= 4) {
#pragma unroll
            for (int d0 = 0; d0 < 2; ++d0)
#pragma unroll
                for (int r = 0; r < 16; ++r) xch[(d0 * 16 + r) * 64] = o[d0][r] * inv;
        }
        __syncthreads();
        if (wid < 4) {
            float ss = 0.f;
#pragma unroll
            for (int d0 = 0; d0 < 2; ++d0)
#pragma unroll
                for (int r = 0; r < 16; ++r) { const float x = o[d0][r] * inv - A.lam_full * xch[(d0 * 16 + r) * 64]; o[d0][r] = x; ss += x * x; }
            ss += __shfl_xor(ss, 32);
            const float rs = (1.0f / sqrtf(ss * (1.f / 64.f) + EPS)) * A.one_m_li;
#pragma unroll
            for (int d0 = 0; d0 < 2; ++d0)
#pragma unroll
                for (int g4 = 0; g4 < 4; ++g4) {
                    const int dd = 32 * d0 + 8 * g4 + 4 * hi;
                    const f32x4 gg = *(const f32x4*)(A.subg + dd);
                    const float rs8 = rs * F8_SM;
                    W8[d0][g4] = (unsigned)__builtin_amdgcn_cvt_pk_fp8_f32(o[d0][4 * g4 + 2] * rs8 * gg[2], o[d0][4 * g4 + 3] * rs8 * gg[3], __builtin_amdgcn_cvt_pk_fp8_f32(o[d0][4 * g4 + 0] * rs8 * gg[0], o[d0][4 * g4 + 1] * rs8 * gg[1], 0, false), true);
                }
            store_rows();
        }
    } else {
#pragma unroll
        for (int d0 = 0; d0 < 2; ++d0)
#pragma unroll
            for (int g4 = 0; g4 < 4; ++g4) {
                const float inv8 = inv * F8_SM;
                W8[d0][g4] = (unsigned)__builtin_amdgcn_cvt_pk_fp8_f32(o[d0][4 * g4 + 2] * inv8, o[d0][4 * g4 + 3] * inv8, __builtin_amdgcn_cvt_pk_fp8_f32(o[d0][4 * g4 + 0] * inv8, o[d0][4 * g4 + 1] * inv8, 0, false), true);
            }
        store_rows();
    }
    __syncthreads();
}
__device__ __forceinline__ void attn_phase(Frame& F, const Args& a, int l) {
    unsigned char* ws = F.ws;
    AttnPtrs A;
    A.P = (const bf16_t*)(ws + WS_P); A.QM = (const bf16_t*)(ws + WS_QM); A.KVM = (const bf16_t*)(ws + WS_KVM); A.MIX = (unsigned char*)(ws + WS_MIX);
    A.sink = a.in[14] + l * 8; A.subg = a.in[13] + l * 64;
    A.lam_full = ((const float*)(ws + WS_CTL))[CW_LAM + l]; A.one_m_li = 1.0f - a.lam_init[l];
    const int n1 = NB * 4 * 8, n2 = n1 + NB * 4 * 16, n3 = n2 + NB * 8 * 8;
    const int n4 = (l == NL - 1) ? n3 : n3 + NB * 4, n5 = (l == NL - 1) ? n3 : n4 + NB * 4 * 2, n6 = (l == NL - 1) ? n3 : n5 + NB * 8;
    unsigned* ctr = (unsigned*)(ws + WS_CTL) + CW_ATTQ + l;
    volatile LAS unsigned* qslot = (volatile LAS unsigned*)(F.lds + MISC_OFF + 1024);
#ifndef ATT_DUP
#define ATT_DUP 0
#endif
    const int ndup = ATT_DUP == 1 ? n1 : (ATT_DUP == 2 ? n2 - n1 : (ATT_DUP == 3 ? n3 - n2 : 0));
    const int nconv = CONV_NCHUNK, total = n6 + nconv + ndup;
    if (opaque_tid() == 0) qslot[0] = atomicAdd(ctr, 1u);
    __syncthreads();
    int u = (int)qslot[0];
    while (u < total) {
        unsigned nxt = 0u;
        if (opaque_tid() == 0) nxt = atomicAdd((unsigned*)(ws + WS_CTL) + CW_ATTQ + l, 1u);
        if ((u & 3) == 3 && (u >> 2) < nconv) {
            nxt = (unsigned)__builtin_amdgcn_readfirstlane((int)nxt);
            const int ch = u >> 2, base = l * FAST_PER_LAYER + ch * CONV_CHUNK;
            fast_convert(F, a, opaque_tid(), base, base + CONV_CHUNK, F.wave, NWAVES);
        } else {
            int ua = u - min(nconv, u >> 2);
            if (ua >= n6) ua = (ATT_DUP == 1 ? 0 : (ATT_DUP == 2 ? n1 : n2)) + (ua - n6);
            int kind, ub, uh, uq;
            if (ua < n1) { kind = 0; ub = ua >> 5; uh = (ua >> 3) & 3; uq = 1 + (ua & 7); }
            else if (ua < n2) { const int v = ua - n1; kind = 1; ub = v >> 6; uh = (v >> 4) & 3; uq = 2 + (v & 15); }
            else if (ua < n3) { const int v = ua - n2; kind = 2; ub = v >> 6; uh = (v >> 3) & 7; uq = 1 + (v & 7); }
            else if (ua < n4) { const int v = ua - n3; kind = 0; ub = v >> 2; uh = v & 3; uq = 0; }
            else if (ua < n5) { const int v = ua - n4; kind = 1; ub = v >> 3; uh = (v >> 1) & 3; uq = v & 1; }
            else { const int v = ua - n5; kind = 2; ub = v >> 3; uh = v & 7; uq = 0; }
            if (kind == 0) attn_unit<0>(A, ub, uh, uq, F.lds, nxt);
            else if (kind == 1) attn_unit<1>(A, ub, uh, uq, F.lds, nxt);
            else attn_unit<2>(A, ub, uh, uq, F.lds, nxt);
        }
        if (opaque_tid() == 0) qslot[0] = nxt;
        __syncthreads();
        u = (int)qslot[0];
    }
}

constexpr int PH_PER_LAYER = 8, N_PHASES = 2 + NL * PH_PER_LAYER;
__global__ void __launch_bounds__(NTHR, 2) trunk_fwd(Args args) {
    extern __shared__ __attribute__((aligned(16))) unsigned char lds_raw[];
    Frame F;
    F.lds = (LAS unsigned char*)lds_raw; F.ws = args.ws;
    F.tid = threadIdx.x; F.lane = F.tid & 63; F.wave = __builtin_amdgcn_readfirstlane(F.tid >> 6);
    F.G = gridDim.x; { const int bx = blockIdx.x; F.vcu = (F.G % 8 == 0) ? (bx % 8) * (F.G / 8) + bx / 8 : bx; }
    volatile LAS unsigned* MISC = (volatile LAS unsigned*)(F.lds + MISC_OFF);
    if (F.tid < 64) MISC[F.tid] = 0u;
    __syncthreads();
    const int lo = args.ph_lo, hi = args.ph_hi;
    const bool multi = (hi - lo) > 1;
    XcdBarrier bar; bar.bar = (unsigned*)(F.ws + WS_CTL) + CW_BAR; bar.x = 0; bar.st = MISC;
    if (multi) bar = xcd_barrier_post((unsigned*)(F.ws + WS_CTL) + CW_BAR, MISC);
    unsigned char* ws = F.ws;
#ifndef DIAG_KINDS
#define DIAG_KINDS 0x3ff
#endif
#ifndef REP_PRO
#define REP_PRO 1
#define REP_WIN 1
#define REP_UP 1
#define REP_ATT 1
#define REP_GU 1
#define REP_DOWN 1
#endif
#define KON(x) (((DIAG_KINDS) >> (x)) & 1)
#define IN(k) (lo <= (k) && (k) < hi)
#define SEAM(k) do { if (IN(k) && IN((k) + 1)) xcd_barrier(bar); } while (0)
    if (KON(0) && IN(0)) { asm volatile("; PHASE_MARK 0"); for (int rep = 0; rep < REP_PRO; ++rep) prologue_phase(F, args); }
    SEAM(0);
    for (int l = 0; l < NL; ++l) {
        const int pb = 1 + l * PH_PER_LAYER;
        const bool last = (l == NL - 1);
        if (KON(1) && IN(pb + 0)) { asm volatile("; PHASE_MARK 1");
#ifndef REP_N1
#define REP_N1 1
#endif
            for (int rep = 1; rep < REP_N1; ++rep) norm1_phase<0, false>(F, args, l, true);
            if (l == 0) norm1_phase<0, true>(F, args, l); else norm1_phase<0, false>(F, args, l); }
        SEAM(pb + 0);
        const bool chain = (F.G == 256);
        const pg8::ChainMap CM{(int)blockIdx.x & 7, (int)blockIdx.x >> 3};
        if (KON(2) && IN(pb + 1)) { asm volatile("; PHASE_MARK 2");
            pg8::EpiWin E{(bf16_t*)(ws + WS_P), (float*)(ws + WS_SSQ), (const float*)(ws + WS_ROPER), (const float*)(ws + WS_ROPEW)};
            if (chain) {
                pg8::WinChainSched S{(const char*)(ws + WS_H), (const char*)(ws + WS_WIN) + (size_t)l * PW * D, D / 2, D / 2, CM};
                for (int rep = 0; rep < REP_WIN; ++rep) pg8::gemm_phase<pg8::EpiWin, pg8::WinChainSched, true, true>(F.lds, D / 2, D / 2, D / 2, S, E);
            } else {
                pg8::DenseSched S{(const char*)(ws + WS_H), (const char*)(ws + WS_WIN) + (size_t)l * PW * D, D / 2, D / 2, NPAN, PW / 256, F.G, (int)blockIdx.x, 0};
                for (int rep = 0; rep < REP_WIN; ++rep) pg8::gemm_phase<pg8::EpiWin, pg8::DenseSched, true, true>(F.lds, D / 2, D / 2, D / 2, S, E);
            }
        }
        if (!chain) SEAM(pb + 1);
        else {
            __builtin_amdgcn_fence(__ATOMIC_ACQUIRE, "agent"); asm volatile("s_waitcnt vmcnt(0)" ::: "memory"); __syncthreads();
        }
        if (KON(3) && IN(pb + 2)) { asm volatile("; PHASE_MARK 3");
            pg8::EpiUp E{(bf16_t*)(ws + WS_QM), (bf16_t*)(ws + WS_KVM), (const float*)(ws + WS_SSQ), (const float*)(ws + WS_ROPER)};
            if (chain) {
                pg8::UpChainSched S{(const char*)(ws + WS_P), (const char*)(ws + WS_WUQ) + (size_t)l * 512 * 256 * 2, (const char*)(ws + WS_WUKV) + (size_t)l * 512 * 256 * 2, CM};
                for (int rep = 0; rep < REP_UP; ++rep) pg8::gemm_phase<pg8::EpiUp, pg8::UpChainSched, true>(F.lds, 256, PW, 256, S, E);
            } else {
                pg8::UpSched S{(const char*)(ws + WS_P), (const char*)(ws + WS_WUQ) + (size_t)l * 512 * 256 * 2, (const char*)(ws + WS_WUKV) + (size_t)l * 512 * 256 * 2, F.G, (int)blockIdx.x};
                for (int rep = 0; rep < REP_UP; ++rep) pg8::gemm_phase<pg8::EpiUp, pg8::UpSched, true>(F.lds, 256, PW, 256, S, E);
            }
        }
        SEAM(pb + 2);
        if (KON(4) && IN(pb + 3)) { asm volatile("; PHASE_MARK 4"); for (int rep = 0; rep < REP_ATT; ++rep) attn_phase(F, args, l); }
        SEAM(pb + 3);
        if (KON(5) && IN(pb + 4)) { asm volatile("; PHASE_MARK 5");
            pg8::DenseSched S{(const char*)(ws + WS_MIX), (const char*)(ws + WS_WOUT) + (size_t)l * D * D, D / 2, D / 2, last ? NB * 8 : NPAN, D / 256, F.G, (int)blockIdx.x, last ? 1 : 0};
            pg8::EpiWout E{(bf16_t*)(ws + WS_X), (const float*)(ws + WS_MOD) + (size_t)l * 17 * 6144};
            pg8::gemm_phase<pg8::EpiWout, pg8::DenseSched, true, true>(F.lds, D / 2, D / 2, D / 2, S, E);
        }
        SEAM(pb + 4);
        if (KON(6) && IN(pb + 5)) { asm volatile("; PHASE_MARK 6"); norm2_router_phase(F, args, l); }
        SEAM(pb + 5);
        if (KON(7) && IN(pb + 6)) { asm volatile("; PHASE_MARK 7");
            load_counts(F, l);
            pg8::MoeSched<true> S{(const char*)(ws + WS_H), (const char*)(ws + WS_WGU) + (size_t)l * NE * 2048 * D, (const int*)(ws + WS_SLOTTOK),
                                  (volatile LAS int*)(F.lds + MISC_OFF + 256), (volatile LAS int*)(F.lds + MISC_OFF + 512), 8, F.G, (int)blockIdx.x, (size_t)2048 * D, opaque_tid() & 31};
            pg8::EpiGateUp E{(unsigned char*)(ws + WS_ACT), args.in[20] + (size_t)l * NE * D, args.in[22] + (size_t)l * NE * D};
            for (int rep = 0; rep < REP_GU; ++rep) pg8::gemm_phase<pg8::EpiGateUp, pg8::MoeSched<true>, true, true>(F.lds, D / 2, D / 2, D / 2, S, E);
        }
        SEAM(pb + 6);
        if (KON(8) && IN(pb + 7)) { asm volatile("; PHASE_MARK 8");
            load_counts(F, l);
            pg8::MoeSched<false> S{(const char*)(ws + WS_ACT), (const char*)(ws + WS_WD) + (size_t)l * NE * D * D, (const int*)(ws + WS_SLOTTOK),
                                   (volatile LAS int*)(F.lds + MISC_OFF + 256), (volatile LAS int*)(F.lds + MISC_OFF + 512), 4, F.G, (int)blockIdx.x, (size_t)D * D, opaque_tid() & 31};
            pg8::EpiDown E{(bf16_t*)(ws + WS_Y), args.in[24] + (size_t)l * NE * D, (const float*)(ws + WS_SLOTW)};
            for (int rep = 0; rep < REP_DOWN; ++rep) pg8::gemm_phase<pg8::EpiDown, pg8::MoeSched<false>, true, true>(F.lds, D / 2, D / 2, D / 2, S, E);
        }
        SEAM(pb + 7);
    }
    if (KON(9) && IN(N_PHASES - 1)) { asm volatile("; PHASE_MARK 9"); norm1_phase<1, false>(F, args, NL); }
#undef IN
#undef SEAM
}

extern "C" void kernel_launch(void* const* d_in, const int* in_sizes, int n_in, void* d_out, int out_size, void* d_ws, size_t ws_size, hipStream_t stream) {
    static int grid = 0;
    if (grid == 0) {
        if (n_in != 26 || ws_size < WS_END) { fprintf(stderr, "kernel_launch: unexpected inputs (n_in %d, ws %zu)\n", n_in, ws_size); grid = -1; return; }
        int dev = 0, cus = 0, per_cu = 0;
        if (hipGetDevice(&dev) != hipSuccess || hipDeviceGetAttribute(&cus, hipDeviceAttributeMultiprocessorCount, dev) != hipSuccess) { grid = -1; return; }
        if (hipFuncSetAttribute((const void*)trunk_fwd, hipFuncAttributeMaxDynamicSharedMemorySize, LDS_BYTES) != hipSuccess) { fprintf(stderr, "kernel_launch: hipFuncSetAttribute failed\n"); grid = -1; return; }
        if (hipOccupancyMaxActiveBlocksPerMultiprocessor(&per_cu, (const void*)trunk_fwd, NTHR, LDS_BYTES) != hipSuccess || per_cu < 1)
            fprintf(stderr, "kernel_launch: occupancy query reports %d workgroups per CU\n", per_cu);
        (void)hipGetLastError();
        grid = cus;
    }
    if (grid < 0) return;
    if (hipMemsetAsync((char*)d_ws + WS_CTL, 0, CTL_ZERO_BYTES, stream) != hipSuccess) return;
    Args a{};
    for (int i = 0; i < 26; ++i) a.in[i] = (const float*)d_in[i];
    a.out = (float*)d_out; a.ws = (unsigned char*)d_ws;
    for (int i = 0; i < 8; ++i) a.invf8[i] = pow(10000.0, -(double)i / 8.0);
    for (int i = 0; i < 16; ++i) a.invf16[i] = pow(10000.0, -(double)i / 16.0);
    for (int i = 0; i < 4; ++i) a.lam_init[i] = (float)(0.8 - 0.6 * exp(-0.3 * (double)i));
#if MK_ONE_LAUNCH
    a.ph_lo = 0; a.ph_hi = N_PHASES;
    hipLaunchKernelGGL(trunk_fwd, dim3(grid), dim3(NTHR), LDS_BYTES, stream, a);
#else
    for (int p = 0; p < N_PHASES; ++p) { a.ph_lo = p; a.ph_hi = p + 1; hipLaunchKernelGGL(trunk_fwd, dim3(grid), dim3(NTHR), LDS_BYTES, stream, a); }
#endif
}
```

```cpp
#include <hip/hip_runtime.h>
#include <cstdio>
#include <cstdint>
#include <cmath>

#ifndef MK_ONE_LAUNCH
#define MK_ONE_LAUNCH 1
#endif

#define LAS __attribute__((address_space(3)))
#define GAS __attribute__((address_space(1)))
typedef unsigned short bf16_t;
typedef short bf16x8 __attribute__((ext_vector_type(8)));
typedef short v4i16_t __attribute__((ext_vector_type(4)));
typedef float f32x4 __attribute__((ext_vector_type(4)));
typedef float f32x2 __attribute__((ext_vector_type(2)));
typedef float f32x16 __attribute__((ext_vector_type(16)));
typedef unsigned u32x4 __attribute__((ext_vector_type(4)));
typedef unsigned u32x2 __attribute__((ext_vector_type(2)));
typedef __bf16 bf16x2_t __attribute__((ext_vector_type(2)));

constexpr int NB = 16, SEQ = 2048, CTX = 256, NTK = SEQ + CTX, T = NB * NTK, D = 1024, NL = 4, NE = 32;
constexpr int PW = 2048;
constexpr int NPAN = T / 256;
constexpr int MAXPAN = 608;
constexpr int NWAVES = 8, NTHR = 512;
constexpr float EPS = 1e-6f;
constexpr float LOG2E = 1.4426950408889634f;
constexpr float SC_MLA = 0.10206207261596577f * LOG2E;
constexpr float SC_DIFF = 0.17677669529663687f * LOG2E;
constexpr float SC_SWA = 0.125f * LOG2E;
constexpr float F8_SW = 64.0f, F8_SA = 4.0f;
constexpr float F8_INV = 1.0f / (F8_SW * F8_SA);
constexpr float F8_SM = 16.0f, F8_INVM = 1.0f / (F8_SW * F8_SM);
constexpr float F8_SY = 64.0f;

constexpr size_t MiB = 1u << 20;
constexpr size_t WS_CTL = 0, CTL_ZERO_BYTES = 1 * MiB;
constexpr size_t WS_MOD = 1 * MiB;
constexpr size_t WS_ROPER = 3 * MiB;
constexpr size_t WS_ROPEW = WS_ROPER + 262144;
constexpr size_t WS_SSQ = 4 * MiB;
constexpr size_t WS_TOKSLOT = 6 * MiB;
constexpr size_t WS_SLOTTOK = 7 * MiB;
constexpr size_t WS_SLOTW = 12 * MiB;
constexpr size_t WS_WR = 17 * MiB;
constexpr size_t WS_WUQ = 18 * MiB;
constexpr size_t WS_WUKV = 19 * MiB;
constexpr size_t WS_WIN = 20 * MiB;
constexpr size_t WS_WOUT = 36 * MiB;
constexpr size_t WS_WGU = 44 * MiB;
constexpr size_t WS_WD = 556 * MiB;
constexpr size_t WS_X = 812 * MiB;
constexpr size_t WS_H = 956 * MiB;
constexpr size_t WS_ACT = 1028 * MiB;
constexpr size_t WS_P = WS_ACT;
constexpr size_t WS_QM = WS_ACT + 144 * MiB;
constexpr size_t WS_KVM = WS_ACT + 171 * MiB;
constexpr size_t WS_MIX = WS_ACT + 207 * MiB;
constexpr size_t WS_Y = 1332 * MiB;
constexpr size_t WS_END = 1636 * MiB;
constexpr int CW_LAM = 64;
constexpr int CW_ATTQ = 2048;
constexpr int CW_CUR = 1024;
constexpr int CW_BAR = 4096;

constexpr int RING_BYTES = 131072;
constexpr int MISC_OFF = RING_BYTES;
constexpr int GOFF_OFF = RING_BYTES + 4096;
constexpr int LCONST_OFF = RING_BYTES + 4096 + 8192;
constexpr int LCONST2_OFF = LCONST_OFF + 8192;
constexpr int LDS_BYTES = RING_BYTES + 4096 + 8192 + 8192 + 8192;

__device__ __forceinline__ unsigned cvtpk(float lo, float hi) { f32x2 v = {lo, hi}; bf16x2_t b = __builtin_convertvector(v, bf16x2_t); return __builtin_bit_cast(unsigned, b); }
__device__ __forceinline__ float bf2f(unsigned short b) { return __uint_as_float(((unsigned)b) << 16); }
__device__ __forceinline__ float bflo(unsigned w) { return __uint_as_float(w << 16); }
__device__ __forceinline__ float bfhi(unsigned w) { return __uint_as_float(w & 0xffff0000u); }
__device__ __forceinline__ float wave_sum(float v) {
#pragma unroll
    for (int o = 1; o < 64; o <<= 1) v += __shfl_xor(v, o);
    return v;
}
__device__ __forceinline__ int opaque_tid() { int t = threadIdx.x; asm volatile("" : "+v"(t)); return t; }
__device__ __forceinline__ int il(int i, int hd) { return (i & 1) ? (i >> 1) + (hd >> 1) : (i >> 1); }

#define XB_TMO      128
#define XB_XCNT(j)  (256  + 64 * (j))
#define XB_XSUB(j)  (1280 + 64 * (j))
#define XB_XGEN(j)  (2304 + 64 * (j))
#define XB_TOP      3328
#define XB_TOPGEN   3392
#define XCD_BAR_WORDS 3456
#define XB_SPIN_CAP (1u << 20)
__device__ __forceinline__ unsigned xb_ld(unsigned* p)              { return __hip_atomic_load(p, __ATOMIC_RELAXED, __HIP_MEMORY_SCOPE_AGENT); }
__device__ __forceinline__ unsigned xb_add(unsigned* p, unsigned v) { return __hip_atomic_fetch_add(p, v, __ATOMIC_RELAXED, __HIP_MEMORY_SCOPE_AGENT); }
__device__ __forceinline__ unsigned xb_xcc_id() { return (unsigned)__builtin_amdgcn_s_getreg((3 << 11) | 20) & 0xFu; }
#define XB_SPIN(cond, bar) do { unsigned _sp = 0; while (cond) { __builtin_amdgcn_s_sleep(1); \
    if ((++_sp & 255u) == 0u) { if (xb_ld(&(bar)[XB_TMO])) break; if (_sp > XB_SPIN_CAP) { atomicAdd(&(bar)[XB_TMO], 1u); break; } } } } while (0)
struct XcdBarrier { unsigned* bar; unsigned x; volatile LAS unsigned* st; };
__device__ __forceinline__ XcdBarrier xcd_barrier_post(unsigned* bar, volatile LAS unsigned* st) {
    XcdBarrier b; b.bar = bar; b.x = xb_xcc_id(); b.st = st;
    if (threadIdx.x == 0) (void)xb_add(&bar[XB_XCNT(b.x)], 1u);
    return b;
}
__device__ __forceinline__ void xcd_barrier_complete(unsigned* bar, unsigned x, unsigned& nloc, unsigned& nx) {
    const unsigned G = gridDim.x * gridDim.y * gridDim.z;
    unsigned sum, cnt, mine, sp = 0u;
    for (;;) {
        sum = 0u; cnt = 0u; mine = 0u;
#pragma unroll
        for (unsigned j = 0; j < 16; ++j) { const unsigned c = xb_ld(&bar[XB_XCNT(j)]); sum += c; cnt += (c > 0u) ? 1u : 0u; mine = (j == x) ? c : mine; }
        if (sum == G) break;
        __builtin_amdgcn_s_sleep(1);
        if ((++sp & 255u) == 0u) { if (xb_ld(&bar[XB_TMO])) break; if (sp > XB_SPIN_CAP) { atomicAdd(&bar[XB_TMO], 1u); break; } }
    }
    nloc = mine > 0u ? mine : 1u; nx = cnt > 0u ? cnt : 1u;
}
__device__ __forceinline__ void xcd_barrier(const XcdBarrier& b) {
    asm volatile("s_waitcnt vmcnt(0)" ::: "memory");
    __syncthreads();
    if (threadIdx.x == 0) {
        unsigned* bar = b.bar;
        __builtin_amdgcn_s_waitcnt(0);
        unsigned nloc = b.st[0], nx = b.st[1];
        if (nloc == 0u) { xcd_barrier_complete(bar, b.x, nloc, nx); b.st[0] = nloc; b.st[1] = nx; }
        const unsigned old = xb_add(&bar[XB_XSUB(b.x)], 1u);
        const unsigned gen = old / nloc;
        if (old + 1u == (gen + 1u) * nloc) {
            __builtin_amdgcn_fence(__ATOMIC_RELEASE, "agent");
            asm volatile("s_waitcnt vmcnt(0)" ::: "memory");
            const unsigned og = xb_add(&bar[XB_TOP], 1u);
            const unsigned tg = og / nx;
            if (og + 1u == (tg + 1u) * nx) xb_add(&bar[XB_TOPGEN], 1u);
            else XB_SPIN(xb_ld(&bar[XB_TOPGEN]) == tg, bar);
            __builtin_amdgcn_fence(__ATOMIC_ACQUIRE, "agent");
            xb_add(&bar[XB_XGEN(b.x)], 1u);
            asm volatile("s_waitcnt vmcnt(0)" ::: "memory");
        } else {
            XB_SPIN(xb_ld(&bar[XB_XGEN(b.x)]) == gen, bar);
            __builtin_amdgcn_fence(__ATOMIC_ACQUIRE, "agent");
            asm volatile("s_waitcnt vmcnt(0)" ::: "memory");
        }
    }
    __syncthreads();
}

struct Args {
    const float* in[26];
    float* out; unsigned char* ws;
    double invf8[8]; double invf16[16];
    float lam_init[4];
    int ph_lo, ph_hi;
};
struct Frame {
    LAS unsigned char* lds;
    unsigned char* ws;
    int tid, lane, wave, vcu, G;
};

namespace pg8 {
constexpr int BM = 256, BK = 64, HALF = 128, HTB = HALF * BK * 2, STAGE_BYTES = 8 * HTB;
__host__ __device__ __forceinline__ int lds_byte(int r, int c) { const int st = (r >> 4) * 2 + (c >> 5), rr = r & 15, cc = c & 31, ob = rr * 64 + cc * 2; return st * 1024 + (ob ^ (((ob >> 9) & 1) << 5)); }
__host__ __device__ __forceinline__ void stage_rc(int b, int& R, int& C) { const int st = b / 1024, sb = b % 1024, swz = sb ^ (((sb >> 9) & 1) << 5); R = (st >> 1) * 16 + swz / 64; C = (st & 1) * 32 + (swz % 64) / 2; }
__host__ __device__ __forceinline__ int perm32(int rho) { const int n = rho >> 4, i = rho & 15; return 8 * (i >> 2) + 4 * n + (i & 3); }

typedef int v8i32 __attribute__((ext_vector_type(8)));
typedef int u32x4i __attribute__((ext_vector_type(4)));
__device__ __forceinline__ v8i32 pk8(bf16x8 lo, bf16x8 hi) { const u32x4 a = __builtin_bit_cast(u32x4, lo), b = __builtin_bit_cast(u32x4, hi); return (v8i32){(int)a.x, (int)a.y, (int)a.z, (int)a.w, (int)b.x, (int)b.y, (int)b.z, (int)b.w}; }
struct Unit { const char* a; const char* b; int pm, pn, e, j, cnt; };

template <class Epi, class Sched, bool ALIGN_EPI, bool FP8 = false>
__device__ __forceinline__ void gemm_phase(LAS unsigned char* lds, const int K, const int lda, const int ldb, const Sched& S, const Epi& E) {
    const int tid = opaque_tid(), wid = __builtin_amdgcn_readfirstlane(tid >> 6), lane = tid & 63, wr = wid >> 2, wc = wid & 3, fr = lane & 15, fq = lane >> 4;
    const int nt = K / BK;
    int Rs[2], Cs[2]; unsigned voffBp[2];
#pragma unroll
    for (int i = 0; i < 2; ++i) { int R, C; stage_rc(tid * 16 + i * 8192, R, C); Rs[i] = R; Cs[i] = C; const int Rb = Epi::PERM ? ((R & ~31) + perm32(R & 31)) : R; voffBp[i] = (unsigned)(Rb * ldb + C) * 2u; }
    const size_t kstep = (size_t)(BK * 2);
    const size_t hstepB = (size_t)HALF * ldb * 2;
    const unsigned ldsw = (unsigned)wid * 1024u;
#define PG8_SA(b, h) (((b) * 2 + (h)) * HTB)
#define PG8_SB(b, h) ((4 + (b) * 2 + (h)) * HTB)
#define PG8_STAGE2(bufoff, gbase, o0, o1) do { \
        __builtin_amdgcn_global_load_lds((const unsigned*)((const char*)(gbase) + (o0)), (LAS unsigned*)(lds + (bufoff) + ldsw), 16, 0, 0); \
        __builtin_amdgcn_global_load_lds((const unsigned*)((const char*)(gbase) + (o1)), (LAS unsigned*)(lds + (bufoff) + ldsw + 8192), 16, 0, 0); } while (0)
#define PG8_STAGEB(bufoff, gbase) PG8_STAGE2(bufoff, gbase, voffB[0], voffB[1])
#define PG8_STAGEBP(bufoff, gbase) PG8_STAGE2(bufoff, gbase, voffBp[0], voffBp[1])
#define PG8_LD32(p) __builtin_shufflevector(*(const LAS u32x4i*)(p), *(const LAS u32x4i*)((p) + 1024), 0, 1, 2, 3, 4, 5, 6, 7)
#define PG8_LDA(dst, b, h) do { if constexpr (FP8) { _Pragma("unroll") for (int m = 0; m < 4; ++m) dst##8[m] = PG8_LD32(lds + PG8_SA(b, h) + aoff + m * 2048); } \
        else { _Pragma("unroll") for (int m = 0; m < 4; ++m) _Pragma("unroll") for (int k = 0; k < 2; ++k) dst[m][k] = *(const LAS bf16x8*)(lds + PG8_SA(b, h) + aoff + m * 2048 + k * 1024); } } while (0)
#define PG8_LDB(dst, b, h) do { if constexpr (FP8) { _Pragma("unroll") for (int n = 0; n < 2; ++n) dst##8[n] = PG8_LD32(lds + PG8_SB(b, h) + boff + n * 2048); } \
        else { _Pragma("unroll") for (int n = 0; n < 2; ++n) _Pragma("unroll") for (int k = 0; k < 2; ++k) dst[n][k] = *(const LAS bf16x8*)(lds + PG8_SB(b, h) + boff + n * 2048 + k * 1024); } } while (0)
  \

#define PG8_MMA(ai, bj, At, Bt) do { __builtin_amdgcn_s_setprio(1); _Pragma("unroll") for (int m = 0; m < 4; ++m) _Pragma("unroll") for (int n = 0; n < 2; ++n) { \
        if constexpr (FP8) { asm volatile("v_mfma_scale_f32_16x16x128_f8f6f4 %0, %1, %2, %0, %3, %3 op_sel_hi:[0,0,0]" : "+v"(acc[ai][bj][m][n]) : "v"(Bt##8[n]), "v"(At##8[m]), "v"(f8scale)); } \
        else { _Pragma("unroll") for (int k = 0; k < 2; ++k) acc[ai][bj][m][n] = __builtin_amdgcn_mfma_f32_16x16x32_bf16(Bt[n][k], At[m][k], acc[ai][bj][m][n], 0, 0, 0); } } \
        __builtin_amdgcn_s_setprio(0); } while (0)
#define PG8_WAIT_V(n) asm volatile("s_waitcnt vmcnt(" #n ")" ::: "memory")
#define PG8_WAIT_L(n) asm volatile("s_waitcnt lgkmcnt(" #n ")" ::: "memory")
#define PG8_BAR __builtin_amdgcn_s_barrier()
#define PG8_SCHED __builtin_amdgcn_sched_barrier(0)
    Unit cur, nxt; int ui = 0;
    if (!S.next(0, cur)) return;
    f32x4 acc[2][2][4][2];
#pragma unroll
    for (int a = 0; a < 2; ++a)
#pragma unroll
        for (int b = 0; b < 2; ++b)
#pragma unroll
            for (int m = 0; m < 4; ++m)
#pragma unroll
                for (int n = 0; n < 2; ++n) acc[a][b][m][n] = (f32x4){0.f, 0.f, 0.f, 0.f};
    bf16x8 At[4][2], B0[2][2], B1[2][2]; v8i32 At8[4], B08[2], B18[2];
    unsigned vc00, vc01, vc10, vc11, vn00, vn01, vn10, vn11;
    vc00 = (unsigned)(S.arow(cur, Rs[0]) * lda + Cs[0]) * 2u; vc01 = (unsigned)(S.arow(cur, Rs[1]) * lda + Cs[1]) * 2u;
    vc10 = (unsigned)(S.arow(cur, HALF + Rs[0]) * lda + Cs[0]) * 2u; vc11 = (unsigned)(S.arow(cur, HALF + Rs[1]) * lda + Cs[1]) * 2u;
    const char* cA = cur.a; const char* cB = cur.b;
    { const int t3_ = opaque_tid(), l3_ = t3_ & 63, fr3_ = l3_ & 15, fq3_ = l3_ >> 4; u32x4 lc_;
      { int R, C; stage_rc(t3_ * 16, R, C); const int Rb = Epi::PERM ? ((R & ~31) + perm32(R & 31)) : R; lc_.x = (unsigned)(Rb * ldb + C) * 2u; }
      { int R, C; stage_rc(t3_ * 16 + 8192, R, C); const int Rb = Epi::PERM ? ((R & ~31) + perm32(R & 31)) : R; lc_.y = (unsigned)(Rb * ldb + C) * 2u; }
      lc_.z = (unsigned)lds_byte(wr * 64 + fr3_, fq3_ * 8); lc_.w = (unsigned)lds_byte(wc * 32 + fr3_, fq3_ * 8);
      *(LAS u32x4*)(lds + LCONST_OFF + (t3_ << 4)) = lc_;
      if constexpr (Sched::GATHER) { int R0, C0, R1, C1; stage_rc(t3_ * 16, R0, C0); stage_rc(t3_ * 16 + 8192, R1, C1); *(LAS u32x4*)(lds + LCONST2_OFF + (t3_ << 4)) = (u32x4){(unsigned)R0, (unsigned)C0, (unsigned)R1, (unsigned)C1}; } }
    PG8_STAGEBP(PG8_SB(0, 0), cB); PG8_STAGEBP(PG8_SB(0, 1), cB + hstepB); PG8_STAGE2(PG8_SA(0, 0), cA, vc00, vc01); PG8_STAGE2(PG8_SA(0, 1), cA, vc10, vc11);
    if (wr == 1) PG8_BAR;
    PG8_WAIT_V(2); PG8_BAR;
    PG8_STAGEBP(PG8_SB(1, 0), cB + kstep); PG8_STAGE2(PG8_SA(1, 0), cA + kstep, vc00, vc01); PG8_STAGEBP(PG8_SB(1, 1), cB + hstepB + kstep);
    PG8_WAIT_V(6); PG8_BAR;
    bool has_next = S.next(1, nxt);
    if (Sched::GATHER && has_next) {
        int R0, C0, R1, C1; { const int t2_ = opaque_tid(); stage_rc(t2_ * 16, R0, C0); stage_rc(t2_ * 16 + 8192, R1, C1); }
        LAS unsigned* gp = (LAS unsigned*)(lds + GOFF_OFF) + (opaque_tid() << 2);
        gp[0] = (unsigned)(S.arow(nxt, R0) * lda + C0) * 2u; gp[1] = (unsigned)(S.arow(nxt, R1) * lda + C1) * 2u;
        gp[2] = (unsigned)(S.arow(nxt, HALF + R0) * lda + C0) * 2u; gp[3] = (unsigned)(S.arow(nxt, HALF + R1) * lda + C1) * 2u;
    }
    for (;;) {
        const char* nA = has_next ? nxt.a : cA; const char* nB = has_next ? nxt.b : cB;
        vn00 = vc00; vn01 = vc01; vn10 = vc10; vn11 = vc11;
#ifndef KREP
#define KREP 1
#endif
        constexpr int krep = (FP8 && Epi::PROBE) ? KREP : 1;
#pragma unroll 1
        for (int tq = 0; tq < krep * nt; tq += 2) {
            const int t = tq % nt;
            const bool last = (tq == krep * nt - 2);
            const int f8scale = (tq < nt) ? 0x7F7F7F7F : 0;
            unsigned voffB[2]; int aoff, boff;
            { const u32x4 lc_ = *(const LAS u32x4*)(lds + LCONST_OFF + (opaque_tid() << 4)); voffB[0] = lc_.x; voffB[1] = lc_.y; aoff = (int)lc_.z; boff = (int)lc_.w; }
            if (Sched::GATHER && last) { const LAS unsigned* gp = (const LAS unsigned*)(lds + GOFF_OFF) + (opaque_tid() << 2); vn00 = gp[0]; vn01 = gp[1]; vn10 = gp[2]; vn11 = gp[3]; }
            const char* a1 = cA + (size_t)(t + 1) * kstep;
            const char* a2 = last ? nA : cA + (size_t)((t + 2) % nt) * kstep; const char* b2 = last ? nB : cB + (size_t)((t + 2) % nt) * kstep;
            const char* a3 = a2 + kstep; const char* b3 = b2 + kstep;
            const unsigned w00 = (Sched::GATHER && last) ? vn00 : vc00, w01 = (Sched::GATHER && last) ? vn01 : vc01, w10 = (Sched::GATHER && last) ? vn10 : vc10, w11 = (Sched::GATHER && last) ? vn11 : vc11;
            const bool relax = (Epi::NST > 0) && (tq == 0) && (ui > 0);
            PG8_LDB(B0, 0, 0); PG8_LDB(B1, 0, 1); PG8_SCHED; PG8_LDA(At, 0, 0); PG8_STAGE2(PG8_SA(1, 1), a1, vc10, vc11);
            if (relax) asm volatile("s_waitcnt vmcnt(%0)" :: "n"(8 + Epi::NST) : "memory"); else PG8_WAIT_V(8);
            PG8_WAIT_L(0); PG8_BAR; PG8_MMA(0, 0, At, B0); PG8_MMA(0, 1, At, B1); PG8_BAR; PG8_SCHED;
            PG8_LDA(At, 0, 1); PG8_STAGEB(PG8_SB(0, 0), b2); PG8_STAGEB(PG8_SB(0, 1), b2 + hstepB); PG8_STAGE2(PG8_SA(0, 0), a2, w00, w01);
            if (relax) asm volatile("s_waitcnt vmcnt(%0)" :: "n"(8 + Epi::NST) : "memory"); else PG8_WAIT_V(8);
            PG8_WAIT_L(0); PG8_BAR; PG8_MMA(1, 0, At, B0); PG8_MMA(1, 1, At, B1); PG8_BAR; PG8_SCHED;
            PG8_LDB(B0, 1, 0); PG8_LDB(B1, 1, 1); PG8_SCHED; PG8_LDA(At, 1, 0); PG8_STAGE2(PG8_SA(0, 1), a2, w10, w11);
            PG8_WAIT_V(8); PG8_WAIT_L(0); PG8_BAR; PG8_MMA(0, 0, At, B0); PG8_MMA(0, 1, At, B1); PG8_BAR; PG8_SCHED;
            PG8_LDA(At, 1, 1); PG8_STAGEB(PG8_SB(1, 0), b3); PG8_STAGEB(PG8_SB(1, 1), b3 + hstepB); PG8_STAGE2(PG8_SA(1, 0), a3, w00, w01);
            PG8_WAIT_V(8); PG8_WAIT_L(0); PG8_BAR; PG8_MMA(1, 0, At, B0); PG8_MMA(1, 1, At, B1); PG8_BAR; PG8_SCHED;
        }
        Unit nn; bool has_nn = has_next && S.next(ui + 2, nn);
        int gt0 = 0, gt1 = 0, gt2 = 0, gt3 = 0;
        if constexpr (Sched::GATHER) if (has_nn) {
            int R0, C0, R1, C1; { const u32x4 rc_ = *(const LAS u32x4*)(lds + LCONST2_OFF + (opaque_tid() << 4)); R0 = (int)rc_.x; C0 = (int)rc_.y; R1 = (int)rc_.z; C1 = (int)rc_.w; }
            gt0 = S.arow_raw(nn, R0); gt1 = S.arow_raw(nn, R1); gt2 = S.arow_raw(nn, HALF + R0); gt3 = S.arow_raw(nn, HALF + R1);
        }
        if constexpr (ALIGN_EPI) { if (wr == 0) PG8_BAR; }
#ifndef REP_EPI
#define REP_EPI 1
#endif
        if constexpr (FP8) asm volatile("s_nop 15\n\ts_nop 15" ::: "memory");
        { const int l2_ = opaque_tid() & 63; for (int rep_ = 0; rep_ < (Epi::PROBE ? REP_EPI : 1); ++rep_) E(acc, cur, wr, wc, l2_ & 15, l2_ >> 4); }
        if (!has_next) break;
#pragma unroll
        for (int a = 0; a < 2; ++a)
#pragma unroll
            for (int b = 0; b < 2; ++b)
#pragma unroll
                for (int m = 0; m < 4; ++m)
#pragma unroll
                    for (int n = 0; n < 2; ++n) { double z0_, z1_; asm volatile("v_mov_b64 %0, 0\n\tv_mov_b64 %1, 0" : "=v"(z0_), "=v"(z1_));
                        typedef double f64x2_t __attribute__((ext_vector_type(2))); const f64x2_t zz_ = {z0_, z1_}; acc[a][b][m][n] = __builtin_bit_cast(f32x4, zz_); }
        cur = nxt; cA = nA; cB = nB; ++ui; vc00 = vn00; vc01 = vn01; vc10 = vn10; vc11 = vn11;
        nxt = nn; has_next = has_nn;
        if constexpr (Sched::GATHER) asm volatile("" : "+v"(gt0), "+v"(gt1), "+v"(gt2), "+v"(gt3));
        if constexpr (Sched::GATHER) if (has_next) {
            int R0, C0, R1, C1; { const u32x4 rc_ = *(const LAS u32x4*)(lds + LCONST2_OFF + (opaque_tid() << 4)); R0 = (int)rc_.x; C0 = (int)rc_.y; R1 = (int)rc_.z; C1 = (int)rc_.w; }
            LAS unsigned* gp = (LAS unsigned*)(lds + GOFF_OFF) + (opaque_tid() << 2);
            gp[0] = (unsigned)(S.arow_fix(nxt, R0, gt0) * lda + C0) * 2u; gp[1] = (unsigned)(S.arow_fix(nxt, R1, gt1) * lda + C1) * 2u;
            gp[2] = (unsigned)(S.arow_fix(nxt, HALF + R0, gt2) * lda + C0) * 2u; gp[3] = (unsigned)(S.arow_fix(nxt, HALF + R1, gt3) * lda + C1) * 2u;
        }
        if constexpr (ALIGN_EPI) { if (wr == 1) PG8_BAR; }
    }
    PG8_WAIT_V(0);
    if constexpr (!ALIGN_EPI) { if (wr == 0) PG8_BAR; }
    PG8_BAR;
#undef PG8_SA
#undef PG8_SB
#undef PG8_STAGE2
#undef PG8_STAGEB
#undef PG8_LDA
#undef PG8_LD32
#undef PG8_LDB
#undef PG8_MMA
#undef PG8_WAIT_V
#undef PG8_WAIT_L
#undef PG8_BAR
#undef PG8_SCHED
}

__device__ __forceinline__ int xcd_remap(int L, int nwg) {
    const int q = nwg / 8, r = nwg % 8, xcd = L % 8, off = L / 8;
    return (xcd < r ? xcd * (q + 1) : r * (q + 1) + (xcd - r) * q) + off;
}

struct DenseSched {
    static constexpr bool GATHER = false;
    const char* A; const char* Bt; int lda, ldb, npan, nN, G, c, latent_only;
    __device__ __forceinline__ bool next(int i, Unit& u) const {
        const int L = i * G + c, nwg = npan * nN; if (L >= nwg) return false;
        const int w = xcd_remap(L, nwg), p = w / nN, pn = w % nN;
        const int pm = latent_only ? (p >> 3) * 9 + 1 + (p & 7) : p;
        u.pm = pm; u.pn = pn; u.e = 0; u.j = 0; u.cnt = 0;
        u.a = A + (size_t)pm * 256 * lda * 2; u.b = Bt + (size_t)pn * 256 * ldb * 2; return true;
    }
    __device__ __forceinline__ int arow(const Unit&, int r) const { return r; }
};
struct UpSched {
    static constexpr bool GATHER = false;
    const char* P; const char* Wuq; const char* Wukv; int G, c;
    __device__ __forceinline__ bool next(int i, Unit& u) const {
        const int L = i * G + c, nwg = NPAN * 4; if (L >= nwg) return false;
        const int w = xcd_remap(L, nwg), p = w >> 2, pn = w & 3;
        u.pm = p; u.pn = pn; u.e = 0; u.j = 0; u.cnt = 0;
        u.a = P + (size_t)p * 256 * PW * 2 + (pn >= 2 ? 512 : 0);
        u.b = (pn >= 2 ? Wukv : Wuq) + (size_t)(pn & 1) * 256 * 256 * 2; return true;
    }
    __device__ __forceinline__ int arow(const Unit&, int r) const { return r; }
};
struct ChainMap {
    int x, r;
    __device__ __forceinline__ int nchain() const { return r < 4 ? 2 : 1; }
    __device__ __forceinline__ int chain(int j) const { return r + 32 * j; }
    __device__ __forceinline__ int nplain() const { return r < 4 ? 1 : (r < 24 ? 4 : 3); }
    __device__ __forceinline__ int plain(int j) const { return r < 4 ? 56 + r : (j == 0 ? r - 4 : (j == 1 ? 24 + r : (j == 2 ? 56 + r : 84 + r))); }
};
struct WinChainSched {
    static constexpr bool GATHER = false;
    const char* A; const char* Bt; int lda, ldb; ChainMap M;
    __device__ __forceinline__ bool next(int i, Unit& u) const {
        const int nc = M.nchain(); if (i >= nc + M.nplain()) return false;
        int q, pn;
        if (i < nc) { const int ch = M.chain(i); q = ch >> 1; pn = ch & 1; } else { const int idx = M.plain(i - nc); q = idx / 6; pn = 2 + idx - q * 6; }
        const int pm = M.x + 8 * q;
        u.pm = pm; u.pn = pn; u.e = 0; u.j = 0; u.cnt = 0;
        u.a = A + (size_t)pm * 256 * lda * 2; u.b = Bt + (size_t)pn * 256 * ldb * 2; return true;
    }
    __device__ __forceinline__ int arow(const Unit&, int r) const { return r; }
};
struct UpChainSched {
    static constexpr bool GATHER = false;
    const char* P; const char* Wuq; const char* Wukv; ChainMap M;
    __device__ __forceinline__ bool next(int i, Unit& u) const {
        if (i >= 2 * M.nchain()) return false;
        const int ch = M.chain(i >> 1), q = ch >> 1, hf = ch & 1, pn = 2 * hf + (i & 1), pm = M.x + 8 * q;
        u.pm = pm; u.pn = pn; u.e = 0; u.j = 0; u.cnt = 0;
        u.a = P + (size_t)pm * 256 * PW * 2 + (hf ? 512 : 0);
        u.b = (hf ? Wukv : Wuq) + (size_t)(pn & 1) * 256 * 256 * 2; return true;
    }
    __device__ __forceinline__ int arow(const Unit&, int r) const { return r; }
};
template <bool GATHER_> struct MoeSched {
    static constexpr bool GATHER = GATHER_;
    const char* A; const char* Bt; const int* slot_tok; volatile LAS int* PB; volatile LAS int* CNT; int nN, G, c; size_t bexp; int ln;
    __device__ __forceinline__ bool next(int i, Unit& u) const {
        const int np = PB[32], nwg = np * nN; const int L = i * G + c; if (L >= nwg) return false;
        const int w = xcd_remap(L, nwg), p = w / nN, pn = w % nN;
        const unsigned long long bal = __ballot(PB[ln + 1] <= p);
        const int e = __builtin_popcount((unsigned)(bal & 0xffffffffull));
        u.pm = p; u.pn = pn; u.e = e; u.j = p - PB[e]; u.cnt = CNT[e];
        u.a = GATHER ? A : A + (size_t)p * 256 * D;
        u.b = Bt + (size_t)e * bexp + (size_t)pn * 256 * D; return true;
    }
    __device__ __forceinline__ int arow_raw(const Unit& u, int r) const { if constexpr (GATHER) return slot_tok[(size_t)u.e * T + min(u.j * 256 + r, u.cnt - 1)]; else return r; }
    __device__ __forceinline__ int arow_fix(const Unit& u, int r, int v) const { if constexpr (GATHER) return (u.j * 256 + r) < u.cnt ? v : 0; else return r; }
    __device__ __forceinline__ int arow(const Unit& u, int r) const {
        if constexpr (GATHER) { const int pos = u.j * 256 + r; const int v = slot_tok[(size_t)u.e * T + min(pos, u.cnt - 1)]; return pos < u.cnt ? v : 0; }
        else return r;
    }
};

__device__ __forceinline__ void rope4(f32x4& v0, f32x4& v1, const f32x4* tab) {
    const f32x4 t0 = tab[0], t1 = tab[1];
    f32x4 a, b;
    a[0] = v0[0] * t0[0] - v0[1] * t0[1]; a[1] = v0[1] * t0[0] + v0[0] * t0[1];
    a[2] = v0[2] * t0[2] - v0[3] * t0[3]; a[3] = v0[3] * t0[2] + v0[2] * t0[3];
    b[0] = v1[0] * t1[0] - v1[1] * t1[1]; b[1] = v1[1] * t1[0] + v1[0] * t1[1];
    b[2] = v1[2] * t1[2] - v1[3] * t1[3]; b[3] = v1[3] * t1[2] + v1[2] * t1[3];
    v0 = a; v1 = b;
}
__device__ __forceinline__ u32x4 pack8(const f32x4& v0, const f32x4& v1) { u32x4 w; w.x = cvtpk(v0[0], v0[1]); w.y = cvtpk(v0[2], v0[3]); w.z = cvtpk(v1[0], v1[1]); w.w = cvtpk(v1[2], v1[3]); return w; }

struct EpiWin {
    static constexpr bool PERM = true, PROBE = false; static constexpr int NST = 16;
    bf16_t* P; float* ssq; const float* ropeR; const float* ropeW;
    __device__ __forceinline__ void operator()(const f32x4 (&acc)[2][2][4][2], const Unit& u, int wr, int wc, int fr, int fq) const {
        const int pn = u.pn;
        int mode[2];
        mode[0] = (pn == 2 || pn == 3) ? 1 : ((pn == 5 || pn == 6 || pn == 7) ? 2 : 0);
        mode[1] = (pn == 2 || pn == 3) ? 1 : ((pn == 5 || pn == 6) ? 2 : ((pn == 1 && wc == 0) ? 1 : 0));
        const int iR = 4 * fq, iW = 16 * (wc & 1) + 4 * fq;
        f32x4 tb[2][2][2];
        auto rowof = [&](int g) { return u.pm * 256 + (g >> 2) * 128 + wr * 64 + (g & 3) * 16 + fr; };
        auto ldtab = [&](int g) {
            const int nb = rowof(g) % NTK; const int t = nb >= CTX ? nb - CTX : 0;
#pragma unroll
            for (int bj = 0; bj < 2; ++bj) {
                if (mode[bj] == 1) { const f32x4* p = (const f32x4*)(ropeR + ((size_t)t * 16 + iR) * 2); tb[g & 1][bj][0] = p[0]; tb[g & 1][bj][1] = p[1]; }
                else if (mode[bj] == 2) { const f32x4* p = (const f32x4*)(ropeW + ((size_t)t * 32 + iW) * 2); tb[g & 1][bj][0] = p[0]; tb[g & 1][bj][1] = p[1]; }
            }
        };
        ldtab(0);
#pragma unroll
        for (int g = 0; g < 8; ++g) {
            const int ai = g >> 2, m = g & 3;
            const int row = rowof(g);
            const bool latent = (row % NTK) >= CTX;
            if (g + 1 < 8) ldtab(g + 1);
            float ss = 0.f;
#pragma unroll
            for (int bj = 0; bj < 2; ++bj) {
                f32x4 v0 = acc[ai][bj][m][0] * F8_INV, v1 = acc[ai][bj][m][1] * F8_INV;
                if (pn == 0 || (pn == 1 && bj == 0)) ss += (v0[0] * v0[0] + v0[1] * v0[1]) + (v0[2] * v0[2] + v0[3] * v0[3]) + (v1[0] * v1[0] + v1[1] * v1[1]) + (v1[2] * v1[2] + v1[3] * v1[3]);
                if (mode[bj] != 0) {
                    f32x4 t0 = tb[g & 1][bj][0], t1 = tb[g & 1][bj][1];
                    if (!latent) { t0 = (f32x4){1.f, 0.f, 1.f, 0.f}; t1 = t0; }
                    const f32x4 tt[2] = {t0, t1};
                    rope4(v0, v1, tt);
                }
                *(u32x4*)(P + (size_t)row * PW + pn * 256 + bj * 128 + wc * 32 + fq * 8) = pack8(v0, v1);
            }
            if (pn < 2) { ss += __shfl_xor(ss, 16); ss += __shfl_xor(ss, 32); if (fq == 0) ssq[(size_t)row * 8 + pn * 4 + wc] = ss; }
        }
    }
};
struct EpiUp {
    static constexpr bool PERM = true, PROBE = false; static constexpr int NST = 0;
    bf16_t* QM; bf16_t* KVM; const float* ssq; const float* ropeR;
    __device__ __forceinline__ void operator()(const f32x4 (&acc)[2][2][4][2], const Unit& u, int wr, int wc, int fr, int fq) const {
        const bool isq = u.pn < 2;
        int col0[2], rp[2];
#pragma unroll
        for (int bj = 0; bj < 2; ++bj) { col0[bj] = (u.pn & 1) * 256 + bj * 128 + wc * 32 + fq * 8; const int hl = col0[bj] % 96; rp[bj] = (isq && col0[bj] < 384 && hl >= 64) ? ((hl - 64) >> 1) : -1; }
        f32x4 sq[2]; f32x4 tb[2][2][2];
        auto rowof = [&](int g) { return u.pm * 256 + (g >> 2) * 128 + wr * 64 + (g & 3) * 16 + fr; };
        auto ld = [&](int g) {
            const int row = rowof(g); const int nb = row % NTK; const int t = nb >= CTX ? nb - CTX : 0;
            sq[g & 1] = *(const f32x4*)(ssq + (size_t)row * 8 + (isq ? 0 : 4));
#pragma unroll
            for (int bj = 0; bj < 2; ++bj) if (rp[bj] >= 0) { const f32x4* p = (const f32x4*)(ropeR + ((size_t)t * 16 + rp[bj]) * 2); tb[g & 1][bj][0] = p[0]; tb[g & 1][bj][1] = p[1]; }
        };
        ld(0);
#pragma unroll
        for (int g = 0; g < 8; ++g) {
            const int ai = g >> 2, m = g & 3;
            const int row = rowof(g);
            const bool latent = (row % NTK) >= CTX;
            if (g + 1 < 8) ld(g + 1);
            const f32x4 s4 = sq[g & 1];
            const float ssum = (s4[0] + s4[1]) + (s4[2] + s4[3]);
            const float rstd = __builtin_amdgcn_rsqf(ssum * (isq ? (1.f / 256.f) : (1.f / 128.f)) + EPS);
#pragma unroll
            for (int bj = 0; bj < 2; ++bj) {
                f32x4 v0 = acc[ai][bj][m][0] * rstd, v1 = acc[ai][bj][m][1] * rstd;
                if (isq) {
                    if (col0[bj] < 384) {
                        if (rp[bj] >= 0) {
                            f32x4 t0 = tb[g & 1][bj][0], t1 = tb[g & 1][bj][1];
                            if (!latent) { t0 = (f32x4){1.f, 0.f, 1.f, 0.f}; t1 = t0; }
                            const f32x4 tt[2] = {t0, t1};
                            rope4(v0, v1, tt);
                        }
                        *(u32x4*)(QM + (size_t)row * 384 + col0[bj]) = pack8(v0, v1);
                    }
                } else *(u32x4*)(KVM + (size_t)row * 512 + col0[bj]) = pack8(v0, v1);
            }
        }
    }
};
struct EpiWout {
    static constexpr bool PERM = true, PROBE = false; static constexpr int NST = 16;
    bf16_t* X; const float* modl;
    __device__ __forceinline__ void operator()(const f32x4 (&acc)[2][2][4][2], const Unit& u, int wr, int wc, int fr, int fq) const {
        const int b = u.pm / 9, modrow = (u.pm - b * 9 == 0) ? 16 : b;
        const float* gate = modl + (size_t)modrow * 6144 + 2 * D;
        const int col0 = u.pn * 256 + wc * 32 + 8 * fq;
        f32x4 gv[2][2];
#pragma unroll
        for (int bj = 0; bj < 2; ++bj)
#pragma unroll
            for (int n = 0; n < 2; ++n) gv[bj][n] = *(const f32x4*)(gate + col0 + bj * 128 + n * 4);
        u32x4 xq[2][2];
        auto rowp = [&](int g) { return X + (size_t)(u.pm * 256 + (g >> 2) * 128 + wr * 64 + (g & 3) * 16 + fr) * D + col0; };
        xq[0][0] = *(const u32x4*)(rowp(0)); xq[0][1] = *(const u32x4*)(rowp(0) + 128);
#pragma unroll
        for (int g = 0; g < 8; ++g) {
            const int ai = g >> 2, m = g & 3;
            if (g + 1 < 8) { xq[(g + 1) & 1][0] = *(const u32x4*)(rowp(g + 1)); xq[(g + 1) & 1][1] = *(const u32x4*)(rowp(g + 1) + 128); }
#pragma unroll
            for (int bj = 0; bj < 2; ++bj) {
                const u32x4 xw = xq[g & 1][bj];
                f32x4 x0 = {bflo(xw.x), bfhi(xw.x), bflo(xw.y), bfhi(xw.y)}, x1 = {bflo(xw.z), bfhi(xw.z), bflo(xw.w), bfhi(xw.w)};
                x0 += gv[bj][0] * (acc[ai][bj][m][0] * F8_INVM); x1 += gv[bj][1] * (acc[ai][bj][m][1] * F8_INVM);
                *(u32x4*)(rowp(g) + bj * 128) = pack8(x0, x1);
            }
        }
    }
};
__device__ __forceinline__ f32x4 swiglu4(f32x4 g, f32x4 up, float s) {
    g = __builtin_elementwise_min(g, (f32x4){7.0f, 7.0f, 7.0f, 7.0f});
    up = __builtin_elementwise_min(__builtin_elementwise_max(up, (f32x4){-7.0f, -7.0f, -7.0f, -7.0f}), (f32x4){7.0f, 7.0f, 7.0f, 7.0f});
    const f32x4 t = g * (-1.702f * LOG2E);
    f32x4 e; e[0] = __builtin_amdgcn_exp2f(t[0]); e[1] = __builtin_amdgcn_exp2f(t[1]); e[2] = __builtin_amdgcn_exp2f(t[2]); e[3] = __builtin_amdgcn_exp2f(t[3]);
    const f32x4 d = e + 1.0f;
    f32x4 r; r[0] = __builtin_amdgcn_rcpf(d[0]); r[1] = __builtin_amdgcn_rcpf(d[1]); r[2] = __builtin_amdgcn_rcpf(d[2]); r[3] = __builtin_amdgcn_rcpf(d[3]);
    return (g * r) * (up * s + s);
}
struct EpiGateUp {
    static constexpr bool PERM = true, PROBE = true; static constexpr int NST = 4;
    unsigned char* ACT; const float* bg; const float* bu;
    __device__ __forceinline__ void operator()(const f32x4 (&acc)[2][2][4][2], const Unit& u, int wr, int wc, int fr, int fq) const {
        const int colL = u.pn * 128 + wc * 32 + fq * 8;
        const f32x4 g0 = *(const f32x4*)(bg + (size_t)u.e * D + colL), g1 = *(const f32x4*)(bg + (size_t)u.e * D + colL + 4);
        const f32x4 u0 = *(const f32x4*)(bu + (size_t)u.e * D + colL), u1 = *(const f32x4*)(bu + (size_t)u.e * D + colL + 4);
#pragma unroll
        for (int ai = 0; ai < 2; ++ai)
#pragma unroll
            for (int mp = 0; mp < 2; ++mp) {
                u32x2 w8[2];
#pragma unroll
                for (int h = 0; h < 2; ++h) {
                    const int m = 2 * mp + h;
                    const f32x4 ga = acc[ai][0][m][0] * F8_INV + g0, gb = acc[ai][0][m][1] * F8_INV + g1, ua = acc[ai][1][m][0] * F8_INV + u0, ub = acc[ai][1][m][1] * F8_INV + u1;
                    const f32x4 ra = swiglu4(ga, ua, F8_SA), rb = swiglu4(gb, ub, F8_SA);
                    w8[h].x = (unsigned)__builtin_amdgcn_cvt_pk_fp8_f32(ra[2], ra[3], __builtin_amdgcn_cvt_pk_fp8_f32(ra[0], ra[1], 0, false), true);
                    w8[h].y = (unsigned)__builtin_amdgcn_cvt_pk_fp8_f32(rb[2], rb[3], __builtin_amdgcn_cvt_pk_fp8_f32(rb[0], rb[1], 0, false), true);
                }
                const auto sx = __builtin_amdgcn_permlane16_swap(w8[0].x, w8[1].x, false, false), sy = __builtin_amdgcn_permlane16_swap(w8[0].y, w8[1].y, false, false);
                const int srow = u.pm * 256 + ai * 128 + wr * 64 + (2 * mp + (fq & 1)) * 16 + fr;
                u32x4 w16; w16.x = sx[0]; w16.y = sy[0]; w16.z = sx[1]; w16.w = sy[1];
                *(u32x4*)(ACT + (size_t)srow * D + (u.pn * 128 + wc * 32 + (fq & 2) * 8)) = w16;
            }
    }
};
struct EpiDown {
    static constexpr bool PERM = true, PROBE = true; static constexpr int NST = 8;
    bf16_t* Y; const float* bd; const float* slot_w;
    __device__ __forceinline__ void operator()(const f32x4 (&acc)[2][2][4][2], const Unit& u, int wr, int wc, int fr, int fq) const {
        const int col0 = u.pn * 256 + wc * 32 + fq * 8;
        f32x4 bv[2][2];
#pragma unroll
        for (int bj = 0; bj < 2; ++bj)
#pragma unroll
            for (int n = 0; n < 2; ++n) bv[bj][n] = *(const f32x4*)(bd + (size_t)u.e * D + col0 + bj * 128 + n * 4);
        float wv[8];
#pragma unroll
        for (int g = 0; g < 8; ++g) { const int pos = u.j * 256 + (g >> 2) * 128 + wr * 64 + (g & 3) * 16 + fr; wv[g] = slot_w[(size_t)u.e * T + min(pos, u.cnt - 1)]; }
#pragma unroll
        for (int g = 0; g < 8; ++g) { const int pos = u.j * 256 + (g >> 2) * 128 + wr * 64 + (g & 3) * 16 + fr; wv[g] = pos < u.cnt ? wv[g] : 0.f; }
#pragma unroll
        for (int ai = 0; ai < 2; ++ai)
#pragma unroll
            for (int mp = 0; mp < 2; ++mp) {
                const int rl = ai * 128 + wr * 64 + (2 * mp + (fq & 1)) * 16 + fr;
#pragma unroll
                for (int bj = 0; bj < 2; ++bj) {
                    u32x2 w8[2];
#pragma unroll
                    for (int h = 0; h < 2; ++h) {
                        const int m = 2 * mp + h; const float w = wv[ai * 4 + m];
                        const f32x4 v0 = (acc[ai][bj][m][0] * F8_INV + bv[bj][0]) * (w * F8_SY), v1 = (acc[ai][bj][m][1] * F8_INV + bv[bj][1]) * (w * F8_SY);
                        w8[h].x = (unsigned)__builtin_amdgcn_cvt_pk_fp8_f32(v0[2], v0[3], __builtin_amdgcn_cvt_pk_fp8_f32(v0[0], v0[1], 0, false), true);
                        w8[h].y = (unsigned)__builtin_amdgcn_cvt_pk_fp8_f32(v1[2], v1[3], __builtin_amdgcn_cvt_pk_fp8_f32(v1[0], v1[1], 0, false), true);
                    }
                    const auto sx = __builtin_amdgcn_permlane16_swap(w8[0].x, w8[1].x, false, false), sy = __builtin_amdgcn_permlane16_swap(w8[0].y, w8[1].y, false, false);
                    u32x4 w16; w16.x = sx[0]; w16.y = sy[0]; w16.z = sx[1]; w16.w = sy[1];
                    *(u32x4*)((unsigned char*)Y + (size_t)(u.pm * 256 + rl) * D + (u.pn * 256 + wc * 32 + (fq & 2) * 8) + bj * 128) = w16;
                }
            }
    }
};
}

__device__ __forceinline__ int winmap(int p, float& sc) {
    sc = 1.f;
    if (p < 384) return p;
    if (p < 416) return 384 + il(p - 384, 32);
    if (p < 512) return -1;
    if (p < 768)  { const int q = p - 512;  sc = SC_DIFF; return 416 + (q & ~31) + il(q & 31, 32); }
    if (p < 1024) { const int q = p - 768;  return 672 + (q & ~31) + il(q & 31, 32); }
    if (p < 1280) return 928 + (p - 1024);
    if (p < 1792) { const int q = p - 1280; sc = SC_SWA; return 1184 + (q & ~63) + il(q & 63, 64); }
    if (p < 1920) { const int q = p - 1792; return 1696 + (q & ~63) + il(q & 63, 64); }
    return 1824 + (p - 1920);
}
__device__ __forceinline__ int uqmap(int n) {
    if (n >= 384) return -1;
    const int h = n / 96, i = n - h * 96;
    return h * 96 + (i < 64 ? i : 64 + il(i - 64, 32));
}
struct CvtItem { const float* src; int ld, kvalid, k0, n0, nrows, mapkind, ldd; bf16_t* dst; const float* rowscale; };
constexpr int CVT_PER_LAYER = 256 + 16 + 16 + 8;
constexpr int CVT_ITEMS = NL * CVT_PER_LAYER;
__device__ __forceinline__ void cvt_decode(const Args& a, unsigned char* ws, int it, CvtItem& c) {
    const int l = it / CVT_PER_LAYER; int r = it - l * CVT_PER_LAYER;
    c.rowscale = nullptr; c.mapkind = 0; c.nrows = 64;
    if (r < 256) { c.src = a.in[7] + (size_t)l * D * 1952; c.ld = 1952; c.kvalid = D; c.k0 = (r >> 5) * 128; c.n0 = (r & 31) * 64; c.mapkind = 1; c.ldd = D;
        c.dst = (bf16_t*)(ws + WS_WIN + ((size_t)l * PW * D + (size_t)c.n0 * D)); return; }
    r -= 256;
    if (r < 16) { c.src = a.in[9] + (size_t)l * 256 * 384; c.ld = 384; c.kvalid = 256; c.k0 = (r >> 3) * 128; c.n0 = (r & 7) * 64; c.mapkind = 2; c.ldd = 256; c.rowscale = a.in[8] + l * 256;
        c.dst = (bf16_t*)(ws + WS_WUQ) + (size_t)l * 512 * 256 + (size_t)c.n0 * 256; return; }
    r -= 16;
    if (r < 16) { c.src = a.in[11] + (size_t)l * 128 * 512; c.ld = 512; c.kvalid = 128; c.k0 = (r >> 3) * 128; c.n0 = (r & 7) * 64; c.ldd = 256; c.rowscale = a.in[10] + l * 128;
        c.dst = (bf16_t*)(ws + WS_WUKV) + (size_t)l * 512 * 256 + (size_t)c.n0 * 256; return; }
    r -= 16;
    c.src = a.in[17] + (size_t)l * D * 32; c.ld = 32; c.kvalid = D; c.k0 = r * 128; c.n0 = 0; c.nrows = 32; c.mapkind = 3; c.ldd = D;
    c.dst = (bf16_t*)(ws + WS_WR) + (size_t)l * 32 * D;
}
constexpr int FAST_MATS = NL * (1 + 3 * NE);
constexpr int FAST_ITEMS = FAST_MATS * 256;
constexpr int FAST_PER_LAYER = (1 + 3 * NE) * 256;
constexpr int CONV_CHUNK = 64, CONV_NCHUNK = FAST_PER_LAYER / CONV_CHUNK;
__device__ __forceinline__ void fast_decode(const Args& a, unsigned char* ws, int it, const float*& src, unsigned char*& dst8, bool& f8) {
    const int mat = it >> 8, tile = it & 255, k0 = (tile >> 4) * 64, n0 = (tile & 15) * 64;
    const int l = mat / (1 + 3 * NE); int r = mat - l * (1 + 3 * NE);
    const float* sb;
    if (r == 0) { sb = a.in[15] + (size_t)l * D * D; dst8 = ws + WS_WOUT + ((size_t)l * D * D + (size_t)n0 * D + k0); f8 = true; }
    else { r -= 1; const int e = r / 3, which = r - e * 3; const size_t le = (size_t)l * NE + e; f8 = true;
        if (which == 0)      { sb = a.in[19] + le * D * D; dst8 = ws + WS_WGU + le * 2048 * D + (size_t)((n0 >> 7) * 256 + (n0 & 127)) * D + k0; }
        else if (which == 1) { sb = a.in[21] + le * D * D; dst8 = ws + WS_WGU + le * 2048 * D + (size_t)((n0 >> 7) * 256 + 128 + (n0 & 127)) * D + k0; }
        else                 { sb = a.in[23] + le * D * D; dst8 = ws + WS_WD + le * D * D + (size_t)n0 * D + k0; } }
    src = sb + (size_t)k0 * D + n0;
}
__device__ __forceinline__ void fast_convert(Frame& F, const Args& a, int tid, int it0, int it1, int gw, int NGW) {
    unsigned char* ws = F.ws;
    const int lane = tid & 63, q = lane >> 4, c4 = (lane & 15) * 4;
    LAS unsigned char* tl = F.lds + F.wave * 8704;
    f32x4 v[16]; const float* src; unsigned char* dst8; bool f8;
#define FAST_LOAD() do { _Pragma("unroll") for (int x = 0; x < 16; ++x) { const int kr = f8 ? 16 * (x >> 2) + 4 * q + (x & 3) : 8 * (x >> 1) + 2 * q + (x & 1); \
        v[x] = __builtin_nontemporal_load((const f32x4*)(src + (size_t)kr * D + c4)); } } while (0)
    int it = it0 + gw;
    if (it < it1) { fast_decode(a, ws, it, src, dst8, f8); FAST_LOAD(); }
    for (; it < it1; it += NGW) {
        unsigned char* cdst = dst8; const bool cf8 = f8;
        if (cf8) {
#pragma unroll
            for (int i = 0; i < 4; ++i)
#pragma unroll
                for (int j = 0; j < 4; ++j)
                    *(LAS unsigned*)(tl + (c4 + j) * 68 + 16 * i + 4 * q) = (unsigned)__builtin_amdgcn_cvt_pk_fp8_f32(v[4 * i + 2][j] * F8_SW, v[4 * i + 3][j] * F8_SW, __builtin_amdgcn_cvt_pk_fp8_f32(v[4 * i][j] * F8_SW, v[4 * i + 1][j] * F8_SW, 0, false), true);
        } else {
#pragma unroll
            for (int i = 0; i < 8; ++i)
#pragma unroll
                for (int j = 0; j < 4; ++j) *(LAS unsigned*)(tl + (c4 + j) * 136 + (8 * i + 2 * q) * 2) = cvtpk(v[2 * i][j], v[2 * i + 1][j]);
        }
        const int nx = it + NGW;
        if (nx < it1) { fast_decode(a, ws, nx, src, dst8, f8); FAST_LOAD(); }
        asm volatile("s_waitcnt lgkmcnt(0)" ::: "memory");
        if (cf8) {
#pragma unroll
            for (int p = 0; p < 4; ++p) {
                const int n = 16 * p + (lane >> 2), c = lane & 3;
                const LAS unsigned* t4 = (const LAS unsigned*)(tl + n * 68 + c * 16);
                u32x4 w; w.x = t4[0]; w.y = t4[1]; w.z = t4[2]; w.w = t4[3];
                __builtin_nontemporal_store(w, (u32x4*)(cdst + (size_t)n * D + c * 16));
            }
        } else {
#pragma unroll
            for (int p = 0; p < 8; ++p) {
                const int n = 8 * p + (lane >> 3), c = lane & 7;
                const u32x2 lo = *(const LAS u32x2*)(tl + n * 136 + c * 16), hi2 = *(const LAS u32x2*)(tl + n * 136 + c * 16 + 8);
                u32x4 w; w.x = lo.x; w.y = lo.y; w.z = hi2.x; w.w = hi2.y;
                __builtin_nontemporal_store(w, (u32x4*)(cdst + (size_t)n * D * 2 + c * 16));
            }
        }
        asm volatile("s_waitcnt lgkmcnt(0)" ::: "memory");
    }
#undef FAST_LOAD
}
__device__ __forceinline__ void cvt_load(const CvtItem& c, int tid, float (&v)[16]) {
    const int nn = tid & 63, kk = tid >> 6;
    float sc = 1.f; int sn;
    if (c.mapkind == 1) sn = winmap(c.n0 + nn, sc);
    else if (c.mapkind == 2) { sn = uqmap(c.n0 + nn); sc = SC_MLA; }
    else if (c.mapkind == 3) sn = nn < 32 ? nn : -1;
    else sn = c.n0 + nn;
#pragma unroll
    for (int i = 0; i < 16; ++i) {
        const int k = c.k0 + kk + 8 * i;
        float x = 0.f;
        if (sn >= 0 && k < c.kvalid) { x = c.src[(size_t)k * c.ld + sn] * sc; if (c.rowscale) x *= c.rowscale[k]; }
        v[i] = x;
    }
}
__device__ __forceinline__ void prologue_phase(Frame& F, const Args& a) {
    unsigned char* ws = F.ws;
    const int tid = opaque_tid();
    __syncthreads();
    {
        LAS unsigned short* tile = (LAS unsigned short*)F.lds;
        float v[16]; CvtItem c;
        int it = F.vcu;
        if (it < CVT_ITEMS) { cvt_decode(a, ws, it, c); cvt_load(c, tid, v); }
        for (; it < CVT_ITEMS; it += F.G) {
            const int nn = tid & 63, kk = tid >> 6;
            const bool f8 = (c.mapkind == 1);
            if (f8) {
                LAS unsigned char* t8 = (LAS unsigned char*)tile;
#pragma unroll
                for (int i = 0; i < 16; ++i) t8[nn * 132 + kk + 8 * i] = (unsigned char)(__builtin_amdgcn_cvt_pk_fp8_f32(v[i] * F8_SW, 0.f, 0, false) & 0xff);
            } else {
#pragma unroll
                for (int i = 0; i < 16; ++i) tile[nn * 130 + kk + 8 * i] = (unsigned short)(cvtpk(v[i], 0.f) & 0xffffu);
            }
            __syncthreads();
            const CvtItem cc = c;
            const int nx = it + F.G;
            if (nx < CVT_ITEMS) { cvt_decode(a, ws, nx, c); cvt_load(c, tid, v); }
            const LAS unsigned* t32 = (const LAS unsigned*)tile;
            if (f8) {
                const int n = tid >> 3, ch = tid & 7;
                u32x4 w; const LAS unsigned* s = t32 + n * 33 + ch * 4;
                w.x = s[0]; w.y = s[1]; w.z = s[2]; w.w = s[3];
                *(u32x4*)((unsigned char*)cc.dst + (size_t)n * cc.ldd + cc.k0 + ch * 16) = w;
            } else {
#pragma unroll
                for (int p = 0; p < 2; ++p) {
                    const int n = (tid >> 4) + 32 * p, ch = tid & 15;
                    if (n < cc.nrows) {
                        u32x4 w; const LAS unsigned* s = t32 + n * 65 + ch * 4;
                        w.x = s[0]; w.y = s[1]; w.z = s[2]; w.w = s[3];
                        *(u32x4*)(cc.dst + (size_t)n * cc.ldd + cc.k0 + ch * 8) = w;
                    }
                }
            }
            __syncthreads();
        }
    }
    {
        LAS float* sil = (LAS float*)F.lds;
        LAS float* part = (LAS float*)(F.lds + 1024 * 17 * 4);
        __syncthreads();
        for (int i = tid; i < 17 * D; i += NTHR) { const int r = i / D, k = i - r * D; const float x = r < 16 ? a.in[1][(size_t)r * D + k] : a.in[3][k]; sil[k * 17 + r] = x / (1.f + __expf(-x)); }
        __syncthreads();
        float* MOD = (float*)(ws + WS_MOD);
        const int col = tid & 63, kg = tid >> 6;
        for (int ch = F.vcu; ch < NL * 96; ch += F.G) {
            const int l = ch / 96, j0 = (ch - l * 96) * 64;
            const float* w = a.in[4] + (size_t)l * D * 6144 + j0 + col;
            float accv[17];
#pragma unroll
            for (int r = 0; r < 17; ++r) accv[r] = 0.f;
#pragma unroll 4
            for (int k = kg * 128; k < kg * 128 + 128; ++k) {
                const float wv = w[(size_t)k * 6144];
#pragma unroll
                for (int r = 0; r < 17; ++r) accv[r] += sil[k * 17 + r] * wv;
            }
#pragma unroll
            for (int r = 0; r < 17; ++r) part[(kg * 17 + r) * 64 + col] = accv[r];
            __syncthreads();
            for (int i = tid; i < 17 * 64; i += NTHR) {
                const int r = i >> 6, cc = i & 63; float s = 0.f;
#pragma unroll
                for (int g = 0; g < 8; ++g) s += part[(g * 17 + r) * 64 + cc];
                MOD[((size_t)l * 17 + r) * 6144 + j0 + cc] = s + a.in[5][(size_t)l * 6144 + j0 + cc];
            }
            __syncthreads();
        }
    }
    {
        const int gt = F.vcu * NTHR + tid, GT = F.G * NTHR;
        float* ropeR = (float*)(ws + WS_ROPER); float* ropeW = (float*)(ws + WS_ROPEW);
        for (int i = gt; i < SEQ * 48; i += GT) {
            int t, j; double f; float* dst;
            if (i < SEQ * 16) { t = i >> 4; j = i & 15; f = a.invf8[j & 7]; dst = ropeR + (size_t)i * 2; const int pos = (j < 8) ? (t >> 6) : (t & 63); f *= (double)pos; }
            else { const int ii = i - SEQ * 16; t = ii >> 5; j = ii & 31; f = a.invf16[j & 15]; dst = ropeW + (size_t)ii * 2; const int pos = (j < 16) ? (t >> 6) : (t & 63); f *= (double)pos; }
            const double n = __builtin_rint(f * 0.15915494309189535);
            const double r = (f - n * 6.283185307179586) - n * 2.4492935982947064e-16;
            const double r2 = r * r;
            double s = 1.0, cs = 1.0;
#pragma unroll
            for (int q = 27; q >= 3; q -= 2) s = 1.0 - s * r2 / (double)(q * (q - 1));
            s *= r;
#pragma unroll
            for (int q = 26; q >= 2; q -= 2) cs = 1.0 - cs * r2 / (double)(q * (q - 1));
            dst[0] = (float)cs; dst[1] = (float)s;
        }
        if (gt < NL) {
            const float* lam = a.in[12] + gt * 128; float s1 = 0.f, s2 = 0.f;
            for (int k = 0; k < 32; ++k) { s1 += lam[k] * lam[32 + k]; s2 += lam[64 + k] * lam[96 + k]; }
            ((float*)(ws + WS_CTL))[CW_LAM + gt] = expf(s1) - expf(s2) + a.lam_init[gt];
        }
    }
}

__device__ __forceinline__ void load_counts(Frame& F, int l) {
    volatile LAS int* PB = (volatile LAS int*)(F.lds + MISC_OFF + 256);
    volatile LAS int* CNT = (volatile LAS int*)(F.lds + MISC_OFF + 512);
    __syncthreads();
    const int tid = opaque_tid(), lane = tid & 63;
    if (tid < 64) {
        const unsigned* cur = (const unsigned*)(F.ws + WS_CTL) + CW_CUR + l * 32;
        const int c = lane < 32 ? (int)cur[lane] : 0;
        const int np = (c + 255) >> 8;
        int incl = np;
#pragma unroll
        for (int o = 1; o < 32; o <<= 1) { const int y = __shfl_up(incl, o); if ((lane & 31) >= o) incl += y; }
        if (lane < 32) { PB[lane + 1] = incl; CNT[lane] = c; }
        if (lane == 0) PB[0] = 0;
    }
    __syncthreads();
}
template <int MODE, bool FIRST> __device__ __forceinline__ void norm1_phase(Frame& F, const Args& a, int l, bool dummy = false) {
    unsigned char* ws = F.ws;
    bf16_t* X = (bf16_t*)(ws + WS_X); bf16_t* H = (bf16_t*)(ws + WS_H); const bf16_t* Y = (const bf16_t*)(ws + WS_Y);
    bf16_t* Xw = dummy ? (bf16_t*)(ws + WS_ACT + 160 * MiB) : X; if (dummy) H = (bf16_t*)(ws + WS_ACT + 232 * MiB);
    const float* MOD = (const float*)(ws + WS_MOD);
    const unsigned* tokslot = (const unsigned*)(ws + WS_TOKSLOT);
    constexpr bool comb = (MODE == 1) || !FIRST;
    constexpr int NR = FIRST ? 4 : 2;
    const int lp = (MODE == 1) ? NL - 1 : l - 1;
    if (comb) load_counts(F, lp);
    volatile LAS int* PB = (volatile LAS int*)(F.lds + MISC_OFF + 256);
    const int lane = opaque_tid() & 63;
    int vcu_ = F.vcu; asm volatile("" : "+s"(vcu_));
    const int gw = vcu_ * NWAVES + F.wave, NGW = F.G * NWAVES;
    const int nrows = (MODE == 1) ? NB * SEQ : T;
    const float* gvec = (MODE == 1) ? a.in[25] : a.in[6] + (size_t)l * D;
    f32x4 gv[4];
#pragma unroll
    for (int j = 0; j < 4; ++j) gv[j] = *(const f32x4*)(gvec + 16 * lane + 4 * j);
    auto rowinfo = [&](int ri, int& tok, int& bb, int& nb) { if (MODE == 1) { bb = ri >> 11; nb = CTX + (ri & 2047); tok = bb * NTK + nb; } else { tok = ri; bb = tok / NTK; nb = tok - bb * NTK; } };
    auto stageA = [&](int ri, u32x4 (&raw)[NR], u32x4& ts) {
        int tok, bb, nb; rowinfo(ri, tok, bb, nb);
        if constexpr (FIRST) {
            const float* src = nb < CTX ? a.in[2] + ((size_t)bb * CTX + nb) * D : a.in[0] + ((size_t)bb * SEQ + (nb - CTX)) * D;
#pragma unroll
            for (int j = 0; j < 4; ++j) raw[j] = *(const u32x4*)(src + 16 * lane + 4 * j);
        } else {
            const u32x4* xp = (const u32x4*)(X + (size_t)tok * D + 16 * lane); raw[0] = xp[0]; raw[1] = xp[1];
        }
        if (comb) ts = *(const u32x4*)(tokslot + (size_t)tok * 4);
    };
    auto stageB = [&](const u32x4& ts, u32x4 (&yv)[4]) {
#pragma unroll
        for (int k = 0; k < 4; ++k) {
            const unsigned w = ts[k]; const int e = (int)(w >> 16), pos = (int)(w & 0xffffu);
            const unsigned char* yr = (const unsigned char*)Y + ((size_t)PB[e] * 256 + pos) * D;
            yv[k] = *(const u32x4*)(yr + 16 * lane);
        }
    };
    auto stageC = [&](int ri, const u32x4 (&raw)[NR], const u32x4 (&yv)[4]) {
        __builtin_amdgcn_sched_barrier(0);
        int tok, bb, nb; rowinfo(ri, tok, bb, nb);
        const int modrow = nb < CTX ? 16 : bb;
        f32x4 v[4];
#pragma unroll
        for (int j = 0; j < 4; ++j) {
            if constexpr (FIRST) v[j] = __builtin_bit_cast(f32x4, raw[j]);
            else { const unsigned w0 = (j & 1) ? raw[j >> 1].z : raw[j >> 1].x, w1 = (j & 1) ? raw[j >> 1].w : raw[j >> 1].y; v[j] = (f32x4){bflo(w0), bfhi(w0), bflo(w1), bfhi(w1)}; }
        }
        if (comb) {
            const float* g5 = MOD + ((size_t)lp * 17 + modrow) * 6144 + 5 * D;
#pragma unroll
            for (int j = 0; j < 4; ++j) {
                f32x4 sj = (f32x4){0.f, 0.f, 0.f, 0.f};
#pragma unroll
                for (int k = 0; k < 4; ++k) { const unsigned y = yv[k][j]; const f32x2 lo = __builtin_amdgcn_cvt_pk_f32_fp8((int)y, false), hi2 = __builtin_amdgcn_cvt_pk_f32_fp8((int)y, true); sj[0] += lo[0]; sj[1] += lo[1]; sj[2] += hi2[0]; sj[3] += hi2[1]; }
                v[j] += *(const f32x4*)(g5 + 16 * lane + 4 * j) * (sj * (1.0f / F8_SY));
            }
        }
        float ss = 0.f;
#pragma unroll
        for (int j = 0; j < 4; ++j) ss += (v[j][0] * v[j][0] + v[j][1] * v[j][1]) + (v[j][2] * v[j][2] + v[j][3] * v[j][3]);
        const float rstd = 1.0f / sqrtf(wave_sum(ss) * (1.f / D) + EPS);
        if (MODE == 1) {
            float* o = a.out + (size_t)ri * D;
#pragma unroll
            for (int j = 0; j < 4; ++j) *(f32x4*)(o + 16 * lane + 4 * j) = v[j] * rstd * gv[j];
        } else {
            const float* mr = MOD + ((size_t)l * 17 + modrow) * 6144;
            u32x4 xb[2], h8;
#pragma unroll
            for (int j = 0; j < 4; ++j) {
                const unsigned p0 = cvtpk(v[j][0], v[j][1]), p1 = cvtpk(v[j][2], v[j][3]);
                if (j & 1) { xb[j >> 1].z = p0; xb[j >> 1].w = p1; } else { xb[j >> 1].x = p0; xb[j >> 1].y = p1; }
                const f32x4 sh = *(const f32x4*)(mr + 16 * lane + 4 * j), sc = *(const f32x4*)(mr + D + 16 * lane + 4 * j);
                const f32x4 h = (v[j] * rstd * gv[j] * (sc + 1.0f) + sh) * F8_SA;
                h8[j] = (unsigned)__builtin_amdgcn_cvt_pk_fp8_f32(h[2], h[3], __builtin_amdgcn_cvt_pk_fp8_f32(h[0], h[1], 0, false), true);
            }
            { u32x4* xp = (u32x4*)(Xw + (size_t)tok * D + 16 * lane); xp[0] = xb[0]; xp[1] = xb[1]; }
            *(u32x4*)((unsigned char*)H + (size_t)tok * D + 16 * lane) = h8;
        }
    };
    u32x4 rawC[NR], rawN[NR], rawF[NR]; u32x4 tsN = {0u, 0u, 0u, 0u}, tsF = {0u, 0u, 0u, 0u}, tsC = {0u, 0u, 0u, 0u}; u32x4 yC[4], yN[4];
    if (gw < nrows) stageA(gw, rawC, tsC);
    if (gw + NGW < nrows) stageA(gw + NGW, rawN, tsN);
    if (comb && gw < nrows) stageB(tsC, yC);
    for (int ri = gw; ri < nrows; ri += NGW) {
        if (ri + 2 * NGW < nrows) stageA(ri + 2 * NGW, rawF, tsF);
        if (comb && ri + NGW < nrows) stageB(tsN, yN);
        stageC(ri, rawC, yC);
#pragma unroll
        for (int j = 0; j < NR; ++j) { rawC[j] = rawN[j]; rawN[j] = rawF[j]; }
        tsN = tsF;
#pragma unroll
        for (int k = 0; k < 4; ++k) yC[k] = yN[k];
    }
}
__device__ __forceinline__ void norm2_router_phase(Frame& F, const Args& a, int l) {
    unsigned char* ws = F.ws;
    const bf16_t* X = (const bf16_t*)(ws + WS_X); unsigned char* H8 = (unsigned char*)(ws + WS_H);
    const float* MOD = (const float*)(ws + WS_MOD);
    unsigned* tokslot = (unsigned*)(ws + WS_TOKSLOT); int* slot_tok = (int*)(ws + WS_SLOTTOK); float* slot_w = (float*)(ws + WS_SLOTW);
    unsigned* cursor = (unsigned*)(ws + WS_CTL) + CW_CUR + l * 32;
    const bf16_t* Wr = (const bf16_t*)(ws + WS_WR) + (size_t)l * 32 * D;
    const bool last = (l == NL - 1);
    const int ngroups = last ? NB * SEQ / 32 : T / 32;
    const int tid = opaque_tid(), lane = tid & 63, wave = F.wave, r32 = lane & 31, hi = lane >> 5;
    constexpr int FT_RS = 2064;
    LAS unsigned char* FT = F.lds;
    LAS float* LP = (LAS float*)(F.lds + 32 * FT_RS);
    LAS float* LG = LP + 8 * 32 * 33;
    LAS int* lcnt = (LAS int*)(LG + 32 * 33);
    LAS int* lbase = lcnt + 32;
    bf16x8 wf[8];
#pragma unroll
    for (int s = 0; s < 8; ++s) wf[s] = *(const bf16x8*)(Wr + (size_t)r32 * D + (8 * wave + s) * 16 + hi * 8);
    const float* gvec = a.in[16] + (size_t)l * D;
    f32x4 gv[4];
#pragma unroll
    for (int j = 0; j < 4; ++j) gv[j] = *(const f32x4*)(gvec + 16 * lane + 4 * j);
    if (tid < 32) lcnt[tid] = 0;
    __syncthreads();
    auto ginfo = [&](int g, int& tok0, int& modrow) {
        int b; bool isctx;
        if (last) { b = g >> 6; tok0 = b * NTK + CTX + (g & 63) * 32; isctx = false; } else { tok0 = g * 32; b = tok0 / NTK; isctx = (tok0 - b * NTK) < CTX; }
        modrow = isctx ? 16 : b;
    };
    u32x4 xq[4][2], xn[4][2]; f32x4 shv[4], scv[4], shn[4], scn[4];
    auto gload = [&](int g, u32x4 (&x)[4][2], f32x4 (&sh)[4], f32x4 (&sc)[4]) {
        int tok0, modrow; ginfo(g, tok0, modrow);
        const float* mr = MOD + ((size_t)l * 17 + modrow) * 6144;
#pragma unroll
        for (int q = 0; q < 4; ++q) { const u32x4* xp = (const u32x4*)(X + (size_t)(tok0 + wave * 4 + q) * D + 16 * lane); x[q][0] = xp[0]; x[q][1] = xp[1]; }
#pragma unroll
        for (int j = 0; j < 4; ++j) { sh[j] = *(const f32x4*)(mr + 3 * D + 16 * lane + 4 * j); sc[j] = *(const f32x4*)(mr + 4 * D + 16 * lane + 4 * j); }
    };
    if ((int)F.vcu >= ngroups) return;
    const int glast = F.vcu + ((ngroups - 1 - F.vcu) / F.G) * F.G;
    gload(F.vcu, xq, shv, scv);
    for (int g = F.vcu; g < ngroups; g += F.G) {
        int tok0, modrow_; ginfo(g, tok0, modrow_);
        gload(min(g + F.G, glast), xn, shn, scn);
#pragma unroll
        for (int q = 0; q < 4; ++q) {
            const int rl = wave * 4 + q, tok = tok0 + rl;
            f32x4 v[4]; float ss = 0.f;
#pragma unroll
            for (int j = 0; j < 4; ++j) { const unsigned w0 = (j & 1) ? xq[q][j >> 1].z : xq[q][j >> 1].x, w1 = (j & 1) ? xq[q][j >> 1].w : xq[q][j >> 1].y;
                v[j] = (f32x4){bflo(w0), bfhi(w0), bflo(w1), bfhi(w1)}; ss += (v[j][0] * v[j][0] + v[j][1] * v[j][1]) + (v[j][2] * v[j][2] + v[j][3] * v[j][3]); }
            const float rstd = 1.0f / sqrtf(wave_sum(ss) * (1.f / D) + EPS);
            u32x4 h8; u32x4 hb[2];
#pragma unroll
            for (int j = 0; j < 4; ++j) {
                const f32x4 h = v[j] * rstd * gv[j] * (scv[j] + 1.0f) + shv[j];
                const unsigned p0 = cvtpk(h[0], h[1]), p1 = cvtpk(h[2], h[3]);
                if (j & 1) { hb[j >> 1].z = p0; hb[j >> 1].w = p1; } else { hb[j >> 1].x = p0; hb[j >> 1].y = p1; }
                h8[j] = (unsigned)__builtin_amdgcn_cvt_pk_fp8_f32(h[2] * F8_SA, h[3] * F8_SA, __builtin_amdgcn_cvt_pk_fp8_f32(h[0] * F8_SA, h[1] * F8_SA, 0, false), true);
            }
            *(u32x4*)(H8 + (size_t)tok * D + 16 * lane) = h8;
            LAS u32x4* fp = (LAS u32x4*)(FT + rl * FT_RS + 32 * lane); fp[0] = hb[0]; fp[1] = hb[1];
        }
#pragma unroll
        for (int q = 0; q < 4; ++q) { xq[q][0] = xn[q][0]; xq[q][1] = xn[q][1]; }
#pragma unroll
        for (int j = 0; j < 4; ++j) { shv[j] = shn[j]; scv[j] = scn[j]; }
        __syncthreads();
        {
            f32x16 acc = {};
#pragma unroll
            for (int s = 0; s < 8; ++s) {
                const bf16x8 af = *(const LAS bf16x8*)(FT + r32 * FT_RS + ((8 * wave + s) * 16 + hi * 8) * 2);
                acc = __builtin_amdgcn_mfma_f32_32x32x16_bf16(af, wf[s], acc, 0, 0, 0);
            }
#pragma unroll
            for (int r = 0; r < 16; ++r) { const int row = (r & 3) + 8 * (r >> 2) + 4 * hi; LP[(wave * 32 + row) * 33 + r32] = acc[r]; }
        }
        __syncthreads();
        for (int i = tid; i < 1024; i += NTHR) {
            const int row = i >> 5, e = i & 31; float s = a.in[18][l * 32 + e];
#pragma unroll
            for (int w = 0; w < 8; ++w) s += LP[(w * 32 + row) * 33 + e];
            LG[row * 33 + e] = s;
        }
        __syncthreads();
        int te[4]; float tw[4]; int rk[4];
        if (tid < 32) {
            float lv[32];
#pragma unroll
            for (int e = 0; e < 32; ++e) lv[e] = LG[tid * 33 + e];
            float tv[4];
#pragma unroll
            for (int k = 0; k < 4; ++k) {
                float best = -3.0e38f; int bi = 0;
#pragma unroll
                for (int e = 0; e < 32; ++e) { const bool up = lv[e] > best; best = up ? lv[e] : best; bi = up ? e : bi; }
                tv[k] = best; te[k] = bi;
#pragma unroll
                for (int e = 0; e < 32; ++e) lv[e] = (e == bi) ? -3.0e38f : lv[e];
            }
            const float e1 = __expf(tv[1] - tv[0]), e2 = __expf(tv[2] - tv[0]), e3 = __expf(tv[3] - tv[0]);
            const float inv = 1.0f / (1.0f + e1 + e2 + e3);
            tw[0] = inv; tw[1] = e1 * inv; tw[2] = e2 * inv; tw[3] = e3 * inv;
#pragma unroll
            for (int k = 0; k < 4; ++k) rk[k] = atomicAdd((int*)&lcnt[te[k]], 1);
        }
        __syncthreads();
        if (tid < 32) { const int c = lcnt[tid]; lbase[tid] = c ? (int)atomicAdd(&cursor[tid], (unsigned)c) : 0; }
        __syncthreads();
        if (tid < 32) {
            const int tok = tok0 + tid; u32x4 ts;
#pragma unroll
            for (int k = 0; k < 4; ++k) { const int pos = lbase[te[k]] + rk[k]; slot_tok[(size_t)te[k] * T + pos] = tok; slot_w[(size_t)te[k] * T + pos] = tw[k]; ts[k] = ((unsigned)te[k] << 16) | (unsigned)pos; }
            *(u32x4*)(tokslot + (size_t)tok * 4) = ts;
            lcnt[tid] = 0;
        }
        __syncthreads();
    }
}

struct AttnPtrs { const bf16_t* P; const bf16_t* QM; const bf16_t* KVM; unsigned char* MIX; const float* sink; const float* subg; float lam_full, one_m_li; };
constexpr int KB_OFF0 = 0, KB_STRIDE = 16384, VB_OFF0 = 32768, VB_STRIDE = 12288, XCH_OFF = 81920;
#define ATT_PIN(x) asm volatile("" : "+v"(x))
#define ATT_SBAR() __builtin_amdgcn_sched_barrier(0)
#define ATT_THR 8.0f
#ifndef ATT_WSLICE
#define ATT_WSLICE 10
#endif
#ifndef ATT_PF
#define ATT_PF 2
#endif
template <int KIND> __device__ __forceinline__ void attn_unit(const AttnPtrs& A, int b, int h, int qblk, LAS unsigned char* lds, unsigned& qnext) {
    constexpr int DQK = KIND == 0 ? 96 : (KIND == 1 ? 32 : 64);
    constexpr int NF = DQK / 16, RSK = DQK * 2 + 16, RSV = 192, NMF = 8 + 2 * NF;
    const int tid = opaque_tid(), lane = tid & 63, r32 = lane & 31, hi = lane >> 5, wid = __builtin_amdgcn_readfirstlane(tid >> 6);
    const size_t tokb = (size_t)b * NTK;
    const int mp = KIND == 1 ? (wid >> 2) : 0;
    const int qrow0 = KIND == 1 ? qblk * 128 + (wid & 3) * 32 : qblk * 256 + wid * 32;
    const bool ctxunit = KIND == 1 ? (qblk < 2) : (qblk == 0);
    const size_t tokq = tokb + qrow0 + r32;
    const int kvh = h >> 2;
    bf16x8 qf[NF];
#pragma unroll
    for (int d0 = 0; d0 < NF; ++d0) {
        const bf16_t* src = KIND == 0 ? A.QM + tokq * 384 + h * 96 + d0 * 16 + hi * 8
                          : KIND == 1 ? A.P + tokq * PW + 512 + (2 * h + mp) * 32 + d0 * 16 + hi * 8
                                      : A.P + tokq * PW + 1280 + h * 64 + d0 * 16 + hi * 8;
        qf[d0] = *(const bf16x8*)src;
    }
    float mrun = 0.f; f32x2 lrun2 = {0.f, 0.f}; f32x16 o[2]; o[0] = f32x16{}; o[1] = f32x16{};
    f32x16 negm = f32x16{};
    const int T0 = KIND == 2 ? (qblk - 1) * 256 : 0;
    int ntile, ttlo = 0;
    if (ctxunit) ntile = 4;
    else if (KIND == 2) { ttlo = max(0, (T0 >> 6) - 2); const int tthi = min(31, (T0 >> 6) + 5); ntile = 4 + (tthi - ttlo + 1); }
    else ntile = 36;
#define TILE_OF(i) ((KIND == 2 && (i) >= 4) ? 4 + ttlo + ((i) - 4) : (i))
    u32x4 krA0, krA1, vrA, krB0, krB1, vrB;
    const char* kp0; const char* kp1 = nullptr; const char* vp; unsigned ks0, ks1 = 0u, vs;
    if (KIND == 0) {
        { const int row = tid / 12, ch = tid - row * 12; const size_t tok = tokb + row;
          kp0 = ch < 8 ? (const char*)(A.KVM + tok * 512 + h * 128 + ch * 8) : (const char*)(A.P + tok * PW + 384 + (ch - 8) * 8); ks0 = ch < 8 ? 64u * 512u * 2u : 64u * PW * 2u; }
        { const int q = (tid & 255) + 512, row = q / 12, ch = q - row * 12; const size_t tok = tokb + row;
          kp1 = ch < 8 ? (const char*)(A.KVM + tok * 512 + h * 128 + ch * 8) : (const char*)(A.P + tok * PW + 384 + (ch - 8) * 8); ks1 = ch < 8 ? 64u * 512u * 2u : 64u * PW * 2u; }
        { const int row = tid >> 3, ch = tid & 7; vp = (const char*)(A.KVM + (tokb + row) * 512 + h * 128 + 64 + ch * 8); vs = 64u * 512u * 2u; }
    } else if (KIND == 1) {
        { const int m2 = tid >> 8, row = (tid & 255) >> 2, ch = tid & 3; kp0 = (const char*)(A.P + (tokb + row) * PW + 768 + (2 * h + m2) * 32 + ch * 8); ks0 = 64u * PW * 2u; }
        { const int row = tid >> 3, ch = tid & 7; vp = (const char*)(A.P + (tokb + row) * PW + 1024 + h * 64 + ch * 8); vs = 64u * PW * 2u; }
    } else {
        const int row = tid >> 3, ch = tid & 7;
        kp0 = (const char*)(A.P + (tokb + row) * PW + 1792 + kvh * 64 + ch * 8); ks0 = 64u * PW * 2u;
        vp = (const char*)(A.P + (tokb + row) * PW + 1920 + kvh * 64 + ch * 8); vs = 64u * PW * 2u;
    }
    const char* gb = (const char*)A.P;
    const unsigned ko0 = (unsigned)(kp0 - gb), ko1 = (KIND == 0) ? (unsigned)(kp1 - gb) : 0u, vo = (unsigned)(vp - gb);
    const unsigned ksh0 = ks0 == 65536u ? 16u : 18u, ksh1 = ks1 == 65536u ? 16u : 18u, vsh = vs == 65536u ? 16u : 18u;
    auto gload = [&](int tt, u32x4& kr0, u32x4& kr1, u32x4& vr) {
        kr0 = *(const u32x4*)(gb + (size_t)(((unsigned)tt << ksh0) + ko0));
        if (KIND == 0) kr1 = *(const u32x4*)(gb + (size_t)(((unsigned)tt << ksh1) + ko1));
        vr = *(const u32x4*)(gb + (size_t)(((unsigned)tt << vsh) + vo));
    };
    auto lstore = [&](int i, const u32x4& kr0, const u32x4& kr1, const u32x4& vr) {
        LAS unsigned char* kb = lds + KB_OFF0 + (i & 1) * KB_STRIDE; LAS unsigned char* vb = lds + VB_OFF0 + (i & 3) * VB_STRIDE;
        if (KIND == 0) {
            { const int row = tid / 12, ch = tid - row * 12; *(LAS u32x4*)(kb + row * RSK + ch * 16) = kr0; }
            if (tid < 256) { const int q = tid + 512, row = q / 12, ch = q - row * 12; *(LAS u32x4*)(kb + row * RSK + ch * 16) = kr1; }
        } else if (KIND == 1) {
            const int m2 = tid >> 8, row = (tid & 255) >> 2, ch = tid & 3; *(LAS u32x4*)(kb + m2 * 8192 + row * RSK + ch * 16) = kr0;
        } else { const int row = tid >> 3, ch = tid & 7; *(LAS u32x4*)(kb + row * RSK + ch * 16) = kr0; }
        { const int row = tid >> 3, ch = tid & 7; *(LAS u32x4*)(vb + row * RSV + ch * 16) = vr; }
    };
    const int qpos = T0 + wid * 32 + r32;
    const int koff = (KIND == 1 ? mp * 8192 : 0) + r32 * RSK + hi * 16;
    const int voff = ((lane >> 4) & 1) * 32 + (lane & 3) * 8 + (4 * hi + ((lane & 15) >> 2)) * RSV;
    auto fetch = [&](int j, const LAS unsigned char* vb, const LAS unsigned char* kb) -> bf16x8 {
        if (j < 8) {
            const int sI = j >> 1, d0 = j & 1;
            const v4i16_t lo = __builtin_amdgcn_ds_read_tr16_b64_v4i16((LAS v4i16_t*)(vb + voff + (16 * sI) * RSV + d0 * 64));
            const v4i16_t hh = __builtin_amdgcn_ds_read_tr16_b64_v4i16((LAS v4i16_t*)(vb + voff + (16 * sI + 8) * RSV + d0 * 64));
            return (bf16x8){lo[0], lo[1], lo[2], lo[3], hh[0], hh[1], hh[2], hh[3]};
        } else {
            const int d0 = (j - 8) >> 1, half = (j - 8) & 1;
            return *(const LAS bf16x8*)(kb + koff + half * 32 * RSK + d0 * 32);
        }
    };
    gload(TILE_OF(0), krA0, krA1, vrA); gload(TILE_OF(1), krB0, krB1, vrB);
    lstore(0, krA0, krA1, vrA); lstore(1, krB0, krB1, vrB);
    gload(TILE_OF(2), krA0, krA1, vrA);
    qnext = (unsigned)__builtin_amdgcn_readfirstlane((int)qnext);
    __syncthreads();
    f32x16 pA0 = f32x16{}, pA1 = f32x16{}, pB0, pB1;
    {
        const LAS unsigned char* kb = lds + KB_OFF0;
#pragma unroll
        for (int d0 = 0; d0 < NF; ++d0) {
            const bf16x8 k0 = *(const LAS bf16x8*)(kb + koff + d0 * 32), k1 = *(const LAS bf16x8*)(kb + koff + 32 * RSK + d0 * 32);
            pA0 = __builtin_amdgcn_mfma_f32_32x32x16_bf16(k0, qf[d0], pA0, 0, 0, 0);
            pA1 = __builtin_amdgcn_mfma_f32_32x32x16_bf16(k1, qf[d0], pA1, 0, 0, 0);
        }
    }
    bf16x8 paX[4], paY[4];
#pragma unroll
    for (int sI = 0; sI < 4; ++sI) { paX[sI] = (bf16x8){0, 0, 0, 0, 0, 0, 0, 0}; paY[sI] = (bf16x8){0, 0, 0, 0, 0, 0, 0, 0}; }
    __syncthreads();
#define ATT_STEP(C0, C1, N0, N1, PP, PC, i, KR0, KR1, VR) do { \
        const int tt_ = TILE_OF(i); \
        if (KIND == 2 && !ctxunit && tt_ >= 4) { \
            const int k0_ = (tt_ - 4) * 64, tw_ = T0 + wid * 32; \
            if (k0_ + 63 - tw_ > 128 || k0_ - (tw_ + 31) < -128) {     \
                const int kbase_ = k0_ + 4 * hi - qpos; \
                _Pragma("unroll") for (int r = 0; r < 16; ++r) { const int dk = kbase_ + (r & 3) + 8 * (r >> 2); if (dk > 128 || dk < -128) C0[r] = -1.0e30f; if (dk + 32 > 128 || dk + 32 < -128) C1[r] = -1.0e30f; } \
            } \
        } \
        const LAS unsigned char* vb_ = lds + VB_OFF0 + (((i) + 3 + ((i) == 0 ? 1 : 0)) & 3) * VB_STRIDE;                  \
        const LAS unsigned char* kb_ = lds + KB_OFF0 + (((i) + 1 < ntile ? (i) + 1 : (i)) & 1) * KB_STRIDE;       \
        bf16x8 op_[ATT_PF + 1]; _Pragma("unroll") for (int j = 0; j < ATT_PF; ++j) op_[j] = fetch(j, vb_, kb_); \
        float mx_ = -3.0e38f, alpha_ = 1.f; f32x2 ls2_ = {0.f, 0.f}; unsigned long long gbal_ = 0ull;     \
        ATT_SBAR(); \
        _Pragma("unroll") for (int k = 0; k < 20; ++k) { \
            if (k == ATT_WSLICE) { if ((i) + 2 < ntile) lstore((i) + 2, KR0, KR1, VR); }     \
            if (k + ATT_PF < NMF) op_[(k + ATT_PF) % (ATT_PF + 1)] = fetch(k + ATT_PF, vb_, kb_); \
            if (k < 8) { o[k & 1] = __builtin_amdgcn_mfma_f32_32x32x16_bf16(op_[k % (ATT_PF + 1)], PP[k >> 1], o[k & 1], 0, 0, 0); } \
            else if (k < NMF) { const int j_ = k - 8; \
                if (j_ == 0) N0 = __builtin_amdgcn_mfma_f32_32x32x16_bf16(op_[k % (ATT_PF + 1)], qf[0], negm, 0, 0, 0); \
                else if (j_ == 1) N1 = __builtin_amdgcn_mfma_f32_32x32x16_bf16(op_[k % (ATT_PF + 1)], qf[0], negm, 0, 0, 0); \
                else if (j_ & 1) N1 = __builtin_amdgcn_mfma_f32_32x32x16_bf16(op_[k % (ATT_PF + 1)], qf[j_ >> 1], N1, 0, 0, 0); \
                else N0 = __builtin_amdgcn_mfma_f32_32x32x16_bf16(op_[k % (ATT_PF + 1)], qf[j_ >> 1], N0, 0, 0, 0); } \
            if (k < 4) { float a_ = fmaxf(fmaxf(C0[4 * k], C0[4 * k + 1]), C0[4 * k + 2]); const float b_ = fmaxf(fmaxf(C0[4 * k + 3], C1[4 * k]), C1[4 * k + 1]); a_ = fmaxf(fmaxf(a_, C1[4 * k + 2]), C1[4 * k + 3]); mx_ = fmaxf(fmaxf(mx_, a_), b_); ATT_PIN(mx_); }     \
            else if (k == 4) { auto rr_ = __builtin_amdgcn_permlane32_swap(__float_as_uint(mx_), __float_as_uint(mx_), false, false); { const float ma_ = __uint_as_float(rr_[0]), mb_ = __uint_as_float(rr_[1]); asm("v_max_f32 %0, %1, %2" : "=v"(mx_) : "v"(ma_), "v"(mb_)); }     \
                  \
                const bool far_ = ((i) == 0) ? (fabsf(mx_) > ATT_THR) : (mx_ > ATT_THR); \
                gbal_ = __builtin_amdgcn_ballot_w64(far_); \
                if (gbal_ != 0ull) { const float dl_ = ((i) == 0) ? mx_ : fmaxf(mx_, 0.f); \
                    _Pragma("unroll") for (int r = 0; r < 16; ++r) { C0[r] -= dl_; C1[r] -= dl_; } \
                    mrun += dl_; alpha_ = ((i) == 0) ? 1.0f : __builtin_amdgcn_exp2f(-dl_); \
                    _Pragma("unroll") for (int r = 0; r < 16; ++r) negm[r] = -mrun; ATT_PIN(negm); ATT_PIN(alpha_); } } \
            else if (k < 13) { const int e_ = k - 5; \
                C0[2 * e_] = __builtin_amdgcn_exp2f(C0[2 * e_]); C0[2 * e_ + 1] = __builtin_amdgcn_exp2f(C0[2 * e_ + 1]); \
                C1[2 * e_] = __builtin_amdgcn_exp2f(C1[2 * e_]); C1[2 * e_ + 1] = __builtin_amdgcn_exp2f(C1[2 * e_ + 1]); \
                ls2_ += (f32x2){C0[2 * e_], C0[2 * e_ + 1]}; ls2_ += (f32x2){C1[2 * e_], C1[2 * e_ + 1]}; ATT_PIN(ls2_); } \
            else if (k < 17) { const int c_ = k - 13; u32x4 w_; \
                if (c_ < 2) { w_.x = cvtpk(C0[8 * c_ + 0], C0[8 * c_ + 1]); w_.y = cvtpk(C0[8 * c_ + 2], C0[8 * c_ + 3]); w_.z = cvtpk(C0[8 * c_ + 4], C0[8 * c_ + 5]); w_.w = cvtpk(C0[8 * c_ + 6], C0[8 * c_ + 7]); } \
                else { const int c2_ = c_ - 2; w_.x = cvtpk(C1[8 * c2_ + 0], C1[8 * c2_ + 1]); w_.y = cvtpk(C1[8 * c2_ + 2], C1[8 * c2_ + 3]); w_.z = cvtpk(C1[8 * c2_ + 4], C1[8 * c2_ + 5]); w_.w = cvtpk(C1[8 * c2_ + 6], C1[8 * c2_ + 7]); } \
                ATT_PIN(w_); PC[c_] = __builtin_bit_cast(bf16x8, w_); } \
            else if (k == 17) { if (gbal_ != 0ull) { lrun2 *= alpha_; _Pragma("unroll") for (int r = 0; r < 16; ++r) o[0][r] *= alpha_; ATT_PIN(o[0]); } lrun2 += ls2_; ATT_PIN(lrun2); } \
            else if (k == 18) { if (gbal_ != 0ull) { _Pragma("unroll") for (int r = 0; r < 16; ++r) o[1][r] *= alpha_; ATT_PIN(o[1]); } } \
            ATT_SBAR(); \
        } \
    } while (0)
#ifndef ATT_PRIO
#define ATT_PRIO 1
#endif
    if (ATT_PRIO && wid >= 4) __builtin_amdgcn_s_setprio(1);
    for (int i = 0; i < ntile; i += 2) {
        { const int j3 = min(i + 3, ntile - 1); gload(TILE_OF(j3), krB0, krB1, vrB); }
        ATT_STEP(pA0, pA1, pB0, pB1, paY, paX, i, krA0, krA1, vrA);
        __syncthreads();
        { const int j4 = min(i + 4, ntile - 1); gload(TILE_OF(j4), krA0, krA1, vrA); }
        ATT_STEP(pB0, pB1, pA0, pA1, paX, paY, i + 1, krB0, krB1, vrB);
        __syncthreads();
    }
#undef ATT_STEP
#undef TILE_OF
    if (ATT_PRIO) __builtin_amdgcn_s_setprio(0);
    {
        const LAS unsigned char* vb = lds + VB_OFF0 + ((ntile - 1) & 3) * VB_STRIDE;
#pragma unroll
        for (int j = 0; j < 8; ++j) { const bf16x8 vfr = fetch(j, vb, vb); o[j & 1] = __builtin_amdgcn_mfma_f32_32x32x16_bf16(vfr, paY[j >> 1], o[j & 1], 0, 0, 0); }
    }
    const float lrun = lrun2[0] + lrun2[1];
    float lt = lrun + __shfl_xor(lrun, 32);
    if (KIND == 2) lt += __builtin_amdgcn_exp2f(A.sink[h] * LOG2E - mrun);
    const float inv = 1.0f / lt;
    const int colbase = (KIND == 0 ? 0 : (KIND == 1 ? 256 : 512)) + h * 64;
    unsigned char* orow = A.MIX + tokq * D + colbase;
    unsigned W8[2][4];
    auto store_rows = [&]() {
#pragma unroll
        for (int d0 = 0; d0 < 2; ++d0) {
            const auto s0 = __builtin_amdgcn_permlane32_swap(W8[d0][0], W8[d0][1], false, false), s1 = __builtin_amdgcn_permlane32_swap(W8[d0][2], W8[d0][3], false, false);
            const auto t0 = __builtin_amdgcn_permlane32_swap(s0[0], s1[0], false, false), t1 = __builtin_amdgcn_permlane32_swap(s0[1], s1[1], false, false);
            u32x4 w; w.x = t0[0]; w.y = t1[0]; w.z = t0[1]; w.w = t1[1];
            *(u32x4*)(orow + 32 * d0 + 16 * hi) = w;
        }
    };
    if (KIND == 1) {
        LAS float* xch = (LAS float*)(lds + XCH_OFF) + (wid & 3) * 2048 + lane;
        if (wid >= 4) {
#pragma unroll
            for (int d0 = 0; d0 < 2; ++d0)
#pragma unroll
                for (int r = 0; r < 16; ++r) xch[(d0 * 16 + r) * 64] = o[d0][r] * inv;
        }
        __syncthreads();
        if (wid < 4) {
            float ss = 0.f;
#pragma unroll
            for (int d0 = 0; d0 < 2; ++d0)
#pragma unroll
                for (int r = 0; r < 16; ++r) { const float x = o[d0][r] * inv - A.lam_full * xch[(d0 * 16 + r) * 64]; o[d0][r] = x; ss += x * x; }
            ss += __shfl_xor(ss, 32);
            const float rs = (1.0f / sqrtf(ss * (1.f / 64.f) + EPS)) * A.one_m_li;
#pragma unroll
            for (int d0 = 0; d0 < 2; ++d0)
#pragma unroll
                for (int g4 = 0; g4 < 4; ++g4) {
                    const int dd = 32 * d0 + 8 * g4 + 4 * hi;
                    const f32x4 gg = *(const f32x4*)(A.subg + dd);
                    const float rs8 = rs * F8_SM;
                    W8[d0][g4] = (unsigned)__builtin_amdgcn_cvt_pk_fp8_f32(o[d0][4 * g4 + 2] * rs8 * gg[2], o[d0][4 * g4 + 3] * rs8 * gg[3], __builtin_amdgcn_cvt_pk_fp8_f32(o[d0][4 * g4 + 0] * rs8 * gg[0], o[d0][4 * g4 + 1] * rs8 * gg[1], 0, false), true);
                }
            store_rows();
        }
    } else {
#pragma unroll
        for (int d0 = 0; d0 < 2; ++d0)
#pragma unroll
            for (int g4 = 0; g4 < 4; ++g4) {
                const float inv8 = inv * F8_SM;
                W8[d0][g4] = (unsigned)__builtin_amdgcn_cvt_pk_fp8_f32(o[d0][4 * g4 + 2] * inv8, o[d0][4 * g4 + 3] * inv8, __builtin_amdgcn_cvt_pk_fp8_f32(o[d0][4 * g4 + 0] * inv8, o[d0][4 * g4 + 1] * inv8, 0, false), true);
            }
        store_rows();
    }
    __syncthreads();
}
__device__ __forceinline__ void attn_phase(Frame& F, const Args& a, int l) {
    unsigned char* ws = F.ws;
    AttnPtrs A;
    A.P = (const bf16_t*)(ws + WS_P); A.QM = (const bf16_t*)(ws + WS_QM); A.KVM = (const bf16_t*)(ws + WS_KVM); A.MIX = (unsigned char*)(ws + WS_MIX);
    A.sink = a.in[14] + l * 8; A.subg = a.in[13] + l * 64;
    A.lam_full = ((const float*)(ws + WS_CTL))[CW_LAM + l]; A.one_m_li = 1.0f - a.lam_init[l];
    const int n1 = NB * 4 * 8, n2 = n1 + NB * 4 * 16, n3 = n2 + NB * 8 * 8;
    const int n4 = (l == NL - 1) ? n3 : n3 + NB * 4, n5 = (l == NL - 1) ? n3 : n4 + NB * 4 * 2, n6 = (l == NL - 1) ? n3 : n5 + NB * 8;
    unsigned* ctr = (unsigned*)(ws + WS_CTL) + CW_ATTQ + l;
    volatile LAS unsigned* qslot = (volatile LAS unsigned*)(F.lds + MISC_OFF + 1024);
#ifndef ATT_DUP
#define ATT_DUP 0
#endif
    const int ndup = ATT_DUP == 1 ? n1 : (ATT_DUP == 2 ? n2 - n1 : (ATT_DUP == 3 ? n3 - n2 : 0));
    const int nconv = CONV_NCHUNK, total = n6 + nconv + ndup;
    if (opaque_tid() == 0) qslot[0] = atomicAdd(ctr, 1u);
    __syncthreads();
    int u = (int)qslot[0];
    while (u < total) {
        unsigned nxt = 0u;
        if (opaque_tid() == 0) nxt = atomicAdd((unsigned*)(ws + WS_CTL) + CW_ATTQ + l, 1u);
        if ((u & 3) == 3 && (u >> 2) < nconv) {
            nxt = (unsigned)__builtin_amdgcn_readfirstlane((int)nxt);
            const int ch = u >> 2, base = l * FAST_PER_LAYER + ch * CONV_CHUNK;
            fast_convert(F, a, opaque_tid(), base, base + CONV_CHUNK, F.wave, NWAVES);
        } else {
            int ua = u - min(nconv, u >> 2);
            if (ua >= n6) ua = (ATT_DUP == 1 ? 0 : (ATT_DUP == 2 ? n1 : n2)) + (ua - n6);
            int kind, ub, uh, uq;
            if (ua < n1) { kind = 0; ub = ua >> 5; uh = (ua >> 3) & 3; uq = 1 + (ua & 7); }
            else if (ua < n2) { const int v = ua - n1; kind = 1; ub = v >> 6; uh = (v >> 4) & 3; uq = 2 + (v & 15); }
            else if (ua < n3) { const int v = ua - n2; kind = 2; ub = v >> 6; uh = (v >> 3) & 7; uq = 1 + (v & 7); }
            else if (ua < n4) { const int v = ua - n3; kind = 0; ub = v >> 2; uh = v & 3; uq = 0; }
            else if (ua < n5) { const int v = ua - n4; kind = 1; ub = v >> 3; uh = (v >> 1) & 3; uq = v & 1; }
            else { const int v = ua - n5; kind = 2; ub = v >> 3; uh = v & 7; uq = 0; }
            if (kind == 0) attn_unit<0>(A, ub, uh, uq, F.lds, nxt);
            else if (kind == 1) attn_unit<1>(A, ub, uh, uq, F.lds, nxt);
            else attn_unit<2>(A, ub, uh, uq, F.lds, nxt);
        }
        if (opaque_tid() == 0) qslot[0] = nxt;
        __syncthreads();
        u = (int)qslot[0];
    }
}

constexpr int PH_PER_LAYER = 8, N_PHASES = 2 + NL * PH_PER_LAYER;
__global__ void __launch_bounds__(NTHR, 2) trunk_fwd(Args args) {
    extern __shared__ __attribute__((aligned(16))) unsigned char lds_raw[];
    Frame F;
    F.lds = (LAS unsigned char*)lds_raw; F.ws = args.ws;
    F.tid = threadIdx.x; F.lane = F.tid & 63; F.wave = __builtin_amdgcn_readfirstlane(F.tid >> 6);
    F.G = gridDim.x; { const int bx = blockIdx.x; F.vcu = (F.G % 8 == 0) ? (bx % 8) * (F.G / 8) + bx / 8 : bx; }
    volatile LAS unsigned* MISC = (volatile LAS unsigned*)(F.lds + MISC_OFF);
    if (F.tid < 64) MISC[F.tid] = 0u;
    __syncthreads();
    const int lo = args.ph_lo, hi = args.ph_hi;
    const bool multi = (hi - lo) > 1;
    XcdBarrier bar; bar.bar = (unsigned*)(F.ws + WS_CTL) + CW_BAR; bar.x = 0; bar.st = MISC;
    if (multi) bar = xcd_barrier_post((unsigned*)(F.ws + WS_CTL) + CW_BAR, MISC);
    unsigned char* ws = F.ws;
#ifndef DIAG_KINDS
#define DIAG_KINDS 0x3ff
#endif
#ifndef REP_PRO
#define REP_PRO 1
#define REP_WIN 1
#define REP_UP 1
#define REP_ATT 1
#define REP_GU 1
#define REP_DOWN 1
#endif
#define KON(x) (((DIAG_KINDS) >> (x)) & 1)
#define IN(k) (lo <= (k) && (k) < hi)
#define SEAM(k) do { if (IN(k) && IN((k) + 1)) xcd_barrier(bar); } while (0)
    if (KON(0) && IN(0)) { asm volatile("; PHASE_MARK 0"); for (int rep = 0; rep < REP_PRO; ++rep) prologue_phase(F, args); }
    SEAM(0);
    for (int l = 0; l < NL; ++l) {
        const int pb = 1 + l * PH_PER_LAYER;
        const bool last = (l == NL - 1);
        if (KON(1) && IN(pb + 0)) { asm volatile("; PHASE_MARK 1");
#ifndef REP_N1
#define REP_N1 1
#endif
            for (int rep = 1; rep < REP_N1; ++rep) norm1_phase<0, false>(F, args, l, true);
            if (l == 0) norm1_phase<0, true>(F, args, l); else norm1_phase<0, false>(F, args, l); }
        SEAM(pb + 0);
        const bool chain = (F.G == 256);
        const pg8::ChainMap CM{(int)blockIdx.x & 7, (int)blockIdx.x >> 3};
        if (KON(2) && IN(pb + 1)) { asm volatile("; PHASE_MARK 2");
            pg8::EpiWin E{(bf16_t*)(ws + WS_P), (float*)(ws + WS_SSQ), (const float*)(ws + WS_ROPER), (const float*)(ws + WS_ROPEW)};
            if (chain) {
                pg8::WinChainSched S{(const char*)(ws + WS_H), (const char*)(ws + WS_WIN) + (size_t)l * PW * D, D / 2, D / 2, CM};
                for (int rep = 0; rep < REP_WIN; ++rep) pg8::gemm_phase<pg8::EpiWin, pg8::WinChainSched, true, true>(F.lds, D / 2, D / 2, D / 2, S, E);
            } else {
                pg8::DenseSched S{(const char*)(ws + WS_H), (const char*)(ws + WS_WIN) + (size_t)l * PW * D, D / 2, D / 2, NPAN, PW / 256, F.G, (int)blockIdx.x, 0};
                for (int rep = 0; rep < REP_WIN; ++rep) pg8::gemm_phase<pg8::EpiWin, pg8::DenseSched, true, true>(F.lds, D / 2, D / 2, D / 2, S, E);
            }
        }
        if (!chain) SEAM(pb + 1);
        else {
            __builtin_amdgcn_fence(__ATOMIC_ACQUIRE, "agent"); asm volatile("s_waitcnt vmcnt(0)" ::: "memory"); __syncthreads();
        }
        if (KON(3) && IN(pb + 2)) { asm volatile("; PHASE_MARK 3");
            pg8::EpiUp E{(bf16_t*)(ws + WS_QM), (bf16_t*)(ws + WS_KVM), (const float*)(ws + WS_SSQ), (const float*)(ws + WS_ROPER)};
            if (chain) {
                pg8::UpChainSched S{(const char*)(ws + WS_P), (const char*)(ws + WS_WUQ) + (size_t)l * 512 * 256 * 2, (const char*)(ws + WS_WUKV) + (size_t)l * 512 * 256 * 2, CM};
                for (int rep = 0; rep < REP_UP; ++rep) pg8::gemm_phase<pg8::EpiUp, pg8::UpChainSched, true>(F.lds, 256, PW, 256, S, E);
            } else {
                pg8::UpSched S{(const char*)(ws + WS_P), (const char*)(ws + WS_WUQ) + (size_t)l * 512 * 256 * 2, (const char*)(ws + WS_WUKV) + (size_t)l * 512 * 256 * 2, F.G, (int)blockIdx.x};
                for (int rep = 0; rep < REP_UP; ++rep) pg8::gemm_phase<pg8::EpiUp, pg8::UpSched, true>(F.lds, 256, PW, 256, S, E);
            }
        }
        SEAM(pb + 2);
        if (KON(4) && IN(pb + 3)) { asm volatile("; PHASE_MARK 4"); for (int rep = 0; rep < REP_ATT; ++rep) attn_phase(F, args, l); }
        SEAM(pb + 3);
        if (KON(5) && IN(pb + 4)) { asm volatile("; PHASE_MARK 5");
            pg8::DenseSched S{(const char*)(ws + WS_MIX), (const char*)(ws + WS_WOUT) + (size_t)l * D * D, D / 2, D / 2, last ? NB * 8 : NPAN, D / 256, F.G, (int)blockIdx.x, last ? 1 : 0};
            pg8::EpiWout E{(bf16_t*)(ws + WS_X), (const float*)(ws + WS_MOD) + (size_t)l * 17 * 6144};
            pg8::gemm_phase<pg8::EpiWout, pg8::DenseSched, true, true>(F.lds, D / 2, D / 2, D / 2, S, E);
        }
        SEAM(pb + 4);
        if (KON(6) && IN(pb + 5)) { asm volatile("; PHASE_MARK 6"); norm2_router_phase(F, args, l); }
        SEAM(pb + 5);
        if (KON(7) && IN(pb + 6)) { asm volatile("; PHASE_MARK 7");
            load_counts(F, l);
            pg8::MoeSched<true> S{(const char*)(ws + WS_H), (const char*)(ws + WS_WGU) + (size_t)l * NE * 2048 * D, (const int*)(ws + WS_SLOTTOK),
                                  (volatile LAS int*)(F.lds + MISC_OFF + 256), (volatile LAS int*)(F.lds + MISC_OFF + 512), 8, F.G, (int)blockIdx.x, (size_t)2048 * D, opaque_tid() & 31};
            pg8::EpiGateUp E{(unsigned char*)(ws + WS_ACT), args.in[20] + (size_t)l * NE * D, args.in[22] + (size_t)l * NE * D};
            for (int rep = 0; rep < REP_GU; ++rep) pg8::gemm_phase<pg8::EpiGateUp, pg8::MoeSched<true>, true, true>(F.lds, D / 2, D / 2, D / 2, S, E);
        }
        SEAM(pb + 6);
        if (KON(8) && IN(pb + 7)) { asm volatile("; PHASE_MARK 8");
            load_counts(F, l);
            pg8::MoeSched<false> S{(const char*)(ws + WS_ACT), (const char*)(ws + WS_WD) + (size_t)l * NE * D * D, (const int*)(ws + WS_SLOTTOK),
                                   (volatile LAS int*)(F.lds + MISC_OFF + 256), (volatile LAS int*)(F.lds + MISC_OFF + 512), 4, F.G, (int)blockIdx.x, (size_t)D * D, opaque_tid() & 31};
            pg8::EpiDown E{(bf16_t*)(ws + WS_Y), args.in[24] + (size_t)l * NE * D, (const float*)(ws + WS_SLOTW)};
            for (int rep = 0; rep < REP_DOWN; ++rep) pg8::gemm_phase<pg8::EpiDown, pg8::MoeSched<false>, true, true>(F.lds, D / 2, D / 2, D / 2, S, E);
        }
        SEAM(pb + 7);
    }
    if (KON(9) && IN(N_PHASES - 1)) { asm volatile("; PHASE_MARK 9"); norm1_phase<1, false>(F, args, NL); }
#undef IN
#undef SEAM
}

extern "C" void kernel_launch(void* const* d_in, const int* in_sizes, int n_in, void* d_out, int out_size, void* d_ws, size_t ws_size, hipStream_t stream) {
    static int grid = 0;
    if (grid == 0) {
        if (n_in != 26 || ws_size < WS_END) { fprintf(stderr, "kernel_launch: unexpected inputs (n_in %d, ws %zu)\n", n_in, ws_size); grid = -1; return; }
        int dev = 0, cus = 0, per_cu = 0;
        if (hipGetDevice(&dev) != hipSuccess || hipDeviceGetAttribute(&cus, hipDeviceAttributeMultiprocessorCount, dev) != hipSuccess) { grid = -1; return; }
        if (hipFuncSetAttribute((const void*)trunk_fwd, hipFuncAttributeMaxDynamicSharedMemorySize, LDS_BYTES) != hipSuccess) { fprintf(stderr, "kernel_launch: hipFuncSetAttribute failed\n"); grid = -1; return; }
        if (hipOccupancyMaxActiveBlocksPerMultiprocessor(&per_cu, (const void*)trunk_fwd, NTHR, LDS_BYTES) != hipSuccess || per_cu < 1)
            fprintf(stderr, "kernel_launch: occupancy query reports %d workgroups per CU\n", per_cu);
        (void)hipGetLastError();
        grid = cus;
    }
    if (grid < 0) return;
    if (hipMemsetAsync((char*)d_ws + WS_CTL, 0, CTL_ZERO_BYTES, stream) != hipSuccess) return;
    Args a{};
    for (int i = 0; i < 26; ++i) a.in[i] = (const float*)d_in[i];
    a.out = (float*)d_out; a.ws = (unsigned char*)d_ws;
    for (int i = 0; i < 8; ++i) a.invf8[i] = pow(10000.0, -(double)i / 8.0);
    for (int i = 0; i < 16; ++i) a.invf16[i] = pow(10000.0, -(double)i / 16.0);
    for (int i = 0; i < 4; ++i) a.lam_init[i] = (float)(0.8 - 0.6 * exp(-0.3 * (double)i));
#if MK_ONE_LAUNCH
    a.ph_lo = 0; a.ph_hi = N_PHASES;
    hipLaunchKernelGGL(trunk_fwd, dim3(grid), dim3(NTHR), LDS_BYTES, stream, a);
#else
    for (int p = 0; p < N_PHASES; ++p) { a.ph_lo = p; a.ph_hi = p + 1; hipLaunchKernelGGL(trunk_fwd, dim3(grid), dim3(NTHR), LDS_BYTES, stream, a); }
#endif
}
```

```cpp
#include <hip/hip_runtime.h>
#include <cstdio>
#include <cstdint>
#include <cmath>

#ifndef MK_ONE_LAUNCH
#define MK_ONE_LAUNCH 1
#endif

#define LAS __attribute__((address_space(3)))
#define GAS __attribute__((address_space(1)))
typedef unsigned short bf16_t;
typedef short bf16x8 __attribute__((ext_vector_type(8)));
typedef short v4i16_t __attribute__((ext_vector_type(4)));
typedef float f32x4 __attribute__((ext_vector_type(4)));
typedef float f32x2 __attribute__((ext_vector_type(2)));
typedef float f32x16 __attribute__((ext_vector_type(16)));
typedef unsigned u32x4 __attribute__((ext_vector_type(4)));
typedef unsigned u32x2 __attribute__((ext_vector_type(2)));
typedef __bf16 bf16x2_t __attribute__((ext_vector_type(2)));

constexpr int NB = 16, SEQ = 2048, CTX = 256, NTK = SEQ + CTX, T = NB * NTK, D = 1024, NL = 4, NE = 32;
constexpr int PW = 2048;
constexpr int NPAN = T / 256;
constexpr int MAXPAN = 608;
constexpr int NWAVES = 8, NTHR = 512;
constexpr float EPS = 1e-6f;
constexpr float LOG2E = 1.4426950408889634f;
constexpr float SC_MLA = 0.10206207261596577f * LOG2E;
constexpr float SC_DIFF = 0.17677669529663687f * LOG2E;
constexpr float SC_SWA = 0.125f * LOG2E;
constexpr float F8_SW = 64.0f, F8_SA = 4.0f;
constexpr float F8_INV = 1.0f / (F8_SW * F8_SA);
constexpr float F8_SM = 16.0f, F8_INVM = 1.0f / (F8_SW * F8_SM);
constexpr float F8_SY = 64.0f;

constexpr size_t MiB = 1u << 20;
constexpr size_t WS_CTL = 0, CTL_ZERO_BYTES = 1 * MiB;
constexpr size_t WS_MOD = 1 * MiB;
constexpr size_t WS_ROPER = 3 * MiB;
constexpr size_t WS_ROPEW = WS_ROPER + 262144;
constexpr size_t WS_SSQ = 4 * MiB;
constexpr size_t WS_TOKSLOT = 6 * MiB;
constexpr size_t WS_SLOTTOK = 7 * MiB;
constexpr size_t WS_SLOTW = 12 * MiB;
constexpr size_t WS_WR = 17 * MiB;
constexpr size_t WS_WUQ = 18 * MiB;
constexpr size_t WS_WUKV = 19 * MiB;
constexpr size_t WS_WIN = 20 * MiB;
constexpr size_t WS_WOUT = 36 * MiB;
constexpr size_t WS_WGU = 44 * MiB;
constexpr size_t WS_WD = 556 * MiB;
constexpr size_t WS_X = 812 * MiB;
constexpr size_t WS_H = 956 * MiB;
constexpr size_t WS_ACT = 1028 * MiB;
constexpr size_t WS_P = WS_ACT;
constexpr size_t WS_QM = WS_ACT + 144 * MiB;
constexpr size_t WS_KVM = WS_ACT + 171 * MiB;
constexpr size_t WS_MIX = WS_ACT + 207 * MiB;
constexpr size_t WS_Y = 1332 * MiB;
constexpr size_t WS_END = 1636 * MiB;
constexpr int CW_LAM = 64;
constexpr int CW_ATTQ = 2048;
constexpr int CW_CUR = 1024;
constexpr int CW_BAR = 4096;

constexpr int RING_BYTES = 131072;
constexpr int MISC_OFF = RING_BYTES;
constexpr int GOFF_OFF = RING_BYTES + 4096;
constexpr int LCONST_OFF = RING_BYTES + 4096 + 8192;
constexpr int LCONST2_OFF = LCONST_OFF + 8192;
constexpr int LDS_BYTES = RING_BYTES + 4096 + 8192 + 8192 + 8192;

__device__ __forceinline__ unsigned cvtpk(float lo, float hi) { f32x2 v = {lo, hi}; bf16x2_t b = __builtin_convertvector(v, bf16x2_t); return __builtin_bit_cast(unsigned, b); }
__device__ __forceinline__ float bf2f(unsigned short b) { return __uint_as_float(((unsigned)b) << 16); }
__device__ __forceinline__ float bflo(unsigned w) { return __uint_as_float(w << 16); }
__device__ __forceinline__ float bfhi(unsigned w) { return __uint_as_float(w & 0xffff0000u); }
__device__ __forceinline__ float wave_sum(float v) {
#pragma unroll
    for (int o = 1; o < 64; o <<= 1) v += __shfl_xor(v, o);
    return v;
}
__device__ __forceinline__ int opaque_tid() { int t = threadIdx.x; asm volatile("" : "+v"(t)); return t; }
__device__ __forceinline__ int il(int i, int hd) { return (i & 1) ? (i >> 1) + (hd >> 1) : (i >> 1); }

#define XB_TMO      128
#define XB_XCNT(j)  (256  + 64 * (j))
#define XB_XSUB(j)  (1280 + 64 * (j))
#define XB_XGEN(j)  (2304 + 64 * (j))
#define XB_TOP      3328
#define XB_TOPGEN   3392
#define XCD_BAR_WORDS 3456
#define XB_SPIN_CAP (1u << 20)
__device__ __forceinline__ unsigned xb_ld(unsigned* p)              { return __hip_atomic_load(p, __ATOMIC_RELAXED, __HIP_MEMORY_SCOPE_AGENT); }
__device__ __forceinline__ unsigned xb_add(unsigned* p, unsigned v) { return __hip_atomic_fetch_add(p, v, __ATOMIC_RELAXED, __HIP_MEMORY_SCOPE_AGENT); }
__device__ __forceinline__ unsigned xb_xcc_id() { return (unsigned)__builtin_amdgcn_s_getreg((3 << 11) | 20) & 0xFu; }
#define XB_SPIN(cond, bar) do { unsigned _sp = 0; while (cond) { __builtin_amdgcn_s_sleep(1); \
    if ((++_sp & 255u) == 0u) { if (xb_ld(&(bar)[XB_TMO])) break; if (_sp > XB_SPIN_CAP) { atomicAdd(&(bar)[XB_TMO], 1u); break; } } } } while (0)
struct XcdBarrier { unsigned* bar; unsigned x; volatile LAS unsigned* st; };
__device__ __forceinline__ XcdBarrier xcd_barrier_post(unsigned* bar, volatile LAS unsigned* st) {
    XcdBarrier b; b.bar = bar; b.x = xb_xcc_id(); b.st = st;
    if (threadIdx.x == 0) (void)xb_add(&bar[XB_XCNT(b.x)], 1u);
    return b;
}
__device__ __forceinline__ void xcd_barrier_complete(unsigned* bar, unsigned x, unsigned& nloc, unsigned& nx) {
    const unsigned G = gridDim.x * gridDim.y * gridDim.z;
    unsigned sum, cnt, mine, sp = 0u;
    for (;;) {
        sum = 0u; cnt = 0u; mine = 0u;
#pragma unroll
        for (unsigned j = 0; j < 16; ++j) { const unsigned c = xb_ld(&bar[XB_XCNT(j)]); sum += c; cnt += (c > 0u) ? 1u : 0u; mine = (j == x) ? c : mine; }
        if (sum == G) break;
        __builtin_amdgcn_s_sleep(1);
        if ((++sp & 255u) == 0u) { if (xb_ld(&bar[XB_TMO])) break; if (sp > XB_SPIN_CAP) { atomicAdd(&bar[XB_TMO], 1u); break; } }
    }
    nloc = mine > 0u ? mine : 1u; nx = cnt > 0u ? cnt : 1u;
}
__device__ __forceinline__ void xcd_barrier(const XcdBarrier& b) {
    asm volatile("s_waitcnt vmcnt(0)" ::: "memory");
    __syncthreads();
    if (threadIdx.x == 0) {
        unsigned* bar = b.bar;
        __builtin_amdgcn_s_waitcnt(0);
        unsigned nloc = b.st[0], nx = b.st[1];
        if (nloc == 0u) { xcd_barrier_complete(bar, b.x, nloc, nx); b.st[0] = nloc; b.st[1] = nx; }
        const unsigned old = xb_add(&bar[XB_XSUB(b.x)], 1u);
        const unsigned gen = old / nloc;
        if (old + 1u == (gen + 1u) * nloc) {
            __builtin_amdgcn_fence(__ATOMIC_RELEASE, "agent");
            asm volatile("s_waitcnt vmcnt(0)" ::: "memory");
            const unsigned og = xb_add(&bar[XB_TOP], 1u);
            const unsigned tg = og / nx;
            if (og + 1u == (tg + 1u) * nx) xb_add(&bar[XB_TOPGEN], 1u);
            else XB_SPIN(xb_ld(&bar[XB_TOPGEN]) == tg, bar);
            __builtin_amdgcn_fence(__ATOMIC_ACQUIRE, "agent");
            xb_add(&bar[XB_XGEN(b.x)], 1u);
            asm volatile("s_waitcnt vmcnt(0)" ::: "memory");
        } else {
            XB_SPIN(xb_ld(&bar[XB_XGEN(b.x)]) == gen, bar);
            __builtin_amdgcn_fence(__ATOMIC_ACQUIRE, "agent");
            asm volatile("s_waitcnt vmcnt(0)" ::: "memory");
        }
    }
    __syncthreads();
}

struct Args {
    const float* in[26];
    float* out; unsigned char* ws;
    double invf8[8]; double invf16[16];
    float lam_init[4];
    int ph_lo, ph_hi;
};
struct Frame {
    LAS unsigned char* lds;
    unsigned char* ws;
    int tid, lane, wave, vcu, G;
};

namespace pg8 {
constexpr int BM = 256, BK = 64, HALF = 128, HTB = HALF * BK * 2, STAGE_BYTES = 8 * HTB;
__host__ __device__ __forceinline__ int lds_byte(int r, int c) { const int st = (r >> 4) * 2 + (c >> 5), rr = r & 15, cc = c & 31, ob = rr * 64 + cc * 2; return st * 1024 + (ob ^ (((ob >> 9) & 1) << 5)); }
__host__ __device__ __forceinline__ void stage_rc(int b, int& R, int& C) { const int st = b / 1024, sb = b % 1024, swz = sb ^ (((sb >> 9) & 1) << 5); R = (st >> 1) * 16 + swz / 64; C = (st & 1) * 32 + (swz % 64) / 2; }
__host__ __device__ __forceinline__ int perm32(int rho) { const int n = rho >> 4, i = rho & 15; return 8 * (i >> 2) + 4 * n + (i & 3); }

typedef int v8i32 __attribute__((ext_vector_type(8)));
typedef int u32x4i __attribute__((ext_vector_type(4)));
__device__ __forceinline__ v8i32 pk8(bf16x8 lo, bf16x8 hi) { const u32x4 a = __builtin_bit_cast(u32x4, lo), b = __builtin_bit_cast(u32x4, hi); return (v8i32){(int)a.x, (int)a.y, (int)a.z, (int)a.w, (int)b.x, (int)b.y, (int)b.z, (int)b.w}; }
struct Unit { const char* a; const char* b; int pm, pn, e, j, cnt; };

template <class Epi, class Sched, bool ALIGN_EPI, bool FP8 = false>
__device__ __forceinline__ void gemm_phase(LAS unsigned char* lds, const int K, const int lda, const int ldb, const Sched& S, const Epi& E) {
    const int tid = opaque_tid(), wid = __builtin_amdgcn_readfirstlane(tid >> 6), lane = tid & 63, wr = wid >> 2, wc = wid & 3, fr = lane & 15, fq = lane >> 4;
    const int nt = K / BK;
    int Rs[2], Cs[2]; unsigned voffBp[2];
#pragma unroll
    for (int i = 0; i < 2; ++i) { int R, C; stage_rc(tid * 16 + i * 8192, R, C); Rs[i] = R; Cs[i] = C; const int Rb = Epi::PERM ? ((R & ~31) + perm32(R & 31)) : R; voffBp[i] = (unsigned)(Rb * ldb + C) * 2u; }
    const size_t kstep = (size_t)(BK * 2);
    const size_t hstepB = (size_t)HALF * ldb * 2;
    const unsigned ldsw = (unsigned)wid * 1024u;
#define PG8_SA(b, h) (((b) * 2 + (h)) * HTB)
#define PG8_SB(b, h) ((4 + (b) * 2 + (h)) * HTB)
#define PG8_STAGE2(bufoff, gbase, o0, o1) do { \
        __builtin_amdgcn_global_load_lds((const unsigned*)((const char*)(gbase) + (o0)), (LAS unsigned*)(lds + (bufoff) + ldsw), 16, 0, 0); \
        __builtin_amdgcn_global_load_lds((const unsigned*)((const char*)(gbase) + (o1)), (LAS unsigned*)(lds + (bufoff) + ldsw + 8192), 16, 0, 0); } while (0)
#define PG8_STAGEB(bufoff, gbase) PG8_STAGE2(bufoff, gbase, voffB[0], voffB[1])
#define PG8_STAGEBP(bufoff, gbase) PG8_STAGE2(bufoff, gbase, voffBp[0], voffBp[1])
#define PG8_LD32(p) __builtin_shufflevector(*(const LAS u32x4i*)(p), *(const LAS u32x4i*)((p) + 1024), 0, 1, 2, 3, 4, 5, 6, 7)
#define PG8_LDA(dst, b, h) do { if constexpr (FP8) { _Pragma("unroll") for (int m = 0; m < 4; ++m) dst##8[m] = PG8_LD32(lds + PG8_SA(b, h) + aoff + m * 2048); } \
        else { _Pragma("unroll") for (int m = 0; m < 4; ++m) _Pragma("unroll") for (int k = 0; k < 2; ++k) dst[m][k] = *(const LAS bf16x8*)(lds + PG8_SA(b, h) + aoff + m * 2048 + k * 1024); } } while (0)
#define PG8_LDB(dst, b, h) do { if constexpr (FP8) { _Pragma("unroll") for (int n = 0; n < 2; ++n) dst##8[n] = PG8_LD32(lds + PG8_SB(b, h) + boff + n * 2048); } \
        else { _Pragma("unroll") for (int n = 0; n < 2; ++n) _Pragma("unroll") for (int k = 0; k < 2; ++k) dst[n][k] = *(const LAS bf16x8*)(lds + PG8_SB(b, h) + boff + n * 2048 + k * 1024); } } while (0)
  \

#define PG8_MMA(ai, bj, At, Bt) do { __builtin_amdgcn_s_setprio(1); _Pragma("unroll") for (int m = 0; m < 4; ++m) _Pragma("unroll") for (int n = 0; n < 2; ++n) { \
        if constexpr (FP8) { asm volatile("v_mfma_scale_f32_16x16x128_f8f6f4 %0, %1, %2, %0, %3, %3 op_sel_hi:[0,0,0]" : "+v"(acc[ai][bj][m][n]) : "v"(Bt##8[n]), "v"(At##8[m]), "v"(f8scale)); } \
        else { _Pragma("unroll") for (int k = 0; k < 2; ++k) acc[ai][bj][m][n] = __builtin_amdgcn_mfma_f32_16x16x32_bf16(Bt[n][k], At[m][k], acc[ai][bj][m][n], 0, 0, 0); } } \
        __builtin_amdgcn_s_setprio(0); } while (0)
#define PG8_WAIT_V(n) asm volatile("s_waitcnt vmcnt(" #n ")" ::: "memory")
#define PG8_WAIT_L(n) asm volatile("s_waitcnt lgkmcnt(" #n ")" ::: "memory")
#define PG8_BAR __builtin_amdgcn_s_barrier()
#define PG8_SCHED __builtin_amdgcn_sched_barrier(0)
    Unit cur, nxt; int ui = 0;
    if (!S.next(0, cur)) return;
    f32x4 acc[2][2][4][2];
#pragma unroll
    for (int a = 0; a < 2; ++a)
#pragma unroll
        for (int b = 0; b < 2; ++b)
#pragma unroll
            for (int m = 0; m < 4; ++m)
#pragma unroll
                for (int n = 0; n < 2; ++n) acc[a][b][m][n] = (f32x4){0.f, 0.f, 0.f, 0.f};
    bf16x8 At[4][2], B0[2][2], B1[2][2]; v8i32 At8[4], B08[2], B18[2];
    unsigned vc00, vc01, vc10, vc11, vn00, vn01, vn10, vn11;
    vc00 = (unsigned)(S.arow(cur, Rs[0]) * lda + Cs[0]) * 2u; vc01 = (unsigned)(S.arow(cur, Rs[1]) * lda + Cs[1]) * 2u;
    vc10 = (unsigned)(S.arow(cur, HALF + Rs[0]) * lda + Cs[0]) * 2u; vc11 = (unsigned)(S.arow(cur, HALF + Rs[1]) * lda + Cs[1]) * 2u;
    const char* cA = cur.a; const char* cB = cur.b;
    { const int t3_ = opaque_tid(), l3_ = t3_ & 63, fr3_ = l3_ & 15, fq3_ = l3_ >> 4; u32x4 lc_;
      { int R, C; stage_rc(t3_ * 16, R, C); const int Rb = Epi::PERM ? ((R & ~31) + perm32(R & 31)) : R; lc_.x = (unsigned)(Rb * ldb + C) * 2u; }
      { int R, C; stage_rc(t3_ * 16 + 8192, R, C); const int Rb = Epi::PERM ? ((R & ~31) + perm32(R & 31)) : R; lc_.y = (unsigned)(Rb * ldb + C) * 2u; }
      lc_.z = (unsigned)lds_byte(wr * 64 + fr3_, fq3_ * 8); lc_.w = (unsigned)lds_byte(wc * 32 + fr3_, fq3_ * 8);
      *(LAS u32x4*)(lds + LCONST_OFF + (t3_ << 4)) = lc_;
      if constexpr (Sched::GATHER) { int R0, C0, R1, C1; stage_rc(t3_ * 16, R0, C0); stage_rc(t3_ * 16 + 8192, R1, C1); *(LAS u32x4*)(lds + LCONST2_OFF + (t3_ << 4)) = (u32x4){(unsigned)R0, (unsigned)C0, (unsigned)R1, (unsigned)C1}; } }
    PG8_STAGEBP(PG8_SB(0, 0), cB); PG8_STAGEBP(PG8_SB(0, 1), cB + hstepB); PG8_STAGE2(PG8_SA(0, 0), cA, vc00, vc01); PG8_STAGE2(PG8_SA(0, 1), cA, vc10, vc11);
    if (wr == 1) PG8_BAR;
    PG8_WAIT_V(2); PG8_BAR;
    PG8_STAGEBP(PG8_SB(1, 0), cB + kstep); PG8_STAGE2(PG8_SA(1, 0), cA + kstep, vc00, vc01); PG8_STAGEBP(PG8_SB(1, 1), cB + hstepB + kstep);
    PG8_WAIT_V(6); PG8_BAR;
    bool has_next = S.next(1, nxt);
    if (Sched::GATHER && has_next) {
        int R0, C0, R1, C1; { const int t2_ = opaque_tid(); stage_rc(t2_ * 16, R0, C0); stage_rc(t2_ * 16 + 8192, R1, C1); }
        LAS unsigned* gp = (LAS unsigned*)(lds + GOFF_OFF) + (opaque_tid() << 2);
        gp[0] = (unsigned)(S.arow(nxt, R0) * lda + C0) * 2u; gp[1] = (unsigned)(S.arow(nxt, R1) * lda + C1) * 2u;
        gp[2] = (unsigned)(S.arow(nxt, HALF + R0) * lda + C0) * 2u; gp[3] = (unsigned)(S.arow(nxt, HALF + R1) * lda + C1) * 2u;
    }
    for (;;) {
        const char* nA = has_next ? nxt.a : cA; const char* nB = has_next ? nxt.b : cB;
        vn00 = vc00; vn01 = vc01; vn10 = vc10; vn11 = vc11;
#ifndef KREP
#define KREP 1
#endif
        constexpr int krep = (FP8 && Epi::PROBE) ? KREP : 1;
#pragma unroll 1
        for (int tq = 0; tq < krep * nt; tq += 2) {
            const int t = tq % nt;
            const bool last = (tq == krep * nt - 2);
            const int f8scale = (tq < nt) ? 0x7F7F7F7F : 0;
            unsigned voffB[2]; int aoff, boff;
            { const u32x4 lc_ = *(const LAS u32x4*)(lds + LCONST_OFF + (opaque_tid() << 4)); voffB[0] = lc_.x; voffB[1] = lc_.y; aoff = (int)lc_.z; boff = (int)lc_.w; }
            if (Sched::GATHER && last) { const LAS unsigned* gp = (const LAS unsigned*)(lds + GOFF_OFF) + (opaque_tid() << 2); vn00 = gp[0]; vn01 = gp[1]; vn10 = gp[2]; vn11 = gp[3]; }
            const char* a1 = cA + (size_t)(t + 1) * kstep;
            const char* a2 = last ? nA : cA + (size_t)((t + 2) % nt) * kstep; const char* b2 = last ? nB : cB + (size_t)((t + 2) % nt) * kstep;
            const char* a3 = a2 + kstep; const char* b3 = b2 + kstep;
            const unsigned w00 = (Sched::GATHER && last) ? vn00 : vc00, w01 = (Sched::GATHER && last) ? vn01 : vc01, w10 = (Sched::GATHER && last) ? vn10 : vc10, w11 = (Sched::GATHER && last) ? vn11 : vc11;
            const bool relax = (Epi::NST > 0) && (tq == 0) && (ui > 0);
            PG8_LDB(B0, 0, 0); PG8_LDB(B1, 0, 1); PG8_SCHED; PG8_LDA(At, 0, 0); PG8_STAGE2(PG8_SA(1, 1), a1, vc10, vc11);
            if (relax) asm volatile("s_waitcnt vmcnt(%0)" :: "n"(8 + Epi::NST) : "memory"); else PG8_WAIT_V(8);
            PG8_WAIT_L(0); PG8_BAR; PG8_MMA(0, 0, At, B0); PG8_MMA(0, 1, At, B1); PG8_BAR; PG8_SCHED;
            PG8_LDA(At, 0, 1); PG8_STAGEB(PG8_SB(0, 0), b2); PG8_STAGEB(PG8_SB(0, 1), b2 + hstepB); PG8_STAGE2(PG8_SA(0, 0), a2, w00, w01);
            if (relax) asm volatile("s_waitcnt vmcnt(%0)" :: "n"(8 + Epi::NST) : "memory"); else PG8_WAIT_V(8);
            PG8_WAIT_L(0); PG8_BAR; PG8_MMA(1, 0, At, B0); PG8_MMA(1, 1, At, B1); PG8_BAR; PG8_SCHED;
            PG8_LDB(B0, 1, 0); PG8_LDB(B1, 1, 1); PG8_SCHED; PG8_LDA(At, 1, 0); PG8_STAGE2(PG8_SA(0, 1), a2, w10, w11);
            PG8_WAIT_V(8); PG8_WAIT_L(0); PG8_BAR; PG8_MMA(0, 0, At, B0); PG8_MMA(0, 1, At, B1); PG8_BAR; PG8_SCHED;
            PG8_LDA(At, 1, 1); PG8_STAGEB(PG8_SB(1, 0), b3); PG8_STAGEB(PG8_SB(1, 1), b3 + hstepB); PG8_STAGE2(PG8_SA(1, 0), a3, w00, w01);
            PG8_WAIT_V(8); PG8_WAIT_L(0); PG8_BAR; PG8_MMA(1, 0, At, B0); PG8_MMA(1, 1, At, B1); PG8_BAR; PG8_SCHED;
        }
        Unit nn; bool has_nn = has_next && S.next(ui + 2, nn);
        int gt0 = 0, gt1 = 0, gt2 = 0, gt3 = 0;
        if constexpr (Sched::GATHER) if (has_nn) {
            int R0, C0, R1, C1; { const u32x4 rc_ = *(const LAS u32x4*)(lds + LCONST2_OFF + (opaque_tid() << 4)); R0 = (int)rc_.x; C0 = (int)rc_.y; R1 = (int)rc_.z; C1 = (int)rc_.w; }
            gt0 = S.arow_raw(nn, R0); gt1 = S.arow_raw(nn, R1); gt2 = S.arow_raw(nn, HALF + R0); gt3 = S.arow_raw(nn, HALF + R1);
        }
        if constexpr (ALIGN_EPI) { if (wr == 0) PG8_BAR; }
#ifndef REP_EPI
#define REP_EPI 1
#endif
        if constexpr (FP8) asm volatile("s_nop 15\n\ts_nop 15" ::: "memory");
        { const int l2_ = opaque_tid() & 63; for (int rep_ = 0; rep_ < (Epi::PROBE ? REP_EPI : 1); ++rep_) E(acc, cur, wr, wc, l2_ & 15, l2_ >> 4); }
        if (!has_next) break;
#pragma unroll
        for (int a = 0; a < 2; ++a)
#pragma unroll
            for (int b = 0; b < 2; ++b)
#pragma unroll
                for (int m = 0; m < 4; ++m)
#pragma unroll
                    for (int n = 0; n < 2; ++n) { double z0_, z1_; asm volatile("v_mov_b64 %0, 0\n\tv_mov_b64 %1, 0" : "=v"(z0_), "=v"(z1_));
                        typedef double f64x2_t __attribute__((ext_vector_type(2))); const f64x2_t zz_ = {z0_, z1_}; acc[a][b][m][n] = __builtin_bit_cast(f32x4, zz_); }
        cur = nxt; cA = nA; cB = nB; ++ui; vc00 = vn00; vc01 = vn01; vc10 = vn10; vc11 = vn11;
        nxt = nn; has_next = has_nn;
        if constexpr (Sched::GATHER) asm volatile("" : "+v"(gt0), "+v"(gt1), "+v"(gt2), "+v"(gt3));
        if constexpr (Sched::GATHER) if (has_next) {
            int R0, C0, R1, C1; { const u32x4 rc_ = *(const LAS u32x4*)(lds + LCONST2_OFF + (opaque_tid() << 4)); R0 = (int)rc_.x; C0 = (int)rc_.y; R1 = (int)rc_.z; C1 = (int)rc_.w; }
            LAS unsigned* gp = (LAS unsigned*)(lds + GOFF_OFF) + (opaque_tid() << 2);
            gp[0] = (unsigned)(S.arow_fix(nxt, R0, gt0) * lda + C0) * 2u; gp[1] = (unsigned)(S.arow_fix(nxt, R1, gt1) * lda + C1) * 2u;
            gp[2] = (unsigned)(S.arow_fix(nxt, HALF + R0, gt2) * lda + C0) * 2u; gp[3] = (unsigned)(S.arow_fix(nxt, HALF + R1, gt3) * lda + C1) * 2u;
        }
        if constexpr (ALIGN_EPI) { if (wr == 1) PG8_BAR; }
    }
    PG8_WAIT_V(0);
    if constexpr (!ALIGN_EPI) { if (wr == 0) PG8_BAR; }
    PG8_BAR;
#undef PG8_SA
#undef PG8_SB
#undef PG8_STAGE2
#undef PG8_STAGEB
#undef PG8_LDA
#undef PG8_LD32
#undef PG8_LDB
#undef PG8_MMA
#undef PG8_WAIT_V
#undef PG8_WAIT_L
#undef PG8_BAR
#undef PG8_SCHED
}

__device__ __forceinline__ int xcd_remap(int L, int nwg) {
    const int q = nwg / 8, r = nwg % 8, xcd = L % 8, off = L / 8;
    return (xcd < r ? xcd * (q + 1) : r * (q + 1) + (xcd - r) * q) + off;
}

struct DenseSched {
    static constexpr bool GATHER = false;
    const char* A; const char* Bt; int lda, ldb, npan, nN, G, c, latent_only;
    __device__ __forceinline__ bool next(int i, Unit& u) const {
        const int L = i * G + c, nwg = npan * nN; if (L >= nwg) return false;
        const int w = xcd_remap(L, nwg), p = w / nN, pn = w % nN;
        const int pm = latent_only ? (p >> 3) * 9 + 1 + (p & 7) : p;
        u.pm = pm; u.pn = pn; u.e = 0; u.j = 0; u.cnt = 0;
        u.a = A + (size_t)pm * 256 * lda * 2; u.b = Bt + (size_t)pn * 256 * ldb * 2; return true;
    }
    __device__ __forceinline__ int arow(const Unit&, int r) const { return r; }
};
struct UpSched {
    static constexpr bool GATHER = false;
    const char* P; const char* Wuq; const char* Wukv; int G, c;
    __device__ __forceinline__ bool next(int i, Unit& u) const {
        const int L = i * G + c, nwg = NPAN * 4; if (L >= nwg) return false;
        const int w = xcd_remap(L, nwg), p = w >> 2, pn = w & 3;
        u.pm = p; u.pn = pn; u.e = 0; u.j = 0; u.cnt = 0;
        u.a = P + (size_t)p * 256 * PW * 2 + (pn >= 2 ? 512 : 0);
        u.b = (pn >= 2 ? Wukv : Wuq) + (size_t)(pn & 1) * 256 * 256 * 2; return true;
    }
    __device__ __forceinline__ int arow(const Unit&, int r) const { return r; }
};
struct ChainMap {
    int x, r;
    __device__ __forceinline__ int nchain() const { return r < 4 ? 2 : 1; }
    __device__ __forceinline__ int chain(int j) const { return r + 32 * j; }
    __device__ __forceinline__ int nplain() const { return r < 4 ? 1 : (r < 24 ? 4 : 3); }
    __device__ __forceinline__ int plain(int j) const { return r < 4 ? 56 + r : (j == 0 ? r - 4 : (j == 1 ? 24 + r : (j == 2 ? 56 + r : 84 + r))); }
};
struct WinChainSched {
    static constexpr bool GATHER = false;
    const char* A; const char* Bt; int lda, ldb; ChainMap M;
    __device__ __forceinline__ bool next(int i, Unit& u) const {
        const int nc = M.nchain(); if (i >= nc + M.nplain()) return false;
        int q, pn;
        if (i < nc) { const int ch = M.chain(i); q = ch >> 1; pn = ch & 1; } else { const int idx = M.plain(i - nc); q = idx / 6; pn = 2 + idx - q * 6; }
        const int pm = M.x + 8 * q;
        u.pm = pm; u.pn = pn; u.e = 0; u.j = 0; u.cnt = 0;
        u.a = A + (size_t)pm * 256 * lda * 2; u.b = Bt + (size_t)pn * 256 * ldb * 2; return true;
    }
    __device__ __forceinline__ int arow(const Unit&, int r) const { return r; }
};
struct UpChainSched {
    static constexpr bool GATHER = false;
    const char* P; const char* Wuq; const char* Wukv; ChainMap M;
    __device__ __forceinline__ bool next(int i, Unit& u) const {
        if (i >= 2 * M.nchain()) return false;
        const int ch = M.chain(i >> 1), q = ch >> 1, hf = ch & 1, pn = 2 * hf + (i & 1), pm = M.x + 8 * q;
        u.pm = pm; u.pn = pn; u.e = 0; u.j = 0; u.cnt = 0;
        u.a = P + (size_t)pm * 256 * PW * 2 + (hf ? 512 : 0);
        u.b = (hf ? Wukv : Wuq) + (size_t)(pn & 1) * 256 * 256 * 2; return true;
    }
    __device__ __forceinline__ int arow(const Unit&, int r) const { return r; }
};
template <bool GATHER_> struct MoeSched {
    static constexpr bool GATHER = GATHER_;
    const char* A; const char* Bt; const int* slot_tok; volatile LAS int* PB; volatile LAS int* CNT; int nN, G, c; size_t bexp; int ln;
    __device__ __forceinline__ bool next(int i, Unit& u) const {
        const int np = PB[32], nwg = np * nN; const int L = i * G + c; if (L >= nwg) return false;
        const int w = xcd_remap(L, nwg), p = w / nN, pn = w % nN;
        const unsigned long long bal = __ballot(PB[ln + 1] <= p);
        const int e = __builtin_popcount((unsigned)(bal & 0xffffffffull));
        u.pm = p; u.pn = pn; u.e = e; u.j = p - PB[e]; u.cnt = CNT[e];
        u.a = GATHER ? A : A + (size_t)p * 256 * D;
        u.b = Bt + (size_t)e * bexp + (size_t)pn * 256 * D; return true;
    }
    __device__ __forceinline__ int arow_raw(const Unit& u, int r) const { if constexpr (GATHER) return slot_tok[(size_t)u.e * T + min(u.j * 256 + r, u.cnt - 1)]; else return r; }
    __device__ __forceinline__ int arow_fix(const Unit& u, int r, int v) const { if constexpr (GATHER) return (u.j * 256 + r) < u.cnt ? v : 0; else return r; }
    __device__ __forceinline__ int arow(const Unit& u, int r) const {
        if constexpr (GATHER) { const int pos = u.j * 256 + r; const int v = slot_tok[(size_t)u.e * T + min(pos, u.cnt - 1)]; return pos < u.cnt ? v : 0; }
        else return r;
    }
};

__device__ __forceinline__ void rope4(f32x4& v0, f32x4& v1, const f32x4* tab) {
    const f32x4 t0 = tab[0], t1 = tab[1];
    f32x4 a, b;
    a[0] = v0[0] * t0[0] - v0[1] * t0[1]; a[1] = v0[1] * t0[0] + v0[0] * t0[1];
    a[2] = v0[2] * t0[2] - v0[3] * t0[3]; a[3] = v0[3] * t0[2] + v0[2] * t0[3];
    b[0] = v1[0] * t1[0] - v1[1] * t1[1]; b[1] = v1[1] * t1[0] + v1[0] * t1[1];
    b[2] = v1[2] * t1[2] - v1[3] * t1[3]; b[3] = v1[3] * t1[2] + v1[2] * t1[3];
    v0 = a; v1 = b;
}
__device__ __forceinline__ u32x4 pack8(const f32x4& v0, const f32x4& v1) { u32x4 w; w.x = cvtpk(v0[0], v0[1]); w.y = cvtpk(v0[2], v0[3]); w.z = cvtpk(v1[0], v1[1]); w.w = cvtpk(v1[2], v1[3]); return w; }

struct EpiWin {
    static constexpr bool PERM = true, PROBE = false; static constexpr int NST = 16;
    bf16_t* P; float* ssq; const float* ropeR; const float* ropeW;
    __device__ __forceinline__ void operator()(const f32x4 (&acc)[2][2][4][2], const Unit& u, int wr, int wc, int fr, int fq) const {
        const int pn = u.pn;
        int mode[2];
        mode[0] = (pn == 2 || pn == 3) ? 1 : ((pn == 5 || pn == 6 || pn == 7) ? 2 : 0);
        mode[1] = (pn == 2 || pn == 3) ? 1 : ((pn == 5 || pn == 6) ? 2 : ((pn == 1 && wc == 0) ? 1 : 0));
        const int iR = 4 * fq, iW = 16 * (wc & 1) + 4 * fq;
        f32x4 tb[2][2][2];
        auto rowof = [&](int g) { return u.pm * 256 + (g >> 2) * 128 + wr * 64 + (g & 3) * 16 + fr; };
        auto ldtab = [&](int g) {
            const int nb = rowof(g) % NTK; const int t = nb >= CTX ? nb - CTX : 0;
#pragma unroll
            for (int bj = 0; bj < 2; ++bj) {
                if (mode[bj] == 1) { const f32x4* p = (const f32x4*)(ropeR + ((size_t)t * 16 + iR) * 2); tb[g & 1][bj][0] = p[0]; tb[g & 1][bj][1] = p[1]; }
                else if (mode[bj] == 2) { const f32x4* p = (const f32x4*)(ropeW + ((size_t)t * 32 + iW) * 2); tb[g & 1][bj][0] = p[0]; tb[g & 1][bj][1] = p[1]; }
            }
        };
        ldtab(0);
#pragma unroll
        for (int g = 0; g < 8; ++g) {
            const int ai = g >> 2, m = g & 3;
            const int row = rowof(g);
            const bool latent = (row % NTK) >= CTX;
            if (g + 1 < 8) ldtab(g + 1);
            float ss = 0.f;
#pragma unroll
            for (int bj = 0; bj < 2; ++bj) {
                f32x4 v0 = acc[ai][bj][m][0] * F8_INV, v1 = acc[ai][bj][m][1] * F8_INV;
                if (pn == 0 || (pn == 1 && bj == 0)) ss += (v0[0] * v0[0] + v0[1] * v0[1]) + (v0[2] * v0[2] + v0[3] * v0[3]) + (v1[0] * v1[0] + v1[1] * v1[1]) + (v1[2] * v1[2] + v1[3] * v1[3]);
                if (mode[bj] != 0) {
                    f32x4 t0 = tb[g & 1][bj][0], t1 = tb[g & 1][bj][1];
                    if (!latent) { t0 = (f32x4){1.f, 0.f, 1.f, 0.f}; t1 = t0; }
                    const f32x4 tt[2] = {t0, t1};
                    rope4(v0, v1, tt);
                }
                *(u32x4*)(P + (size_t)row * PW + pn * 256 + bj * 128 + wc * 32 + fq * 8) = pack8(v0, v1);
            }
            if (pn < 2) { ss += __shfl_xor(ss, 16); ss += __shfl_xor(ss, 32); if (fq == 0) ssq[(size_t)row * 8 + pn * 4 + wc] = ss; }
        }
    }
};
struct EpiUp {
    static constexpr bool PERM = true, PROBE = false; static constexpr int NST = 0;
    bf16_t* QM; bf16_t* KVM; const float* ssq; const float* ropeR;
    __device__ __forceinline__ void operator()(const f32x4 (&acc)[2][2][4][2], const Unit& u, int wr, int wc, int fr, int fq) const {
        const bool isq = u.pn < 2;
        int col0[2], rp[2];
#pragma unroll
        for (int bj = 0; bj < 2; ++bj) { col0[bj] = (u.pn & 1) * 256 + bj * 128 + wc * 32 + fq * 8; const int hl = col0[bj] % 96; rp[bj] = (isq && col0[bj] < 384 && hl >= 64) ? ((hl - 64) >> 1) : -1; }
        f32x4 sq[2]; f32x4 tb[2][2][2];
        auto rowof = [&](int g) { return u.pm * 256 + (g >> 2) * 128 + wr * 64 + (g & 3) * 16 + fr; };
        auto ld = [&](int g) {
            const int row = rowof(g); const int nb = row % NTK; const int t = nb >= CTX ? nb - CTX : 0;
            sq[g & 1] = *(const f32x4*)(ssq + (size_t)row * 8 + (isq ? 0 : 4));
#pragma unroll
            for (int bj = 0; bj < 2; ++bj) if (rp[bj] >= 0) { const f32x4* p = (const f32x4*)(ropeR + ((size_t)t * 16 + rp[bj]) * 2); tb[g & 1][bj][0] = p[0]; tb[g & 1][bj][1] = p[1]; }
        };
        ld(0);
#pragma unroll
        for (int g = 0; g < 8; ++g) {
            const int ai = g >> 2, m = g & 3;
            const int row = rowof(g);
            const bool latent = (row % NTK) >= CTX;
            if (g + 1 < 8) ld(g + 1);
            const f32x4 s4 = sq[g & 1];
            const float ssum = (s4[0] + s4[1]) + (s4[2] + s4[3]);
            const float rstd = __builtin_amdgcn_rsqf(ssum * (isq ? (1.f / 256.f) : (1.f / 128.f)) + EPS);
#pragma unroll
            for (int bj = 0; bj < 2; ++bj) {
                f32x4 v0 = acc[ai][bj][m][0] * rstd, v1 = acc[ai][bj][m][1] * rstd;
                if (isq) {
                    if (col0[bj] < 384) {
                        if (rp[bj] >= 0) {
                            f32x4 t0 = tb[g & 1][bj][0], t1 = tb[g & 1][bj][1];
                            if (!latent) { t0 = (f32x4){1.f, 0.f, 1.f, 0.f}; t1 = t0; }
                            const f32x4 tt[2] = {t0, t1};
                            rope4(v0, v1, tt);
                        }
                        *(u32x4*)(QM + (size_t)row * 384 + col0[bj]) = pack8(v0, v1);
                    }
                } else *(u32x4*)(KVM + (size_t)row * 512 + col0[bj]) = pack8(v0, v1);
            }
        }
    }
};
struct EpiWout {
    static constexpr bool PERM = true, PROBE = false; static constexpr int NST = 16;
    bf16_t* X; const float* modl;
    __device__ __forceinline__ void operator()(const f32x4 (&acc)[2][2][4][2], const Unit& u, int wr, int wc, int fr, int fq) const {
        const int b = u.pm / 9, modrow = (u.pm - b * 9 == 0) ? 16 : b;
        const float* gate = modl + (size_t)modrow * 6144 + 2 * D;
        const int col0 = u.pn * 256 + wc * 32 + 8 * fq;
        f32x4 gv[2][2];
#pragma unroll
        for (int bj = 0; bj < 2; ++bj)
#pragma unroll
            for (int n = 0; n < 2; ++n) gv[bj][n] = *(const f32x4*)(gate + col0 + bj * 128 + n * 4);
        u32x4 xq[2][2];
        auto rowp = [&](int g) { return X + (size_t)(u.pm * 256 + (g >> 2) * 128 + wr * 64 + (g & 3) * 16 + fr) * D + col0; };
        xq[0][0] = *(const u32x4*)(rowp(0)); xq[0][1] = *(const u32x4*)(rowp(0) + 128);
#pragma unroll
        for (int g = 0; g < 8; ++g) {
            const int ai = g >> 2, m = g & 3;
            if (g + 1 < 8) { xq[(g + 1) & 1][0] = *(const u32x4*)(rowp(g + 1)); xq[(g + 1) & 1][1] = *(const u32x4*)(rowp(g + 1) + 128); }
#pragma unroll
            for (int bj = 0; bj < 2; ++bj) {
                const u32x4 xw = xq[g & 1][bj];
                f32x4 x0 = {bflo(xw.x), bfhi(xw.x), bflo(xw.y), bfhi(xw.y)}, x1 = {bflo(xw.z), bfhi(xw.z), bflo(xw.w), bfhi(xw.w)};
                x0 += gv[bj][0] * (acc[ai][bj][m][0] * F8_INVM); x1 += gv[bj][1] * (acc[ai][bj][m][1] * F8_INVM);
                *(u32x4*)(rowp(g) + bj * 128) = pack8(x0, x1);
            }
        }
    }
};
__device__ __forceinline__ f32x4 swiglu4(f32x4 g, f32x4 up, float s) {
    g = __builtin_elementwise_min(g, (f32x4){7.0f, 7.0f, 7.0f, 7.0f});
    up = __builtin_elementwise_min(__builtin_elementwise_max(up, (f32x4){-7.0f, -7.0f, -7.0f, -7.0f}), (f32x4){7.0f, 7.0f, 7.0f, 7.0f});
    const f32x4 t = g * (-1.702f * LOG2E);
    f32x4 e; e[0] = __builtin_amdgcn_exp2f(t[0]); e[1] = __builtin_amdgcn_exp2f(t[1]); e[2] = __builtin_amdgcn_exp2f(t[2]); e[3] = __builtin_amdgcn_exp2f(t[3]);
    const f32x4 d = e + 1.0f;
    f32x4 r; r[0] = __builtin_amdgcn_rcpf(d[0]); r[1] = __builtin_amdgcn_rcpf(d[1]); r[2] = __builtin_amdgcn_rcpf(d[2]); r[3] = __builtin_amdgcn_rcpf(d[3]);
    return (g * r) * (up * s + s);
}
struct EpiGateUp {
    static constexpr bool PERM = true, PROBE = true; static constexpr int NST = 4;
    unsigned char* ACT; const float* bg; const float* bu;
    __device__ __forceinline__ void operator()(const f32x4 (&acc)[2][2][4][2], const Unit& u, int wr, int wc, int fr, int fq) const {
        const int colL = u.pn * 128 + wc * 32 + fq * 8;
        const f32x4 g0 = *(const f32x4*)(bg + (size_t)u.e * D + colL), g1 = *(const f32x4*)(bg + (size_t)u.e * D + colL + 4);
        const f32x4 u0 = *(const f32x4*)(bu + (size_t)u.e * D + colL), u1 = *(const f32x4*)(bu + (size_t)u.e * D + colL + 4);
#pragma unroll
        for (int ai = 0; ai < 2; ++ai)
#pragma unroll
            for (int mp = 0; mp < 2; ++mp) {
                u32x2 w8[2];
#pragma unroll
                for (int h = 0; h < 2; ++h) {
                    const int m = 2 * mp + h;
                    const f32x4 ga = acc[ai][0][m][0] * F8_INV + g0, gb = acc[ai][0][m][1] * F8_INV + g1, ua = acc[ai][1][m][0] * F8_INV + u0, ub = acc[ai][1][m][1] * F8_INV + u1;
                    const f32x4 ra = swiglu4(ga, ua, F8_SA), rb = swiglu4(gb, ub, F8_SA);
                    w8[h].x = (unsigned)__builtin_amdgcn_cvt_pk_fp8_f32(ra[2], ra[3], __builtin_amdgcn_cvt_pk_fp8_f32(ra[0], ra[1], 0, false), true);
                    w8[h].y = (unsigned)__builtin_amdgcn_cvt_pk_fp8_f32(rb[2], rb[3], __builtin_amdgcn_cvt_pk_fp8_f32(rb[0], rb[1], 0, false), true);
                }
                const auto sx = __builtin_amdgcn_permlane16_swap(w8[0].x, w8[1].x, false, false), sy = __builtin_amdgcn_permlane16_swap(w8[0].y, w8[1].y, false, false);
                const int srow = u.pm * 256 + ai * 128 + wr * 64 + (2 * mp + (fq & 1)) * 16 + fr;
                u32x4 w16; w16.x = sx[0]; w16.y = sy[0]; w16.z = sx[1]; w16.w = sy[1];
                *(u32x4*)(ACT + (size_t)srow * D + (u.pn * 128 + wc * 32 + (fq & 2) * 8)) = w16;
            }
    }
};
struct EpiDown {
    static constexpr bool PERM = true, PROBE = true; static constexpr int NST = 8;
    bf16_t* Y; const float* bd; const float* slot_w;
    __device__ __forceinline__ void operator()(const f32x4 (&acc)[2][2][4][2], const Unit& u, int wr, int wc, int fr, int fq) const {
        const int col0 = u.pn * 256 + wc * 32 + fq * 8;
        f32x4 bv[2][2];
#pragma unroll
        for (int bj = 0; bj < 2; ++bj)
#pragma unroll
            for (int n = 0; n < 2; ++n) bv[bj][n] = *(const f32x4*)(bd + (size_t)u.e * D + col0 + bj * 128 + n * 4);
        float wv[8];
#pragma unroll
        for (int g = 0; g < 8; ++g) { const int pos = u.j * 256 + (g >> 2) * 128 + wr * 64 + (g & 3) * 16 + fr; wv[g] = slot_w[(size_t)u.e * T + min(pos, u.cnt - 1)]; }
#pragma unroll
        for (int g = 0; g < 8; ++g) { const int pos = u.j * 256 + (g >> 2) * 128 + wr * 64 + (g & 3) * 16 + fr; wv[g] = pos < u.cnt ? wv[g] : 0.f; }
#pragma unroll
        for (int ai = 0; ai < 2; ++ai)
#pragma unroll
            for (int mp = 0; mp < 2; ++mp) {
                const int rl = ai * 128 + wr * 64 + (2 * mp + (fq & 1)) * 16 + fr;
#pragma unroll
                for (int bj = 0; bj < 2; ++bj) {
                    u32x2 w8[2];
#pragma unroll
                    for (int h = 0; h < 2; ++h) {
                        const int m = 2 * mp + h; const float w = wv[ai * 4 + m];
                        const f32x4 v0 = (acc[ai][bj][m][0] * F8_INV + bv[bj][0]) * (w * F8_SY), v1 = (acc[ai][bj][m][1] * F8_INV + bv[bj][1]) * (w * F8_SY);
                        w8[h].x = (unsigned)__builtin_amdgcn_cvt_pk_fp8_f32(v0[2], v0[3], __builtin_amdgcn_cvt_pk_fp8_f32(v0[0], v0[1], 0, false), true);
                        w8[h].y = (unsigned)__builtin_amdgcn_cvt_pk_fp8_f32(v1[2], v1[3], __builtin_amdgcn_cvt_pk_fp8_f32(v1[0], v1[1], 0, false), true);
                    }
                    const auto sx = __builtin_amdgcn_permlane16_swap(w8[0].x, w8[1].x, false, false), sy = __builtin_amdgcn_permlane16_swap(w8[0].y, w8[1].y, false, false);
                    u32x4 w16; w16.x = sx[0]; w16.y = sy[0]; w16.z = sx[1]; w16.w = sy[1];
                    *(u32x4*)((unsigned char*)Y + (size_t)(u.pm * 256 + rl) * D + (u.pn * 256 + wc * 32 + (fq & 2) * 8) + bj * 128) = w16;
                }
            }
    }
};
}

__device__ __forceinline__ int winmap(int p, float& sc) {
    sc = 1.f;
    if (p < 384) return p;
    if (p < 416) return 384 + il(p - 384, 32);
    if (p < 512) return -1;
    if (p < 768)  { const int q = p - 512;  sc = SC_DIFF; return 416 + (q & ~31) + il(q & 31, 32); }
    if (p < 1024) { const int q = p - 768;  return 672 + (q & ~31) + il(q & 31, 32); }
    if (p < 1280) return 928 + (p - 1024);
    if (p < 1792) { const int q = p - 1280; sc = SC_SWA; return 1184 + (q & ~63) + il(q & 63, 64); }
    if (p < 1920) { const int q = p - 1792; return 1696 + (q & ~63) + il(q & 63, 64); }
    return 1824 + (p - 1920);
}
__device__ __forceinline__ int uqmap(int n) {
    if (n >= 384) return -1;
    const int h = n / 96, i = n - h * 96;
    return h * 96 + (i < 64 ? i : 64 + il(i - 64, 32));
}
struct CvtItem { const float* src; int ld, kvalid, k0, n0, nrows, mapkind, ldd; bf16_t* dst; const float* rowscale; };
constexpr int CVT_PER_LAYER = 256 + 16 + 16 + 8;
constexpr int CVT_ITEMS = NL * CVT_PER_LAYER;
__device__ __forceinline__ void cvt_decode(const Args& a, unsigned char* ws, int it, CvtItem& c) {
    const int l = it / CVT_PER_LAYER; int r = it - l * CVT_PER_LAYER;
    c.rowscale = nullptr; c.mapkind = 0; c.nrows = 64;
    if (r < 256) { c.src = a.in[7] + (size_t)l * D * 1952; c.ld = 1952; c.kvalid = D; c.k0 = (r >> 5) * 128; c.n0 = (r & 31) * 64; c.mapkind = 1; c.ldd = D;
        c.dst = (bf16_t*)(ws + WS_WIN + ((size_t)l * PW * D + (size_t)c.n0 * D)); return; }
    r -= 256;
    if (r < 16) { c.src = a.in[9] + (size_t)l * 256 * 384; c.ld = 384; c.kvalid = 256; c.k0 = (r >> 3) * 128; c.n0 = (r & 7) * 64; c.mapkind = 2; c.ldd = 256; c.rowscale = a.in[8] + l * 256;
        c.dst = (bf16_t*)(ws + WS_WUQ) + (size_t)l * 512 * 256 + (size_t)c.n0 * 256; return; }
    r -= 16;
    if (r < 16) { c.src = a.in[11] + (size_t)l * 128 * 512; c.ld = 512; c.kvalid = 128; c.k0 = (r >> 3) * 128; c.n0 = (r & 7) * 64; c.ldd = 256; c.rowscale = a.in[10] + l * 128;
        c.dst = (bf16_t*)(ws + WS_WUKV) + (size_t)l * 512 * 256 + (size_t)c.n0 * 256; return; }
    r -= 16;
    c.src = a.in[17] + (size_t)l * D * 32; c.ld = 32; c.kvalid = D; c.k0 = r * 128; c.n0 = 0; c.nrows = 32; c.mapkind = 3; c.ldd = D;
    c.dst = (bf16_t*)(ws + WS_WR) + (size_t)l * 32 * D;
}
constexpr int FAST_MATS = NL * (1 + 3 * NE);
constexpr int FAST_ITEMS = FAST_MATS * 128;
constexpr int FAST_PER_LAYER = (1 + 3 * NE) * 128;
constexpr int CONV_CHUNK = 32, CONV_NCHUNK = FAST_PER_LAYER / CONV_CHUNK;
__device__ __forceinline__ void fast_decode(const Args& a, unsigned char* ws, int it, const float*& src, unsigned char*& dst8, bool& f8) {
    const int mat = it >> 7, tile = it & 127, k0 = (tile >> 4) * 128, n0 = (tile & 15) * 64;
    const int l = mat / (1 + 3 * NE); int r = mat - l * (1 + 3 * NE);
    const float* sb;
    if (r == 0) { sb = a.in[15] + (size_t)l * D * D; dst8 = ws + WS_WOUT + ((size_t)l * D * D + (size_t)n0 * D + k0); f8 = true; }
    else { r -= 1; const int e = r / 3, which = r - e * 3; const size_t le = (size_t)l * NE + e; f8 = true;
        if (which == 0)      { sb = a.in[19] + le * D * D; dst8 = ws + WS_WGU + le * 2048 * D + (size_t)((n0 >> 7) * 256 + (n0 & 127)) * D + k0; }
        else if (which == 1) { sb = a.in[21] + le * D * D; dst8 = ws + WS_WGU + le * 2048 * D + (size_t)((n0 >> 7) * 256 + 128 + (n0 & 127)) * D + k0; }
        else                 { sb = a.in[23] + le * D * D; dst8 = ws + WS_WD + le * D * D + (size_t)n0 * D + k0; } }
    src = sb + (size_t)k0 * D + n0;
}
__device__ __forceinline__ void fast_convert(Frame& F, const Args& a, int tid, int it0, int it1, int gw, int NGW) {
    unsigned char* ws = F.ws;
    const int lane = tid & 63, q = lane >> 4, c4 = (lane & 15) * 4;
    LAS unsigned char* tl = F.lds + F.wave * 8704;
    f32x4 v[32]; const float* src; unsigned char* dst8; bool f8;
#define FAST_LOAD() do { _Pragma("unroll") for (int x = 0; x < 32; ++x) { const int kr = 16 * (x >> 2) + 4 * q + (x & 3); \
        v[x] = __builtin_nontemporal_load((const f32x4*)(src + (size_t)kr * D + c4)); } } while (0)
    int it = it0 + gw;
    if (it < it1) { fast_decode(a, ws, it, src, dst8, f8); FAST_LOAD(); }
    for (; it < it1; it += NGW) {
        unsigned char* cdst = dst8;
#pragma unroll
        for (int i = 0; i < 8; ++i)
#pragma unroll
            for (int j = 0; j < 4; ++j)
                *(LAS unsigned*)(tl + (c4 + j) * 132 + 16 * i + 4 * q) = (unsigned)__builtin_amdgcn_cvt_pk_fp8_f32(v[4 * i + 2][j] * F8_SW, v[4 * i + 3][j] * F8_SW, __builtin_amdgcn_cvt_pk_fp8_f32(v[4 * i][j] * F8_SW, v[4 * i + 1][j] * F8_SW, 0, false), true);
        const int nx = it + NGW;
        if (nx < it1) { fast_decode(a, ws, nx, src, dst8, f8); FAST_LOAD(); }
        asm volatile("s_waitcnt lgkmcnt(0)" ::: "memory");
#pragma unroll
        for (int p = 0; p < 8; ++p) {
            const int n = 8 * p + (lane >> 3), c = lane & 7;
            const LAS unsigned* t4 = (const LAS unsigned*)(tl + n * 132 + c * 16);
            u32x4 w; w.x = t4[0]; w.y = t4[1]; w.z = t4[2]; w.w = t4[3];
            __builtin_nontemporal_store(w, (u32x4*)(cdst + (size_t)n * D + c * 16));
        }
        asm volatile("s_waitcnt lgkmcnt(0)" ::: "memory");
    }
#undef FAST_LOAD
}
__device__ __forceinline__ void cvt_load(const CvtItem& c, int tid, float (&v)[16]) {
    const int nn = tid & 63, kk = tid >> 6;
    float sc = 1.f; int sn;
    if (c.mapkind == 1) sn = winmap(c.n0 + nn, sc);
    else if (c.mapkind == 2) { sn = uqmap(c.n0 + nn); sc = SC_MLA; }
    else if (c.mapkind == 3) sn = nn < 32 ? nn : -1;
    else sn = c.n0 + nn;
#pragma unroll
    for (int i = 0; i < 16; ++i) {
        const int k = c.k0 + kk + 8 * i;
        float x = 0.f;
        if (sn >= 0 && k < c.kvalid) { x = c.src[(size_t)k * c.ld + sn] * sc; if (c.rowscale) x *= c.rowscale[k]; }
        v[i] = x;
    }
}
__device__ __forceinline__ void prologue_phase(Frame& F, const Args& a) {
    unsigned char* ws = F.ws;
    const int tid = opaque_tid();
    __syncthreads();
    {
        LAS unsigned short* tile = (LAS unsigned short*)F.lds;
        float v[16]; CvtItem c;
        int it = F.vcu;
        if (it < CVT_ITEMS) { cvt_decode(a, ws, it, c); cvt_load(c, tid, v); }
        for (; it < CVT_ITEMS; it += F.G) {
            const int nn = tid & 63, kk = tid >> 6;
            const bool f8 = (c.mapkind == 1);
            if (f8) {
                LAS unsigned char* t8 = (LAS unsigned char*)tile;
#pragma unroll
                for (int i = 0; i < 16; ++i) t8[nn * 132 + kk + 8 * i] = (unsigned char)(__builtin_amdgcn_cvt_pk_fp8_f32(v[i] * F8_SW, 0.f, 0, false) & 0xff);
            } else {
#pragma unroll
                for (int i = 0; i < 16; ++i) tile[nn * 130 + kk + 8 * i] = (unsigned short)(cvtpk(v[i], 0.f) & 0xffffu);
            }
            __syncthreads();
            const CvtItem cc = c;
            const int nx = it + F.G;
            if (nx < CVT_ITEMS) { cvt_decode(a, ws, nx, c); cvt_load(c, tid, v); }
            const LAS unsigned* t32 = (const LAS unsigned*)tile;
            if (f8) {
                const int n = tid >> 3, ch = tid & 7;
                u32x4 w; const LAS unsigned* s = t32 + n * 33 + ch * 4;
                w.x = s[0]; w.y = s[1]; w.z = s[2]; w.w = s[3];
                *(u32x4*)((unsigned char*)cc.dst + (size_t)n * cc.ldd + cc.k0 + ch * 16) = w;
            } else {
#pragma unroll
                for (int p = 0; p < 2; ++p) {
                    const int n = (tid >> 4) + 32 * p, ch = tid & 15;
                    if (n < cc.nrows) {
                        u32x4 w; const LAS unsigned* s = t32 + n * 65 + ch * 4;
                        w.x = s[0]; w.y = s[1]; w.z = s[2]; w.w = s[3];
                        *(u32x4*)(cc.dst + (size_t)n * cc.ldd + cc.k0 + ch * 8) = w;
                    }
                }
            }
            __syncthreads();
        }
    }
    {
        LAS float* sil = (LAS float*)F.lds;
        LAS float* part = (LAS float*)(F.lds + 1024 * 17 * 4);
        __syncthreads();
        for (int i = tid; i < 17 * D; i += NTHR) { const int r = i / D, k = i - r * D; const float x = r < 16 ? a.in[1][(size_t)r * D + k] : a.in[3][k]; sil[k * 17 + r] = x / (1.f + __expf(-x)); }
        __syncthreads();
        float* MOD = (float*)(ws + WS_MOD);
        const int col = tid & 63, kg = tid >> 6;
        for (int ch = F.vcu; ch < NL * 96; ch += F.G) {
            const int l = ch / 96, j0 = (ch - l * 96) * 64;
            const float* w = a.in[4] + (size_t)l * D * 6144 + j0 + col;
            float accv[17];
#pragma unroll
            for (int r = 0; r < 17; ++r) accv[r] = 0.f;
#pragma unroll 4
            for (int k = kg * 128; k < kg * 128 + 128; ++k) {
                const float wv = w[(size_t)k * 6144];
#pragma unroll
                for (int r = 0; r < 17; ++r) accv[r] += sil[k * 17 + r] * wv;
            }
#pragma unroll
            for (int r = 0; r < 17; ++r) part[(kg * 17 + r) * 64 + col] = accv[r];
            __syncthreads();
            for (int i = tid; i < 17 * 64; i += NTHR) {
                const int r = i >> 6, cc = i & 63; float s = 0.f;
#pragma unroll
                for (int g = 0; g < 8; ++g) s += part[(g * 17 + r) * 64 + cc];
                MOD[((size_t)l * 17 + r) * 6144 + j0 + cc] = s + a.in[5][(size_t)l * 6144 + j0 + cc];
            }
            __syncthreads();
        }
    }
    {
        const int gt = F.vcu * NTHR + tid, GT = F.G * NTHR;
        float* ropeR = (float*)(ws + WS_ROPER); float* ropeW = (float*)(ws + WS_ROPEW);
        for (int i = gt; i < SEQ * 48; i += GT) {
            int t, j; double f; float* dst;
            if (i < SEQ * 16) { t = i >> 4; j = i & 15; f = a.invf8[j & 7]; dst = ropeR + (size_t)i * 2; const int pos = (j < 8) ? (t >> 6) : (t & 63); f *= (double)pos; }
            else { const int ii = i - SEQ * 16; t = ii >> 5; j = ii & 31; f = a.invf16[j & 15]; dst = ropeW + (size_t)ii * 2; const int pos = (j < 16) ? (t >> 6) : (t & 63); f *= (double)pos; }
            const double n = __builtin_rint(f * 0.15915494309189535);
            const double r = (f - n * 6.283185307179586) - n * 2.4492935982947064e-16;
            const double r2 = r * r;
            double s = 1.0, cs = 1.0;
#pragma unroll
            for (int q = 27; q >= 3; q -= 2) s = 1.0 - s * r2 / (double)(q * (q - 1));
            s *= r;
#pragma unroll
            for (int q = 26; q >= 2; q -= 2) cs = 1.0 - cs * r2 / (double)(q * (q - 1));
            dst[0] = (float)cs; dst[1] = (float)s;
        }
        if (gt < NL) {
            const float* lam = a.in[12] + gt * 128; float s1 = 0.f, s2 = 0.f;
            for (int k = 0; k < 32; ++k) { s1 += lam[k] * lam[32 + k]; s2 += lam[64 + k] * lam[96 + k]; }
            ((float*)(ws + WS_CTL))[CW_LAM + gt] = expf(s1) - expf(s2) + a.lam_init[gt];
        }
    }
}

__device__ __forceinline__ void load_counts(Frame& F, int l) {
    volatile LAS int* PB = (volatile LAS int*)(F.lds + MISC_OFF + 256);
    volatile LAS int* CNT = (volatile LAS int*)(F.lds + MISC_OFF + 512);
    __syncthreads();
    const int tid = opaque_tid(), lane = tid & 63;
    if (tid < 64) {
        const unsigned* cur = (const unsigned*)(F.ws + WS_CTL) + CW_CUR + l * 32;
        const int c = lane < 32 ? (int)cur[lane] : 0;
        const int np = (c + 255) >> 8;
        int incl = np;
#pragma unroll
        for (int o = 1; o < 32; o <<= 1) { const int y = __shfl_up(incl, o); if ((lane & 31) >= o) incl += y; }
        if (lane < 32) { PB[lane + 1] = incl; CNT[lane] = c; }
        if (lane == 0) PB[0] = 0;
    }
    __syncthreads();
}
template <int MODE, bool FIRST> __device__ __forceinline__ void norm1_phase(Frame& F, const Args& a, int l, bool dummy = false) {
    unsigned char* ws = F.ws;
    bf16_t* X = (bf16_t*)(ws + WS_X); bf16_t* H = (bf16_t*)(ws + WS_H); const bf16_t* Y = (const bf16_t*)(ws + WS_Y);
    bf16_t* Xw = dummy ? (bf16_t*)(ws + WS_ACT + 160 * MiB) : X; if (dummy) H = (bf16_t*)(ws + WS_ACT + 232 * MiB);
    const float* MOD = (const float*)(ws + WS_MOD);
    const unsigned* tokslot = (const unsigned*)(ws + WS_TOKSLOT);
    constexpr bool comb = (MODE == 1) || !FIRST;
    constexpr int NR = FIRST ? 4 : 2;
    const int lp = (MODE == 1) ? NL - 1 : l - 1;
    if (comb) load_counts(F, lp);
    volatile LAS int* PB = (volatile LAS int*)(F.lds + MISC_OFF + 256);
    const int lane = opaque_tid() & 63;
    int vcu_ = F.vcu; asm volatile("" : "+s"(vcu_));
    const int gw = vcu_ * NWAVES + F.wave, NGW = F.G * NWAVES;
    const int nrows = (MODE == 1) ? NB * SEQ : T;
    const float* gvec = (MODE == 1) ? a.in[25] : a.in[6] + (size_t)l * D;
    f32x4 gv[4];
#pragma unroll
    for (int j = 0; j < 4; ++j) gv[j] = *(const f32x4*)(gvec + 16 * lane + 4 * j);
    auto rowinfo = [&](int ri, int& tok, int& bb, int& nb) { if (MODE == 1) { bb = ri >> 11; nb = CTX + (ri & 2047); tok = bb * NTK + nb; } else { tok = ri; bb = tok / NTK; nb = tok - bb * NTK; } };
    auto stageA = [&](int ri, u32x4 (&raw)[NR], u32x4& ts) {
        int tok, bb, nb; rowinfo(ri, tok, bb, nb);
        if constexpr (FIRST) {
            const float* src = nb < CTX ? a.in[2] + ((size_t)bb * CTX + nb) * D : a.in[0] + ((size_t)bb * SEQ + (nb - CTX)) * D;
#pragma unroll
            for (int j = 0; j < 4; ++j) raw[j] = *(const u32x4*)(src + 16 * lane + 4 * j);
        } else {
            const u32x4* xp = (const u32x4*)(X + (size_t)tok * D + 16 * lane); raw[0] = xp[0]; raw[1] = xp[1];
        }
        if (comb) ts = *(const u32x4*)(tokslot + (size_t)tok * 4);
    };
    auto stageB = [&](const u32x4& ts, u32x4 (&yv)[4]) {
#pragma unroll
        for (int k = 0; k < 4; ++k) {
            const unsigned w = ts[k]; const int e = (int)(w >> 16), pos = (int)(w & 0xffffu);
            const unsigned char* yr = (const unsigned char*)Y + ((size_t)PB[e] * 256 + pos) * D;
            yv[k] = *(const u32x4*)(yr + 16 * lane);
        }
    };
    auto stageC = [&](int ri, const u32x4 (&raw)[NR], const u32x4 (&yv)[4]) {
        __builtin_amdgcn_sched_barrier(0);
        int tok, bb, nb; rowinfo(ri, tok, bb, nb);
        const int modrow = nb < CTX ? 16 : bb;
        f32x4 v[4];
#pragma unroll
        for (int j = 0; j < 4; ++j) {
            if constexpr (FIRST) v[j] = __builtin_bit_cast(f32x4, raw[j]);
            else { const unsigned w0 = (j & 1) ? raw[j >> 1].z : raw[j >> 1].x, w1 = (j & 1) ? raw[j >> 1].w : raw[j >> 1].y; v[j] = (f32x4){bflo(w0), bfhi(w0), bflo(w1), bfhi(w1)}; }
        }
        if (comb) {
            const float* g5 = MOD + ((size_t)lp * 17 + modrow) * 6144 + 5 * D;
#pragma unroll
            for (int j = 0; j < 4; ++j) {
                f32x4 sj = (f32x4){0.f, 0.f, 0.f, 0.f};
#pragma unroll
                for (int k = 0; k < 4; ++k) { const unsigned y = yv[k][j]; const f32x2 lo = __builtin_amdgcn_cvt_pk_f32_fp8((int)y, false), hi2 = __builtin_amdgcn_cvt_pk_f32_fp8((int)y, true); sj[0] += lo[0]; sj[1] += lo[1]; sj[2] += hi2[0]; sj[3] += hi2[1]; }
                v[j] += *(const f32x4*)(g5 + 16 * lane + 4 * j) * (sj * (1.0f / F8_SY));
            }
        }
        float ss = 0.f;
#pragma unroll
        for (int j = 0; j < 4; ++j) ss += (v[j][0] * v[j][0] + v[j][1] * v[j][1]) + (v[j][2] * v[j][2] + v[j][3] * v[j][3]);
        const float rstd = 1.0f / sqrtf(wave_sum(ss) * (1.f / D) + EPS);
        if (MODE == 1) {
            float* o = a.out + (size_t)ri * D;
#pragma unroll
            for (int j = 0; j < 4; ++j) *(f32x4*)(o + 16 * lane + 4 * j) = v[j] * rstd * gv[j];
        } else {
            const float* mr = MOD + ((size_t)l * 17 + modrow) * 6144;
            u32x4 xb[2], h8;
#pragma unroll
            for (int j = 0; j < 4; ++j) {
                const unsigned p0 = cvtpk(v[j][0], v[j][1]), p1 = cvtpk(v[j][2], v[j][3]);
                if (j & 1) { xb[j >> 1].z = p0; xb[j >> 1].w = p1; } else { xb[j >> 1].x = p0; xb[j >> 1].y = p1; }
                const f32x4 sh = *(const f32x4*)(mr + 16 * lane + 4 * j), sc = *(const f32x4*)(mr + D + 16 * lane + 4 * j);
                const f32x4 h = (v[j] * rstd * gv[j] * (sc + 1.0f) + sh) * F8_SA;
                h8[j] = (unsigned)__builtin_amdgcn_cvt_pk_fp8_f32(h[2], h[3], __builtin_amdgcn_cvt_pk_fp8_f32(h[0], h[1], 0, false), true);
            }
            { u32x4* xp = (u32x4*)(Xw + (size_t)tok * D + 16 * lane); xp[0] = xb[0]; xp[1] = xb[1]; }
            *(u32x4*)((unsigned char*)H + (size_t)tok * D + 16 * lane) = h8;
        }
    };
    u32x4 rawC[NR], rawN[NR], rawF[NR]; u32x4 tsN = {0u, 0u, 0u, 0u}, tsF = {0u, 0u, 0u, 0u}, tsC = {0u, 0u, 0u, 0u}; u32x4 yC[4], yN[4];
    if (gw < nrows) stageA(gw, rawC, tsC);
    if (gw + NGW < nrows) stageA(gw + NGW, rawN, tsN);
    if (comb && gw < nrows) stageB(tsC, yC);
    for (int ri = gw; ri < nrows; ri += NGW) {
        if (ri + 2 * NGW < nrows) stageA(ri + 2 * NGW, rawF, tsF);
        if (comb && ri + NGW < nrows) stageB(tsN, yN);
        stageC(ri, rawC, yC);
#pragma unroll
        for (int j = 0; j < NR; ++j) { rawC[j] = rawN[j]; rawN[j] = rawF[j]; }
        tsN = tsF;
#pragma unroll
        for (int k = 0; k < 4; ++k) yC[k] = yN[k];
    }
}
__device__ __forceinline__ void norm2_router_phase(Frame& F, const Args& a, int l) {
    unsigned char* ws = F.ws;
    const bf16_t* X = (const bf16_t*)(ws + WS_X); unsigned char* H8 = (unsigned char*)(ws + WS_H);
    const float* MOD = (const float*)(ws + WS_MOD);
    unsigned* tokslot = (unsigned*)(ws + WS_TOKSLOT); int* slot_tok = (int*)(ws + WS_SLOTTOK); float* slot_w = (float*)(ws + WS_SLOTW);
    unsigned* cursor = (unsigned*)(ws + WS_CTL) + CW_CUR + l * 32;
    const bf16_t* Wr = (const bf16_t*)(ws + WS_WR) + (size_t)l * 32 * D;
    const bool last = (l == NL - 1);
    const int ngroups = last ? NB * SEQ / 32 : T / 32;
    const int tid = opaque_tid(), lane = tid & 63, wave = F.wave, r32 = lane & 31, hi = lane >> 5;
    constexpr int FT_RS = 2064;
    LAS unsigned char* FT = F.lds;
    LAS float* LP = (LAS float*)(F.lds + 32 * FT_RS);
    LAS float* LG = LP + 8 * 32 * 33;
    LAS int* lcnt = (LAS int*)(LG + 32 * 33);
    LAS int* lbase = lcnt + 32;
    bf16x8 wf[8];
#pragma unroll
    for (int s = 0; s < 8; ++s) wf[s] = *(const bf16x8*)(Wr + (size_t)r32 * D + (8 * wave + s) * 16 + hi * 8);
    const float* gvec = a.in[16] + (size_t)l * D;
    f32x4 gv[4];
#pragma unroll
    for (int j = 0; j < 4; ++j) gv[j] = *(const f32x4*)(gvec + 16 * lane + 4 * j);
    if (tid < 32) lcnt[tid] = 0;
    __syncthreads();
    auto ginfo = [&](int g, int& tok0, int& modrow) {
        int b; bool isctx;
        if (last) { b = g >> 6; tok0 = b * NTK + CTX + (g & 63) * 32; isctx = false; } else { tok0 = g * 32; b = tok0 / NTK; isctx = (tok0 - b * NTK) < CTX; }
        modrow = isctx ? 16 : b;
    };
    u32x4 xq[4][2], xn[4][2]; f32x4 shv[4], scv[4], shn[4], scn[4];
    auto gload = [&](int g, u32x4 (&x)[4][2], f32x4 (&sh)[4], f32x4 (&sc)[4]) {
        int tok0, modrow; ginfo(g, tok0, modrow);
        const float* mr = MOD + ((size_t)l * 17 + modrow) * 6144;
#pragma unroll
        for (int q = 0; q < 4; ++q) { const u32x4* xp = (const u32x4*)(X + (size_t)(tok0 + wave * 4 + q) * D + 16 * lane); x[q][0] = xp[0]; x[q][1] = xp[1]; }
#pragma unroll
        for (int j = 0; j < 4; ++j) { sh[j] = *(const f32x4*)(mr + 3 * D + 16 * lane + 4 * j); sc[j] = *(const f32x4*)(mr + 4 * D + 16 * lane + 4 * j); }
    };
    if ((int)F.vcu >= ngroups) return;
    const int glast = F.vcu + ((ngroups - 1 - F.vcu) / F.G) * F.G;
    gload(F.vcu, xq, shv, scv);
    for (int g = F.vcu; g < ngroups; g += F.G) {
        int tok0, modrow_; ginfo(g, tok0, modrow_);
        gload(min(g + F.G, glast), xn, shn, scn);
#pragma unroll
        for (int q = 0; q < 4; ++q) {
            const int rl = wave * 4 + q, tok = tok0 + rl;
            f32x4 v[4]; float ss = 0.f;
#pragma unroll
            for (int j = 0; j < 4; ++j) { const unsigned w0 = (j & 1) ? xq[q][j >> 1].z : xq[q][j >> 1].x, w1 = (j & 1) ? xq[q][j >> 1].w : xq[q][j >> 1].y;
                v[j] = (f32x4){bflo(w0), bfhi(w0), bflo(w1), bfhi(w1)}; ss += (v[j][0] * v[j][0] + v[j][1] * v[j][1]) + (v[j][2] * v[j][2] + v[j][3] * v[j][3]); }
            const float rstd = 1.0f / sqrtf(wave_sum(ss) * (1.f / D) + EPS);
            u32x4 h8; u32x4 hb[2];
#pragma unroll
            for (int j = 0; j < 4; ++j) {
                const f32x4 h = v[j] * rstd * gv[j] * (scv[j] + 1.0f) + shv[j];
                const unsigned p0 = cvtpk(h[0], h[1]), p1 = cvtpk(h[2], h[3]);
                if (j & 1) { hb[j >> 1].z = p0; hb[j >> 1].w = p1; } else { hb[j >> 1].x = p0; hb[j >> 1].y = p1; }
                h8[j] = (unsigned)__builtin_amdgcn_cvt_pk_fp8_f32(h[2] * F8_SA, h[3] * F8_SA, __builtin_amdgcn_cvt_pk_fp8_f32(h[0] * F8_SA, h[1] * F8_SA, 0, false), true);
            }
            *(u32x4*)(H8 + (size_t)tok * D + 16 * lane) = h8;
            LAS u32x4* fp = (LAS u32x4*)(FT + rl * FT_RS + 32 * lane); fp[0] = hb[0]; fp[1] = hb[1];
        }
#pragma unroll
        for (int q = 0; q < 4; ++q) { xq[q][0] = xn[q][0]; xq[q][1] = xn[q][1]; }
#pragma unroll
        for (int j = 0; j < 4; ++j) { shv[j] = shn[j]; scv[j] = scn[j]; }
        __syncthreads();
        {
            f32x16 acc = {};
#pragma unroll
            for (int s = 0; s < 8; ++s) {
                const bf16x8 af = *(const LAS bf16x8*)(FT + r32 * FT_RS + ((8 * wave + s) * 16 + hi * 8) * 2);
                acc = __builtin_amdgcn_mfma_f32_32x32x16_bf16(af, wf[s], acc, 0, 0, 0);
            }
#pragma unroll
            for (int r = 0; r < 16; ++r) { const int row = (r & 3) + 8 * (r >> 2) + 4 * hi; LP[(wave * 32 + row) * 33 + r32] = acc[r]; }
        }
        __syncthreads();
        for (int i = tid; i < 1024; i += NTHR) {
            const int row = i >> 5, e = i & 31; float s = a.in[18][l * 32 + e];
#pragma unroll
            for (int w = 0; w < 8; ++w) s += LP[(w * 32 + row) * 33 + e];
            LG[row * 33 + e] = s;
        }
        __syncthreads();
        int te[4]; float tw[4]; int rk[4];
        if (tid < 32) {
            float lv[32];
#pragma unroll
            for (int e = 0; e < 32; ++e) lv[e] = LG[tid * 33 + e];
            float tv[4];
#pragma unroll
            for (int k = 0; k < 4; ++k) {
                float best = -3.0e38f; int bi = 0;
#pragma unroll
                for (int e = 0; e < 32; ++e) { const bool up = lv[e] > best; best = up ? lv[e] : best; bi = up ? e : bi; }
                tv[k] = best; te[k] = bi;
#pragma unroll
                for (int e = 0; e < 32; ++e) lv[e] = (e == bi) ? -3.0e38f : lv[e];
            }
            const float e1 = __expf(tv[1] - tv[0]), e2 = __expf(tv[2] - tv[0]), e3 = __expf(tv[3] - tv[0]);
            const float inv = 1.0f / (1.0f + e1 + e2 + e3);
            tw[0] = inv; tw[1] = e1 * inv; tw[2] = e2 * inv; tw[3] = e3 * inv;
#pragma unroll
            for (int k = 0; k < 4; ++k) rk[k] = atomicAdd((int*)&lcnt[te[k]], 1);
        }
        __syncthreads();
        if (tid < 32) { const int c = lcnt[tid]; lbase[tid] = c ? (int)atomicAdd(&cursor[tid], (unsigned)c) : 0; }
        __syncthreads();
        if (tid < 32) {
            const int tok = tok0 + tid; u32x4 ts;
#pragma unroll
            for (int k = 0; k < 4; ++k) { const int pos = lbase[te[k]] + rk[k]; slot_tok[(size_t)te[k] * T + pos] = tok; slot_w[(size_t)te[k] * T + pos] = tw[k]; ts[k] = ((unsigned)te[k] << 16) | (unsigned)pos; }
            *(u32x4*)(tokslot + (size_t)tok * 4) = ts;
            lcnt[tid] = 0;
        }
        __syncthreads();
    }
}

struct AttnPtrs { const bf16_t* P; const bf16_t* QM; const bf16_t* KVM; unsigned char* MIX; const float* sink; const float* subg; float lam_full, one_m_li; };
constexpr int KB_OFF0 = 0, KB_STRIDE = 16384, VB_OFF0 = 32768, VB_STRIDE = 12288, XCH_OFF = 81920;
#define ATT_PIN(x) asm volatile("" : "+v"(x))
#define ATT_SBAR() __builtin_amdgcn_sched_barrier(0)
#define ATT_THR 8.0f
#ifndef ATT_WSLICE
#define ATT_WSLICE 10
#endif
#ifndef ATT_PF
#define ATT_PF 2
#endif
template <int KIND> __device__ __forceinline__ void attn_unit(const AttnPtrs& A, int b, int h, int qblk, LAS unsigned char* lds, unsigned& qnext) {
    constexpr int DQK = KIND == 0 ? 96 : (KIND == 1 ? 32 : 64);
    constexpr int NF = DQK / 16, RSK = DQK * 2 + 16, RSV = 192, NMF = 8 + 2 * NF;
    const int tid = opaque_tid(), lane = tid & 63, r32 = lane & 31, hi = lane >> 5, wid = __builtin_amdgcn_readfirstlane(tid >> 6);
    const size_t tokb = (size_t)b * NTK;
    const int mp = KIND == 1 ? (wid >> 2) : 0;
    const int qrow0 = KIND == 1 ? qblk * 128 + (wid & 3) * 32 : qblk * 256 + wid * 32;
    const bool ctxunit = KIND == 1 ? (qblk < 2) : (qblk == 0);
    const size_t tokq = tokb + qrow0 + r32;
    const int kvh = h >> 2;
    bf16x8 qf[NF];
#pragma unroll
    for (int d0 = 0; d0 < NF; ++d0) {
        const bf16_t* src = KIND == 0 ? A.QM + tokq * 384 + h * 96 + d0 * 16 + hi * 8
                          : KIND == 1 ? A.P + tokq * PW + 512 + (2 * h + mp) * 32 + d0 * 16 + hi * 8
                                      : A.P + tokq * PW + 1280 + h * 64 + d0 * 16 + hi * 8;
        qf[d0] = *(const bf16x8*)src;
    }
    float mrun = 0.f; f32x2 lrun2 = {0.f, 0.f}; f32x16 o[2]; o[0] = f32x16{}; o[1] = f32x16{};
    f32x16 negm = f32x16{};
    const int T0 = KIND == 2 ? (qblk - 1) * 256 : 0;
    int ntile, ttlo = 0;
    if (ctxunit) ntile = 4;
    else if (KIND == 2) { ttlo = max(0, (T0 >> 6) - 2); const int tthi = min(31, (T0 >> 6) + 5); ntile = 4 + (tthi - ttlo + 1); }
    else ntile = 36;
#define TILE_OF(i) ((KIND == 2 && (i) >= 4) ? 4 + ttlo + ((i) - 4) : (i))
    u32x4 krA0, krA1, vrA, krB0, krB1, vrB;
    const char* kp0; const char* kp1 = nullptr; const char* vp; unsigned ks0, ks1 = 0u, vs;
    if (KIND == 0) {
        { const int row = tid / 12, ch = tid - row * 12; const size_t tok = tokb + row;
          kp0 = ch < 8 ? (const char*)(A.KVM + tok * 512 + h * 128 + ch * 8) : (const char*)(A.P + tok * PW + 384 + (ch - 8) * 8); ks0 = ch < 8 ? 64u * 512u * 2u : 64u * PW * 2u; }
        { const int q = (tid & 255) + 512, row = q / 12, ch = q - row * 12; const size_t tok = tokb + row;
          kp1 = ch < 8 ? (const char*)(A.KVM + tok * 512 + h * 128 + ch * 8) : (const char*)(A.P + tok * PW + 384 + (ch - 8) * 8); ks1 = ch < 8 ? 64u * 512u * 2u : 64u * PW * 2u; }
        { const int row = tid >> 3, ch = tid & 7; vp = (const char*)(A.KVM + (tokb + row) * 512 + h * 128 + 64 + ch * 8); vs = 64u * 512u * 2u; }
    } else if (KIND == 1) {
        { const int m2 = tid >> 8, row = (tid & 255) >> 2, ch = tid & 3; kp0 = (const char*)(A.P + (tokb + row) * PW + 768 + (2 * h + m2) * 32 + ch * 8); ks0 = 64u * PW * 2u; }
        { const int row = tid >> 3, ch = tid & 7; vp = (const char*)(A.P + (tokb + row) * PW + 1024 + h * 64 + ch * 8); vs = 64u * PW * 2u; }
    } else {
        const int row = tid >> 3, ch = tid & 7;
        kp0 = (const char*)(A.P + (tokb + row) * PW + 1792 + kvh * 64 + ch * 8); ks0 = 64u * PW * 2u;
        vp = (const char*)(A.P + (tokb + row) * PW + 1920 + kvh * 64 + ch * 8); vs = 64u * PW * 2u;
    }
    const char* gb = (const char*)A.P;
    const unsigned ko0 = (unsigned)(kp0 - gb), ko1 = (KIND == 0) ? (unsigned)(kp1 - gb) : 0u, vo = (unsigned)(vp - gb);
    const unsigned ksh0 = ks0 == 65536u ? 16u : 18u, ksh1 = ks1 == 65536u ? 16u : 18u, vsh = vs == 65536u ? 16u : 18u;
    auto gload = [&](int tt, u32x4& kr0, u32x4& kr1, u32x4& vr) {
        kr0 = *(const u32x4*)(gb + (size_t)(((unsigned)tt << ksh0) + ko0));
        if (KIND == 0) kr1 = *(const u32x4*)(gb + (size_t)(((unsigned)tt << ksh1) + ko1));
        vr = *(const u32x4*)(gb + (size_t)(((unsigned)tt << vsh) + vo));
    };
    auto lstore = [&](int i, const u32x4& kr0, const u32x4& kr1, const u32x4& vr) {
        LAS unsigned char* kb = lds + KB_OFF0 + (i & 1) * KB_STRIDE; LAS unsigned char* vb = lds + VB_OFF0 + (i & 3) * VB_STRIDE;
        if (KIND == 0) {
            { const int row = tid / 12, ch = tid - row * 12; *(LAS u32x4*)(kb + row * RSK + ch * 16) = kr0; }
            if (tid < 256) { const int q = tid + 512, row = q / 12, ch = q - row * 12; *(LAS u32x4*)(kb + row * RSK + ch * 16) = kr1; }
        } else if (KIND == 1) {
            const int m2 = tid >> 8, row = (tid & 255) >> 2, ch = tid & 3; *(LAS u32x4*)(kb + m2 * 8192 + row * RSK + ch * 16) = kr0;
        } else { const int row = tid >> 3, ch = tid & 7; *(LAS u32x4*)(kb + row * RSK + ch * 16) = kr0; }
        { const int row = tid >> 3, ch = tid & 7; *(LAS u32x4*)(vb + row * RSV + ch * 16) = vr; }
    };
    const int qpos = T0 + wid * 32 + r32;
    const int koff = (KIND == 1 ? mp * 8192 : 0) + r32 * RSK + hi * 16;
    const int voff = ((lane >> 4) & 1) * 32 + (lane & 3) * 8 + (4 * hi + ((lane & 15) >> 2)) * RSV;
    auto fetch = [&](int j, const LAS unsigned char* vb, const LAS unsigned char* kb) -> bf16x8 {
        if (j < 8) {
            const int sI = j >> 1, d0 = j & 1;
            const v4i16_t lo = __builtin_amdgcn_ds_read_tr16_b64_v4i16((LAS v4i16_t*)(vb + voff + (16 * sI) * RSV + d0 * 64));
            const v4i16_t hh = __builtin_amdgcn_ds_read_tr16_b64_v4i16((LAS v4i16_t*)(vb + voff + (16 * sI + 8) * RSV + d0 * 64));
            return (bf16x8){lo[0], lo[1], lo[2], lo[3], hh[0], hh[1], hh[2], hh[3]};
        } else {
            const int d0 = (j - 8) >> 1, half = (j - 8) & 1;
            return *(const LAS bf16x8*)(kb + koff + half * 32 * RSK + d0 * 32);
        }
    };
    gload(TILE_OF(0), krA0, krA1, vrA); gload(TILE_OF(1), krB0, krB1, vrB);
    lstore(0, krA0, krA1, vrA); lstore(1, krB0, krB1, vrB);
    gload(TILE_OF(2), krA0, krA1, vrA);
    qnext = (unsigned)__builtin_amdgcn_readfirstlane((int)qnext);
    __syncthreads();
    f32x16 pA0 = f32x16{}, pA1 = f32x16{}, pB0, pB1;
    {
        const LAS unsigned char* kb = lds + KB_OFF0;
#pragma unroll
        for (int d0 = 0; d0 < NF; ++d0) {
            const bf16x8 k0 = *(const LAS bf16x8*)(kb + koff + d0 * 32), k1 = *(const LAS bf16x8*)(kb + koff + 32 * RSK + d0 * 32);
            pA0 = __builtin_amdgcn_mfma_f32_32x32x16_bf16(k0, qf[d0], pA0, 0, 0, 0);
            pA1 = __builtin_amdgcn_mfma_f32_32x32x16_bf16(k1, qf[d0], pA1, 0, 0, 0);
        }
    }
    bf16x8 paX[4], paY[4];
#pragma unroll
    for (int sI = 0; sI < 4; ++sI) { paX[sI] = (bf16x8){0, 0, 0, 0, 0, 0, 0, 0}; paY[sI] = (bf16x8){0, 0, 0, 0, 0, 0, 0, 0}; }
    __syncthreads();
#define ATT_STEP(C0, C1, N0, N1, PP, PC, i, KR0, KR1, VR) do { \
        const int tt_ = TILE_OF(i); \
        if (KIND == 2 && !ctxunit && tt_ >= 4) { \
            const int k0_ = (tt_ - 4) * 64, tw_ = T0 + wid * 32; \
            if (k0_ + 63 - tw_ > 128 || k0_ - (tw_ + 31) < -128) {     \
                const int kbase_ = k0_ + 4 * hi - qpos; \
                _Pragma("unroll") for (int r = 0; r < 16; ++r) { const int dk = kbase_ + (r & 3) + 8 * (r >> 2); if (dk > 128 || dk < -128) C0[r] = -1.0e30f; if (dk + 32 > 128 || dk + 32 < -128) C1[r] = -1.0e30f; } \
            } \
        } \
        const LAS unsigned char* vb_ = lds + VB_OFF0 + (((i) + 3 + ((i) == 0 ? 1 : 0)) & 3) * VB_STRIDE;                  \
        const LAS unsigned char* kb_ = lds + KB_OFF0 + (((i) + 1 < ntile ? (i) + 1 : (i)) & 1) * KB_STRIDE;       \
        bf16x8 op_[ATT_PF + 1]; _Pragma("unroll") for (int j = 0; j < ATT_PF; ++j) op_[j] = fetch(j, vb_, kb_); \
        float mx_ = -3.0e38f, alpha_; f32x2 ls2_ = {0.f, 0.f}; unsigned long long gbal_ = 0ull; unsigned gflag_ = 0u;         \
        ATT_SBAR(); \
        _Pragma("unroll") for (int k = 0; k < 20; ++k) { \
            if (k == ATT_WSLICE) { if ((i) + 2 < ntile) lstore((i) + 2, KR0, KR1, VR); }     \
            if (k + ATT_PF < NMF) op_[(k + ATT_PF) % (ATT_PF + 1)] = fetch(k + ATT_PF, vb_, kb_); \
            if (k < 8) { o[k & 1] = __builtin_amdgcn_mfma_f32_32x32x16_bf16(op_[k % (ATT_PF + 1)], PP[k >> 1], o[k & 1], 0, 0, 0); } \
            else if (k < NMF) { const int j_ = k - 8; \
                if (j_ == 0) N0 = __builtin_amdgcn_mfma_f32_32x32x16_bf16(op_[k % (ATT_PF + 1)], qf[0], negm, 0, 0, 0); \
                else if (j_ == 1) N1 = __builtin_amdgcn_mfma_f32_32x32x16_bf16(op_[k % (ATT_PF + 1)], qf[0], negm, 0, 0, 0); \
                else if (j_ & 1) N1 = __builtin_amdgcn_mfma_f32_32x32x16_bf16(op_[k % (ATT_PF + 1)], qf[j_ >> 1], N1, 0, 0, 0); \
                else N0 = __builtin_amdgcn_mfma_f32_32x32x16_bf16(op_[k % (ATT_PF + 1)], qf[j_ >> 1], N0, 0, 0, 0); } \
            if (k < 4) { float a_ = fmaxf(fmaxf(C0[4 * k], C0[4 * k + 1]), C0[4 * k + 2]); const float b_ = fmaxf(fmaxf(C0[4 * k + 3], C1[4 * k]), C1[4 * k + 1]); a_ = fmaxf(fmaxf(a_, C1[4 * k + 2]), C1[4 * k + 3]); mx_ = fmaxf(fmaxf(mx_, a_), b_); ATT_PIN(mx_); }     \
            else if (k == 4) { \
                  \
                const bool far_ = ((i) == 0) ? (fabsf(mx_) > ATT_THR) : (mx_ > ATT_THR); \
                gbal_ = __builtin_amdgcn_ballot_w64(far_); \
                asm volatile("s_cmp_lg_u64 %1, 0\n\ts_cselect_b32 %0, 1, 0" : "=s"(gflag_) : "s"(gbal_) : "scc"); \
                if (gflag_ != 0u) { { auto rr_ = __builtin_amdgcn_permlane32_swap(__float_as_uint(mx_), __float_as_uint(mx_), false, false); mx_ = fmaxf(__uint_as_float(rr_[0]), __uint_as_float(rr_[1])); } \
                    const float dl_ = ((i) == 0) ? mx_ : fmaxf(mx_, 0.f); \
                    _Pragma("unroll") for (int r = 0; r < 16; ++r) { C0[r] -= dl_; C1[r] -= dl_; } \
                    mrun += dl_; alpha_ = ((i) == 0) ? 1.0f : __builtin_amdgcn_exp2f(-dl_); \
                    _Pragma("unroll") for (int r = 0; r < 16; ++r) negm[r] = -mrun; ATT_PIN(negm); ATT_PIN(alpha_); } } \
            else if (k < 13) { const int e_ = k - 5; \
                C0[2 * e_] = __builtin_amdgcn_exp2f(C0[2 * e_]); C0[2 * e_ + 1] = __builtin_amdgcn_exp2f(C0[2 * e_ + 1]); \
                C1[2 * e_] = __builtin_amdgcn_exp2f(C1[2 * e_]); C1[2 * e_ + 1] = __builtin_amdgcn_exp2f(C1[2 * e_ + 1]); \
                ls2_ += (f32x2){C0[2 * e_], C0[2 * e_ + 1]}; ls2_ += (f32x2){C1[2 * e_], C1[2 * e_ + 1]}; ATT_PIN(ls2_); } \
            else if (k < 17) { const int c_ = k - 13; u32x4 w_; \
                if (c_ < 2) { w_.x = cvtpk(C0[8 * c_ + 0], C0[8 * c_ + 1]); w_.y = cvtpk(C0[8 * c_ + 2], C0[8 * c_ + 3]); w_.z = cvtpk(C0[8 * c_ + 4], C0[8 * c_ + 5]); w_.w = cvtpk(C0[8 * c_ + 6], C0[8 * c_ + 7]); } \
                else { const int c2_ = c_ - 2; w_.x = cvtpk(C1[8 * c2_ + 0], C1[8 * c2_ + 1]); w_.y = cvtpk(C1[8 * c2_ + 2], C1[8 * c2_ + 3]); w_.z = cvtpk(C1[8 * c2_ + 4], C1[8 * c2_ + 5]); w_.w = cvtpk(C1[8 * c2_ + 6], C1[8 * c2_ + 7]); } \
                ATT_PIN(w_); PC[c_] = __builtin_bit_cast(bf16x8, w_); } \
            else if (k == 17) { unsigned g17_ = gflag_; asm volatile("" : "+s"(g17_)); if (g17_ != 0u) { lrun2 *= alpha_; _Pragma("unroll") for (int r = 0; r < 16; ++r) o[0][r] *= alpha_; ATT_PIN(o[0]); } lrun2 += ls2_; ATT_PIN(lrun2); } \
            else if (k == 18) { unsigned g18_ = gflag_; asm volatile("" : "+s"(g18_)); if (g18_ != 0u) { _Pragma("unroll") for (int r = 0; r < 16; ++r) o[1][r] *= alpha_; ATT_PIN(o[1]); } } \
            ATT_SBAR(); \
        } \
    } while (0)
#ifndef ATT_PRIO
#define ATT_PRIO 1
#endif
    if (ATT_PRIO && wid >= 4) __builtin_amdgcn_s_setprio(1);
    for (int i = 0; i < ntile; i += 2) {
        { const int j3 = min(i + 3, ntile - 1); gload(TILE_OF(j3), krB0, krB1, vrB); }
        ATT_STEP(pA0, pA1, pB0, pB1, paY, paX, i, krA0, krA1, vrA);
        __syncthreads();
        { const int j4 = min(i + 4, ntile - 1); gload(TILE_OF(j4), krA0, krA1, vrA); }
        ATT_STEP(pB0, pB1, pA0, pA1, paX, paY, i + 1, krB0, krB1, vrB);
        __syncthreads();
    }
#undef ATT_STEP
#undef TILE_OF
    if (ATT_PRIO) __builtin_amdgcn_s_setprio(0);
    {
        const LAS unsigned char* vb = lds + VB_OFF0 + ((ntile - 1) & 3) * VB_STRIDE;
#pragma unroll
        for (int j = 0; j < 8; ++j) { const bf16x8 vfr = fetch(j, vb, vb); o[j & 1] = __builtin_amdgcn_mfma_f32_32x32x16_bf16(vfr, paY[j >> 1], o[j & 1], 0, 0, 0); }
    }
    const float lrun = lrun2[0] + lrun2[1];
    float lt = lrun + __shfl_xor(lrun, 32);
    if (KIND == 2) lt += __builtin_amdgcn_exp2f(A.sink[h] * LOG2E - mrun);
    const float inv = 1.0f / lt;
    const int colbase = (KIND == 0 ? 0 : (KIND == 1 ? 256 : 512)) + h * 64;
    unsigned char* orow = A.MIX + tokq * D + colbase;
    unsigned W8[2][4];
    auto store_rows = [&]() {
#pragma unroll
        for (int d0 = 0; d0 < 2; ++d0) {
            const auto s0 = __builtin_amdgcn_permlane32_swap(W8[d0][0], W8[d0][1], false, false), s1 = __builtin_amdgcn_permlane32_swap(W8[d0][2], W8[d0][3], false, false);
            const auto t0 = __builtin_amdgcn_permlane32_swap(s0[0], s1[0], false, false), t1 = __builtin_amdgcn_permlane32_swap(s0[1], s1[1], false, false);
            u32x4 w; w.x = t0[0]; w.y = t1[0]; w.z = t0[1]; w.w = t1[1];
            *(u32x4*)(orow + 32 * d0 + 16 * hi) = w;
        }
    };
    if (KIND == 1) {
        LAS float* xch = (LAS float*)(lds + XCH_OFF) + (wid & 3) * 2048 + lane;
        if (wid >= 4) {
#pragma unroll
            for (int d0 = 0; d0 < 2; ++d0)
#pragma unroll
                for (int r = 0; r < 16; ++r) xch[(d0 * 16 + r) * 64] = o[d0][r] * inv;
        }
        __syncthreads();
        if (wid < 4) {
            float ss = 0.f;
#pragma unroll
            for (int d0 = 0; d0 < 2; ++d0)
#pragma unroll
                for (int r = 0; r < 16; ++r) { const float x = o[d0][r] * inv - A.lam_full * xch[(d0 * 16 + r) * 64]; o[d0][r] = x; ss += x * x; }
            ss += __shfl_xor(ss, 32);
            const float rs = (1.0f / sqrtf(ss * (1.f / 64.f) + EPS)) * A.one_m_li;
#pragma unroll
            for (int d0 = 0; d0 < 2; ++d0)
#pragma unroll
                for (int g4 = 0; g4 < 4; ++g4) {
                    const int dd = 32 * d0 + 8 * g4 + 4 * hi;
                    const f32x4 gg = *(const f32x4*)(A.subg + dd);
                    const float rs8 = rs * F8_SM;
                    W8[d0][g4] = (unsigned)__builtin_amdgcn_cvt_pk_fp8_f32(o[d0][4 * g4 + 2] * rs8 * gg[2], o[d0][4 * g4 + 3] * rs8 * gg[3], __builtin_amdgcn_cvt_pk_fp8_f32(o[d0][4 * g4 + 0] * rs8 * gg[0], o[d0][4 * g4 + 1] * rs8 * gg[1], 0, false), true);
                }
            store_rows();
        }
    } else {
#pragma unroll
        for (int d0 = 0; d0 < 2; ++d0)
#pragma unroll
            for (int g4 = 0; g4 < 4; ++g4) {
                const float inv8 = inv * F8_SM;
                W8[d0][g4] = (unsigned)__builtin_amdgcn_cvt_pk_fp8_f32(o[d0][4 * g4 + 2] * inv8, o[d0][4 * g4 + 3] * inv8, __builtin_amdgcn_cvt_pk_fp8_f32(o[d0][4 * g4 + 0] * inv8, o[d0][4 * g4 + 1] * inv8, 0, false), true);
            }
        store_rows();
    }
    __syncthreads();
}
__device__ __forceinline__ void attn_phase(Frame& F, const Args& a, int l) {
    unsigned char* ws = F.ws;
    AttnPtrs A;
    A.P = (const bf16_t*)(ws + WS_P); A.QM = (const bf16_t*)(ws + WS_QM); A.KVM = (const bf16_t*)(ws + WS_KVM); A.MIX = (unsigned char*)(ws + WS_MIX);
    A.sink = a.in[14] + l * 8; A.subg = a.in[13] + l * 64;
    A.lam_full = ((const float*)(ws + WS_CTL))[CW_LAM + l]; A.one_m_li = 1.0f - a.lam_init[l];
    const int n1 = NB * 4 * 8, n2 = n1 + NB * 4 * 16, n3 = n2 + NB * 8 * 8;
    const int n4 = (l == NL - 1) ? n3 : n3 + NB * 4, n5 = (l == NL - 1) ? n3 : n4 + NB * 4 * 2, n6 = (l == NL - 1) ? n3 : n5 + NB * 8;
    unsigned* ctr = (unsigned*)(ws + WS_CTL) + CW_ATTQ + l;
    volatile LAS unsigned* qslot = (volatile LAS unsigned*)(F.lds + MISC_OFF + 1024);
#ifndef ATT_DUP
#define ATT_DUP 0
#endif
    const int ndup = ATT_DUP == 1 ? n1 : (ATT_DUP == 2 ? n2 - n1 : (ATT_DUP == 3 ? n3 - n2 : 0));
    const int nconv = CONV_NCHUNK, total = n6 + nconv + ndup;
    if (opaque_tid() == 0) qslot[0] = atomicAdd(ctr, 1u);
    __syncthreads();
    int u = (int)qslot[0];
    while (u < total) {
        unsigned nxt = 0u;
        if (opaque_tid() == 0) nxt = atomicAdd((unsigned*)(ws + WS_CTL) + CW_ATTQ + l, 1u);
        if ((u & 3) == 3 && (u >> 2) < nconv) {
            nxt = (unsigned)__builtin_amdgcn_readfirstlane((int)nxt);
            const int ch = u >> 2, base = l * FAST_PER_LAYER + ch * CONV_CHUNK;
            fast_convert(F, a, opaque_tid(), base, base + CONV_CHUNK, F.wave, NWAVES);
        } else {
            int ua = u - min(nconv, u >> 2);
            if (ua >= n6) ua = (ATT_DUP == 1 ? 0 : (ATT_DUP == 2 ? n1 : n2)) + (ua - n6);
            int kind, ub, uh, uq;
            if (ua < n1) { kind = 0; ub = ua >> 5; uh = (ua >> 3) & 3; uq = 1 + (ua & 7); }
            else if (ua < n2) { const int v = ua - n1; kind = 1; ub = v >> 6; uh = (v >> 4) & 3; uq = 2 + (v & 15); }
            else if (ua < n3) { const int v = ua - n2; kind = 2; ub = v >> 6; uh = (v >> 3) & 7; uq = 1 + (v & 7); }
            else if (ua < n4) { const int v = ua - n3; kind = 0; ub = v >> 2; uh = v & 3; uq = 0; }
            else if (ua < n5) { const int v = ua - n4; kind = 1; ub = v >> 3; uh = (v >> 1) & 3; uq = v & 1; }
            else { const int v = ua - n5; kind = 2; ub = v >> 3; uh = v & 7; uq = 0; }
            if (kind == 0) attn_unit<0>(A, ub, uh, uq, F.lds, nxt);
            else if (kind == 1) attn_unit<1>(A, ub, uh, uq, F.lds, nxt);
            else attn_unit<2>(A, ub, uh, uq, F.lds, nxt);
        }
        if (opaque_tid() == 0) qslot[0] = nxt;
        __syncthreads();
        u = (int)qslot[0];
    }
}

constexpr int PH_PER_LAYER = 8, N_PHASES = 2 + NL * PH_PER_LAYER;
__global__ void __launch_bounds__(NTHR, 2) trunk_fwd(Args args) {
    extern __shared__ __attribute__((aligned(16))) unsigned char lds_raw[];
    Frame F;
    F.lds = (LAS unsigned char*)lds_raw; F.ws = args.ws;
    F.tid = threadIdx.x; F.lane = F.tid & 63; F.wave = __builtin_amdgcn_readfirstlane(F.tid >> 6);
    F.G = gridDim.x; { const int bx = blockIdx.x; F.vcu = (F.G % 8 == 0) ? (bx % 8) * (F.G / 8) + bx / 8 : bx; }
    volatile LAS unsigned* MISC = (volatile LAS unsigned*)(F.lds + MISC_OFF);
    if (F.tid < 64) MISC[F.tid] = 0u;
    __syncthreads();
    const int lo = args.ph_lo, hi = args.ph_hi;
    const bool multi = (hi - lo) > 1;
    XcdBarrier bar; bar.bar = (unsigned*)(F.ws + WS_CTL) + CW_BAR; bar.x = 0; bar.st = MISC;
    if (multi) bar = xcd_barrier_post((unsigned*)(F.ws + WS_CTL) + CW_BAR, MISC);
    unsigned char* ws = F.ws;
#ifndef DIAG_KINDS
#define DIAG_KINDS 0x3ff
#endif
#ifndef REP_PRO
#define REP_PRO 1
#define REP_WIN 1
#define REP_UP 1
#define REP_ATT 1
#define REP_GU 1
#define REP_DOWN 1
#endif
#define KON(x) (((DIAG_KINDS) >> (x)) & 1)
#define IN(k) (lo <= (k) && (k) < hi)
#define SEAM(k) do { if (IN(k) && IN((k) + 1)) xcd_barrier(bar); } while (0)
    if (KON(0) && IN(0)) { asm volatile("; PHASE_MARK 0"); for (int rep = 0; rep < REP_PRO; ++rep) prologue_phase(F, args); }
    SEAM(0);
    for (int l = 0; l < NL; ++l) {
        const int pb = 1 + l * PH_PER_LAYER;
        const bool last = (l == NL - 1);
        if (KON(1) && IN(pb + 0)) { asm volatile("; PHASE_MARK 1");
#ifndef REP_N1
#define REP_N1 1
#endif
            for (int rep = 1; rep < REP_N1; ++rep) norm1_phase<0, false>(F, args, l, true);
            if (l == 0) norm1_phase<0, true>(F, args, l); else norm1_phase<0, false>(F, args, l); }
        SEAM(pb + 0);
        const bool chain = (F.G == 256);
        const pg8::ChainMap CM{(int)blockIdx.x & 7, (int)blockIdx.x >> 3};
        if (KON(2) && IN(pb + 1)) { asm volatile("; PHASE_MARK 2");
            pg8::EpiWin E{(bf16_t*)(ws + WS_P), (float*)(ws + WS_SSQ), (const float*)(ws + WS_ROPER), (const float*)(ws + WS_ROPEW)};
            if (chain) {
                pg8::WinChainSched S{(const char*)(ws + WS_H), (const char*)(ws + WS_WIN) + (size_t)l * PW * D, D / 2, D / 2, CM};
                for (int rep = 0; rep < REP_WIN; ++rep) pg8::gemm_phase<pg8::EpiWin, pg8::WinChainSched, true, true>(F.lds, D / 2, D / 2, D / 2, S, E);
            } else {
                pg8::DenseSched S{(const char*)(ws + WS_H), (const char*)(ws + WS_WIN) + (size_t)l * PW * D, D / 2, D / 2, NPAN, PW / 256, F.G, (int)blockIdx.x, 0};
                for (int rep = 0; rep < REP_WIN; ++rep) pg8::gemm_phase<pg8::EpiWin, pg8::DenseSched, true, true>(F.lds, D / 2, D / 2, D / 2, S, E);
            }
        }
        if (!chain) SEAM(pb + 1);
        else {
            __builtin_amdgcn_fence(__ATOMIC_ACQUIRE, "agent"); asm volatile("s_waitcnt vmcnt(0)" ::: "memory"); __syncthreads();
        }
        if (KON(3) && IN(pb + 2)) { asm volatile("; PHASE_MARK 3");
            pg8::EpiUp E{(bf16_t*)(ws + WS_QM), (bf16_t*)(ws + WS_KVM), (const float*)(ws + WS_SSQ), (const float*)(ws + WS_ROPER)};
            if (chain) {
                pg8::UpChainSched S{(const char*)(ws + WS_P), (const char*)(ws + WS_WUQ) + (size_t)l * 512 * 256 * 2, (const char*)(ws + WS_WUKV) + (size_t)l * 512 * 256 * 2, CM};
                for (int rep = 0; rep < REP_UP; ++rep) pg8::gemm_phase<pg8::EpiUp, pg8::UpChainSched, true>(F.lds, 256, PW, 256, S, E);
            } else {
                pg8::UpSched S{(const char*)(ws + WS_P), (const char*)(ws + WS_WUQ) + (size_t)l * 512 * 256 * 2, (const char*)(ws + WS_WUKV) + (size_t)l * 512 * 256 * 2, F.G, (int)blockIdx.x};
                for (int rep = 0; rep < REP_UP; ++rep) pg8::gemm_phase<pg8::EpiUp, pg8::UpSched, true>(F.lds, 256, PW, 256, S, E);
            }
        }
        SEAM(pb + 2);
        if (KON(4) && IN(pb + 3)) { asm volatile("; PHASE_MARK 4"); for (int rep = 0; rep < REP_ATT; ++rep) attn_phase(F, args, l); }
        SEAM(pb + 3);
        if (KON(5) && IN(pb + 4)) { asm volatile("; PHASE_MARK 5");
            pg8::DenseSched S{(const char*)(ws + WS_MIX), (const char*)(ws + WS_WOUT) + (size_t)l * D * D, D / 2, D / 2, last ? NB * 8 : NPAN, D / 256, F.G, (int)blockIdx.x, last ? 1 : 0};
            pg8::EpiWout E{(bf16_t*)(ws + WS_X), (const float*)(ws + WS_MOD) + (size_t)l * 17 * 6144};
            pg8::gemm_phase<pg8::EpiWout, pg8::DenseSched, true, true>(F.lds, D / 2, D / 2, D / 2, S, E);
        }
        SEAM(pb + 4);
        if (KON(6) && IN(pb + 5)) { asm volatile("; PHASE_MARK 6"); norm2_router_phase(F, args, l); }
        SEAM(pb + 5);
        if (KON(7) && IN(pb + 6)) { asm volatile("; PHASE_MARK 7");
            load_counts(F, l);
            pg8::MoeSched<true> S{(const char*)(ws + WS_H), (const char*)(ws + WS_WGU) + (size_t)l * NE * 2048 * D, (const int*)(ws + WS_SLOTTOK),
                                  (volatile LAS int*)(F.lds + MISC_OFF + 256), (volatile LAS int*)(F.lds + MISC_OFF + 512), 8, F.G, (int)blockIdx.x, (size_t)2048 * D, opaque_tid() & 31};
            pg8::EpiGateUp E{(unsigned char*)(ws + WS_ACT), args.in[20] + (size_t)l * NE * D, args.in[22] + (size_t)l * NE * D};
            for (int rep = 0; rep < REP_GU; ++rep) pg8::gemm_phase<pg8::EpiGateUp, pg8::MoeSched<true>, true, true>(F.lds, D / 2, D / 2, D / 2, S, E);
        }
        SEAM(pb + 6);
        if (KON(8) && IN(pb + 7)) { asm volatile("; PHASE_MARK 8");
            load_counts(F, l);
            pg8::MoeSched<false> S{(const char*)(ws + WS_ACT), (const char*)(ws + WS_WD) + (size_t)l * NE * D * D, (const int*)(ws + WS_SLOTTOK),
                                   (volatile LAS int*)(F.lds + MISC_OFF + 256), (volatile LAS int*)(F.lds + MISC_OFF + 512), 4, F.G, (int)blockIdx.x, (size_t)D * D, opaque_tid() & 31};
            pg8::EpiDown E{(bf16_t*)(ws + WS_Y), args.in[24] + (size_t)l * NE * D, (const float*)(ws + WS_SLOTW)};
            for (int rep = 0; rep < REP_DOWN; ++rep) pg8::gemm_phase<pg8::EpiDown, pg8::MoeSched<false>, true, true>(F.lds, D / 2, D / 2, D / 2, S, E);
        }
        SEAM(pb + 7);
    }
    if (KON(9) && IN(N_PHASES - 1)) { asm volatile("; PHASE_MARK 9"); norm1_phase<1, false>(F, args, NL); }
#undef IN
#undef SEAM
}

extern "C" void kernel_launch(void* const* d_in, const int* in_sizes, int n_in, void* d_out, int out_size, void* d_ws, size_t ws_size, hipStream_t stream) {
    static int grid = 0;
    if (grid == 0) {
        if (n_in != 26 || ws_size < WS_END) { fprintf(stderr, "kernel_launch: unexpected inputs (n_in %d, ws %zu)\n", n_in, ws_size); grid = -1; return; }
        int dev = 0, cus = 0, per_cu = 0;
        if (hipGetDevice(&dev) != hipSuccess || hipDeviceGetAttribute(&cus, hipDeviceAttributeMultiprocessorCount, dev) != hipSuccess) { grid = -1; return; }
        if (hipFuncSetAttribute((const void*)trunk_fwd, hipFuncAttributeMaxDynamicSharedMemorySize, LDS_BYTES) != hipSuccess) { fprintf(stderr, "kernel_launch: hipFuncSetAttribute failed\n"); grid = -1; return; }
        if (hipOccupancyMaxActiveBlocksPerMultiprocessor(&per_cu, (const void*)trunk_fwd, NTHR, LDS_BYTES) != hipSuccess || per_cu < 1)
            fprintf(stderr, "kernel_launch: occupancy query reports %d workgroups per CU\n", per_cu);
        (void)hipGetLastError();
        grid = cus;
    }
    if (grid < 0) return;
    if (hipMemsetAsync((char*)d_ws + WS_CTL, 0, CTL_ZERO_BYTES, stream) != hipSuccess) return;
    Args a{};
    for (int i = 0; i < 26; ++i) a.in[i] = (const float*)d_in[i];
    a.out = (float*)d_out; a.ws = (unsigned char*)d_ws;
    for (int i = 0; i < 8; ++i) a.invf8[i] = pow(10000.0, -(double)i / 8.0);
    for (int i = 0; i < 16; ++i) a.invf16[i] = pow(10000.0, -(double)i / 16.0);
    for (int i = 0; i < 4; ++i) a.lam_init[i] = (float)(0.8 - 0.6 * exp(-0.3 * (double)i));
#if MK_ONE_LAUNCH
    a.ph_lo = 0; a.ph_hi = N_PHASES;
    hipLaunchKernelGGL(trunk_fwd, dim3(grid), dim3(NTHR), LDS_BYTES, stream, a);
#else
    for (int p = 0; p < N_PHASES; ++p) { a.ph_lo = p; a.ph_hi = p + 1; hipLaunchKernelGGL(trunk_fwd, dim3(grid), dim3(NTHR), LDS_BYTES, stream, a); }
#endif
}
```
